# Optimizing an MI355X kernel written in HIP

```python
import numpy as np
import jax
import jax.numpy as jnp
from jax import lax

D_MODEL = 1024
BATCH = 4
SEQ = 8192
DEPTH = 4

POOL_WINDOWS = (2, 4, 8, 16)
N_POOL_GROUPS = 4
POOL_WIDTH = D_MODEL // 2
POOL_GROUP = POOL_WIDTH // N_POOL_GROUPS
HEAD_DIM = 64
N_HEADS = D_MODEL // HEAD_DIM
N_KV = 2
HEADS_PER_KV = N_HEADS // N_KV
ROPE_DIM = HEAD_DIM // 4
ROPE_THETA = 500000.0
CMP_LEN = 32
CMP_STRIDE = 16
CMP_HIDDEN = 4 * HEAD_DIM
SEL_LEN = 64
SEL_TOP = 16
WINDOW = 512
Q_BLOCK = 128
FORCED_SCORE = 1e9
Q_WIDTH = N_HEADS * HEAD_DIM
KV_WIDTH = N_KV * HEAD_DIM
IN_WIDTH = POOL_WIDTH + Q_WIDTH + 6 * KV_WIDTH + 3 * N_HEADS + 2 * D_MODEL
N_EXPERTS = 32
TOP_K = 4
D_EXPERT = D_MODEL
SWIGLU_LIMIT = 7.0
SWIGLU_ALPHA = 1.702
MOE_BLOCK = 256
EPS = 1e-6
NEG = -1e30

kernel_name = 'hybrid_pool_nsa_moe_trunk'


def rms_norm(x, gain):
    xf = x.astype(jnp.float32)
    y = xf * lax.rsqrt(jnp.mean(xf * xf, axis=-1, keepdims=True) + EPS)
    return (y * gain.astype(jnp.float32)).astype(x.dtype)


def partial_rope(x, pos):
    half = ROPE_DIM // 2
    inv_freq = ROPE_THETA ** (-jnp.arange(half, dtype=jnp.float32) / half)
    ang = pos.astype(jnp.float32)[:, None] * inv_freq[None, :]
    shape = (pos.shape[0],) + (1,) * (x.ndim - 3) + (half,)
    cos = jnp.cos(ang).reshape(shape)
    sin = jnp.sin(ang).reshape(shape)
    xr = x[..., :ROPE_DIM].astype(jnp.float32)
    x1, x2 = xr[..., :half], xr[..., half:]
    rot = jnp.concatenate([x1 * cos - x2 * sin, x2 * cos + x1 * sin], axis=-1)
    return jnp.concatenate([rot.astype(x.dtype), x[..., ROPE_DIM:]], axis=-1)


def pool_mixer(u, w_pool, pool_scale):
    b, s, _ = u.shape
    uf = u.astype(jnp.float32).reshape(b, s, N_POOL_GROUPS, POOL_GROUP)
    cs = jnp.pad(jnp.cumsum(uf, axis=1), ((0, 0), (1, 0), (0, 0), (0, 0)))
    t = jnp.arange(s)[:, None]
    win = jnp.asarray(POOL_WINDOWS, jnp.int32)[None, :]
    lo = jnp.maximum(t + 1 - win, 0)
    total = cs[:, 1:] - cs[:, lo, jnp.arange(N_POOL_GROUPS)]
    mean = total / (t + 1 - lo).astype(jnp.float32)[None, :, :, None]
    y = jnp.einsum('bsgc,gce->bsge', mean - uf, w_pool.astype(jnp.float32))
    y = y.reshape(b, s, POOL_WIDTH) * pool_scale.astype(jnp.float32)
    return y.astype(u.dtype)


def masked_softmax(scores, mask):
    return jax.nn.softmax(jnp.where(mask, scores, NEG), axis=-1)


def nsa_mixer(q, k_cmp, v_cmp, k_slc, v_slc, k_win, v_win, gate_logits,
              q_norm, k_norm, cmp_pos, cmp_w1, cmp_b1, cmp_w2):
    b, s = q.shape[0], q.shape[1]
    pos = jnp.arange(s, dtype=jnp.int32)
    q = partial_rope(rms_norm(q, q_norm), pos)
    k_slc = partial_rope(rms_norm(k_slc, k_norm[1]), pos)
    k_win = partial_rope(rms_norm(k_win, k_norm[2]), pos)

    n_cmp = (s - CMP_LEN) // CMP_STRIDE + 1
    cmp_idx = np.arange(n_cmp)[:, None] * CMP_STRIDE + np.arange(CMP_LEN)[None, :]
    cmp_end = jnp.asarray(cmp_idx[:, -1], jnp.int32)

    def compress(t, i):
        blocks = t[:, cmp_idx] + cmp_pos[i][:, None, :]
        flat = jnp.swapaxes(blocks, 2, 3).reshape(b, n_cmp, N_KV, CMP_LEN * HEAD_DIM)
        hid = jax.nn.silu(flat @ cmp_w1[i] + cmp_b1[i])
        return hid @ cmp_w2[i]

    kc = partial_rope(rms_norm(compress(k_cmp, 0), k_norm[0]), cmp_end)
    vc = compress(v_cmp, 1)

    n_sel = s // SEL_LEN
    n_top = min(SEL_TOP, n_sel)
    sel_start = np.arange(n_sel) * SEL_LEN
    overlap = jnp.asarray(((cmp_idx[:, :1] < sel_start[None, :] + SEL_LEN)
                           & (cmp_idx[:, -1:] >= sel_start[None, :])).astype(np.float32))
    ks_blk = k_slc.reshape(b, n_sel, SEL_LEN, N_KV, HEAD_DIM).transpose(0, 3, 1, 2, 4)
    vs_blk = v_slc.reshape(b, n_sel, SEL_LEN, N_KV, HEAD_DIM).transpose(0, 3, 1, 2, 4)

    kw_pad = jnp.pad(k_win, ((0, 0), (WINDOW, 0), (0, 0), (0, 0)))
    vw_pad = jnp.pad(v_win, ((0, 0), (WINDOW, 0), (0, 0), (0, 0)))
    span = WINDOW + Q_BLOCK

    n_q = s // Q_BLOCK
    q_blk = jnp.moveaxis(q.reshape(b, n_q, Q_BLOCK, N_KV, HEADS_PER_KV, HEAD_DIM), 1, 0)
    g_blk = jnp.moveaxis(gate_logits.reshape(b, n_q, Q_BLOCK, 3, N_KV, HEADS_PER_KV), 1, 0)
    b_ix = jnp.arange(b)[:, None, None, None]
    g_ix = jnp.arange(N_KV)[None, :, None, None]
    sel_ids = jnp.arange(n_sel)
    scale = HEAD_DIM ** -0.5

    def block(args):
        qi, gi, blk = args
        q0 = blk * Q_BLOCK
        t = q0 + jnp.arange(Q_BLOCK)
        s_c = jnp.einsum('bqghd,bngd->bgqhn', qi, kc).astype(jnp.float32) * scale
        m_c = (cmp_end[None, :] <= t[:, None])[None, None, :, None, :]
        p_c = jnp.where(m_c, masked_softmax(s_c, m_c), 0.0)
        o_c = jnp.einsum('bgqhn,bngd->bqghd', p_c.astype(vc.dtype), vc)
        imp = jnp.einsum('bgqhn,ns->bgqs', p_c, overlap)
        cur = t // SEL_LEN
        forced = (sel_ids[None, :] == cur[:, None]) | (sel_ids[None, :] == 0)
        causal_blk = sel_ids[None, :] <= cur[:, None]
        imp = jnp.where(forced, FORCED_SCORE, jnp.where(causal_blk, imp, -1.0))
        _, sel = lax.top_k(imp, n_top)
        ks_g = ks_blk[b_ix, g_ix, sel].reshape(b, N_KV, Q_BLOCK, n_top * SEL_LEN, HEAD_DIM)
        vs_g = vs_blk[b_ix, g_ix, sel].reshape(b, N_KV, Q_BLOCK, n_top * SEL_LEN, HEAD_DIM)
        kp = (sel[..., None] * SEL_LEN + jnp.arange(SEL_LEN)).reshape(b, N_KV, Q_BLOCK, n_top * SEL_LEN)
        s_s = jnp.einsum('bqghd,bgqnd->bgqhn', qi, ks_g).astype(jnp.float32) * scale
        m_s = (kp <= t[None, None, :, None])[:, :, :, None, :]
        p_s = masked_softmax(s_s, m_s)
        o_s = jnp.einsum('bgqhn,bgqnd->bqghd', p_s.astype(vs_g.dtype), vs_g)
        kw = lax.dynamic_slice_in_dim(kw_pad, q0, span, axis=1)
        vw = lax.dynamic_slice_in_dim(vw_pad, q0, span, axis=1)
        kpos = q0 - WINDOW + jnp.arange(span)
        diff = t[:, None] - kpos[None, :]
        m_w = ((diff >= 0) & (diff < WINDOW) & (kpos[None, :] >= 0))[None, None, :, None, :]
        s_w = jnp.einsum('bqghd,bngd->bgqhn', qi, kw).astype(jnp.float32) * scale
        p_w = masked_softmax(s_w, m_w)
        o_w = jnp.einsum('bgqhn,bngd->bqghd', p_w.astype(vw.dtype), vw)
        g = jax.nn.sigmoid(gi.astype(jnp.float32))[..., None]
        out = (g[:, :, 0] * o_c.astype(jnp.float32) + g[:, :, 1] * o_s.astype(jnp.float32)
               + g[:, :, 2] * o_w.astype(jnp.float32))
        return out.astype(qi.dtype)

    out = lax.map(block, (q_blk, g_blk, jnp.arange(n_q, dtype=jnp.int32)))
    return jnp.moveaxis(out, 0, 1).reshape(b, s, N_HEADS * HEAD_DIM)


def moe_ffn(h, router_w, router_b, w_gate_up, b_gate_up, w_down, b_down):
    n, d = h.shape
    logits = (h @ router_w + router_b).astype(jnp.float32)
    top_v, top_e = lax.top_k(logits, TOP_K)
    gate = jax.nn.softmax(top_v, axis=-1)
    nk = n * TOP_K
    flat_e = top_e.reshape(-1)
    flat_tok = jnp.repeat(jnp.arange(n, dtype=jnp.int32), TOP_K)
    flat_g = gate.reshape(-1)
    order = jnp.argsort(flat_e)
    sorted_e = flat_e[order]
    counts = jnp.bincount(flat_e, length=N_EXPERTS)
    starts = jnp.cumsum(counts) - counts
    padded = (counts + MOE_BLOCK - 1) // MOE_BLOCK * MOE_BLOCK
    pad_end = jnp.cumsum(padded)
    pad_start = pad_end - padded
    dest = pad_start[sorted_e] + jnp.arange(nk) - starts[sorted_e]
    n_blocks = -(-nk // MOE_BLOCK) + N_EXPERTS
    n_rows = n_blocks * MOE_BLOCK
    row_tok = jnp.zeros((n_rows,), jnp.int32).at[dest].set(flat_tok[order])
    row_w = jnp.zeros((n_rows,), jnp.float32).at[dest].set(flat_g[order])
    blk_e = jnp.minimum(jnp.searchsorted(pad_end, jnp.arange(n_blocks) * MOE_BLOCK, side='right'),
                        N_EXPERTS - 1)

    def expert_block(args):
        toks, e = args
        xb = h[toks]
        gu = xb @ w_gate_up[e] + b_gate_up[e]
        g_lin, u_lin = gu[:, 0::2], gu[:, 1::2]
        g_lin = jnp.minimum(g_lin, SWIGLU_LIMIT)
        u_lin = jnp.clip(u_lin, -SWIGLU_LIMIT, SWIGLU_LIMIT)
        act = (u_lin + 1) * g_lin * jax.nn.sigmoid(g_lin * SWIGLU_ALPHA)
        return act @ w_down[e] + b_down[e]

    y = lax.map(expert_block, (row_tok.reshape(n_blocks, MOE_BLOCK), blk_e))
    y = y.reshape(n_rows, d).astype(jnp.float32) * row_w[:, None]
    return jax.ops.segment_sum(y, row_tok, num_segments=n).astype(h.dtype)


def hybrid_layer(x, c, norm1, norm2, ada_w, ada_b, w_in, w_pool, pool_scale, q_norm, k_norm,
                 cmp_pos, cmp_w1, cmp_b1, cmp_w2, w_proj_a, w_proj_b, w_out,
                 router_w, router_b, w_gate_up, b_gate_up, w_down, b_down):
    b, s, d = x.shape
    mod = jax.nn.silu(c) @ ada_w + ada_b
    shift1, scale1, gate1, shift2, scale2, gate2 = [m[:, None, :] for m in jnp.split(mod, 6, axis=-1)]

    h = rms_norm(x, norm1) * (1 + scale1) + shift1
    z = h @ w_in
    offsets = np.cumsum([POOL_WIDTH, Q_WIDTH] + [KV_WIDTH] * 6 + [3 * N_HEADS])
    u_pool, q, kcm, vcm, ksl, vsl, kwn, vwn, nsa_g, merge_g = jnp.split(
        z, [int(o) for o in offsets], axis=-1)

    def kv(t):
        return t.reshape(b, s, N_KV, HEAD_DIM)

    y_a = pool_mixer(u_pool, w_pool, pool_scale) @ w_proj_a
    y_b = nsa_mixer(q.reshape(b, s, N_KV, HEADS_PER_KV, HEAD_DIM), kv(kcm), kv(vcm), kv(ksl), kv(vsl),
                    kv(kwn), kv(vwn), nsa_g.reshape(b, s, 3, N_KV, HEADS_PER_KV),
                    q_norm, k_norm, cmp_pos, cmp_w1, cmp_b1, cmp_w2) @ w_proj_b
    g_a, g_b = jnp.split(jax.nn.sigmoid(merge_g), 2, axis=-1)
    x = x + gate1 * ((g_a * y_a + g_b * y_b) @ w_out)

    h2 = rms_norm(x, norm2) * (1 + scale2) + shift2
    y_ffn = moe_ffn(h2.reshape(b * s, d), router_w, router_b, w_gate_up, b_gate_up, w_down, b_down)
    return x + gate2 * y_ffn.reshape(b, s, d)


def setup_inputs(seed: int = 0) -> dict:
    key = jax.random.key(seed)
    keys = list(jax.random.split(key, 32))

    def nrm(shape, scale):
        return jax.random.normal(keys.pop(), shape, jnp.float32) * scale

    D, E, F = D_MODEL, N_EXPERTS, D_EXPERT
    return {
        'x': nrm((BATCH, SEQ, D), 1.0),
        'c': nrm((BATCH, D), 1.0),
        'norm1': 1.0 + nrm((DEPTH, D), 0.02),
        'norm2': 1.0 + nrm((DEPTH, D), 0.02),
        'ada_w': nrm((DEPTH, D, 6 * D), 0.5 * D ** -0.5),
        'ada_b': nrm((DEPTH, 6 * D), 0.01),
        'w_in': nrm((DEPTH, D, IN_WIDTH), D ** -0.5),
        'w_pool': nrm((DEPTH, N_POOL_GROUPS, POOL_GROUP, POOL_GROUP), POOL_GROUP ** -0.5),
        'pool_scale': 1.0 + nrm((DEPTH, POOL_WIDTH), 0.02),
        'q_norm': 1.0 + nrm((DEPTH, HEAD_DIM), 0.02),
        'k_norm': 1.0 + nrm((DEPTH, 3, HEAD_DIM), 0.02),
        'cmp_pos': nrm((DEPTH, 2, CMP_LEN, HEAD_DIM), 0.02),
        'cmp_w1': nrm((DEPTH, 2, CMP_LEN * HEAD_DIM, CMP_HIDDEN), (CMP_LEN * HEAD_DIM) ** -0.5),
        'cmp_b1': nrm((DEPTH, 2, CMP_HIDDEN), 0.01),
        'cmp_w2': nrm((DEPTH, 2, CMP_HIDDEN, HEAD_DIM), CMP_HIDDEN ** -0.5),
        'w_proj_a': nrm((DEPTH, POOL_WIDTH, D), POOL_WIDTH ** -0.5),
        'w_proj_b': nrm((DEPTH, Q_WIDTH, D), Q_WIDTH ** -0.5),
        'w_out': nrm((DEPTH, D, D), D ** -0.5),
        'router_w': nrm((DEPTH, D, E), D ** -0.5),
        'router_b': nrm((DEPTH, E), 0.01),
        'w_gate_up': nrm((DEPTH, E, D, 2 * F), D ** -0.5),
        'b_gate_up': nrm((DEPTH, E, 2 * F), 0.01),
        'w_down': nrm((DEPTH, E, F, D), F ** -0.5),
        'b_down': nrm((DEPTH, E, D), 0.01),
    }


def reference(x, c, norm1, norm2, ada_w, ada_b, w_in, w_pool, pool_scale, q_norm, k_norm,
              cmp_pos, cmp_w1, cmp_b1, cmp_w2, w_proj_a, w_proj_b, w_out,
              router_w, router_b, w_gate_up, b_gate_up, w_down, b_down):
    for l in range(DEPTH):
        x = hybrid_layer(x, c, norm1[l], norm2[l], ada_w[l], ada_b[l], w_in[l], w_pool[l],
                         pool_scale[l], q_norm[l], k_norm[l], cmp_pos[l], cmp_w1[l], cmp_b1[l],
                         cmp_w2[l], w_proj_a[l], w_proj_b[l], w_out[l], router_w[l], router_b[l],
                         w_gate_up[l], b_gate_up[l], w_down[l], b_down[l])
    return x
```

```cpp
#include <hip/hip_runtime.h>
#include <cstdio>
#include <cstdint>

namespace pg8 {
#define PG8_LAS __attribute__((address_space(3)))
typedef unsigned short bf16_t;
typedef short bf16x8 __attribute__((ext_vector_type(8)));
typedef float f32x4 __attribute__((ext_vector_type(4)));
typedef unsigned u32x4 __attribute__((ext_vector_type(4)));
constexpr int BM = 256, BK = 64, HALF = 128, HTB = HALF * BK * 2  , STAGE_BYTES = 8 * HTB, NXCD = 8, WGM = 8;

__host__ __device__ __forceinline__ int lds_byte(int r, int c) { const int st = (r >> 4) * 2 + (c >> 5), rr = r & 15, cc = c & 31, ob = rr * 64 + cc * 2; return st * 1024 + (ob ^ (((ob >> 9) & 1) << 5)); }
__host__ __device__ __forceinline__ void stage_rc(int b, int& R, int& C) { const int st = b / 1024, sb = b % 1024, swz = sb ^ (((sb >> 9) & 1) << 5); R = (st >> 1) * 16 + swz / 64; C = (st & 1) * 32 + (swz % 64) / 2; }
__host__ __device__ __forceinline__ int perm32(int rho) { const int n = rho >> 4, i = rho & 15; return 8 * (i >> 2) + 4 * n + (i & 3); }

struct Unit { int pm, pn; };
struct Gemm { const bf16_t* A; const bf16_t* Bt; int M, N, K; const int* tile_e; size_t be_stride; };

struct StaticOrder {
    int nM, nN, nwg, G, c;
    __host__ __device__ void init(int M, int N, int G_, int c_) { nM = M / BM; nN = N / BM; nwg = nM * nN; G = G_; c = c_; }
    __host__ __device__ bool next(int i, Unit& u) const {
        const long L = (long)i * G + c; if (L >= nwg) return false;
        int wgid = (int)L; { const int q = nwg / NXCD, r = nwg % NXCD, xcd = wgid % NXCD, off = wgid / NXCD; wgid = (xcd < r ? xcd * (q + 1) : r * (q + 1) + (xcd - r) * q) + off; }
        const int nig = WGM * nN, gid = wgid / nig, fm = gid * WGM, gsz = (nM - fm) < WGM ? (nM - fm) : WGM;
        u.pm = fm + ((wgid % nig) % gsz); u.pn = (wgid % nig) / gsz; return true;
    }
    __device__ __forceinline__ void a_ready(const Unit&) const {}
    __device__ __forceinline__ void done(const Unit&) const {}
};

__device__ __forceinline__ unsigned cvt_pk_bf16(float lo, float hi) { unsigned r; asm volatile("v_cvt_pk_bf16_f32 %0, %1, %2" : "=v"(r) : "v"(lo), "v"(hi)); return r; }
typedef float f32x2 __attribute__((ext_vector_type(2)));


template <class Epi, class Sched, bool ALIGN_EPI = false, bool SP2 = false>
__device__ __forceinline__ void gemm_phase(PG8_LAS unsigned char* lds, const Gemm g, const Sched& S, const Epi& E, const int tid_in  ) {
    int tid_ = tid_in; asm volatile("" : "+v"(tid_));
    float zz = 0.f; asm volatile("" : "+v"(zz));
    const int tid = tid_, wid = __builtin_amdgcn_readfirstlane(tid >> 6), lane = tid & 63, wr = wid >> 2, wc = wid & 3, fr = lane & 15, fq = lane >> 4;
    const int K = g.K, nt = K / BK;
    unsigned voffA[2], voffB[2];
#pragma unroll
    for (int i = 0; i < 2; ++i) { int R, C; stage_rc(tid * 16 + i * 8192, R, C); const int Rb = Epi::PERM ? ((R & ~31) + perm32(R & 31)) : R;
        voffA[i] = (unsigned)(R * K + C) * 2u; voffB[i] = (unsigned)(Rb * K + C) * 2u; }
    const size_t kstep = (size_t)(BK * 2);
    const size_t hstep = (size_t)HALF * K * 2;
    const size_t tstep = 2 * hstep;
    const unsigned ldsw = (unsigned)wid * 1024u;
    const int aoff = lds_byte(wr * 64 + fr, fq * 8), boff = lds_byte(wc * 32 + fr, fq * 8);
#define PG8_SA(b, h) (((b) * 2 + (h)) * HTB)
#define PG8_SB(b, h) ((4 + (b) * 2 + (h)) * HTB)
#define PG8_STAGE(bufoff, gbase, voff) do { _Pragma("unroll") for (int _i = 0; _i < 2; ++_i) \
        __builtin_amdgcn_global_load_lds((const unsigned*)((const char*)(gbase) + (voff)[_i]), (PG8_LAS unsigned*)(lds + (bufoff) + ldsw + _i * 8192), 16, 0, 0); } while (0)
#define PG8_LDA(dst, b, h) do { _Pragma("unroll") for (int m = 0; m < 4; ++m) _Pragma("unroll") for (int k = 0; k < 2; ++k) dst[m][k] = *(const PG8_LAS bf16x8*)(lds + PG8_SA(b, h) + aoff + m * 2048 + k * 1024); } while (0)
#define PG8_LDB(dst, b, h) do { _Pragma("unroll") for (int n = 0; n < 2; ++n) _Pragma("unroll") for (int k = 0; k < 2; ++k) dst[n][k] = *(const PG8_LAS bf16x8*)(lds + PG8_SB(b, h) + boff + n * 2048 + k * 1024); } while (0)
#define PG8_MMA(ai, bj, At, Bt) do { __builtin_amdgcn_s_setprio(1); _Pragma("unroll") for (int m = 0; m < 4; ++m) _Pragma("unroll") for (int n = 0; n < 2; ++n) _Pragma("unroll") for (int k = 0; k < 2; ++k) \
        acc[ai][bj][m][n] = __builtin_amdgcn_mfma_f32_16x16x32_bf16(Bt[n][k], At[m][k], acc[ai][bj][m][n], 0, 0, 0); __builtin_amdgcn_s_setprio(0); } while (0)
#define PG8_WAIT_V(n) asm volatile("s_waitcnt vmcnt(" #n ")" ::: "memory")
#define PG8_WAIT_L(n) asm volatile("s_waitcnt lgkmcnt(" #n ")" ::: "memory")
#define PG8_BAR __builtin_amdgcn_s_barrier()
#define PG8_SCHED __builtin_amdgcn_sched_barrier(0)
    Unit cur, nxt; int ui = 0;
    if (!S.next(0, cur)) return;
    f32x4 acc[2][2][4][2];
#pragma unroll
    for (int a = 0; a < 2; ++a)
#pragma unroll
        for (int b = 0; b < 2; ++b)
#pragma unroll
            for (int m = 0; m < 4; ++m)
#pragma unroll
                for (int n = 0; n < 2; ++n) acc[a][b][m][n] = (f32x4){zz, zz, zz, zz};
    bf16x8 At[4][2], B0[2][2], B1[2][2];
    const char* cA = (const char*)g.A + (size_t)cur.pm * tstep; const char* cB = (const char*)g.Bt + (g.tile_e ? (size_t)g.tile_e[cur.pm] * g.be_stride : (size_t)0) + (size_t)cur.pn * tstep;
    S.a_ready(cur);
    if constexpr (SP2) {
        PG8_STAGE(PG8_SB(0, 0), cB, voffB); PG8_STAGE(PG8_SB(0, 1), cB + hstep, voffB); PG8_STAGE(PG8_SA(0, 0), cA, voffA); PG8_STAGE(PG8_SA(0, 1), cA + hstep, voffA);
        if (wr == 1) PG8_BAR;
        PG8_WAIT_V(2); PG8_BAR;
        PG8_STAGE(PG8_SB(1, 0), cB + kstep, voffB); PG8_STAGE(PG8_SA(1, 0), cA + kstep, voffA); PG8_STAGE(PG8_SB(1, 1), cB + hstep + kstep, voffB);
        PG8_WAIT_V(6); PG8_BAR;
    } else {
        PG8_STAGE(PG8_SB(0, 0), cB, voffB); PG8_STAGE(PG8_SA(0, 0), cA, voffA); PG8_STAGE(PG8_SB(0, 1), cB + hstep, voffB); PG8_STAGE(PG8_SA(0, 1), cA + hstep, voffA);
        if (wr == 1) PG8_BAR;
        PG8_WAIT_V(4); PG8_BAR;
        PG8_STAGE(PG8_SB(1, 0), cB + kstep, voffB); PG8_STAGE(PG8_SA(1, 0), cA + kstep, voffA); PG8_STAGE(PG8_SB(1, 1), cB + hstep + kstep, voffB);
        PG8_WAIT_V(6); PG8_BAR;
    }
    for (;;) {
        const bool has_next = S.next(ui + 1, nxt);
        const char* nA = has_next ? (const char*)g.A + (size_t)nxt.pm * tstep : cA; const char* nB = has_next ? (const char*)g.Bt + (g.tile_e ? (size_t)g.tile_e[nxt.pm] * g.be_stride : (size_t)0) + (size_t)nxt.pn * tstep : cB;
        for (int t = 0; t < nt; t += 2) {
            const bool last = (t == nt - 2);
            const char* a1 = cA + (size_t)(t + 1) * kstep;
            const char* a2 = last ? nA : cA + (size_t)(t + 2) * kstep; const char* b2 = last ? nB : cB + (size_t)(t + 2) * kstep;
            const char* a3 = a2 + kstep; const char* b3 = b2 + kstep;
            if (last && has_next) S.a_ready(nxt);
            if constexpr (SP2) {
            PG8_LDB(B0, 0, 0); PG8_LDB(B1, 0, 1); PG8_SCHED; PG8_LDA(At, 0, 0); PG8_STAGE(PG8_SA(1, 1), a1 + hstep, voffA);
            PG8_WAIT_V(8); PG8_WAIT_L(0); PG8_BAR; PG8_MMA(0, 0, At, B0); PG8_MMA(0, 1, At, B1); PG8_BAR; PG8_SCHED;
            PG8_LDA(At, 0, 1); PG8_STAGE(PG8_SB(0, 0), b2, voffB); PG8_STAGE(PG8_SB(0, 1), b2 + hstep, voffB); PG8_STAGE(PG8_SA(0, 0), a2, voffA);
            PG8_WAIT_V(8); PG8_WAIT_L(0); PG8_BAR; PG8_MMA(1, 0, At, B0); PG8_MMA(1, 1, At, B1); PG8_BAR; PG8_SCHED;
            PG8_LDB(B0, 1, 0); PG8_LDB(B1, 1, 1); PG8_SCHED; PG8_LDA(At, 1, 0); PG8_STAGE(PG8_SA(0, 1), a2 + hstep, voffA);
            PG8_WAIT_V(8); PG8_WAIT_L(0); PG8_BAR; PG8_MMA(0, 0, At, B0); PG8_MMA(0, 1, At, B1); PG8_BAR; PG8_SCHED;
            PG8_LDA(At, 1, 1); PG8_STAGE(PG8_SB(1, 0), b3, voffB); PG8_STAGE(PG8_SB(1, 1), b3 + hstep, voffB); PG8_STAGE(PG8_SA(1, 0), a3, voffA);
            PG8_WAIT_V(8); PG8_WAIT_L(0); PG8_BAR; PG8_MMA(1, 0, At, B0); PG8_MMA(1, 1, At, B1); PG8_BAR; PG8_SCHED;
            } else {
            PG8_LDB(B0, 0, 0); PG8_SCHED; PG8_LDA(At, 0, 0); PG8_STAGE(PG8_SA(1, 1), a1 + hstep, voffA);
            PG8_WAIT_L(8); PG8_BAR; PG8_WAIT_L(0); PG8_MMA(0, 0, At, B0); PG8_BAR; PG8_SCHED;
            PG8_LDB(B1, 0, 1); PG8_STAGE(PG8_SB(0, 0), b2, voffB);
            PG8_BAR; PG8_WAIT_L(0); PG8_MMA(0, 1, At, B1); PG8_BAR;
            PG8_LDA(At, 0, 1); PG8_STAGE(PG8_SA(0, 0), a2, voffA);
            PG8_BAR; PG8_WAIT_L(0); PG8_MMA(1, 0, At, B0); PG8_BAR; PG8_SCHED;
            PG8_STAGE(PG8_SB(0, 1), b2 + hstep, voffB);
            PG8_WAIT_V(6); PG8_BAR; PG8_MMA(1, 1, At, B1); PG8_BAR;
            PG8_LDB(B0, 1, 0); PG8_SCHED; PG8_LDA(At, 1, 0); PG8_STAGE(PG8_SA(0, 1), a2 + hstep, voffA);
            PG8_WAIT_L(8); PG8_BAR; PG8_WAIT_L(0); PG8_MMA(0, 0, At, B0); PG8_BAR; PG8_SCHED;
            PG8_LDB(B1, 1, 1); PG8_STAGE(PG8_SB(1, 0), b3, voffB);
            PG8_BAR; PG8_WAIT_L(0); PG8_MMA(0, 1, At, B1); PG8_BAR;
            PG8_LDA(At, 1, 1); PG8_STAGE(PG8_SA(1, 0), a3, voffA);
            PG8_BAR; PG8_WAIT_L(0); PG8_MMA(1, 0, At, B0); PG8_BAR; PG8_SCHED;
            PG8_STAGE(PG8_SB(1, 1), b3 + hstep, voffB);
            PG8_WAIT_V(6); PG8_BAR; PG8_MMA(1, 1, At, B1); PG8_BAR;
            }
        }
        if constexpr (ALIGN_EPI) { if (wr == 0) PG8_BAR; }
        if constexpr (!Epi::AFTER_DRAIN) { E(acc, cur, wr, wc, fr, fq); S.done(cur); }
        if (!has_next) break;
#pragma unroll
        for (int a = 0; a < 2; ++a)
#pragma unroll
            for (int b = 0; b < 2; ++b)
#pragma unroll
                for (int m = 0; m < 4; ++m)
#pragma unroll
                    for (int n = 0; n < 2; ++n) acc[a][b][m][n] = (f32x4){zz, zz, zz, zz};
        cur = nxt; cA = nA; cB = nB; ++ui;
        if constexpr (ALIGN_EPI) { if (wr == 1) PG8_BAR; }
    }
    PG8_WAIT_V(0);
    if constexpr (!ALIGN_EPI) { if (wr == 0) PG8_BAR; }
    PG8_BAR;
    if constexpr (Epi::AFTER_DRAIN) { E.fused(acc, cur, wr, wc, fr, fq, lds, wid, lane); S.done(cur); }
#undef PG8_SA
#undef PG8_SB
#undef PG8_STAGE
#undef PG8_LDA
#undef PG8_LDB
#undef PG8_MMA
#undef PG8_WAIT_V
#undef PG8_WAIT_L
#undef PG8_BAR
#undef PG8_SCHED
}

__device__ __forceinline__ float sigmoidf_(float x) { return 1.0f / (1.0f + __expf(-x)); }
__device__ __forceinline__ float bflo(unsigned w) { return __uint_as_float(w << 16); }
__device__ __forceinline__ float bfhi(unsigned w) { return __uint_as_float(w & 0xffff0000u); }

struct EpiStore {
    static constexpr bool PERM = true, AFTER_DRAIN = false;
    bf16_t* O; int ldc; const float* cs;
    __device__ __forceinline__ void operator()(const f32x4 (&acc)[2][2][4][2], const Unit& u, int wr, int wc, int fr, int fq) const {
        const int row0 = u.pm * BM + wr * 64 + fr, col0 = u.pn * BM + wc * 32 + 8 * fq;
        f32x4 sv[2][2];
#pragma unroll
        for (int bj = 0; bj < 2; ++bj)
#pragma unroll
            for (int n = 0; n < 2; ++n) sv[bj][n] = cs ? *(const f32x4*)(cs + col0 + bj * HALF + 4 * n) : (f32x4){1.f, 1.f, 1.f, 1.f};
#pragma unroll
        for (int ai = 0; ai < 2; ++ai)
#pragma unroll
            for (int m = 0; m < 4; ++m) { bf16_t* rowp = O + (size_t)(row0 + ai * HALF + m * 16) * ldc + col0;
#pragma unroll
                for (int bj = 0; bj < 2; ++bj) { const f32x4 v0 = acc[ai][bj][m][0] * sv[bj][0], v1 = acc[ai][bj][m][1] * sv[bj][1];
                    u32x4 w; w.x = cvt_pk_bf16(v0[0], v0[1]); w.y = cvt_pk_bf16(v0[2], v0[3]); w.z = cvt_pk_bf16(v1[0], v1[1]); w.w = cvt_pk_bf16(v1[2], v1[3]);
                    *(u32x4*)(rowp + bj * HALF) = w; } }
    }
};
template <bool ADD> struct EpiGate {
    static constexpr bool PERM = true, AFTER_DRAIN = false;
    bf16_t* O; int ldc; const bf16_t* G; int ldg;
    __device__ __forceinline__ void operator()(const f32x4 (&acc)[2][2][4][2], const Unit& u, int wr, int wc, int fr, int fq) const {
        const int row0 = u.pm * BM + wr * 64 + fr, col0 = u.pn * BM + wc * 32 + 8 * fq;
#pragma unroll
        for (int ai = 0; ai < 2; ++ai)
#pragma unroll
            for (int m = 0; m < 4; ++m) { const size_t row = (size_t)(row0 + ai * HALF + m * 16); bf16_t* rowp = O + row * ldc + col0; const bf16_t* gp = G + row * ldg + col0;
#pragma unroll
                for (int bj = 0; bj < 2; ++bj) { const u32x4 gw = *(const u32x4*)(gp + bj * HALF);
                    f32x4 v0 = acc[ai][bj][m][0], v1 = acc[ai][bj][m][1];
                    v0[0] *= sigmoidf_(bflo(gw.x)); v0[1] *= sigmoidf_(bfhi(gw.x)); v0[2] *= sigmoidf_(bflo(gw.y)); v0[3] *= sigmoidf_(bfhi(gw.y));
                    v1[0] *= sigmoidf_(bflo(gw.z)); v1[1] *= sigmoidf_(bfhi(gw.z)); v1[2] *= sigmoidf_(bflo(gw.w)); v1[3] *= sigmoidf_(bfhi(gw.w));
                    if (ADD) { const u32x4 ow = *(const u32x4*)(rowp + bj * HALF);
                        v0[0] += bflo(ow.x); v0[1] += bfhi(ow.x); v0[2] += bflo(ow.y); v0[3] += bfhi(ow.y);
                        v1[0] += bflo(ow.z); v1[1] += bfhi(ow.z); v1[2] += bflo(ow.w); v1[3] += bfhi(ow.w); }
                    u32x4 w; w.x = cvt_pk_bf16(v0[0], v0[1]); w.y = cvt_pk_bf16(v0[2], v0[3]); w.z = cvt_pk_bf16(v1[0], v1[1]); w.w = cvt_pk_bf16(v1[2], v1[3]);
                    *(u32x4*)(rowp + bj * HALF) = w; } }
    }
};
struct EpiResid {
    static constexpr bool PERM = false, AFTER_DRAIN = false;
    const float* Xin; float* Xout; const float* modp; int mod_bstride;
    __device__ __forceinline__ void operator()(const f32x4 (&acc)[2][2][4][2], const Unit& u, int wr, int wc, int fr, int fq) const {
        const int row0 = u.pm * BM + wr * 64 + fr, col0 = u.pn * BM + wc * 32 + 4 * fq;
        const float* gp = modp + (size_t)((u.pm * BM) >> 13) * mod_bstride;
        f32x4 gv[2][2];
#pragma unroll
        for (int bj = 0; bj < 2; ++bj)
#pragma unroll
            for (int n = 0; n < 2; ++n) gv[bj][n] = *(const f32x4*)(gp + col0 + bj * HALF + n * 16);
#pragma unroll
        for (int ai = 0; ai < 2; ++ai)
#pragma unroll
            for (int m = 0; m < 4; ++m) { const size_t off = (size_t)(row0 + ai * HALF + m * 16) * 1024 + col0;
#pragma unroll
                for (int bj = 0; bj < 2; ++bj)
#pragma unroll
                    for (int n = 0; n < 2; ++n) { const f32x4 xo = *(const f32x4*)(Xin + off + bj * HALF + n * 16);
                        *(f32x4*)(Xout + off + bj * HALF + n * 16) = xo + gv[bj][n] * acc[ai][bj][m][n]; } }
    }
};
__device__ __forceinline__ float swiglu_(float g, float u) { g = fminf(g, 7.0f); u = fminf(fmaxf(u, -7.0f), 7.0f); return (u + 1.0f) * g * sigmoidf_(g * 1.702f); }
struct EpiSwiglu {
    static constexpr bool PERM = true, AFTER_DRAIN = false;
    bf16_t* ACT; const float* bias; const int* tile_e;
    __device__ __forceinline__ void operator()(const f32x4 (&acc)[2][2][4][2], const Unit& u, int wr, int wc, int fr, int fq) const {
        const int row0 = u.pm * BM + wr * 64 + fr, col0 = u.pn * BM + wc * 32 + 8 * fq;
        const float* bp = bias + (size_t)tile_e[u.pm] * 2048;
        f32x4 bv[2][2];
#pragma unroll
        for (int bj = 0; bj < 2; ++bj)
#pragma unroll
            for (int n = 0; n < 2; ++n) bv[bj][n] = *(const f32x4*)(bp + col0 + bj * HALF + 4 * n);
#pragma unroll
        for (int ai = 0; ai < 2; ++ai)
#pragma unroll
            for (int m = 0; m < 4; ++m) { bf16_t* rowp = ACT + (size_t)(row0 + ai * HALF + m * 16) * 1024 + (col0 >> 1);
#pragma unroll
                for (int bj = 0; bj < 2; ++bj) { const f32x4 v0 = acc[ai][bj][m][0] + bv[bj][0], v1 = acc[ai][bj][m][1] + bv[bj][1];
                    typedef unsigned u32x2v __attribute__((ext_vector_type(2)));
                    u32x2v w; w.x = cvt_pk_bf16(swiglu_(v0[0], v0[1]), swiglu_(v0[2], v0[3])); w.y = cvt_pk_bf16(swiglu_(v1[0], v1[1]), swiglu_(v1[2], v1[3]));
                    *(u32x2v*)(rowp + bj * (HALF / 2)) = w; } }
    }
};
struct EpiBiasE {
    static constexpr bool PERM = true, AFTER_DRAIN = false;
    bf16_t* O; const float* bias; const int* tile_e;
    __device__ __forceinline__ void operator()(const f32x4 (&acc)[2][2][4][2], const Unit& u, int wr, int wc, int fr, int fq) const {
        const int row0 = u.pm * BM + wr * 64 + fr, col0 = u.pn * BM + wc * 32 + 8 * fq;
        const float* bp = bias + (size_t)tile_e[u.pm] * 1024;
        f32x4 bv[2][2];
#pragma unroll
        for (int bj = 0; bj < 2; ++bj)
#pragma unroll
            for (int n = 0; n < 2; ++n) bv[bj][n] = *(const f32x4*)(bp + col0 + bj * HALF + 4 * n);
#pragma unroll
        for (int ai = 0; ai < 2; ++ai)
#pragma unroll
            for (int m = 0; m < 4; ++m) { bf16_t* rowp = O + (size_t)(row0 + ai * HALF + m * 16) * 1024 + col0;
#pragma unroll
                for (int bj = 0; bj < 2; ++bj) { const f32x4 v0 = acc[ai][bj][m][0] + bv[bj][0], v1 = acc[ai][bj][m][1] + bv[bj][1];
                    u32x4 w; w.x = cvt_pk_bf16(v0[0], v0[1]); w.y = cvt_pk_bf16(v0[2], v0[3]); w.z = cvt_pk_bf16(v1[0], v1[1]); w.w = cvt_pk_bf16(v1[2], v1[3]);
                    *(u32x4*)(rowp + bj * HALF) = w; } }
    }
};
}


constexpr int NL = 4, NB = 4, SEQ = 8192, DM = 1024, NTOK = NB * SEQ;
constexpr int ZW = 4608;
constexpr int ZC_U = 0, ZC_Q = 512, ZC_KCM = 1536, ZC_VCM = 1664, ZC_KSL = 1792, ZC_VSL = 1920, ZC_KWN = 2048, ZC_VWN = 2176, ZC_MG = 2304, ZC_NG = 4352;
constexpr int IN_W = 4400;
constexpr int NEXP = 32, MOE_ROWS_MAX = (NTOK * 4 / 256 + NEXP) * 256;
constexpr int NPH_LAYER = 13, NPHASES = 2 + NL * NPH_LAYER;
enum { PH_NORM1 = 0, PH_GEMM_IN, PH_POST, PH_ATTN, PH_POOLG, PH_PROJA, PH_PROJB, PH_OUTG, PH_NORM2R, PH_SCATTER, PH_GATEUP, PH_DOWN, PH_COMBINE };

constexpr size_t alignup(size_t x) { return (x + 255) & ~(size_t)255; }
constexpr size_t WS_CTL = 0, CTL_ZERO_BYTES = 1u << 20;
constexpr size_t WS_MOD = WS_CTL + CTL_ZERO_BYTES;
constexpr size_t WS_MODP = WS_MOD + alignup((size_t)NL * NB * 6144 * 4);
constexpr size_t WS_ROPE = WS_MODP + alignup((size_t)4 * NL * NB * 6144 * 4);
constexpr size_t WS_WIN = WS_ROPE + alignup((size_t)SEQ * 16 * 4);
constexpr size_t WS_WPOOL = WS_WIN + alignup((size_t)NL * ZW * DM * 2);
constexpr size_t WS_WA = WS_WPOOL + alignup((size_t)NL * 512 * 512 * 2);
constexpr size_t WS_WB = WS_WA + alignup((size_t)NL * 1024 * 512 * 2);
constexpr size_t WS_WOUT = WS_WB + alignup((size_t)NL * 1024 * 1024 * 2);
constexpr size_t WS_W1 = WS_WOUT + alignup((size_t)NL * 1024 * 1024 * 2);
constexpr size_t WS_W2 = WS_W1 + alignup((size_t)NL * 2 * 256 * 2048 * 2);
constexpr size_t WS_WGU = WS_W2 + alignup((size_t)NL * 2 * 64 * 256 * 2);
constexpr size_t WS_WD = WS_WGU + alignup((size_t)NL * NEXP * 2048 * 1024 * 2);
constexpr size_t WS_H = WS_WD + alignup((size_t)NL * NEXP * 1024 * 1024 * 2);
constexpr size_t WS_Z = WS_H + alignup((size_t)NTOK * DM * 2);
constexpr size_t WS_QN = WS_Z + alignup((size_t)NTOK * ZW * 2);
constexpr size_t WS_KSLC = WS_QN + alignup((size_t)NTOK * DM * 2);
constexpr size_t WS_KWIN = WS_KSLC + alignup((size_t)NB * 2 * SEQ * 64 * 2);
constexpr size_t WS_VSLCT = WS_KWIN + alignup((size_t)NB * 2 * SEQ * 64 * 2);
constexpr size_t WS_VWINT = WS_VSLCT + alignup((size_t)NB * 2 * SEQ * 64 * 2);
constexpr size_t WS_KC = WS_VWINT + alignup((size_t)NB * 2 * SEQ * 64 * 2);
constexpr size_t WS_VCT = WS_KC + alignup((size_t)NB * 2 * 512 * 64 * 2);
constexpr size_t WS_PM = WS_VCT + alignup((size_t)NB * 2 * 512 * 64 * 2);
constexpr size_t WS_PP = WS_PM + alignup((size_t)NTOK * 512 * 2);
constexpr size_t WS_O = WS_PP + alignup((size_t)NTOK * 512 * 2);
constexpr size_t WS_MG = WS_O + alignup((size_t)NTOK * DM * 2);
constexpr size_t WS_TOPE = WS_MG + alignup((size_t)NTOK * DM * 2);
constexpr size_t WS_TOPW = WS_TOPE + alignup((size_t)NTOK * 4 * 4);
constexpr size_t WS_DEST = WS_TOPW + alignup((size_t)NTOK * 4 * 4);
constexpr size_t WS_CNT = WS_DEST + alignup((size_t)NTOK * 4 * 4);
constexpr size_t WS_TILEE = WS_CNT + alignup((size_t)1024 * 32 * 4);
constexpr size_t WS_HS = WS_TILEE + alignup((size_t)1024 * 4);
constexpr size_t WS_ACT = WS_HS + alignup((size_t)MOE_ROWS_MAX * 1024 * 2);
constexpr size_t WS_Y = WS_ACT + alignup((size_t)MOE_ROWS_MAX * 1024 * 2);
constexpr size_t WS_END = WS_Y + alignup((size_t)MOE_ROWS_MAX * 1024 * 2);
constexpr int CW_BAR = 4096;

constexpr int RING_BYTES = 131584;
constexpr int MISC_OFF = 135168;
constexpr int SM_OFF = 136192;
constexpr int LDS_BYTES = 147456;
constexpr int NWAVES = 8;

#define GAS __attribute__((address_space(1)))
#define LAS __attribute__((address_space(3)))
typedef unsigned short bf16;
typedef unsigned v4u __attribute__((ext_vector_type(4)));
typedef unsigned v2u __attribute__((ext_vector_type(2)));
typedef float f32x4 __attribute__((ext_vector_type(4)));
typedef short bf16x8 __attribute__((ext_vector_type(8)));
typedef GAS unsigned gu32;
#define RLX_AGENT __ATOMIC_RELAXED, __HIP_MEMORY_SCOPE_AGENT
#define LDS_WAIT() asm volatile("s_waitcnt lgkmcnt(0)" ::: "memory")
#define VM_WAIT() asm volatile("s_waitcnt vmcnt(0)" ::: "memory")
using pg8::cvt_pk_bf16; using pg8::bflo; using pg8::bfhi; using pg8::sigmoidf_;
__device__ __forceinline__ float bf2f(bf16 h) { return __uint_as_float((unsigned)h << 16); }
__device__ __forceinline__ bf16 f2bf(float f) { return (bf16)(cvt_pk_bf16(f, 0.f) & 0xffffu); }
__device__ __forceinline__ float shx(float v, int mask, int lane) { return __int_as_float(__builtin_amdgcn_ds_bpermute((lane ^ mask) << 2, __float_as_int(v))); }
__device__ __forceinline__ int shxi(int v, int mask, int lane) { return __builtin_amdgcn_ds_bpermute((lane ^ mask) << 2, v); }
__device__ __forceinline__ float shf(float v, int src) { return __int_as_float(__builtin_amdgcn_ds_bpermute(src << 2, __float_as_int(v))); }
__device__ __forceinline__ int shfi(int v, int src) { return __builtin_amdgcn_ds_bpermute(src << 2, v); }
__device__ __forceinline__ float wave_sum(float v, int lane) {
#pragma unroll
    for (int o = 1; o < 64; o <<= 1) v += shx(v, o, lane);
    return v;
}

#define XB_TMO      128
#define XB_XCNT(j)  (256  + 64 * (j))
#define XB_XSUB(j)  (1280 + 64 * (j))
#define XB_XGEN(j)  (2304 + 64 * (j))
#define XB_TOP      3328
#define XB_TOPGEN   3392
#define XCD_BAR_WORDS 3456
#define XB_SPIN_CAP (1u << 18)

__device__ __forceinline__ unsigned xb_ld(unsigned* p)              { return __hip_atomic_load(p, __ATOMIC_RELAXED, __HIP_MEMORY_SCOPE_AGENT); }
__device__ __forceinline__ unsigned xb_add(unsigned* p, unsigned v) { return __hip_atomic_fetch_add(p, v, __ATOMIC_RELAXED, __HIP_MEMORY_SCOPE_AGENT); }
__device__ __forceinline__ unsigned xb_xcc_id() { return (unsigned)__builtin_amdgcn_s_getreg((3 << 11) | 20) & 0xFu; }
#define XB_SPIN(cond, bar) do { unsigned _sp = 0; while (cond) { __builtin_amdgcn_s_sleep(1); \
    if ((++_sp & 255u) == 0u) { if (xb_ld(&(bar)[XB_TMO])) break; if (_sp > XB_SPIN_CAP) { atomicAdd(&(bar)[XB_TMO], 1u); break; } } } } while (0)

struct XcdBarrier {
    unsigned* bar; unsigned x;
    volatile LAS unsigned* st;
};

__device__ __forceinline__ XcdBarrier xcd_barrier_post(unsigned* bar, volatile LAS unsigned* st, const int tid_x  ) {
    XcdBarrier b; b.bar = bar; b.x = xb_xcc_id(); b.st = st;
    if (tid_x == 0) (void)xb_add(&bar[XB_XCNT(b.x)], 1u);
    return b;
}
__device__ __forceinline__ void xcd_barrier_complete(unsigned* bar, unsigned x, unsigned& nloc, unsigned& nx) {
    const unsigned G = gridDim.x * gridDim.y * gridDim.z;
    unsigned sum, cnt, mine, sp = 0u;
    for (;;) {
        sum = 0u; cnt = 0u; mine = 0u;
#pragma unroll
        for (unsigned j = 0; j < 16; ++j) { const unsigned c = xb_ld(&bar[XB_XCNT(j)]); sum += c; cnt += (c > 0u) ? 1u : 0u; mine = (j == x) ? c : mine; }
        if (sum == G) break;
        __builtin_amdgcn_s_sleep(1);
        if ((++sp & 255u) == 0u) { if (xb_ld(&bar[XB_TMO])) break; if (sp > XB_SPIN_CAP) { atomicAdd(&bar[XB_TMO], 1u); break; } }
    }
    nloc = mine > 0u ? mine : 1u; nx = cnt > 0u ? cnt : 1u;
}

__device__ __forceinline__ void xcd_barrier(const XcdBarrier& b, const int tid_x) {
    asm volatile("s_waitcnt vmcnt(0)" ::: "memory");
    __syncthreads();
    if (tid_x == 0) {
        unsigned* bar = b.bar;
        __builtin_amdgcn_s_waitcnt(0);
        unsigned nloc = b.st[0], nx = b.st[1];
        if (nloc == 0u) { xcd_barrier_complete(bar, b.x, nloc, nx); b.st[0] = nloc; b.st[1] = nx; }
        const unsigned old = xb_add(&bar[XB_XSUB(b.x)], 1u);
        const unsigned gen = old / nloc;
        if (old + 1u == (gen + 1u) * nloc) {
            __builtin_amdgcn_fence(__ATOMIC_RELEASE, "agent");
            asm volatile("s_waitcnt vmcnt(0)" ::: "memory");
            const unsigned og = xb_add(&bar[XB_TOP], 1u);
            const unsigned tg = og / nx;
            if (og + 1u == (tg + 1u) * nx) xb_add(&bar[XB_TOPGEN], 1u);
            else XB_SPIN(xb_ld(&bar[XB_TOPGEN]) == tg, bar);
            __builtin_amdgcn_fence(__ATOMIC_ACQUIRE, "agent");
            xb_add(&bar[XB_XGEN(b.x)], 1u);
            asm volatile("s_waitcnt vmcnt(0)" ::: "memory");
        } else {
            XB_SPIN(xb_ld(&bar[XB_XGEN(b.x)]) == gen, bar);
            __builtin_amdgcn_fence(__ATOMIC_ACQUIRE, "agent");
            asm volatile("s_waitcnt vmcnt(0)" ::: "memory");
        }
    }
    __syncthreads();
}


enum { I_X = 0, I_C, I_NORM1, I_NORM2, I_ADAW, I_ADAB, I_WIN, I_WPOOL, I_PSCALE, I_QNORM, I_KNORM, I_CMPPOS, I_CMPW1, I_CMPB1, I_CMPW2, I_WPA, I_WPB, I_WOUT,
       I_RW, I_RB, I_WGU, I_BGU, I_WD, I_BD, N_IN };
struct Args { const float* in[N_IN]; float* out; unsigned char* ws; int ph_lo, ph_hi, li, pad; };

struct Ctx {
    LAS unsigned char* lds;
    int tid, lane, wave, bx, G;
    unsigned char* ws;
};
__device__ __forceinline__ void fresh(Ctx& C) { unsigned z = 0u; asm volatile("" : "+s"(z));   int t = C.wave * 64 + (int)__builtin_amdgcn_mbcnt_hi(~0u, __builtin_amdgcn_mbcnt_lo(~0u, z)); asm volatile("" : "+v"(t)); C.tid = t; C.lane = t & 63; int bx = blockIdx.x, G = gridDim.x; asm volatile("" : "+s"(bx), "+s"(G)); C.bx = bx; C.G = G; }

__device__ __forceinline__ int inmap(int np) { return np < 2304 ? np : (np < 4352 ? np + 48 : (np < 4400 ? np - 2048 : -1)); }
template <bool MAPIN>
__device__ __forceinline__ void p0_transpose_item(const float* W, int K, int N, int NP, bf16* WT, LAS float* scr, int item, int lane) {
    const int nblk = NP / 32, kb = item / nblk, nb = item % nblk, k0 = 64 * kb, n0 = 32 * nb;
    int sc = n0 + (lane & 31); if (MAPIN) sc = inmap(sc);
#pragma unroll 8
    for (int i = 0; i < 32; ++i) { const int kk = 2 * i + (lane >> 5); scr[kk * 33 + (lane & 31)] = (sc >= 0) ? W[(size_t)(k0 + kk) * N + sc] : 0.f; }
    LDS_WAIT(); asm volatile("" ::: "memory");
    const int c = lane & 7;
#pragma unroll
    for (int j = 0; j < 4; ++j) { const int n = (lane >> 3) + 8 * j; const LAS float* s = scr + (8 * c) * 33 + n;
        v4u o; o.x = cvt_pk_bf16(s[0 * 33], s[1 * 33]); o.y = cvt_pk_bf16(s[2 * 33], s[3 * 33]); o.z = cvt_pk_bf16(s[4 * 33], s[5 * 33]); o.w = cvt_pk_bf16(s[6 * 33], s[7 * 33]);
        *(v4u*)(WT + (size_t)(n0 + n) * K + k0 + 8 * c) = o; }
    LDS_WAIT(); asm volatile("" ::: "memory");
}
__device__ __forceinline__ void p0_convert(const Ctx& C, const Args& a) {
    LAS float* scr = (LAS float*)(C.lds + C.wave * 16384);
    const int gw = C.bx * NWAVES + C.wave, NGW = C.G * NWAVES;
    constexpr int IT_IN = 16 * (ZW / 32), IT_A = 8 * 32, IT_B = 16 * 32, IT_O = 16 * 32, IT_W1 = 32 * 8, IT_W2 = 4 * 2, IT_GU = 16 * 64, IT_D = 16 * 32;
    constexpr int IT_LAYER = IT_IN + IT_A + IT_B + IT_O + 2 * IT_W1 + 2 * IT_W2 + NEXP * IT_GU + NEXP * IT_D;
    for (int it = gw; it < NL * IT_LAYER; it += NGW) {
        const int l = it / IT_LAYER; int r = it % IT_LAYER;
        if (r < IT_IN) { p0_transpose_item<true>(a.in[I_WIN] + (size_t)l * DM * IN_W, DM, IN_W, ZW, (bf16*)(C.ws + WS_WIN) + (size_t)l * ZW * DM, scr, r, C.lane); continue; } r -= IT_IN;
        if (r < IT_A) { p0_transpose_item<false>(a.in[I_WPA] + (size_t)l * 512 * 1024, 512, 1024, 1024, (bf16*)(C.ws + WS_WA) + (size_t)l * 1024 * 512, scr, r, C.lane); continue; } r -= IT_A;
        if (r < IT_B) { p0_transpose_item<false>(a.in[I_WPB] + (size_t)l * 1024 * 1024, 1024, 1024, 1024, (bf16*)(C.ws + WS_WB) + (size_t)l * 1024 * 1024, scr, r, C.lane); continue; } r -= IT_B;
        if (r < IT_O) { p0_transpose_item<false>(a.in[I_WOUT] + (size_t)l * 1024 * 1024, 1024, 1024, 1024, (bf16*)(C.ws + WS_WOUT) + (size_t)l * 1024 * 1024, scr, r, C.lane); continue; } r -= IT_O;
        if (r < 2 * IT_W1) { const int kv = r / IT_W1; p0_transpose_item<false>(a.in[I_CMPW1] + (size_t)(l * 2 + kv) * 2048 * 256, 2048, 256, 256, (bf16*)(C.ws + WS_W1) + (size_t)(l * 2 + kv) * 256 * 2048, scr, r % IT_W1, C.lane); continue; } r -= 2 * IT_W1;
        if (r < 2 * IT_W2) { const int kv = r / IT_W2; p0_transpose_item<false>(a.in[I_CMPW2] + (size_t)(l * 2 + kv) * 256 * 64, 256, 64, 64, (bf16*)(C.ws + WS_W2) + (size_t)(l * 2 + kv) * 64 * 256, scr, r % IT_W2, C.lane); continue; } r -= 2 * IT_W2;
        if (r < NEXP * IT_GU) { const int e = r / IT_GU; p0_transpose_item<false>(a.in[I_WGU] + (size_t)(l * NEXP + e) * 1024 * 2048, 1024, 2048, 2048, (bf16*)(C.ws + WS_WGU) + (size_t)(l * NEXP + e) * 2048 * 1024, scr, r % IT_GU, C.lane); continue; } r -= NEXP * IT_GU;
        { const int e = r / IT_D; p0_transpose_item<false>(a.in[I_WD] + (size_t)(l * NEXP + e) * 1024 * 1024, 1024, 1024, 1024, (bf16*)(C.ws + WS_WD) + (size_t)(l * NEXP + e) * 1024 * 1024, scr, r % IT_D, C.lane); }
    }
    const int gt = C.bx * (NWAVES * 64) + C.tid, NGT = C.G * NWAVES * 64;
    { bf16* wp = (bf16*)(C.ws + WS_WPOOL);
      for (int i = gt; i < NL * 512 * 512; i += NGT) { const int l = i >> 18, ep = (i >> 9) & 511, cp = i & 511; float v = 0.f;
          if ((ep >> 7) == (cp >> 7)) v = a.in[I_WPOOL][(((size_t)l * 4 + (ep >> 7)) * 128 + (cp & 127)) * 128 + (ep & 127)];
          wp[i] = f2bf(v); } }
    { float* rp = (float*)(C.ws + WS_ROPE);
      for (int i = gt; i < SEQ * 8; i += NGT) { const int pos = i >> 3, fi = i & 7;
          const float invf[8] = {1.0f, 0.1939227432012558f, 0.03760603070259094f, 0.007292664609849453f, 0.0014142135623842478f, 0.00027424818836152554f, 5.318296098266728e-05f, 1.0313386155758053e-05f};
          float f = invf[0];
#pragma unroll
          for (int q = 1; q < 8; ++q) f = (fi == q) ? invf[q] : f;
          const float ang = (float)pos * f; const double rev = (double)ang * 0.15915494309189535; const float fr = (float)(rev - __builtin_rint(rev));
          rp[pos * 16 + fi] = __builtin_amdgcn_cosf(fr); rp[pos * 16 + 8 + fi] = __builtin_amdgcn_sinf(fr); } }
    __syncthreads();
    { LAS float* sc = (LAS float*)C.lds;
      for (int i = C.tid; i < NB * DM; i += NWAVES * 64) { const float cv = a.in[I_C][i]; sc[i] = cv * sigmoidf_(cv); }
      __syncthreads();
      float* mp = (float*)(C.ws + WS_MODP);
      for (int i = gt; i < 4 * NL * 6144; i += NGT) { const int j = i % 6144, l = (i / 6144) % NL, ks = i / (6144 * NL);
          const float* w = a.in[I_ADAW] + ((size_t)l * DM + ks * 256) * 6144 + j; float a0 = 0.f, a1 = 0.f, a2 = 0.f, a3 = 0.f;
#pragma unroll 8
          for (int k = 0; k < 256; ++k) { const float wv = w[(size_t)k * 6144]; const int kk = ks * 256 + k;
              a0 += sc[kk] * wv; a1 += sc[DM + kk] * wv; a2 += sc[2 * DM + kk] * wv; a3 += sc[3 * DM + kk] * wv; }
          float* o = mp + ((size_t)(ks * NL + l) * NB) * 6144 + j; o[0] = a0; o[6144] = a1; o[2 * 6144] = a2; o[3 * 6144] = a3; }
      __syncthreads(); }
}
__device__ __forceinline__ void p1_mod(const Ctx& C, const Args& a) {
    const int gt = C.bx * (NWAVES * 64) + C.tid, NGT = C.G * NWAVES * 64;
    const float* mp = (const float*)(C.ws + WS_MODP); float* mo = (float*)(C.ws + WS_MOD);
    for (int i = gt; i < NL * NB * 6144; i += NGT) { const int j = i % 6144, l = i / (NB * 6144);
        float s = a.in[I_ADAB][l * 6144 + j];
#pragma unroll
        for (int ks = 0; ks < 4; ++ks) s += mp[(size_t)ks * NL * NB * 6144 + i];
        mo[i] = s; }
}


__device__ __forceinline__ void norm_rows(const Ctx& C, const float* X, const float* gain, const float* mod_l  , int shift_i, int scale_i, bf16* H) {
    const int gw = C.bx * NWAVES + C.wave, NGW = C.G * NWAVES;
    for (int m = gw; m < NTOK; m += NGW) {
        const int b = m >> 13; const f32x4* xr = (const f32x4*)(X + (size_t)m * DM) + C.lane;
        f32x4 v[4]; float s = 0.f;
#pragma unroll
        for (int j = 0; j < 4; ++j) { v[j] = xr[64 * j]; s += (v[j].x * v[j].x + v[j].y * v[j].y) + (v[j].z * v[j].z + v[j].w * v[j].w); }
        const float rstd = 1.0f / sqrtf(wave_sum(s, C.lane) * (1.0f / DM) + 1e-6f);
        const float* mb = mod_l + (size_t)b * 6144; v2u* o8 = (v2u*)(H + (size_t)m * DM) + C.lane;
#pragma unroll
        for (int j = 0; j < 4; ++j) { const int col = 4 * C.lane + 256 * j;
            const f32x4 g = *(const f32x4*)(gain + col), sc = *(const f32x4*)(mb + scale_i * DM + col), sh = *(const f32x4*)(mb + shift_i * DM + col);
            const f32x4 h = v[j] * rstd * g * (sc + 1.0f) + sh;
            v2u w; w.x = cvt_pk_bf16(h.x, h.y); w.y = cvt_pk_bf16(h.z, h.w); o8[64 * j] = w; }
    }
}

__device__ __forceinline__ void post_tokens(const Ctx& C, const Args& a, int l) {
    const int gw = C.bx * NWAVES + C.wave, NGW = C.G * NWAVES, lane = C.lane;
    const bf16* Z = (const bf16*)(C.ws + WS_Z); const float* rope = (const float*)(C.ws + WS_ROPE);
    bf16* Qn = (bf16*)(C.ws + WS_QN); bf16* Kslc = (bf16*)(C.ws + WS_KSLC); bf16* Kwin = (bf16*)(C.ws + WS_KWIN); bf16* Pm = (bf16*)(C.ws + WS_PM);
    const float* qn = a.in[I_QNORM] + l * 64; const float* kn = a.in[I_KNORM] + l * 192;
    for (int m = gw; m < NTOK; m += NGW) {
        const int b = m >> 13, t = m & (SEQ - 1); const bf16* zr = Z + (size_t)m * ZW; const float* rp = rope + t * 16;
        { const int head = lane >> 2, dq = (lane & 3) * 16; const v4u w0 = *(const v4u*)(zr + ZC_Q + head * 64 + dq), w1 = *(const v4u*)(zr + ZC_Q + head * 64 + dq + 8);
          float y[16]; y[0] = bflo(w0.x); y[1] = bfhi(w0.x); y[2] = bflo(w0.y); y[3] = bfhi(w0.y); y[4] = bflo(w0.z); y[5] = bfhi(w0.z); y[6] = bflo(w0.w); y[7] = bfhi(w0.w);
          y[8] = bflo(w1.x); y[9] = bfhi(w1.x); y[10] = bflo(w1.y); y[11] = bfhi(w1.y); y[12] = bflo(w1.z); y[13] = bfhi(w1.z); y[14] = bflo(w1.w); y[15] = bfhi(w1.w);
          float s = 0.f;
#pragma unroll
          for (int i = 0; i < 16; ++i) s += y[i] * y[i];
          s += shx(s, 1, lane); s += shx(s, 2, lane);
          const float rstd = 1.0f / sqrtf(s * (1.0f / 64.0f) + 1e-6f);
#pragma unroll
          for (int i = 0; i < 16; ++i) y[i] = y[i] * rstd * qn[dq + i];
          if ((lane & 3) == 0) {
#pragma unroll
              for (int i = 0; i < 8; ++i) { const float c = rp[i], sn = rp[8 + i], x1 = y[i], x2 = y[8 + i]; y[i] = x1 * c - x2 * sn; y[8 + i] = x2 * c + x1 * sn; } }
          v4u o0, o1; o0.x = cvt_pk_bf16(y[0], y[1]); o0.y = cvt_pk_bf16(y[2], y[3]); o0.z = cvt_pk_bf16(y[4], y[5]); o0.w = cvt_pk_bf16(y[6], y[7]);
          o1.x = cvt_pk_bf16(y[8], y[9]); o1.y = cvt_pk_bf16(y[10], y[11]); o1.z = cvt_pk_bf16(y[12], y[13]); o1.w = cvt_pk_bf16(y[14], y[15]);
          bf16* qo = Qn + (size_t)m * DM + head * 64 + dq; *(v4u*)qo = o0; *(v4u*)(qo + 8) = o1; }
        { const int which = lane >> 4, g = which & 1, li = lane & 15, dk = li * 4; const int sec = (which < 2) ? ZC_KSL : ZC_KWN;
          const v2u w = *(const v2u*)(zr + sec + g * 64 + dk); float y[4] = {bflo(w.x), bfhi(w.x), bflo(w.y), bfhi(w.y)};
          float s = y[0] * y[0] + y[1] * y[1] + y[2] * y[2] + y[3] * y[3];
          s += shx(s, 1, lane); s += shx(s, 2, lane); s += shx(s, 4, lane); s += shx(s, 8, lane);
          const float rstd = 1.0f / sqrtf(s * (1.0f / 64.0f) + 1e-6f); const float* gk = kn + ((which < 2) ? 64 : 128) + dk;
#pragma unroll
          for (int i = 0; i < 4; ++i) y[i] = y[i] * rstd * gk[i];
          float pz[4];
#pragma unroll
          for (int i = 0; i < 4; ++i) pz[i] = shx(y[i], 2, lane);
          if (li < 4) { const int fi = (li & 1) * 4;
#pragma unroll
              for (int i = 0; i < 4; ++i) { const float c = rp[fi + i], sn = rp[8 + fi + i]; y[i] = (li < 2) ? (y[i] * c - pz[i] * sn) : (y[i] * c + pz[i] * sn); } }
          v2u o; o.x = cvt_pk_bf16(y[0], y[1]); o.y = cvt_pk_bf16(y[2], y[3]);
          bf16* ko = ((which < 2) ? Kslc : Kwin) + ((size_t)(b * 2 + g) * SEQ + t) * 64 + dk; *(v2u*)ko = o; }
        { const int ch = lane * 8, w = 2 << (lane >> 4), cnt = (t + 1 < w) ? (t + 1) : w; float sum[8] = {0.f, 0.f, 0.f, 0.f, 0.f, 0.f, 0.f, 0.f}; float self[8];
          for (int k = 0; k < cnt; ++k) { const v4u u = *(const v4u*)(zr - (size_t)k * ZW + ZC_U + ch);
              const float f[8] = {bflo(u.x), bfhi(u.x), bflo(u.y), bfhi(u.y), bflo(u.z), bfhi(u.z), bflo(u.w), bfhi(u.w)};
#pragma unroll
              for (int i = 0; i < 8; ++i) { sum[i] += f[i]; if (k == 0) self[i] = f[i]; } }
          const float inv = 1.0f / (float)cnt; v4u o;
          o.x = cvt_pk_bf16(sum[0] * inv - self[0], sum[1] * inv - self[1]); o.y = cvt_pk_bf16(sum[2] * inv - self[2], sum[3] * inv - self[3]);
          o.z = cvt_pk_bf16(sum[4] * inv - self[4], sum[5] * inv - self[5]); o.w = cvt_pk_bf16(sum[6] * inv - self[6], sum[7] * inv - self[7]);
          *(v4u*)(Pm + (size_t)m * 512 + ch) = o; }
    }
    { bf16* VsT = (bf16*)(C.ws + WS_VSLCT); bf16* VwT = (bf16*)(C.ws + WS_VWINT);
      for (int it = gw; it < 2 * NB * 2 * (SEQ / 64); it += NGW) { const int tt = it & 127, g = (it >> 7) & 1, b = (it >> 8) & 3, which = it >> 10;
          const bf16* src = Z + ((size_t)(b * SEQ + tt * 64 + lane)) * ZW + (which ? ZC_VWN : ZC_VSL) + g * 64;
          bf16* dst = (which ? VwT : VsT) + ((size_t)(b * 2 + g) * 64) * SEQ + tt * 64 + lane;
#pragma unroll
          for (int c = 0; c < 8; ++c) { const v4u u = *(const v4u*)(src + 8 * c); bf16* d = dst + (size_t)(8 * c) * SEQ;
              d[0] = (bf16)(u.x & 0xffff); d[SEQ] = (bf16)(u.x >> 16); d[2 * SEQ] = (bf16)(u.y & 0xffff); d[3 * SEQ] = (bf16)(u.y >> 16);
              d[4 * SEQ] = (bf16)(u.z & 0xffff); d[5 * SEQ] = (bf16)(u.z >> 16); d[6 * SEQ] = (bf16)(u.w & 0xffff); d[7 * SEQ] = (bf16)(u.w >> 16); } } }
}

__device__ __forceinline__ void compress_unit(const Ctx& C, const Args& a, int l, int u) {
    const int kv = u & 1, nt = (u >> 1) & 31, bg = u >> 6, b = bg >> 1, g = bg & 1, n0 = nt * 16;
    const int lane = C.lane, r16 = lane & 15, quad = lane >> 4, w = C.wave;
    const bf16* Z = (const bf16*)(C.ws + WS_Z);
    const bf16* W1t = (const bf16*)(C.ws + WS_W1) + (size_t)(l * 2 + kv) * 256 * 2048;
    const bf16* W2t = (const bf16*)(C.ws + WS_W2) + (size_t)(l * 2 + kv) * 64 * 256;
    const float* pos = a.in[I_CMPPOS] + (size_t)(l * 2 + kv) * 32 * 64;
    const float* b1 = a.in[I_CMPB1] + (size_t)(l * 2 + kv) * 256;
    LAS bf16* hidL = (LAS bf16*)C.lds;
    LAS float* outL = (LAS float*)(C.lds + 16 * 264 * 2);
    const int nl = (n0 + r16 > 510) ? 510 : (n0 + r16);
    const bf16* arow = Z + ((size_t)(b * SEQ + 16 * nl)) * ZW + (kv ? ZC_VCM : ZC_KCM) + g * 64;
    f32x4 acc0 = {0.f, 0.f, 0.f, 0.f}, acc1 = {0.f, 0.f, 0.f, 0.f};
    const bf16* wb0 = W1t + (size_t)(32 * w + r16) * 2048 + quad * 8; const bf16* wb1 = wb0 + (size_t)16 * 2048;
#pragma unroll 4
    for (int ks = 0; ks < 64; ++ks) { const int lrow = ks >> 1, d = (ks & 1) * 32 + quad * 8;
        const v4u zv = *(const v4u*)(arow + (size_t)lrow * ZW + d); const f32x4 p0 = *(const f32x4*)(pos + lrow * 64 + d), p1 = *(const f32x4*)(pos + lrow * 64 + d + 4);
        v4u av; av.x = cvt_pk_bf16(bflo(zv.x) + p0.x, bfhi(zv.x) + p0.y); av.y = cvt_pk_bf16(bflo(zv.y) + p0.z, bfhi(zv.y) + p0.w);
        av.z = cvt_pk_bf16(bflo(zv.z) + p1.x, bfhi(zv.z) + p1.y); av.w = cvt_pk_bf16(bflo(zv.w) + p1.z, bfhi(zv.w) + p1.w);
        const bf16x8 af = __builtin_bit_cast(bf16x8, av);
        const bf16x8 bf0 = *(const bf16x8*)(wb0 + ks * 32), bf1 = *(const bf16x8*)(wb1 + ks * 32);
        acc0 = __builtin_amdgcn_mfma_f32_16x16x32_bf16(af, bf0, acc0, 0, 0, 0);
        acc1 = __builtin_amdgcn_mfma_f32_16x16x32_bf16(af, bf1, acc1, 0, 0, 0); }
    { const float bb0 = b1[32 * w + r16], bb1 = b1[32 * w + 16 + r16];
#pragma unroll
      for (int r = 0; r < 4; ++r) { float h0 = acc0[r] + bb0, h1 = acc1[r] + bb1; h0 = h0 * sigmoidf_(h0); h1 = h1 * sigmoidf_(h1);
          hidL[(4 * quad + r) * 264 + 32 * w + r16] = f2bf(h0); hidL[(4 * quad + r) * 264 + 32 * w + 16 + r16] = f2bf(h1); } }
    __syncthreads();
    if (w < 4) { f32x4 o = {0.f, 0.f, 0.f, 0.f}; const bf16* w2 = W2t + (size_t)(16 * w + r16) * 256 + quad * 8;
#pragma unroll
        for (int ks = 0; ks < 8; ++ks) { const bf16x8 af = *(const LAS bf16x8*)(hidL + r16 * 264 + ks * 32 + quad * 8); const bf16x8 bfr = *(const bf16x8*)(w2 + ks * 32);
            o = __builtin_amdgcn_mfma_f32_16x16x32_bf16(af, bfr, o, 0, 0, 0); }
#pragma unroll
        for (int r = 0; r < 4; ++r) outL[(4 * quad + r) * 68 + 16 * w + r16] = o[r]; }
    __syncthreads();
    if (w == 0) { const int i = lane >> 2, c0 = (lane & 3) * 16, n = n0 + i; float y[16];
#pragma unroll
        for (int j = 0; j < 16; ++j) y[j] = outL[i * 68 + c0 + j];
        if (kv == 0) { float s = 0.f;
#pragma unroll
            for (int j = 0; j < 16; ++j) s += y[j] * y[j];
            s += shx(s, 1, lane); s += shx(s, 2, lane);
            const float rstd = 1.0f / sqrtf(s * (1.0f / 64.0f) + 1e-6f); const float* gk = a.in[I_KNORM] + l * 192 + c0;
#pragma unroll
            for (int j = 0; j < 16; ++j) y[j] = y[j] * rstd * gk[j];
            if ((lane & 3) == 0 && n <= 510) { const float* rp = (const float*)(C.ws + WS_ROPE) + (16 * n + 31) * 16;
#pragma unroll
                for (int j = 0; j < 8; ++j) { const float c = rp[j], sn = rp[8 + j], x1 = y[j], x2 = y[8 + j]; y[j] = x1 * c - x2 * sn; y[8 + j] = x2 * c + x1 * sn; } }
            if (n > 510) {
#pragma unroll
                for (int j = 0; j < 16; ++j) y[j] = 0.f; }
            v4u o0, o1; o0.x = cvt_pk_bf16(y[0], y[1]); o0.y = cvt_pk_bf16(y[2], y[3]); o0.z = cvt_pk_bf16(y[4], y[5]); o0.w = cvt_pk_bf16(y[6], y[7]);
            o1.x = cvt_pk_bf16(y[8], y[9]); o1.y = cvt_pk_bf16(y[10], y[11]); o1.z = cvt_pk_bf16(y[12], y[13]); o1.w = cvt_pk_bf16(y[14], y[15]);
            bf16* ko = (bf16*)(C.ws + WS_KC) + ((size_t)bg * 512 + n) * 64 + c0; *(v4u*)ko = o0; *(v4u*)(ko + 8) = o1;
        } else { bf16* vo = (bf16*)(C.ws + WS_VCT) + ((size_t)bg * 64 + c0) * 512 + n;
#pragma unroll
            for (int j = 0; j < 16; ++j) vo[(size_t)j * 512] = (n > 510) ? (bf16)0 : f2bf(y[j]); } }
    __syncthreads();
}


#define MFMA16(a, b, c) __builtin_amdgcn_mfma_f32_16x16x32_bf16(a, b, c, 0, 0, 0)
__device__ __forceinline__ bf16x8 pack_p(const f32x4& p0, const f32x4& p1) {
    v4u w; w.x = cvt_pk_bf16(p0[0], p0[1]); w.y = cvt_pk_bf16(p0[2], p0[3]); w.z = cvt_pk_bf16(p1[0], p1[1]); w.w = cvt_pk_bf16(p1[2], p1[3]); return __builtin_bit_cast(bf16x8, w);
}
__device__ __forceinline__ bf16x8 load_vt(const bf16* p) {
    const v2u lo = *(const v2u*)p, hi = *(const v2u*)(p + 16); v4u w; w.x = lo.x; w.y = lo.y; w.z = hi.x; w.w = hi.y; return __builtin_bit_cast(bf16x8, w);
}
constexpr float SM_SCALE = 0.125f * 1.4426950408889634f;

template <int NT, class Valid>
__device__ __forceinline__ void softmax_pv_step(f32x4 (&st)[NT], const Valid& valid, float& mrun, float& lrun, f32x4 (&o)[4], const bf16* vt, size_t vpitch, int key0, int r16, int quad) {
    const int lane = quad * 16 + r16;
    float bmax = -1e30f;
#pragma unroll
    for (int i = 0; i < NT; ++i)
#pragma unroll
        for (int r = 0; r < 4; ++r) { const bool ok = valid(key0 + 16 * i + 4 * quad + r); bmax = ok ? fmaxf(bmax, st[i][r]) : bmax; }
    bmax = fmaxf(bmax, shx(bmax, 16, lane)); bmax = fmaxf(bmax, shx(bmax, 32, lane));
    const float mnew = fmaxf(mrun, bmax), alpha = __builtin_amdgcn_exp2f((mrun - mnew) * SM_SCALE);
    float ps = 0.f;
#pragma unroll
    for (int i = 0; i < NT; ++i)
#pragma unroll
        for (int r = 0; r < 4; ++r) { const bool ok = valid(key0 + 16 * i + 4 * quad + r); const float pv = ok ? __builtin_amdgcn_exp2f((st[i][r] - mnew) * SM_SCALE) : 0.f; st[i][r] = pv; ps += pv; }
    ps += shx(ps, 16, lane); ps += shx(ps, 32, lane);
    lrun = lrun * alpha + ps; mrun = mnew;
#pragma unroll
    for (int db = 0; db < 4; ++db) o[db] = o[db] * alpha;
#pragma unroll
    for (int j = 0; j < NT / 2; ++j) { const bf16x8 pb = pack_p(st[2 * j], st[2 * j + 1]);
#pragma unroll
        for (int db = 0; db < 4; ++db) { const bf16x8 va = load_vt(vt + (size_t)(16 * db + r16) * vpitch + key0 + 32 * j + 4 * quad); o[db] = MFMA16(va, pb, o[db]); } }
}

__device__ __forceinline__ void attn_item(const Ctx& C, int b, int g, int t0) {
    const int lane = C.lane, r16 = lane & 15, quad = lane >> 4, tokc = r16 >> 3, head = r16 & 7, tl = t0 + tokc, bg = b * 2 + g;
    const bf16* Qn = (const bf16*)(C.ws + WS_QN); const bf16* Z = (const bf16*)(C.ws + WS_Z);
    f32x4 oc[4]; unsigned m0 = 0u, m1 = 0u, m2 = 0u, m3 = 0u;
    {
        const bf16* qrow = Qn + ((size_t)(b * SEQ + tl)) * DM + (g * 8 + head) * 64;
        const bf16x8 qf0 = *(const bf16x8*)(qrow + quad * 8), qf1 = *(const bf16x8*)(qrow + 32 + quad * 8);
        const int nv_l = (tl >= 31) ? (((tl - 31) >> 4) + 1) : 0;
        const int nv_max = (t0 + 1 >= 31) ? (((t0 + 1 - 31) >> 4) + 1) : 0;
        const int ntile = (nv_max + 15) >> 4;
        const bf16* kc = (const bf16*)(C.ws + WS_KC) + (size_t)bg * 512 * 64;
        const bf16* vct = (const bf16*)(C.ws + WS_VCT) + (size_t)bg * 64 * 512;
        float mx = -1e30f, ls = 0.f;
        for (int i = 0; i < ntile; ++i) { const bf16* kp = kc + (size_t)(16 * i + r16) * 64 + quad * 8; const bf16x8 k0 = *(const bf16x8*)kp, k1 = *(const bf16x8*)(kp + 32);
            f32x4 acc = {0.f, 0.f, 0.f, 0.f}; acc = MFMA16(k0, qf0, acc); acc = MFMA16(k1, qf1, acc);
            float bm = mx;
#pragma unroll
            for (int r = 0; r < 4; ++r) { const bool ok = (16 * i + 4 * quad + r) < nv_l; bm = ok ? fmaxf(bm, acc[r]) : bm; }
            float ps = 0.f;
#pragma unroll
            for (int r = 0; r < 4; ++r) { const bool ok = (16 * i + 4 * quad + r) < nv_l; ps += ok ? __builtin_amdgcn_exp2f((acc[r] - bm) * SM_SCALE) : 0.f; }
            ls = ls * __builtin_amdgcn_exp2f((mx - bm) * SM_SCALE) + ps; mx = bm; }
        { float mall = fmaxf(mx, shx(mx, 16, lane)); mall = fmaxf(mall, shx(mall, 32, lane));
          ls = ls * __builtin_amdgcn_exp2f((mx - mall) * SM_SCALE); ls += shx(ls, 16, lane); ls += shx(ls, 32, lane); mx = mall; }
        const float inv = (ls > 0.f) ? 1.0f / ls : 0.f;
#pragma unroll
        for (int db = 0; db < 4; ++db) oc[db] = (f32x4){0.f, 0.f, 0.f, 0.f};
        LAS float* impL = (LAS float*)(C.lds + C.wave * 1024);
        *(LAS f32x4*)(impL + 4 * lane) = (f32x4){0.f, 0.f, 0.f, 0.f};
        LDS_WAIT();
        float prev_up = 0.f; const int npair = (ntile + 1) >> 1;
        for (int j = 0; j < npair; ++j) {
            f32x4 st[2];
#pragma unroll
            for (int h = 0; h < 2; ++h) { const bf16* kp = kc + (size_t)(32 * j + 16 * h + r16) * 64 + quad * 8; const bf16x8 k0 = *(const bf16x8*)kp, k1 = *(const bf16x8*)(kp + 32);
                f32x4 acc = {0.f, 0.f, 0.f, 0.f}; acc = MFMA16(k0, qf0, acc); acc = MFMA16(k1, qf1, acc);
#pragma unroll
                for (int r = 0; r < 4; ++r) { const bool ok = (32 * j + 16 * h + 4 * quad + r) < nv_l; acc[r] = ok ? __builtin_amdgcn_exp2f((acc[r] - mx) * SM_SCALE) * inv : 0.f; }
                st[h] = acc; }
            const bf16x8 pb = pack_p(st[0], st[1]);
#pragma unroll
            for (int db = 0; db < 4; ++db) { const bf16x8 va = load_vt(vct + (size_t)(16 * db + r16) * 512 + 32 * j + 4 * quad); oc[db] = MFMA16(va, pb, oc[db]); }
#pragma unroll
            for (int h = 0; h < 2; ++h) { float h3 = st[h][3], hs = (st[h][0] + st[h][1]) + (st[h][2] + st[h][3]);
                hs += shx(hs, 1, lane); hs += shx(hs, 2, lane); hs += shx(hs, 4, lane);
                h3 += shx(h3, 1, lane); h3 += shx(h3, 2, lane); h3 += shx(h3, 4, lane);
                const float up = shf(h3, (lane + 48) & 63);
                const float val = hs + ((quad == 0) ? prev_up : up); prev_up = up;
                if (head == 0) impL[tokc * 128 + 4 * (2 * j + h) + quad] = val; }
        }
        if (2 * npair < 32 && head == 0 && quad == 0) impL[tokc * 128 + 8 * npair] = prev_up;
        LDS_WAIT();
        float vals[32];
#pragma unroll
        for (int i = 0; i < 32; ++i) vals[i] = impL[tokc * 128 + 4 * i + quad];
        const int cur_l = tl >> 6;
#pragma unroll
        for (int i = 0; i < 32; ++i) { const int s = 4 * i + quad; float v = vals[i]; v = (s > cur_l) ? -1.0f : v; v = (s == 0 || s == cur_l) ? 1e9f : v; vals[i] = v; }
        for (int round = 0; round < 16; ++round) {
            float bv = vals[0]; int bi = 0;
#pragma unroll
            for (int i = 1; i < 32; ++i) { const bool gt = vals[i] > bv; bv = gt ? vals[i] : bv; bi = gt ? i : bi; }
            int bs = 4 * bi + quad;
#pragma unroll
            for (int off = 16; off <= 32; off <<= 1) { const float ov = shx(bv, off, lane); const int os = shxi(bs, off, lane); const bool take = (ov > bv) || (ov == bv && os < bs); bv = take ? ov : bv; bs = take ? os : bs; }
            const bool mine = (bs & 3) == quad; const int bi2 = bs >> 2;
#pragma unroll
            for (int i = 0; i < 32; ++i) vals[i] = (mine && i == bi2) ? -3.0f : vals[i];
            const unsigned bit = 1u << (bs & 31); const int wd = bs >> 5;
            m0 |= (wd == 0) ? bit : 0u; m1 |= (wd == 1) ? bit : 0u; m2 |= (wd == 2) ? bit : 0u; m3 |= (wd == 3) ? bit : 0u;
        }
    }
    f32x4 os0[4], os1[4]; float ls0 = 1.f, ls1 = 1.f;
    const bf16* ksl = (const bf16*)(C.ws + WS_KSLC) + (size_t)bg * SEQ * 64;
    const bf16* vst = (const bf16*)(C.ws + WS_VSLCT) + (size_t)bg * 64 * SEQ;
#pragma unroll
    for (int tk = 0; tk < 2; ++tk) {
        const int t = t0 + tk, cur = t >> 6;
        const bf16* qrow = Qn + ((size_t)(b * SEQ + t)) * DM + (g * 8 + head) * 64;
        const bf16x8 qs0 = *(const bf16x8*)(qrow + quad * 8), qs1 = *(const bf16x8*)(qrow + 32 + quad * 8);
        unsigned wmask[4] = {(unsigned)__builtin_amdgcn_readlane((int)m0, tk * 8), (unsigned)__builtin_amdgcn_readlane((int)m1, tk * 8),
                             (unsigned)__builtin_amdgcn_readlane((int)m2, tk * 8), (unsigned)__builtin_amdgcn_readlane((int)m3, tk * 8)};
        f32x4 o[4];
#pragma unroll
        for (int db = 0; db < 4; ++db) o[db] = (f32x4){0.f, 0.f, 0.f, 0.f};
        float mrun = -1e30f, lrun = 0.f;
#pragma unroll
        for (int wd = 0; wd < 4; ++wd) { unsigned word = wmask[wd];
            while (word) { const int bit = __builtin_ctz(word); word &= word - 1u; const int s = wd * 32 + bit; if (s > cur) break;
                f32x4 st[4];
#pragma unroll
                for (int i = 0; i < 4; ++i) { const bf16* kp = ksl + (size_t)(64 * s + 16 * i + r16) * 64 + quad * 8; const bf16x8 k0 = *(const bf16x8*)kp, k1 = *(const bf16x8*)(kp + 32);
                    f32x4 acc = {0.f, 0.f, 0.f, 0.f}; acc = MFMA16(k0, qs0, acc); acc = MFMA16(k1, qs1, acc); st[i] = acc; }
                softmax_pv_step<4>(st, [t](int key) { return key <= t; }, mrun, lrun, o, vst, (size_t)SEQ, 64 * s, r16, quad);
            } }
        if (tk == 0) { ls0 = lrun;
#pragma unroll
            for (int db = 0; db < 4; ++db) os0[db] = o[db]; }
        else { ls1 = lrun;
#pragma unroll
            for (int db = 0; db < 4; ++db) os1[db] = o[db]; }
    }
    f32x4 ow[4]; float lw = 1.f;
    {
        const bf16* qrow = Qn + ((size_t)(b * SEQ + tl)) * DM + (g * 8 + head) * 64;
        const bf16x8 qf0 = *(const bf16x8*)(qrow + quad * 8), qf1 = *(const bf16x8*)(qrow + 32 + quad * 8);
        const bf16* kwn = (const bf16*)(C.ws + WS_KWIN) + (size_t)bg * SEQ * 64;
        const bf16* vwt = (const bf16*)(C.ws + WS_VWINT) + (size_t)bg * 64 * SEQ;
#pragma unroll
        for (int db = 0; db < 4; ++db) ow[db] = (f32x4){0.f, 0.f, 0.f, 0.f};
        float mrun = -1e30f, lrun = 0.f;
        const int klo = ((t0 - 511 > 0) ? (t0 - 511) : 0) & ~31;
        for (int k0 = klo; k0 <= t0 + 1; k0 += 32) {
            f32x4 st[2];
#pragma unroll
            for (int i = 0; i < 2; ++i) { const bf16* kp = kwn + (size_t)(k0 + 16 * i + r16) * 64 + quad * 8; const bf16x8 ka = *(const bf16x8*)kp, kb = *(const bf16x8*)(kp + 32);
                f32x4 acc = {0.f, 0.f, 0.f, 0.f}; acc = MFMA16(ka, qf0, acc); acc = MFMA16(kb, qf1, acc); st[i] = acc; }
            softmax_pv_step<2>(st, [tl](int key) { return key <= tl && key + 511 >= tl; }, mrun, lrun, ow, vwt, (size_t)SEQ, k0, r16, quad);
        }
        lw = lrun;
    }
    {
        const bf16* zg = Z + ((size_t)(b * SEQ + tl)) * ZW + ZC_NG + g * 8 + head;
        const float g0 = sigmoidf_(bf2f(zg[0])), g1 = sigmoidf_(bf2f(zg[16])) / (tokc ? ls1 : ls0), g2 = sigmoidf_(bf2f(zg[32])) / lw;
        bf16* orow = (bf16*)(C.ws + WS_O) + ((size_t)(b * SEQ + tl)) * DM + (g * 8 + head) * 64 + 4 * quad;
#pragma unroll
        for (int db = 0; db < 4; ++db) { const f32x4 osl = tokc ? os1[db] : os0[db]; const f32x4 v = oc[db] * g0 + osl * g1 + ow[db] * g2;
            v2u w; w.x = cvt_pk_bf16(v[0], v[1]); w.y = cvt_pk_bf16(v[2], v[3]); *(v2u*)(orow + 16 * db) = w; }
    }
}
__device__ __forceinline__ void attn_phase(const Ctx& C) {
    const int bgi = C.bx & 7, b = bgi >> 1, g = bgi & 1;
    for (int pair = (C.bx >> 3) * NWAVES + C.wave; pair < SEQ / 2; pair += (C.G >> 3) * NWAVES) attn_item(C, b, g, 2 * pair);
}


constexpr int RW_PITCH = 1028;
__device__ __forceinline__ void norm2_router(const Ctx& C, const Args& a, int l) {
    LAS float* rw = (LAS float*)C.lds; LAS int* hist = (LAS int*)(C.lds + SM_OFF);
    const float* rwg = a.in[I_RW] + (size_t)l * DM * NEXP;
    for (int i = C.tid; i < DM * NEXP; i += NWAVES * 64) rw[(i & 31) * RW_PITCH + (i >> 5)] = rwg[i];
    if (C.tid < 32) hist[C.tid] = 0;
    __syncthreads();
    const float* X = a.out; const float* gain = a.in[I_NORM2] + l * DM; const float* mod_l = (const float*)(C.ws + WS_MOD) + (size_t)l * NB * 6144;
    const float* rb = a.in[I_RB] + l * NEXP; bf16* H = (bf16*)(C.ws + WS_H);
    int* tope = (int*)(C.ws + WS_TOPE); float* topw = (float*)(C.ws + WS_TOPW);
    const int lane = C.lane;
    for (int i = 0; i < 16; ++i) {
        const int m = C.bx * 128 + C.wave * 16 + i, b = m >> 13; const f32x4* xr = (const f32x4*)(X + (size_t)m * DM) + lane;
        f32x4 v[4]; float s = 0.f;
#pragma unroll
        for (int j = 0; j < 4; ++j) { v[j] = xr[64 * j]; s += (v[j].x * v[j].x + v[j].y * v[j].y) + (v[j].z * v[j].z + v[j].w * v[j].w); }
        const float rstd = 1.0f / sqrtf(wave_sum(s, lane) * (1.0f / DM) + 1e-6f);
        const float* mb = mod_l + (size_t)b * 6144; v2u* o8 = (v2u*)(H + (size_t)m * DM) + lane;
#pragma unroll
        for (int j = 0; j < 4; ++j) { const int col = 4 * lane + 256 * j;
            const f32x4 gn = *(const f32x4*)(gain + col), sc = *(const f32x4*)(mb + 4 * DM + col), sh = *(const f32x4*)(mb + 3 * DM + col);
            v[j] = v[j] * rstd * gn * (sc + 1.0f) + sh;
            v2u w; w.x = cvt_pk_bf16(v[j].x, v[j].y); w.y = cvt_pk_bf16(v[j].z, v[j].w); o8[64 * j] = w; }
        float lg[32];
#pragma unroll
        for (int e = 0; e < 32; ++e) { float p = 0.f;
#pragma unroll
            for (int j = 0; j < 4; ++j) { const f32x4 wv = *(const LAS f32x4*)(rw + e * RW_PITCH + 4 * lane + 256 * j); p += (v[j].x * wv.x + v[j].y * wv.y) + (v[j].z * wv.z + v[j].w * wv.w); }
            lg[e] = wave_sum(p, lane) + rb[e]; if ((e & 3) == 3) __builtin_amdgcn_sched_barrier(0); }
        int te[4]; float tv[4];
#pragma unroll
        for (int k = 0; k < 4; ++k) { float bv = lg[0]; int be = 0;
#pragma unroll
            for (int e = 1; e < 32; ++e) { const bool gt = lg[e] > bv; bv = gt ? lg[e] : bv; be = gt ? e : be; }
            te[k] = be; tv[k] = bv;
#pragma unroll
            for (int e = 0; e < 32; ++e) lg[e] = (e == be) ? -3.0e38f : lg[e]; }
        const float e1 = __expf(tv[1] - tv[0]), e2 = __expf(tv[2] - tv[0]), e3 = __expf(tv[3] - tv[0]); const float inv = 1.0f / (1.0f + e1 + e2 + e3);
        if (lane < 4) { const int ek = (lane == 0) ? te[0] : (lane == 1) ? te[1] : (lane == 2) ? te[2] : te[3];
            const float wk = (lane == 0) ? inv : (lane == 1) ? e1 * inv : (lane == 2) ? e2 * inv : e3 * inv;
            tope[m * 4 + lane] = ek; topw[m * 4 + lane] = wk; __hip_atomic_fetch_add(hist + ek, 1, __ATOMIC_RELAXED, __HIP_MEMORY_SCOPE_WORKGROUP); }
    }
    __syncthreads();
    if (C.tid < 32) ((int*)(C.ws + WS_CNT))[C.bx * 32 + C.tid] = hist[C.tid];
    __syncthreads();
}
__device__ __forceinline__ void moe_scatter(const Ctx& C) {
    LAS int* sm = (LAS int*)(C.lds + SM_OFF); LAS int* tot = sm + 32; LAS int* base = sm + 64; LAS int* pstart = sm + 96; LAS int* lcnt = sm + 128;
    const int* cnt = (const int*)(C.ws + WS_CNT); int* tile_e = (int*)(C.ws + WS_TILEE);
    if (C.tid < 32) { int t = 0, bs = 0; for (int bb = 0; bb < C.G; ++bb) { const int c = cnt[bb * 32 + C.tid]; t += c; bs += (bb < C.bx) ? c : 0; } tot[C.tid] = t; base[C.tid] = bs; lcnt[C.tid] = 0; }
    __syncthreads();
    if (C.tid == 0) { int ps = 0; for (int e = 0; e < 32; ++e) { pstart[e] = ps; const int nt = (tot[e] + 255) >> 8; if (C.bx == 0) for (int i = 0; i < nt; ++i) tile_e[(ps >> 8) + i] = e; ps += nt << 8; }
        if (C.bx == 0) tile_e[1023] = ps >> 8; }
    __syncthreads();
    const int* tope = (const int*)(C.ws + WS_TOPE); int* dest = (int*)(C.ws + WS_DEST);
    const bf16* H = (const bf16*)(C.ws + WS_H); bf16* Hs = (bf16*)(C.ws + WS_HS); const int lane = C.lane;
    for (int i = 0; i < 16; ++i) { const int m = C.bx * 128 + C.wave * 16 + i; int row = 0;
        if (lane < 4) { const int e = tope[m * 4 + lane]; const int rank = __hip_atomic_fetch_add(lcnt + e, 1, __ATOMIC_RELAXED, __HIP_MEMORY_SCOPE_WORKGROUP); row = pstart[e] + base[e] + rank; dest[m * 4 + lane] = row; }
        const int r0 = shfi(row, 0), r1 = shfi(row, 1), r2 = shfi(row, 2), r3 = shfi(row, 3);
        const v4u* src = (const v4u*)(H + (size_t)m * DM) + lane; const v4u x0 = src[0], x1 = src[64];
        v4u* d0 = (v4u*)(Hs + (size_t)r0 * DM) + lane; d0[0] = x0; d0[64] = x1;
        v4u* d1 = (v4u*)(Hs + (size_t)r1 * DM) + lane; d1[0] = x0; d1[64] = x1;
        v4u* d2 = (v4u*)(Hs + (size_t)r2 * DM) + lane; d2[0] = x0; d2[64] = x1;
        v4u* d3 = (v4u*)(Hs + (size_t)r3 * DM) + lane; d3[0] = x0; d3[64] = x1; }
    __syncthreads();
}
__device__ __forceinline__ void moe_combine(const Ctx& C, const Args& a, int l) {
    const int gw = C.bx * NWAVES + C.wave, NGW = C.G * NWAVES, lane = C.lane;
    const int* dest = (const int*)(C.ws + WS_DEST); const float* topw = (const float*)(C.ws + WS_TOPW); const bf16* Y = (const bf16*)(C.ws + WS_Y);
    const float* mod_l = (const float*)(C.ws + WS_MOD) + (size_t)l * NB * 6144; float* X = a.out;
    for (int m = gw; m < NTOK; m += NGW) { const int b = m >> 13; const float* g2 = mod_l + (size_t)b * 6144 + 5 * DM;
        int r[4]; float w[4];
#pragma unroll
        for (int k = 0; k < 4; ++k) { r[k] = dest[m * 4 + k]; w[k] = topw[m * 4 + k]; }
        f32x4* xr = (f32x4*)(X + (size_t)m * DM) + lane;
#pragma unroll
        for (int j = 0; j < 4; ++j) { const int col = 4 * lane + 256 * j; f32x4 y = {0.f, 0.f, 0.f, 0.f};
#pragma unroll
            for (int k = 0; k < 4; ++k) { const v2u u = *(const v2u*)(Y + (size_t)r[k] * DM + col); y.x += w[k] * bflo(u.x); y.y += w[k] * bfhi(u.x); y.z += w[k] * bflo(u.y); y.w += w[k] * bfhi(u.y); }
            const f32x4 gv = *(const f32x4*)(g2 + col); xr[64 * j] = xr[64 * j] + gv * y; } }
}


#ifndef MK_ONE_LAUNCH
#define MK_ONE_LAUNCH 0
#endif
template <int l>
__device__ __forceinline__ void layer_body(Ctx& C, const Args& args, const XcdBarrier& bar, const int lo, const int hi) {
    bf16* const H = (bf16*)(C.ws + WS_H); bf16* const Z = (bf16*)(C.ws + WS_Z);
    const float* const MOD = (const float*)(C.ws + WS_MOD);
    const int* const tile_e = (const int*)(C.ws + WS_TILEE);
#define IN(k) (fresh(C), lo <= (k) && (k) < hi)
#define SEAM(k) do { if (IN(k) && IN((k) + 1)) xcd_barrier(bar, C.tid); } while (0)

        const int pb = 2 + l * NPH_LAYER;
        const float* mod_l = MOD + (size_t)l * NB * 6144;
        if (IN(pb + PH_NORM1)) norm_rows(C, l == 0 ? args.in[I_X] : args.out, args.in[I_NORM1] + l * DM, mod_l, 0, 1, H);
        SEAM(pb + PH_NORM1);
        if (IN(pb + PH_GEMM_IN)) {
            pg8::Gemm g{H, (const bf16*)(C.ws + WS_WIN) + (size_t)l * ZW * DM, NTOK, ZW, DM, nullptr, 0}; pg8::StaticOrder S; S.init(NTOK, ZW, C.G, C.bx);
            pg8::EpiStore E{Z, ZW, nullptr};
            pg8::gemm_phase<pg8::EpiStore, pg8::StaticOrder, true, true>(C.lds, g, S, E, C.tid); }
        SEAM(pb + PH_GEMM_IN);
        if (IN(pb + PH_POST)) { post_tokens(C, args, l); __syncthreads(); for (int u = C.bx; u < 512; u += C.G) compress_unit(C, args, l, u); }
        SEAM(pb + PH_POST);
        if (IN(pb + PH_ATTN)) attn_phase(C);
        SEAM(pb + PH_ATTN);
        if (IN(pb + PH_POOLG)) {
            pg8::Gemm g{(const bf16*)(C.ws + WS_PM), (const bf16*)(C.ws + WS_WPOOL) + (size_t)l * 512 * 512, NTOK, 512, 512, nullptr, 0}; pg8::StaticOrder S; S.init(NTOK, 512, C.G, C.bx);
            pg8::EpiStore E{(bf16*)(C.ws + WS_PP), 512, args.in[I_PSCALE] + l * 512};
            pg8::gemm_phase<pg8::EpiStore, pg8::StaticOrder, true, true>(C.lds, g, S, E, C.tid); }
        SEAM(pb + PH_POOLG);
        if (IN(pb + PH_PROJA)) {
            pg8::Gemm g{(const bf16*)(C.ws + WS_PP), (const bf16*)(C.ws + WS_WA) + (size_t)l * 1024 * 512, NTOK, 1024, 512, nullptr, 0}; pg8::StaticOrder S; S.init(NTOK, 1024, C.G, C.bx);
            pg8::EpiGate<false> E{(bf16*)(C.ws + WS_MG), 1024, Z + ZC_MG, ZW};
            pg8::gemm_phase<pg8::EpiGate<false>, pg8::StaticOrder, true, true>(C.lds, g, S, E, C.tid); }
        SEAM(pb + PH_PROJA);
        if (IN(pb + PH_PROJB)) {
            pg8::Gemm g{(const bf16*)(C.ws + WS_O), (const bf16*)(C.ws + WS_WB) + (size_t)l * 1024 * 1024, NTOK, 1024, 1024, nullptr, 0}; pg8::StaticOrder S; S.init(NTOK, 1024, C.G, C.bx);
            pg8::EpiGate<true> E{(bf16*)(C.ws + WS_MG), 1024, Z + ZC_MG + 1024, ZW};
            pg8::gemm_phase<pg8::EpiGate<true>, pg8::StaticOrder, true, true>(C.lds, g, S, E, C.tid); }
        SEAM(pb + PH_PROJB);
        if (IN(pb + PH_OUTG)) {
            pg8::Gemm g{(const bf16*)(C.ws + WS_MG), (const bf16*)(C.ws + WS_WOUT) + (size_t)l * 1024 * 1024, NTOK, 1024, 1024, nullptr, 0}; pg8::StaticOrder S; S.init(NTOK, 1024, C.G, C.bx);
            pg8::EpiResid E{l == 0 ? args.in[I_X] : args.out, args.out, mod_l + 2 * DM, 6144};
            pg8::gemm_phase<pg8::EpiResid, pg8::StaticOrder, true, true>(C.lds, g, S, E, C.tid); }
        SEAM(pb + PH_OUTG);
        if (IN(pb + PH_NORM2R)) norm2_router(C, args, l);
        SEAM(pb + PH_NORM2R);
        if (IN(pb + PH_SCATTER)) moe_scatter(C);
        SEAM(pb + PH_SCATTER);
        if (IN(pb + PH_GATEUP)) { const int R = tile_e[1023];
            pg8::Gemm g{(const bf16*)(C.ws + WS_HS), (const bf16*)(C.ws + WS_WGU) + (size_t)l * NEXP * 2048 * 1024, R * 256, 2048, 1024, tile_e, (size_t)2048 * 1024 * 2}; pg8::StaticOrder S; S.init(R * 256, 2048, C.G, C.bx);
            pg8::EpiSwiglu E{(bf16*)(C.ws + WS_ACT), args.in[I_BGU] + (size_t)l * NEXP * 2048, tile_e};
            pg8::gemm_phase<pg8::EpiSwiglu, pg8::StaticOrder, true, true>(C.lds, g, S, E, C.tid); }
        SEAM(pb + PH_GATEUP);
        if (IN(pb + PH_DOWN)) { const int R = tile_e[1023];
            pg8::Gemm g{(const bf16*)(C.ws + WS_ACT), (const bf16*)(C.ws + WS_WD) + (size_t)l * NEXP * 1024 * 1024, R * 256, 1024, 1024, tile_e, (size_t)1024 * 1024 * 2}; pg8::StaticOrder S; S.init(R * 256, 1024, C.G, C.bx);
            pg8::EpiBiasE E{(bf16*)(C.ws + WS_Y), args.in[I_BD] + (size_t)l * NEXP * 1024, tile_e};
            pg8::gemm_phase<pg8::EpiBiasE, pg8::StaticOrder, true, true>(C.lds, g, S, E, C.tid); }
        SEAM(pb + PH_DOWN);
        if (IN(pb + PH_COMBINE)) moe_combine(C, args, l);
        SEAM(pb + PH_COMBINE);

#undef IN
#undef SEAM
}
__global__ void __launch_bounds__(NWAVES * 64, 2) fwd(Args args) {
    extern __shared__ __attribute__((aligned(16))) unsigned char lds_raw[];
    Ctx C; C.lds = (LAS unsigned char*)lds_raw; C.tid = threadIdx.x; C.lane = C.tid & 63; C.wave = __builtin_amdgcn_readfirstlane(C.tid >> 6); C.bx = blockIdx.x; C.G = gridDim.x; C.ws = args.ws;
    for (int u = C.tid; u < (LDS_BYTES - MISC_OFF) / 4; u += NWAVES * 64) ((LAS unsigned*)(C.lds + MISC_OFF))[u] = 0u;
    __syncthreads();
    const int lo = args.ph_lo, hi = args.ph_hi;
    unsigned* barw = (unsigned*)(C.ws + WS_CTL) + CW_BAR + (size_t)args.li * XCD_BAR_WORDS;
    XcdBarrier bar; bar.bar = barw; bar.x = 0; bar.st = nullptr;
    if (hi - lo > 1) bar = xcd_barrier_post(barw, (volatile LAS unsigned*)(C.lds + MISC_OFF) + 8, C.tid);
#define IN(k) (fresh(C), lo <= (k) && (k) < hi)
#define SEAM(k) do { if (IN(k) && IN((k) + 1)) xcd_barrier(bar, C.tid); } while (0)
    bf16* const H = (bf16*)(C.ws + WS_H); bf16* const Z = (bf16*)(C.ws + WS_Z);
    const float* const MOD = (const float*)(C.ws + WS_MOD);
    const int* const tile_e = (const int*)(C.ws + WS_TILEE);

    if (IN(0)) p0_convert(C, args);
    SEAM(0);
    if (IN(1)) p1_mod(C, args);
    SEAM(1);
    layer_body<0>(C, args, bar, lo, hi); layer_body<1>(C, args, bar, lo, hi); layer_body<2>(C, args, bar, lo, hi); layer_body<3>(C, args, bar, lo, hi);
#undef IN
#undef SEAM
}

extern "C" void kernel_launch(void* const* d_in, const int* in_sizes, int n_in, void* d_out, int out_size, void* d_ws, size_t ws_size, hipStream_t stream) {
    static int grid = 0;
    if (grid == 0) {
        if (n_in != N_IN || out_size != NTOK * DM || ws_size < WS_END) { fprintf(stderr, "kernel_launch: unexpected shapes (n_in %d, out %d, ws %zu < %zu)\n", n_in, out_size, ws_size, (size_t)WS_END); grid = -1; return; }
        int dev = 0, cus = 0;
        if (hipGetDevice(&dev) != hipSuccess || hipDeviceGetAttribute(&cus, hipDeviceAttributeMultiprocessorCount, dev) != hipSuccess) { grid = -1; return; }
        if (hipFuncSetAttribute((const void*)fwd, hipFuncAttributeMaxDynamicSharedMemorySize, LDS_BYTES) != hipSuccess) { fprintf(stderr, "kernel_launch: hipFuncSetAttribute failed\n"); grid = -1; return; }
        int per_cu = 0; (void)hipOccupancyMaxActiveBlocksPerMultiprocessor(&per_cu, (const void*)fwd, NWAVES * 64, LDS_BYTES); (void)hipGetLastError();
        if (cus != 256 || per_cu < 1) fprintf(stderr, "kernel_launch: note: %d CUs, occupancy query %d; this kernel is built for one 512-thread workgroup on each of 256 CUs\n", cus, per_cu);
        grid = 256;
    }
    if (grid < 0) return;
    if (hipMemsetAsync((char*)d_ws + WS_CTL, 0, CTL_ZERO_BYTES, stream) != hipSuccess) return;
    Args a{};
    for (int i = 0; i < N_IN; ++i) a.in[i] = (const float*)d_in[i];
    a.out = (float*)d_out; a.ws = (unsigned char*)d_ws;
#if MK_ONE_LAUNCH
    a.ph_lo = 0; a.ph_hi = NPHASES; a.li = 0; a.pad = 0;
    hipLaunchKernelGGL(fwd, dim3(grid), dim3(NWAVES * 64), LDS_BYTES, stream, a);
#else
    for (int ph = 0; ph < NPHASES; ++ph) { a.ph_lo = ph; a.ph_hi = ph + 1; a.li = 0; a.pad = 0;
        hipLaunchKernelGGL(fwd, dim3(grid), dim3(NWAVES * 64), LDS_BYTES, stream, a); }
#endif
}
```

```cpp
#include <hip/hip_runtime.h>
#include <cstdio>
#include <cstdint>

namespace pg8 {
#define PG8_LAS __attribute__((address_space(3)))
typedef unsigned short bf16_t;
typedef short bf16x8 __attribute__((ext_vector_type(8)));
typedef float f32x4 __attribute__((ext_vector_type(4)));
typedef unsigned u32x4 __attribute__((ext_vector_type(4)));
constexpr int BM = 256, BK = 64, HALF = 128, HTB = HALF * BK * 2  , STAGE_BYTES = 8 * HTB, NXCD = 8, WGM = 8;

__host__ __device__ __forceinline__ int lds_byte(int r, int c) { const int st = (r >> 4) * 2 + (c >> 5), rr = r & 15, cc = c & 31, ob = rr * 64 + cc * 2; return st * 1024 + (ob ^ (((ob >> 9) & 1) << 5)); }
__host__ __device__ __forceinline__ void stage_rc(int b, int& R, int& C) { const int st = b / 1024, sb = b % 1024, swz = sb ^ (((sb >> 9) & 1) << 5); R = (st >> 1) * 16 + swz / 64; C = (st & 1) * 32 + (swz % 64) / 2; }
__host__ __device__ __forceinline__ int perm32(int rho) { const int n = rho >> 4, i = rho & 15; return 8 * (i >> 2) + 4 * n + (i & 3); }

struct Unit { int pm, pn; };
struct Gemm { const bf16_t* A; const bf16_t* Bt; int M, N, K; const int* tile_e; size_t be_stride; };

struct StaticOrder {
    int nM, nN, nwg, G, c;
    __host__ __device__ void init(int M, int N, int G_, int c_) { nM = M / BM; nN = N / BM; nwg = nM * nN; G = G_; c = c_; }
    __host__ __device__ bool next(int i, Unit& u) const {
        const long L = (long)i * G + c; if (L >= nwg) return false;
        int wgid = (int)L; { const int q = nwg / NXCD, r = nwg % NXCD, xcd = wgid % NXCD, off = wgid / NXCD; wgid = (xcd < r ? xcd * (q + 1) : r * (q + 1) + (xcd - r) * q) + off; }
        const int nig = WGM * nN, gid = wgid / nig, fm = gid * WGM, gsz = (nM - fm) < WGM ? (nM - fm) : WGM;
        u.pm = fm + ((wgid % nig) % gsz); u.pn = (wgid % nig) / gsz; return true;
    }
    __device__ __forceinline__ void a_ready(const Unit&) const {}
    __device__ __forceinline__ void done(const Unit&) const {}
};

__device__ __forceinline__ unsigned cvt_pk_bf16(float lo, float hi) { unsigned r; asm volatile("v_cvt_pk_bf16_f32 %0, %1, %2" : "=v"(r) : "v"(lo), "v"(hi)); return r; }
typedef float f32x2 __attribute__((ext_vector_type(2)));


template <class Epi, class Sched, bool ALIGN_EPI = false, bool SP2 = false>
__device__ __forceinline__ void gemm_phase(PG8_LAS unsigned char* lds, const Gemm g, const Sched& S, const Epi& E, const int tid_in  ) {
    int tid_ = tid_in; asm volatile("" : "+v"(tid_));
    float zz = 0.f; asm volatile("" : "+v"(zz));
    const int tid = tid_, wid = __builtin_amdgcn_readfirstlane(tid >> 6), lane = tid & 63, wr = wid >> 2, wc = wid & 3, fr = lane & 15, fq = lane >> 4;
    const int K = g.K, nt = K / BK;
    unsigned voffA[2], voffB[2];
#pragma unroll
    for (int i = 0; i < 2; ++i) { int R, C; stage_rc(tid * 16 + i * 8192, R, C); const int Rb = Epi::PERM ? ((R & ~31) + perm32(R & 31)) : R;
        voffA[i] = (unsigned)(R * K + C) * 2u; voffB[i] = (unsigned)(Rb * K + C) * 2u; }
    const size_t kstep = (size_t)(BK * 2);
    const size_t hstep = (size_t)HALF * K * 2;
    const size_t tstep = 2 * hstep;
    const unsigned ldsw = (unsigned)wid * 1024u;
    const int aoff = lds_byte(wr * 64 + fr, fq * 8), boff = lds_byte(wc * 32 + fr, fq * 8);
#define PG8_SA(b, h) (((b) * 2 + (h)) * HTB)
#define PG8_SB(b, h) ((4 + (b) * 2 + (h)) * HTB)
#define PG8_STAGE(bufoff, gbase, voff) do { _Pragma("unroll") for (int _i = 0; _i < 2; ++_i) \
        __builtin_amdgcn_global_load_lds((const unsigned*)((const char*)(gbase) + (voff)[_i]), (PG8_LAS unsigned*)(lds + (bufoff) + ldsw + _i * 8192), 16, 0, 0); } while (0)
#define PG8_LDA(dst, b, h) do { _Pragma("unroll") for (int m = 0; m < 4; ++m) _Pragma("unroll") for (int k = 0; k < 2; ++k) dst[m][k] = *(const PG8_LAS bf16x8*)(lds + PG8_SA(b, h) + aoff + m * 2048 + k * 1024); } while (0)
#define PG8_LDB(dst, b, h) do { _Pragma("unroll") for (int n = 0; n < 2; ++n) _Pragma("unroll") for (int k = 0; k < 2; ++k) dst[n][k] = *(const PG8_LAS bf16x8*)(lds + PG8_SB(b, h) + boff + n * 2048 + k * 1024); } while (0)
#define PG8_MMA(ai, bj, At, Bt) do { __builtin_amdgcn_s_setprio(1); _Pragma("unroll") for (int m = 0; m < 4; ++m) _Pragma("unroll") for (int n = 0; n < 2; ++n) _Pragma("unroll") for (int k = 0; k < 2; ++k) \
        acc[ai][bj][m][n] = __builtin_amdgcn_mfma_f32_16x16x32_bf16(Bt[n][k], At[m][k], acc[ai][bj][m][n], 0, 0, 0); __builtin_amdgcn_s_setprio(0); } while (0)
#define PG8_WAIT_V(n) asm volatile("s_waitcnt vmcnt(" #n ")" ::: "memory")
#define PG8_WAIT_L(n) asm volatile("s_waitcnt lgkmcnt(" #n ")" ::: "memory")
#define PG8_BAR __builtin_amdgcn_s_barrier()
#define PG8_SCHED __builtin_amdgcn_sched_barrier(0)
    Unit cur, nxt; int ui = 0;
    if (!S.next(0, cur)) return;
    f32x4 acc[2][2][4][2];
#pragma unroll
    for (int a = 0; a < 2; ++a)
#pragma unroll
        for (int b = 0; b < 2; ++b)
#pragma unroll
            for (int m = 0; m < 4; ++m)
#pragma unroll
                for (int n = 0; n < 2; ++n) acc[a][b][m][n] = (f32x4){zz, zz, zz, zz};
    bf16x8 At[4][2], B0[2][2], B1[2][2];
    const char* cA = (const char*)g.A + (size_t)cur.pm * tstep; const char* cB = (const char*)g.Bt + (g.tile_e ? (size_t)g.tile_e[cur.pm] * g.be_stride : (size_t)0) + (size_t)cur.pn * tstep;
    S.a_ready(cur);
    if constexpr (SP2) {
        PG8_STAGE(PG8_SB(0, 0), cB, voffB); PG8_STAGE(PG8_SB(0, 1), cB + hstep, voffB); PG8_STAGE(PG8_SA(0, 0), cA, voffA); PG8_STAGE(PG8_SA(0, 1), cA + hstep, voffA);
        if (wr == 1) PG8_BAR;
        PG8_WAIT_V(2); PG8_BAR;
        PG8_STAGE(PG8_SB(1, 0), cB + kstep, voffB); PG8_STAGE(PG8_SA(1, 0), cA + kstep, voffA); PG8_STAGE(PG8_SB(1, 1), cB + hstep + kstep, voffB);
        PG8_WAIT_V(6); PG8_BAR;
    } else {
        PG8_STAGE(PG8_SB(0, 0), cB, voffB); PG8_STAGE(PG8_SA(0, 0), cA, voffA); PG8_STAGE(PG8_SB(0, 1), cB + hstep, voffB); PG8_STAGE(PG8_SA(0, 1), cA + hstep, voffA);
        if (wr == 1) PG8_BAR;
        PG8_WAIT_V(4); PG8_BAR;
        PG8_STAGE(PG8_SB(1, 0), cB + kstep, voffB); PG8_STAGE(PG8_SA(1, 0), cA + kstep, voffA); PG8_STAGE(PG8_SB(1, 1), cB + hstep + kstep, voffB);
        PG8_WAIT_V(6); PG8_BAR;
    }
    for (;;) {
        const bool has_next = S.next(ui + 1, nxt);
        const char* nA = has_next ? (const char*)g.A + (size_t)nxt.pm * tstep : cA; const char* nB = has_next ? (const char*)g.Bt + (g.tile_e ? (size_t)g.tile_e[nxt.pm] * g.be_stride : (size_t)0) + (size_t)nxt.pn * tstep : cB;
        for (int t = 0; t < nt; t += 2) {
            const bool last = (t == nt - 2);
            const char* a1 = cA + (size_t)(t + 1) * kstep;
            const char* a2 = last ? nA : cA + (size_t)(t + 2) * kstep; const char* b2 = last ? nB : cB + (size_t)(t + 2) * kstep;
            const char* a3 = a2 + kstep; const char* b3 = b2 + kstep;
            if (last && has_next) S.a_ready(nxt);
            if constexpr (SP2) {
            PG8_LDB(B0, 0, 0); PG8_LDB(B1, 0, 1); PG8_SCHED; PG8_LDA(At, 0, 0); PG8_STAGE(PG8_SA(1, 1), a1 + hstep, voffA);
            PG8_WAIT_V(8); PG8_WAIT_L(0); PG8_BAR; PG8_MMA(0, 0, At, B0); PG8_MMA(0, 1, At, B1); PG8_BAR; PG8_SCHED;
            PG8_LDA(At, 0, 1); PG8_STAGE(PG8_SB(0, 0), b2, voffB); PG8_STAGE(PG8_SB(0, 1), b2 + hstep, voffB); PG8_STAGE(PG8_SA(0, 0), a2, voffA);
            PG8_WAIT_V(8); PG8_WAIT_L(0); PG8_BAR; PG8_MMA(1, 0, At, B0); PG8_MMA(1, 1, At, B1); PG8_BAR; PG8_SCHED;
            PG8_LDB(B0, 1, 0); PG8_LDB(B1, 1, 1); PG8_SCHED; PG8_LDA(At, 1, 0); PG8_STAGE(PG8_SA(0, 1), a2 + hstep, voffA);
            PG8_WAIT_V(8); PG8_WAIT_L(0); PG8_BAR; PG8_MMA(0, 0, At, B0); PG8_MMA(0, 1, At, B1); PG8_BAR; PG8_SCHED;
            PG8_LDA(At, 1, 1); PG8_STAGE(PG8_SB(1, 0), b3, voffB); PG8_STAGE(PG8_SB(1, 1), b3 + hstep, voffB); PG8_STAGE(PG8_SA(1, 0), a3, voffA);
            PG8_WAIT_V(8); PG8_WAIT_L(0); PG8_BAR; PG8_MMA(1, 0, At, B0); PG8_MMA(1, 1, At, B1); PG8_BAR; PG8_SCHED;
            } else {
            PG8_LDB(B0, 0, 0); PG8_SCHED; PG8_LDA(At, 0, 0); PG8_STAGE(PG8_SA(1, 1), a1 + hstep, voffA);
            PG8_WAIT_L(8); PG8_BAR; PG8_WAIT_L(0); PG8_MMA(0, 0, At, B0); PG8_BAR; PG8_SCHED;
            PG8_LDB(B1, 0, 1); PG8_STAGE(PG8_SB(0, 0), b2, voffB);
            PG8_BAR; PG8_WAIT_L(0); PG8_MMA(0, 1, At, B1); PG8_BAR;
            PG8_LDA(At, 0, 1); PG8_STAGE(PG8_SA(0, 0), a2, voffA);
            PG8_BAR; PG8_WAIT_L(0); PG8_MMA(1, 0, At, B0); PG8_BAR; PG8_SCHED;
            PG8_STAGE(PG8_SB(0, 1), b2 + hstep, voffB);
            PG8_WAIT_V(6); PG8_BAR; PG8_MMA(1, 1, At, B1); PG8_BAR;
            PG8_LDB(B0, 1, 0); PG8_SCHED; PG8_LDA(At, 1, 0); PG8_STAGE(PG8_SA(0, 1), a2 + hstep, voffA);
            PG8_WAIT_L(8); PG8_BAR; PG8_WAIT_L(0); PG8_MMA(0, 0, At, B0); PG8_BAR; PG8_SCHED;
            PG8_LDB(B1, 1, 1); PG8_STAGE(PG8_SB(1, 0), b3, voffB);
            PG8_BAR; PG8_WAIT_L(0); PG8_MMA(0, 1, At, B1); PG8_BAR;
            PG8_LDA(At, 1, 1); PG8_STAGE(PG8_SA(1, 0), a3, voffA);
            PG8_BAR; PG8_WAIT_L(0); PG8_MMA(1, 0, At, B0); PG8_BAR; PG8_SCHED;
            PG8_STAGE(PG8_SB(1, 1), b3 + hstep, voffB);
            PG8_WAIT_V(6); PG8_BAR; PG8_MMA(1, 1, At, B1); PG8_BAR;
            }
        }
        if constexpr (ALIGN_EPI) { if (wr == 0) PG8_BAR; }
        if constexpr (!Epi::AFTER_DRAIN) { E(acc, cur, wr, wc, fr, fq); S.done(cur); }
        if (!has_next) break;
#pragma unroll
        for (int a = 0; a < 2; ++a)
#pragma unroll
            for (int b = 0; b < 2; ++b)
#pragma unroll
                for (int m = 0; m < 4; ++m)
#pragma unroll
                    for (int n = 0; n < 2; ++n) acc[a][b][m][n] = (f32x4){zz, zz, zz, zz};
        cur = nxt; cA = nA; cB = nB; ++ui;
        if constexpr (ALIGN_EPI) { if (wr == 1) PG8_BAR; }
    }
    PG8_WAIT_V(0);
    if constexpr (!ALIGN_EPI) { if (wr == 0) PG8_BAR; }
    PG8_BAR;
    if constexpr (Epi::AFTER_DRAIN) { E.fused(acc, cur, wr, wc, fr, fq, lds, wid, lane); S.done(cur); }
#undef PG8_SA
#undef PG8_SB
#undef PG8_STAGE
#undef PG8_LDA
#undef PG8_LDB
#undef PG8_MMA
#undef PG8_WAIT_V
#undef PG8_WAIT_L
#undef PG8_BAR
#undef PG8_SCHED
}

__device__ __forceinline__ float sigmoidf_(float x) { return 1.0f / (1.0f + __expf(-x)); }
__device__ __forceinline__ float bflo(unsigned w) { return __uint_as_float(w << 16); }
__device__ __forceinline__ float bfhi(unsigned w) { return __uint_as_float(w & 0xffff0000u); }

struct EpiStore {
    static constexpr bool PERM = true, AFTER_DRAIN = false;
    bf16_t* O; int ldc; const float* cs;
    __device__ __forceinline__ void operator()(const f32x4 (&acc)[2][2][4][2], const Unit& u, int wr, int wc, int fr, int fq) const {
        const int row0 = u.pm * BM + wr * 64 + fr, col0 = u.pn * BM + wc * 32 + 8 * fq;
        f32x4 sv[2][2];
#pragma unroll
        for (int bj = 0; bj < 2; ++bj)
#pragma unroll
            for (int n = 0; n < 2; ++n) sv[bj][n] = cs ? *(const f32x4*)(cs + col0 + bj * HALF + 4 * n) : (f32x4){1.f, 1.f, 1.f, 1.f};
#pragma unroll
        for (int ai = 0; ai < 2; ++ai)
#pragma unroll
            for (int m = 0; m < 4; ++m) { bf16_t* rowp = O + (size_t)(row0 + ai * HALF + m * 16) * ldc + col0;
#pragma unroll
                for (int bj = 0; bj < 2; ++bj) { const f32x4 v0 = acc[ai][bj][m][0] * sv[bj][0], v1 = acc[ai][bj][m][1] * sv[bj][1];
                    u32x4 w; w.x = cvt_pk_bf16(v0[0], v0[1]); w.y = cvt_pk_bf16(v0[2], v0[3]); w.z = cvt_pk_bf16(v1[0], v1[1]); w.w = cvt_pk_bf16(v1[2], v1[3]);
                    *(u32x4*)(rowp + bj * HALF) = w; } }
    }
};
template <bool ADD> struct EpiGate {
    static constexpr bool PERM = true, AFTER_DRAIN = false;
    bf16_t* O; int ldc; const bf16_t* G; int ldg;
    __device__ __forceinline__ void operator()(const f32x4 (&acc)[2][2][4][2], const Unit& u, int wr, int wc, int fr, int fq) const {
        const int row0 = u.pm * BM + wr * 64 + fr, col0 = u.pn * BM + wc * 32 + 8 * fq;
#pragma unroll
        for (int ai = 0; ai < 2; ++ai)
#pragma unroll
            for (int m = 0; m < 4; ++m) { const size_t row = (size_t)(row0 + ai * HALF + m * 16); bf16_t* rowp = O + row * ldc + col0; const bf16_t* gp = G + row * ldg + col0;
#pragma unroll
                for (int bj = 0; bj < 2; ++bj) { const u32x4 gw = *(const u32x4*)(gp + bj * HALF);
                    f32x4 v0 = acc[ai][bj][m][0], v1 = acc[ai][bj][m][1];
                    v0[0] *= sigmoidf_(bflo(gw.x)); v0[1] *= sigmoidf_(bfhi(gw.x)); v0[2] *= sigmoidf_(bflo(gw.y)); v0[3] *= sigmoidf_(bfhi(gw.y));
                    v1[0] *= sigmoidf_(bflo(gw.z)); v1[1] *= sigmoidf_(bfhi(gw.z)); v1[2] *= sigmoidf_(bflo(gw.w)); v1[3] *= sigmoidf_(bfhi(gw.w));
                    if (ADD) { const u32x4 ow = *(const u32x4*)(rowp + bj * HALF);
                        v0[0] += bflo(ow.x); v0[1] += bfhi(ow.x); v0[2] += bflo(ow.y); v0[3] += bfhi(ow.y);
                        v1[0] += bflo(ow.z); v1[1] += bfhi(ow.z); v1[2] += bflo(ow.w); v1[3] += bfhi(ow.w); }
                    u32x4 w; w.x = cvt_pk_bf16(v0[0], v0[1]); w.y = cvt_pk_bf16(v0[2], v0[3]); w.z = cvt_pk_bf16(v1[0], v1[1]); w.w = cvt_pk_bf16(v1[2], v1[3]);
                    *(u32x4*)(rowp + bj * HALF) = w; } }
    }
};
struct EpiResid {
    static constexpr bool PERM = false, AFTER_DRAIN = false;
    const float* Xin; float* Xout; const float* modp; int mod_bstride;
    __device__ __forceinline__ void operator()(const f32x4 (&acc)[2][2][4][2], const Unit& u, int wr, int wc, int fr, int fq) const {
        const int row0 = u.pm * BM + wr * 64 + fr, col0 = u.pn * BM + wc * 32 + 4 * fq;
        const float* gp = modp + (size_t)((u.pm * BM) >> 13) * mod_bstride;
        f32x4 gv[2][2];
#pragma unroll
        for (int bj = 0; bj < 2; ++bj)
#pragma unroll
            for (int n = 0; n < 2; ++n) gv[bj][n] = *(const f32x4*)(gp + col0 + bj * HALF + n * 16);
#pragma unroll
        for (int ai = 0; ai < 2; ++ai)
#pragma unroll
            for (int m = 0; m < 4; ++m) { const size_t off = (size_t)(row0 + ai * HALF + m * 16) * 1024 + col0;
#pragma unroll
                for (int bj = 0; bj < 2; ++bj)
#pragma unroll
                    for (int n = 0; n < 2; ++n) { const f32x4 xo = *(const f32x4*)(Xin + off + bj * HALF + n * 16);
                        *(f32x4*)(Xout + off + bj * HALF + n * 16) = xo + gv[bj][n] * acc[ai][bj][m][n]; } }
    }
};
__device__ __forceinline__ float swiglu_(float g, float u) { g = fminf(g, 7.0f); u = fminf(fmaxf(u, -7.0f), 7.0f); return (u + 1.0f) * g * sigmoidf_(g * 1.702f); }
struct EpiSwiglu {
    static constexpr bool PERM = true, AFTER_DRAIN = false;
    bf16_t* ACT; const float* bias; const int* tile_e;
    __device__ __forceinline__ void operator()(const f32x4 (&acc)[2][2][4][2], const Unit& u, int wr, int wc, int fr, int fq) const {
        const int row0 = u.pm * BM + wr * 64 + fr, col0 = u.pn * BM + wc * 32 + 8 * fq;
        const float* bp = bias + (size_t)tile_e[u.pm] * 2048;
        f32x4 bv[2][2];
#pragma unroll
        for (int bj = 0; bj < 2; ++bj)
#pragma unroll
            for (int n = 0; n < 2; ++n) bv[bj][n] = *(const f32x4*)(bp + col0 + bj * HALF + 4 * n);
#pragma unroll
        for (int ai = 0; ai < 2; ++ai)
#pragma unroll
            for (int m = 0; m < 4; ++m) { bf16_t* rowp = ACT + (size_t)(row0 + ai * HALF + m * 16) * 1024 + (col0 >> 1);
#pragma unroll
                for (int bj = 0; bj < 2; ++bj) { const f32x4 v0 = acc[ai][bj][m][0] + bv[bj][0], v1 = acc[ai][bj][m][1] + bv[bj][1];
                    typedef unsigned u32x2v __attribute__((ext_vector_type(2)));
                    u32x2v w; w.x = cvt_pk_bf16(swiglu_(v0[0], v0[1]), swiglu_(v0[2], v0[3])); w.y = cvt_pk_bf16(swiglu_(v1[0], v1[1]), swiglu_(v1[2], v1[3]));
                    *(u32x2v*)(rowp + bj * (HALF / 2)) = w; } }
    }
};
struct EpiBiasE {
    static constexpr bool PERM = true, AFTER_DRAIN = false;
    bf16_t* O; const float* bias; const int* tile_e;
    __device__ __forceinline__ void operator()(const f32x4 (&acc)[2][2][4][2], const Unit& u, int wr, int wc, int fr, int fq) const {
        const int row0 = u.pm * BM + wr * 64 + fr, col0 = u.pn * BM + wc * 32 + 8 * fq;
        const float* bp = bias + (size_t)tile_e[u.pm] * 1024;
        f32x4 bv[2][2];
#pragma unroll
        for (int bj = 0; bj < 2; ++bj)
#pragma unroll
            for (int n = 0; n < 2; ++n) bv[bj][n] = *(const f32x4*)(bp + col0 + bj * HALF + 4 * n);
#pragma unroll
        for (int ai = 0; ai < 2; ++ai)
#pragma unroll
            for (int m = 0; m < 4; ++m) { bf16_t* rowp = O + (size_t)(row0 + ai * HALF + m * 16) * 1024 + col0;
#pragma unroll
                for (int bj = 0; bj < 2; ++bj) { const f32x4 v0 = acc[ai][bj][m][0] + bv[bj][0], v1 = acc[ai][bj][m][1] + bv[bj][1];
                    u32x4 w; w.x = cvt_pk_bf16(v0[0], v0[1]); w.y = cvt_pk_bf16(v0[2], v0[3]); w.z = cvt_pk_bf16(v1[0], v1[1]); w.w = cvt_pk_bf16(v1[2], v1[3]);
                    *(u32x4*)(rowp + bj * HALF) = w; } }
    }
};
}


constexpr int NL = 4, NB = 4, SEQ = 8192, DM = 1024, NTOK = NB * SEQ;
constexpr int ZW = 4608;
constexpr int ZC_U = 0, ZC_Q = 512, ZC_KCM = 1536, ZC_VCM = 1664, ZC_KSL = 1792, ZC_VSL = 1920, ZC_KWN = 2048, ZC_VWN = 2176, ZC_MG = 2304, ZC_NG = 4352;
constexpr int IN_W = 4400;
constexpr int NEXP = 32, MOE_ROWS_MAX = (NTOK * 4 / 256 + NEXP) * 256;
constexpr int NPH_LAYER = 13, NPHASES = 2 + NL * NPH_LAYER;
enum { PH_NORM1 = 0, PH_GEMM_IN, PH_POST, PH_ATTN, PH_POOLG, PH_PROJA, PH_PROJB, PH_OUTG, PH_NORM2R, PH_SCATTER, PH_GATEUP, PH_DOWN, PH_COMBINE };

constexpr size_t alignup(size_t x) { return (x + 255) & ~(size_t)255; }
constexpr size_t WS_CTL = 0, CTL_ZERO_BYTES = 1u << 20;
constexpr size_t WS_MOD = WS_CTL + CTL_ZERO_BYTES;
constexpr size_t WS_MODP = WS_MOD + alignup((size_t)NL * NB * 6144 * 4);
constexpr size_t WS_ROPE = WS_MODP + alignup((size_t)4 * NL * NB * 6144 * 4);
constexpr size_t WS_WIN = WS_ROPE + alignup((size_t)SEQ * 16 * 4);
constexpr size_t WS_WPOOL = WS_WIN + alignup((size_t)NL * ZW * DM * 2);
constexpr size_t WS_WA = WS_WPOOL + alignup((size_t)NL * 512 * 512 * 2);
constexpr size_t WS_WB = WS_WA + alignup((size_t)NL * 1024 * 512 * 2);
constexpr size_t WS_WOUT = WS_WB + alignup((size_t)NL * 1024 * 1024 * 2);
constexpr size_t WS_W1 = WS_WOUT + alignup((size_t)NL * 1024 * 1024 * 2);
constexpr size_t WS_W2 = WS_W1 + alignup((size_t)NL * 2 * 256 * 2048 * 2);
constexpr size_t WS_WGU = WS_W2 + alignup((size_t)NL * 2 * 64 * 256 * 2);
constexpr size_t WS_WD = WS_WGU + alignup((size_t)NL * NEXP * 2048 * 1024 * 2);
constexpr size_t WS_H = WS_WD + alignup((size_t)NL * NEXP * 1024 * 1024 * 2);
constexpr size_t WS_Z = WS_H + alignup((size_t)NTOK * DM * 2);
constexpr size_t WS_QN = WS_Z + alignup((size_t)NTOK * ZW * 2);
constexpr size_t WS_KSLC = WS_QN + alignup((size_t)NTOK * DM * 2);
constexpr size_t WS_KWIN = WS_KSLC + alignup((size_t)NB * 2 * SEQ * 64 * 2);
constexpr size_t WS_VSLCT = WS_KWIN + alignup((size_t)NB * 2 * SEQ * 64 * 2);
constexpr size_t WS_VWINT = WS_VSLCT + alignup((size_t)NB * 2 * SEQ * 64 * 2);
constexpr size_t WS_KC = WS_VWINT + alignup((size_t)NB * 2 * SEQ * 64 * 2);
constexpr size_t WS_VCT = WS_KC + alignup((size_t)NB * 2 * 512 * 64 * 2);
constexpr size_t WS_PM = WS_VCT + alignup((size_t)NB * 2 * 512 * 64 * 2);
constexpr size_t WS_PP = WS_PM + alignup((size_t)NTOK * 512 * 2);
constexpr size_t WS_O = WS_PP + alignup((size_t)NTOK * 512 * 2);
constexpr size_t WS_MG = WS_O + alignup((size_t)NTOK * DM * 2);
constexpr size_t WS_TOPE = WS_MG + alignup((size_t)NTOK * DM * 2);
constexpr size_t WS_TOPW = WS_TOPE + alignup((size_t)NTOK * 4 * 4);
constexpr size_t WS_DEST = WS_TOPW + alignup((size_t)NTOK * 4 * 4);
constexpr size_t WS_CNT = WS_DEST + alignup((size_t)NTOK * 4 * 4);
constexpr size_t WS_TILEE = WS_CNT + alignup((size_t)1024 * 32 * 4);
constexpr size_t WS_HS = WS_TILEE + alignup((size_t)1024 * 4);
constexpr size_t WS_ACT = WS_HS + alignup((size_t)MOE_ROWS_MAX * 1024 * 2);
constexpr size_t WS_Y = WS_ACT + alignup((size_t)MOE_ROWS_MAX * 1024 * 2);
constexpr size_t WS_END = WS_Y + alignup((size_t)MOE_ROWS_MAX * 1024 * 2);
constexpr int CW_BAR = 4096;

constexpr int RING_BYTES = 131584;
constexpr int MISC_OFF = 135168;
constexpr int SM_OFF = 136192;
constexpr int LDS_BYTES = 147456;
constexpr int NWAVES = 8;

#define GAS __attribute__((address_space(1)))
#define LAS __attribute__((address_space(3)))
typedef unsigned short bf16;
typedef unsigned v4u __attribute__((ext_vector_type(4)));
typedef unsigned v2u __attribute__((ext_vector_type(2)));
typedef float f32x4 __attribute__((ext_vector_type(4)));
typedef short bf16x8 __attribute__((ext_vector_type(8)));
typedef GAS unsigned gu32;
#define RLX_AGENT __ATOMIC_RELAXED, __HIP_MEMORY_SCOPE_AGENT
#define LDS_WAIT() asm volatile("s_waitcnt lgkmcnt(0)" ::: "memory")
#define VM_WAIT() asm volatile("s_waitcnt vmcnt(0)" ::: "memory")
using pg8::cvt_pk_bf16; using pg8::bflo; using pg8::bfhi; using pg8::sigmoidf_;
__device__ __forceinline__ float bf2f(bf16 h) { return __uint_as_float((unsigned)h << 16); }
__device__ __forceinline__ bf16 f2bf(float f) { return (bf16)(cvt_pk_bf16(f, 0.f) & 0xffffu); }
__device__ __forceinline__ float shx(float v, int mask, int lane) { return __int_as_float(__builtin_amdgcn_ds_bpermute((lane ^ mask) << 2, __float_as_int(v))); }
__device__ __forceinline__ int shxi(int v, int mask, int lane) { return __builtin_amdgcn_ds_bpermute((lane ^ mask) << 2, v); }
__device__ __forceinline__ float shf(float v, int src) { return __int_as_float(__builtin_amdgcn_ds_bpermute(src << 2, __float_as_int(v))); }
__device__ __forceinline__ int shfi(int v, int src) { return __builtin_amdgcn_ds_bpermute(src << 2, v); }
__device__ __forceinline__ float wave_sum(float v, int lane) {
#pragma unroll
    for (int o = 1; o < 64; o <<= 1) v += shx(v, o, lane);
    return v;
}

#define XB_TMO      128
#define XB_XCNT(j)  (256  + 64 * (j))
#define XB_XSUB(j)  (1280 + 64 * (j))
#define XB_XGEN(j)  (2304 + 64 * (j))
#define XB_TOP      3328
#define XB_TOPGEN   3392
#define XCD_BAR_WORDS 3456
#define XB_SPIN_CAP (1u << 18)

__device__ __forceinline__ unsigned xb_ld(unsigned* p)              { return __hip_atomic_load(p, __ATOMIC_RELAXED, __HIP_MEMORY_SCOPE_AGENT); }
__device__ __forceinline__ unsigned xb_add(unsigned* p, unsigned v) { return __hip_atomic_fetch_add(p, v, __ATOMIC_RELAXED, __HIP_MEMORY_SCOPE_AGENT); }
__device__ __forceinline__ unsigned xb_xcc_id() { return (unsigned)__builtin_amdgcn_s_getreg((3 << 11) | 20) & 0xFu; }
#define XB_SPIN(cond, bar) do { unsigned _sp = 0; while (cond) { __builtin_amdgcn_s_sleep(1); \
    if ((++_sp & 255u) == 0u) { if (xb_ld(&(bar)[XB_TMO])) break; if (_sp > XB_SPIN_CAP) { atomicAdd(&(bar)[XB_TMO], 1u); break; } } } } while (0)

struct XcdBarrier {
    unsigned* bar; unsigned x;
    volatile LAS unsigned* st;
};

__device__ __forceinline__ XcdBarrier xcd_barrier_post(unsigned* bar, volatile LAS unsigned* st, const int tid_x  ) {
    XcdBarrier b; b.bar = bar; b.x = xb_xcc_id(); b.st = st;
    if (tid_x == 0) (void)xb_add(&bar[XB_XCNT(b.x)], 1u);
    return b;
}
__device__ __forceinline__ void xcd_barrier_complete(unsigned* bar, unsigned x, unsigned& nloc, unsigned& nx) {
    const unsigned G = gridDim.x * gridDim.y * gridDim.z;
    unsigned sum, cnt, mine, sp = 0u;
    for (;;) {
        sum = 0u; cnt = 0u; mine = 0u;
#pragma unroll
        for (unsigned j = 0; j < 16; ++j) { const unsigned c = xb_ld(&bar[XB_XCNT(j)]); sum += c; cnt += (c > 0u) ? 1u : 0u; mine = (j == x) ? c : mine; }
        if (sum == G) break;
        __builtin_amdgcn_s_sleep(1);
        if ((++sp & 255u) == 0u) { if (xb_ld(&bar[XB_TMO])) break; if (sp > XB_SPIN_CAP) { atomicAdd(&bar[XB_TMO], 1u); break; } }
    }
    nloc = mine > 0u ? mine : 1u; nx = cnt > 0u ? cnt : 1u;
}

__device__ __forceinline__ void xcd_barrier(const XcdBarrier& b, const int tid_x) {
    asm volatile("s_waitcnt vmcnt(0)" ::: "memory");
    __syncthreads();
    if (tid_x == 0) {
        unsigned* bar = b.bar;
        __builtin_amdgcn_s_waitcnt(0);
        unsigned nloc = b.st[0], nx = b.st[1];
        if (nloc == 0u) { xcd_barrier_complete(bar, b.x, nloc, nx); b.st[0] = nloc; b.st[1] = nx; }
        const unsigned old = xb_add(&bar[XB_XSUB(b.x)], 1u);
        const unsigned gen = old / nloc;
        if (old + 1u == (gen + 1u) * nloc) {
            __builtin_amdgcn_fence(__ATOMIC_RELEASE, "agent");
            asm volatile("s_waitcnt vmcnt(0)" ::: "memory");
            const unsigned og = xb_add(&bar[XB_TOP], 1u);
            const unsigned tg = og / nx;
            if (og + 1u == (tg + 1u) * nx) xb_add(&bar[XB_TOPGEN], 1u);
            else XB_SPIN(xb_ld(&bar[XB_TOPGEN]) == tg, bar);
            __builtin_amdgcn_fence(__ATOMIC_ACQUIRE, "agent");
            xb_add(&bar[XB_XGEN(b.x)], 1u);
            asm volatile("s_waitcnt vmcnt(0)" ::: "memory");
        } else {
            XB_SPIN(xb_ld(&bar[XB_XGEN(b.x)]) == gen, bar);
            __builtin_amdgcn_fence(__ATOMIC_ACQUIRE, "agent");
            asm volatile("s_waitcnt vmcnt(0)" ::: "memory");
        }
    }
    __syncthreads();
}


enum { I_X = 0, I_C, I_NORM1, I_NORM2, I_ADAW, I_ADAB, I_WIN, I_WPOOL, I_PSCALE, I_QNORM, I_KNORM, I_CMPPOS, I_CMPW1, I_CMPB1, I_CMPW2, I_WPA, I_WPB, I_WOUT,
       I_RW, I_RB, I_WGU, I_BGU, I_WD, I_BD, N_IN };
struct Args { const float* in[N_IN]; float* out; unsigned char* ws; int ph_lo, ph_hi, li, pad; };

struct Ctx {
    LAS unsigned char* lds;
    int tid, lane, wave, bx, G;
    unsigned char* ws;
};
__device__ __forceinline__ void fresh(Ctx& C) { unsigned z = 0u; asm volatile("" : "+s"(z));   int t = C.wave * 64 + (int)__builtin_amdgcn_mbcnt_hi(~0u, __builtin_amdgcn_mbcnt_lo(~0u, z)); asm volatile("" : "+v"(t)); C.tid = t; C.lane = t & 63; int bx = blockIdx.x, G = gridDim.x; asm volatile("" : "+s"(bx), "+s"(G)); C.bx = bx; C.G = G; }

__device__ __forceinline__ int inmap(int np) { return np < 2304 ? np : (np < 4352 ? np + 48 : (np < 4400 ? np - 2048 : -1)); }
template <bool MAPIN>
__device__ __forceinline__ void p0_transpose_item(const float* W, int K, int N, int NP, bf16* WT, LAS float* scr, int item, int lane) {
    const int nblk = NP / 32, kb = item / nblk, nb = item % nblk, k0 = 64 * kb, n0 = 32 * nb;
    int sc = n0 + (lane & 31); if (MAPIN) sc = inmap(sc);
#pragma unroll 8
    for (int i = 0; i < 32; ++i) { const int kk = 2 * i + (lane >> 5); scr[kk * 33 + (lane & 31)] = (sc >= 0) ? W[(size_t)(k0 + kk) * N + sc] : 0.f; }
    LDS_WAIT(); asm volatile("" ::: "memory");
    const int c = lane & 7;
#pragma unroll
    for (int j = 0; j < 4; ++j) { const int n = (lane >> 3) + 8 * j; const LAS float* s = scr + (8 * c) * 33 + n;
        v4u o; o.x = cvt_pk_bf16(s[0 * 33], s[1 * 33]); o.y = cvt_pk_bf16(s[2 * 33], s[3 * 33]); o.z = cvt_pk_bf16(s[4 * 33], s[5 * 33]); o.w = cvt_pk_bf16(s[6 * 33], s[7 * 33]);
        *(v4u*)(WT + (size_t)(n0 + n) * K + k0 + 8 * c) = o; }
    LDS_WAIT(); asm volatile("" ::: "memory");
}
__device__ __forceinline__ void p0_convert(const Ctx& C, const Args& a) {
    LAS float* scr = (LAS float*)(C.lds + C.wave * 16384);
    const int gw = C.bx * NWAVES + C.wave, NGW = C.G * NWAVES;
    constexpr int IT_IN = 16 * (ZW / 32), IT_A = 8 * 32, IT_B = 16 * 32, IT_O = 16 * 32, IT_W1 = 32 * 8, IT_W2 = 4 * 2, IT_GU = 16 * 64, IT_D = 16 * 32;
    constexpr int IT_LAYER = IT_IN + IT_A + IT_B + IT_O + 2 * IT_W1 + 2 * IT_W2 + NEXP * IT_GU + NEXP * IT_D;
    for (int it = gw; it < NL * IT_LAYER; it += NGW) {
        const int l = it / IT_LAYER; int r = it % IT_LAYER;
        if (r < IT_IN) { p0_transpose_item<true>(a.in[I_WIN] + (size_t)l * DM * IN_W, DM, IN_W, ZW, (bf16*)(C.ws + WS_WIN) + (size_t)l * ZW * DM, scr, r, C.lane); continue; } r -= IT_IN;
        if (r < IT_A) { p0_transpose_item<false>(a.in[I_WPA] + (size_t)l * 512 * 1024, 512, 1024, 1024, (bf16*)(C.ws + WS_WA) + (size_t)l * 1024 * 512, scr, r, C.lane); continue; } r -= IT_A;
        if (r < IT_B) { p0_transpose_item<false>(a.in[I_WPB] + (size_t)l * 1024 * 1024, 1024, 1024, 1024, (bf16*)(C.ws + WS_WB) + (size_t)l * 1024 * 1024, scr, r, C.lane); continue; } r -= IT_B;
        if (r < IT_O) { p0_transpose_item<false>(a.in[I_WOUT] + (size_t)l * 1024 * 1024, 1024, 1024, 1024, (bf16*)(C.ws + WS_WOUT) + (size_t)l * 1024 * 1024, scr, r, C.lane); continue; } r -= IT_O;
        if (r < 2 * IT_W1) { const int kv = r / IT_W1; p0_transpose_item<false>(a.in[I_CMPW1] + (size_t)(l * 2 + kv) * 2048 * 256, 2048, 256, 256, (bf16*)(C.ws + WS_W1) + (size_t)(l * 2 + kv) * 256 * 2048, scr, r % IT_W1, C.lane); continue; } r -= 2 * IT_W1;
        if (r < 2 * IT_W2) { const int kv = r / IT_W2; p0_transpose_item<false>(a.in[I_CMPW2] + (size_t)(l * 2 + kv) * 256 * 64, 256, 64, 64, (bf16*)(C.ws + WS_W2) + (size_t)(l * 2 + kv) * 64 * 256, scr, r % IT_W2, C.lane); continue; } r -= 2 * IT_W2;
        if (r < NEXP * IT_GU) { const int e = r / IT_GU; p0_transpose_item<false>(a.in[I_WGU] + (size_t)(l * NEXP + e) * 1024 * 2048, 1024, 2048, 2048, (bf16*)(C.ws + WS_WGU) + (size_t)(l * NEXP + e) * 2048 * 1024, scr, r % IT_GU, C.lane); continue; } r -= NEXP * IT_GU;
        { const int e = r / IT_D; p0_transpose_item<false>(a.in[I_WD] + (size_t)(l * NEXP + e) * 1024 * 1024, 1024, 1024, 1024, (bf16*)(C.ws + WS_WD) + (size_t)(l * NEXP + e) * 1024 * 1024, scr, r % IT_D, C.lane); }
    }
    const int gt = C.bx * (NWAVES * 64) + C.tid, NGT = C.G * NWAVES * 64;
    { bf16* wp = (bf16*)(C.ws + WS_WPOOL);
      for (int i = gt; i < NL * 512 * 512; i += NGT) { const int l = i >> 18, ep = (i >> 9) & 511, cp = i & 511; float v = 0.f;
          if ((ep >> 7) == (cp >> 7)) v = a.in[I_WPOOL][(((size_t)l * 4 + (ep >> 7)) * 128 + (cp & 127)) * 128 + (ep & 127)];
          wp[i] = f2bf(v); } }
    { float* rp = (float*)(C.ws + WS_ROPE);
      for (int i = gt; i < SEQ * 8; i += NGT) { const int pos = i >> 3, fi = i & 7;
          const float invf[8] = {1.0f, 0.1939227432012558f, 0.03760603070259094f, 0.007292664609849453f, 0.0014142135623842478f, 0.00027424818836152554f, 5.318296098266728e-05f, 1.0313386155758053e-05f};
          float f = invf[0];
#pragma unroll
          for (int q = 1; q < 8; ++q) f = (fi == q) ? invf[q] : f;
          const float ang = (float)pos * f; const double rev = (double)ang * 0.15915494309189535; const float fr = (float)(rev - __builtin_rint(rev));
          rp[pos * 16 + fi] = __builtin_amdgcn_cosf(fr); rp[pos * 16 + 8 + fi] = __builtin_amdgcn_sinf(fr); } }
    __syncthreads();
    { LAS float* sc = (LAS float*)C.lds;
      for (int i = C.tid; i < NB * DM; i += NWAVES * 64) { const float cv = a.in[I_C][i]; sc[i] = cv * sigmoidf_(cv); }
      __syncthreads();
      float* mp = (float*)(C.ws + WS_MODP);
      for (int i = gt; i < 4 * NL * 6144; i += NGT) { const int j = i % 6144, l = (i / 6144) % NL, ks = i / (6144 * NL);
          const float* w = a.in[I_ADAW] + ((size_t)l * DM + ks * 256) * 6144 + j; float a0 = 0.f, a1 = 0.f, a2 = 0.f, a3 = 0.f;
#pragma unroll 8
          for (int k = 0; k < 256; ++k) { const float wv = w[(size_t)k * 6144]; const int kk = ks * 256 + k;
              a0 += sc[kk] * wv; a1 += sc[DM + kk] * wv; a2 += sc[2 * DM + kk] * wv; a3 += sc[3 * DM + kk] * wv; }
          float* o = mp + ((size_t)(ks * NL + l) * NB) * 6144 + j; o[0] = a0; o[6144] = a1; o[2 * 6144] = a2; o[3 * 6144] = a3; }
      __syncthreads(); }
}
__device__ __forceinline__ void p1_mod(const Ctx& C, const Args& a) {
    const int gt = C.bx * (NWAVES * 64) + C.tid, NGT = C.G * NWAVES * 64;
    const float* mp = (const float*)(C.ws + WS_MODP); float* mo = (float*)(C.ws + WS_MOD);
    for (int i = gt; i < NL * NB * 6144; i += NGT) { const int j = i % 6144, l = i / (NB * 6144);
        float s = a.in[I_ADAB][l * 6144 + j];
#pragma unroll
        for (int ks = 0; ks < 4; ++ks) s += mp[(size_t)ks * NL * NB * 6144 + i];
        mo[i] = s; }
}


__device__ __forceinline__ void norm_rows(const Ctx& C, const float* X, const float* gain, const float* mod_l  , int shift_i, int scale_i, bf16* H) {
    const int gw = C.bx * NWAVES + C.wave, NGW = C.G * NWAVES;
    for (int m = gw; m < NTOK; m += NGW) {
        const int b = m >> 13; const f32x4* xr = (const f32x4*)(X + (size_t)m * DM) + C.lane;
        f32x4 v[4]; float s = 0.f;
#pragma unroll
        for (int j = 0; j < 4; ++j) { v[j] = xr[64 * j]; s += (v[j].x * v[j].x + v[j].y * v[j].y) + (v[j].z * v[j].z + v[j].w * v[j].w); }
        const float rstd = 1.0f / sqrtf(wave_sum(s, C.lane) * (1.0f / DM) + 1e-6f);
        const float* mb = mod_l + (size_t)b * 6144; v2u* o8 = (v2u*)(H + (size_t)m * DM) + C.lane;
#pragma unroll
        for (int j = 0; j < 4; ++j) { const int col = 4 * C.lane + 256 * j;
            const f32x4 g = *(const f32x4*)(gain + col), sc = *(const f32x4*)(mb + scale_i * DM + col), sh = *(const f32x4*)(mb + shift_i * DM + col);
            const f32x4 h = v[j] * rstd * g * (sc + 1.0f) + sh;
            v2u w; w.x = cvt_pk_bf16(h.x, h.y); w.y = cvt_pk_bf16(h.z, h.w); o8[64 * j] = w; }
    }
}

__device__ __forceinline__ void post_tokens(const Ctx& C, const Args& a, int l) {
    const int gw = C.bx * NWAVES + C.wave, NGW = C.G * NWAVES, lane = C.lane;
    const bf16* Z = (const bf16*)(C.ws + WS_Z); const float* rope = (const float*)(C.ws + WS_ROPE);
    bf16* Qn = (bf16*)(C.ws + WS_QN); bf16* Kslc = (bf16*)(C.ws + WS_KSLC); bf16* Kwin = (bf16*)(C.ws + WS_KWIN); bf16* Pm = (bf16*)(C.ws + WS_PM);
    const float* qn = a.in[I_QNORM] + l * 64; const float* kn = a.in[I_KNORM] + l * 192;
    for (int m = gw; m < NTOK; m += NGW) {
        const int b = m >> 13, t = m & (SEQ - 1); const bf16* zr = Z + (size_t)m * ZW; const float* rp = rope + t * 16;
        { const int head = lane >> 2, dq = (lane & 3) * 16; const v4u w0 = *(const v4u*)(zr + ZC_Q + head * 64 + dq), w1 = *(const v4u*)(zr + ZC_Q + head * 64 + dq + 8);
          float y[16]; y[0] = bflo(w0.x); y[1] = bfhi(w0.x); y[2] = bflo(w0.y); y[3] = bfhi(w0.y); y[4] = bflo(w0.z); y[5] = bfhi(w0.z); y[6] = bflo(w0.w); y[7] = bfhi(w0.w);
          y[8] = bflo(w1.x); y[9] = bfhi(w1.x); y[10] = bflo(w1.y); y[11] = bfhi(w1.y); y[12] = bflo(w1.z); y[13] = bfhi(w1.z); y[14] = bflo(w1.w); y[15] = bfhi(w1.w);
          float s = 0.f;
#pragma unroll
          for (int i = 0; i < 16; ++i) s += y[i] * y[i];
          s += shx(s, 1, lane); s += shx(s, 2, lane);
          const float rstd = 1.0f / sqrtf(s * (1.0f / 64.0f) + 1e-6f);
#pragma unroll
          for (int i = 0; i < 16; ++i) y[i] = y[i] * rstd * qn[dq + i];
          if ((lane & 3) == 0) {
#pragma unroll
              for (int i = 0; i < 8; ++i) { const float c = rp[i], sn = rp[8 + i], x1 = y[i], x2 = y[8 + i]; y[i] = x1 * c - x2 * sn; y[8 + i] = x2 * c + x1 * sn; } }
          v4u o0, o1; o0.x = cvt_pk_bf16(y[0], y[1]); o0.y = cvt_pk_bf16(y[2], y[3]); o0.z = cvt_pk_bf16(y[4], y[5]); o0.w = cvt_pk_bf16(y[6], y[7]);
          o1.x = cvt_pk_bf16(y[8], y[9]); o1.y = cvt_pk_bf16(y[10], y[11]); o1.z = cvt_pk_bf16(y[12], y[13]); o1.w = cvt_pk_bf16(y[14], y[15]);
          bf16* qo = Qn + (size_t)m * DM + head * 64 + dq; *(v4u*)qo = o0; *(v4u*)(qo + 8) = o1; }
        { const int which = lane >> 4, g = which & 1, li = lane & 15, dk = li * 4; const int sec = (which < 2) ? ZC_KSL : ZC_KWN;
          const v2u w = *(const v2u*)(zr + sec + g * 64 + dk); float y[4] = {bflo(w.x), bfhi(w.x), bflo(w.y), bfhi(w.y)};
          float s = y[0] * y[0] + y[1] * y[1] + y[2] * y[2] + y[3] * y[3];
          s += shx(s, 1, lane); s += shx(s, 2, lane); s += shx(s, 4, lane); s += shx(s, 8, lane);
          const float rstd = 1.0f / sqrtf(s * (1.0f / 64.0f) + 1e-6f); const float* gk = kn + ((which < 2) ? 64 : 128) + dk;
#pragma unroll
          for (int i = 0; i < 4; ++i) y[i] = y[i] * rstd * gk[i];
          float pz[4];
#pragma unroll
          for (int i = 0; i < 4; ++i) pz[i] = shx(y[i], 2, lane);
          if (li < 4) { const int fi = (li & 1) * 4;
#pragma unroll
              for (int i = 0; i < 4; ++i) { const float c = rp[fi + i], sn = rp[8 + fi + i]; y[i] = (li < 2) ? (y[i] * c - pz[i] * sn) : (y[i] * c + pz[i] * sn); } }
          v2u o; o.x = cvt_pk_bf16(y[0], y[1]); o.y = cvt_pk_bf16(y[2], y[3]);
          bf16* ko = ((which < 2) ? Kslc : Kwin) + ((size_t)(b * 2 + g) * SEQ + t) * 64 + dk; *(v2u*)ko = o; }
        { const int ch = lane * 8, w = 2 << (lane >> 4), cnt = (t + 1 < w) ? (t + 1) : w; float sum[8] = {0.f, 0.f, 0.f, 0.f, 0.f, 0.f, 0.f, 0.f}; float self[8];
          for (int k = 0; k < cnt; ++k) { const v4u u = *(const v4u*)(zr - (size_t)k * ZW + ZC_U + ch);
              const float f[8] = {bflo(u.x), bfhi(u.x), bflo(u.y), bfhi(u.y), bflo(u.z), bfhi(u.z), bflo(u.w), bfhi(u.w)};
#pragma unroll
              for (int i = 0; i < 8; ++i) { sum[i] += f[i]; if (k == 0) self[i] = f[i]; } }
          const float inv = 1.0f / (float)cnt; v4u o;
          o.x = cvt_pk_bf16(sum[0] * inv - self[0], sum[1] * inv - self[1]); o.y = cvt_pk_bf16(sum[2] * inv - self[2], sum[3] * inv - self[3]);
          o.z = cvt_pk_bf16(sum[4] * inv - self[4], sum[5] * inv - self[5]); o.w = cvt_pk_bf16(sum[6] * inv - self[6], sum[7] * inv - self[7]);
          *(v4u*)(Pm + (size_t)m * 512 + ch) = o; }
    }
    { bf16* VsT = (bf16*)(C.ws + WS_VSLCT); bf16* VwT = (bf16*)(C.ws + WS_VWINT);
      for (int it = gw; it < 2 * NB * 2 * (SEQ / 64); it += NGW) { const int tt = it & 127, g = (it >> 7) & 1, b = (it >> 8) & 3, which = it >> 10;
          const bf16* src = Z + ((size_t)(b * SEQ + tt * 64 + lane)) * ZW + (which ? ZC_VWN : ZC_VSL) + g * 64;
          bf16* dst = (which ? VwT : VsT) + ((size_t)(b * 2 + g) * 64) * SEQ + tt * 64 + lane;
#pragma unroll
          for (int c = 0; c < 8; ++c) { const v4u u = *(const v4u*)(src + 8 * c); bf16* d = dst + (size_t)(8 * c) * SEQ;
              d[0] = (bf16)(u.x & 0xffff); d[SEQ] = (bf16)(u.x >> 16); d[2 * SEQ] = (bf16)(u.y & 0xffff); d[3 * SEQ] = (bf16)(u.y >> 16);
              d[4 * SEQ] = (bf16)(u.z & 0xffff); d[5 * SEQ] = (bf16)(u.z >> 16); d[6 * SEQ] = (bf16)(u.w & 0xffff); d[7 * SEQ] = (bf16)(u.w >> 16); } } }
}

__device__ __forceinline__ void compress_unit(const Ctx& C, const Args& a, int l, int u) {
    const int kv = u & 1, nt = (u >> 1) & 31, bg = u >> 6, b = bg >> 1, g = bg & 1, n0 = nt * 16;
    const int lane = C.lane, r16 = lane & 15, quad = lane >> 4, w = C.wave;
    const bf16* Z = (const bf16*)(C.ws + WS_Z);
    const bf16* W1t = (const bf16*)(C.ws + WS_W1) + (size_t)(l * 2 + kv) * 256 * 2048;
    const bf16* W2t = (const bf16*)(C.ws + WS_W2) + (size_t)(l * 2 + kv) * 64 * 256;
    const float* pos = a.in[I_CMPPOS] + (size_t)(l * 2 + kv) * 32 * 64;
    const float* b1 = a.in[I_CMPB1] + (size_t)(l * 2 + kv) * 256;
    LAS bf16* hidL = (LAS bf16*)C.lds;
    LAS float* outL = (LAS float*)(C.lds + 16 * 264 * 2);
    const int nl = (n0 + r16 > 510) ? 510 : (n0 + r16);
    const bf16* arow = Z + ((size_t)(b * SEQ + 16 * nl)) * ZW + (kv ? ZC_VCM : ZC_KCM) + g * 64;
    f32x4 acc0 = {0.f, 0.f, 0.f, 0.f}, acc1 = {0.f, 0.f, 0.f, 0.f};
    const bf16* wb0 = W1t + (size_t)(32 * w + r16) * 2048 + quad * 8; const bf16* wb1 = wb0 + (size_t)16 * 2048;
#pragma unroll 4
    for (int ks = 0; ks < 64; ++ks) { const int lrow = ks >> 1, d = (ks & 1) * 32 + quad * 8;
        const v4u zv = *(const v4u*)(arow + (size_t)lrow * ZW + d); const f32x4 p0 = *(const f32x4*)(pos + lrow * 64 + d), p1 = *(const f32x4*)(pos + lrow * 64 + d + 4);
        v4u av; av.x = cvt_pk_bf16(bflo(zv.x) + p0.x, bfhi(zv.x) + p0.y); av.y = cvt_pk_bf16(bflo(zv.y) + p0.z, bfhi(zv.y) + p0.w);
        av.z = cvt_pk_bf16(bflo(zv.z) + p1.x, bfhi(zv.z) + p1.y); av.w = cvt_pk_bf16(bflo(zv.w) + p1.z, bfhi(zv.w) + p1.w);
        const bf16x8 af = __builtin_bit_cast(bf16x8, av);
        const bf16x8 bf0 = *(const bf16x8*)(wb0 + ks * 32), bf1 = *(const bf16x8*)(wb1 + ks * 32);
        acc0 = __builtin_amdgcn_mfma_f32_16x16x32_bf16(af, bf0, acc0, 0, 0, 0);
        acc1 = __builtin_amdgcn_mfma_f32_16x16x32_bf16(af, bf1, acc1, 0, 0, 0); }
    { const float bb0 = b1[32 * w + r16], bb1 = b1[32 * w + 16 + r16];
#pragma unroll
      for (int r = 0; r < 4; ++r) { float h0 = acc0[r] + bb0, h1 = acc1[r] + bb1; h0 = h0 * sigmoidf_(h0); h1 = h1 * sigmoidf_(h1);
          hidL[(4 * quad + r) * 264 + 32 * w + r16] = f2bf(h0); hidL[(4 * quad + r) * 264 + 32 * w + 16 + r16] = f2bf(h1); } }
    __syncthreads();
    if (w < 4) { f32x4 o = {0.f, 0.f, 0.f, 0.f}; const bf16* w2 = W2t + (size_t)(16 * w + r16) * 256 + quad * 8;
#pragma unroll
        for (int ks = 0; ks < 8; ++ks) { const bf16x8 af = *(const LAS bf16x8*)(hidL + r16 * 264 + ks * 32 + quad * 8); const bf16x8 bfr = *(const bf16x8*)(w2 + ks * 32);
            o = __builtin_amdgcn_mfma_f32_16x16x32_bf16(af, bfr, o, 0, 0, 0); }
#pragma unroll
        for (int r = 0; r < 4; ++r) outL[(4 * quad + r) * 68 + 16 * w + r16] = o[r]; }
    __syncthreads();
    if (w == 0) { const int i = lane >> 2, c0 = (lane & 3) * 16, n = n0 + i; float y[16];
#pragma unroll
        for (int j = 0; j < 16; ++j) y[j] = outL[i * 68 + c0 + j];
        if (kv == 0) { float s = 0.f;
#pragma unroll
            for (int j = 0; j < 16; ++j) s += y[j] * y[j];
            s += shx(s, 1, lane); s += shx(s, 2, lane);
            const float rstd = 1.0f / sqrtf(s * (1.0f / 64.0f) + 1e-6f); const float* gk = a.in[I_KNORM] + l * 192 + c0;
#pragma unroll
            for (int j = 0; j < 16; ++j) y[j] = y[j] * rstd * gk[j];
            if ((lane & 3) == 0 && n <= 510) { const float* rp = (const float*)(C.ws + WS_ROPE) + (16 * n + 31) * 16;
#pragma unroll
                for (int j = 0; j < 8; ++j) { const float c = rp[j], sn = rp[8 + j], x1 = y[j], x2 = y[8 + j]; y[j] = x1 * c - x2 * sn; y[8 + j] = x2 * c + x1 * sn; } }
            if (n > 510) {
#pragma unroll
                for (int j = 0; j < 16; ++j) y[j] = 0.f; }
            v4u o0, o1; o0.x = cvt_pk_bf16(y[0], y[1]); o0.y = cvt_pk_bf16(y[2], y[3]); o0.z = cvt_pk_bf16(y[4], y[5]); o0.w = cvt_pk_bf16(y[6], y[7]);
            o1.x = cvt_pk_bf16(y[8], y[9]); o1.y = cvt_pk_bf16(y[10], y[11]); o1.z = cvt_pk_bf16(y[12], y[13]); o1.w = cvt_pk_bf16(y[14], y[15]);
            bf16* ko = (bf16*)(C.ws + WS_KC) + ((size_t)bg * 512 + n) * 64 + c0; *(v4u*)ko = o0; *(v4u*)(ko + 8) = o1;
        } else { bf16* vo = (bf16*)(C.ws + WS_VCT) + ((size_t)bg * 64 + c0) * 512 + n;
#pragma unroll
            for (int j = 0; j < 16; ++j) vo[(size_t)j * 512] = (n > 510) ? (bf16)0 : f2bf(y[j]); } }
    __syncthreads();
}


#define MFMA16(a, b, c) __builtin_amdgcn_mfma_f32_16x16x32_bf16(a, b, c, 0, 0, 0)
__device__ __forceinline__ bf16x8 pack_p(const f32x4& p0, const f32x4& p1) {
    v4u w; w.x = cvt_pk_bf16(p0[0], p0[1]); w.y = cvt_pk_bf16(p0[2], p0[3]); w.z = cvt_pk_bf16(p1[0], p1[1]); w.w = cvt_pk_bf16(p1[2], p1[3]); return __builtin_bit_cast(bf16x8, w);
}
__device__ __forceinline__ bf16x8 load_vt(const bf16* p) {
    const v2u lo = *(const v2u*)p, hi = *(const v2u*)(p + 16); v4u w; w.x = lo.x; w.y = lo.y; w.z = hi.x; w.w = hi.y; return __builtin_bit_cast(bf16x8, w);
}
constexpr float SM_SCALE = 0.125f * 1.4426950408889634f;

template <int NT, class Valid>
__device__ __forceinline__ void softmax_pv_step(f32x4 (&st)[NT], const Valid& valid, float& mrun, float& lrun, f32x4 (&o)[4], const bf16* vt, size_t vpitch, int key0, int r16, int quad) {
    const int lane = quad * 16 + r16;
    float bmax = -1e30f;
#pragma unroll
    for (int i = 0; i < NT; ++i)
#pragma unroll
        for (int r = 0; r < 4; ++r) { const bool ok = valid(key0 + 16 * i + 4 * quad + r); bmax = ok ? fmaxf(bmax, st[i][r]) : bmax; }
    bmax = fmaxf(bmax, shx(bmax, 16, lane)); bmax = fmaxf(bmax, shx(bmax, 32, lane));
    const float mnew = fmaxf(mrun, bmax), alpha = __builtin_amdgcn_exp2f((mrun - mnew) * SM_SCALE);
    float ps = 0.f;
#pragma unroll
    for (int i = 0; i < NT; ++i)
#pragma unroll
        for (int r = 0; r < 4; ++r) { const bool ok = valid(key0 + 16 * i + 4 * quad + r); const float pv = ok ? __builtin_amdgcn_exp2f((st[i][r] - mnew) * SM_SCALE) : 0.f; st[i][r] = pv; ps += pv; }
    ps += shx(ps, 16, lane); ps += shx(ps, 32, lane);
    lrun = lrun * alpha + ps; mrun = mnew;
#pragma unroll
    for (int db = 0; db < 4; ++db) o[db] = o[db] * alpha;
#pragma unroll
    for (int j = 0; j < NT / 2; ++j) { const bf16x8 pb = pack_p(st[2 * j], st[2 * j + 1]);
#pragma unroll
        for (int db = 0; db < 4; ++db) { const bf16x8 va = load_vt(vt + (size_t)(16 * db + r16) * vpitch + key0 + 32 * j + 4 * quad); o[db] = MFMA16(va, pb, o[db]); } }
}

__device__ __forceinline__ void attn_item(const Ctx& C, int b, int g, int t0) {
    const int lane = C.lane, r16 = lane & 15, quad = lane >> 4, tokc = r16 >> 3, head = r16 & 7, tl = t0 + tokc, bg = b * 2 + g;
    const bf16* Qn = (const bf16*)(C.ws + WS_QN); const bf16* Z = (const bf16*)(C.ws + WS_Z);
    f32x4 oc[4]; unsigned m0 = 0u, m1 = 0u, m2 = 0u, m3 = 0u;
    {
        const bf16* qrow = Qn + ((size_t)(b * SEQ + tl)) * DM + (g * 8 + head) * 64;
        const bf16x8 qf0 = *(const bf16x8*)(qrow + quad * 8), qf1 = *(const bf16x8*)(qrow + 32 + quad * 8);
        const int nv_l = (tl >= 31) ? (((tl - 31) >> 4) + 1) : 0;
        const int nv_max = (t0 + 1 >= 31) ? (((t0 + 1 - 31) >> 4) + 1) : 0;
        const int ntile = (nv_max + 15) >> 4;
        const bf16* kc = (const bf16*)(C.ws + WS_KC) + (size_t)bg * 512 * 64;
        const bf16* vct = (const bf16*)(C.ws + WS_VCT) + (size_t)bg * 64 * 512;
        float mx = -1e30f, ls = 0.f;
        for (int i = 0; i < ntile; ++i) { const bf16* kp = kc + (size_t)(16 * i + r16) * 64 + quad * 8; const bf16x8 k0 = *(const bf16x8*)kp, k1 = *(const bf16x8*)(kp + 32);
            f32x4 acc = {0.f, 0.f, 0.f, 0.f}; acc = MFMA16(k0, qf0, acc); acc = MFMA16(k1, qf1, acc);
            float bm = mx;
#pragma unroll
            for (int r = 0; r < 4; ++r) { const bool ok = (16 * i + 4 * quad + r) < nv_l; bm = ok ? fmaxf(bm, acc[r]) : bm; }
            float ps = 0.f;
#pragma unroll
            for (int r = 0; r < 4; ++r) { const bool ok = (16 * i + 4 * quad + r) < nv_l; ps += ok ? __builtin_amdgcn_exp2f((acc[r] - bm) * SM_SCALE) : 0.f; }
            ls = ls * __builtin_amdgcn_exp2f((mx - bm) * SM_SCALE) + ps; mx = bm; }
        { float mall = fmaxf(mx, shx(mx, 16, lane)); mall = fmaxf(mall, shx(mall, 32, lane));
          ls = ls * __builtin_amdgcn_exp2f((mx - mall) * SM_SCALE); ls += shx(ls, 16, lane); ls += shx(ls, 32, lane); mx = mall; }
        const float inv = (ls > 0.f) ? 1.0f / ls : 0.f;
#pragma unroll
        for (int db = 0; db < 4; ++db) oc[db] = (f32x4){0.f, 0.f, 0.f, 0.f};
        LAS float* impL = (LAS float*)(C.lds + C.wave * 1024);
        *(LAS f32x4*)(impL + 4 * lane) = (f32x4){0.f, 0.f, 0.f, 0.f};
        LDS_WAIT();
        float prev_up = 0.f; const int npair = (ntile + 1) >> 1;
        for (int j = 0; j < npair; ++j) {
            f32x4 st[2];
#pragma unroll
            for (int h = 0; h < 2; ++h) { const bf16* kp = kc + (size_t)(32 * j + 16 * h + r16) * 64 + quad * 8; const bf16x8 k0 = *(const bf16x8*)kp, k1 = *(const bf16x8*)(kp + 32);
                f32x4 acc = {0.f, 0.f, 0.f, 0.f}; acc = MFMA16(k0, qf0, acc); acc = MFMA16(k1, qf1, acc);
#pragma unroll
                for (int r = 0; r < 4; ++r) { const bool ok = (32 * j + 16 * h + 4 * quad + r) < nv_l; acc[r] = ok ? __builtin_amdgcn_exp2f((acc[r] - mx) * SM_SCALE) * inv : 0.f; }
                st[h] = acc; }
            const bf16x8 pb = pack_p(st[0], st[1]);
#pragma unroll
            for (int db = 0; db < 4; ++db) { const bf16x8 va = load_vt(vct + (size_t)(16 * db + r16) * 512 + 32 * j + 4 * quad); oc[db] = MFMA16(va, pb, oc[db]); }
#pragma unroll
            for (int h = 0; h < 2; ++h) { float h3 = st[h][3], hs = (st[h][0] + st[h][1]) + (st[h][2] + st[h][3]);
                hs += shx(hs, 1, lane); hs += shx(hs, 2, lane); hs += shx(hs, 4, lane);
                h3 += shx(h3, 1, lane); h3 += shx(h3, 2, lane); h3 += shx(h3, 4, lane);
                const float up = shf(h3, (lane + 48) & 63);
                const float val = hs + ((quad == 0) ? prev_up : up); prev_up = up;
                if (head == 0) impL[tokc * 128 + 4 * (2 * j + h) + quad] = val; }
        }
        if (2 * npair < 32 && head == 0 && quad == 0) impL[tokc * 128 + 8 * npair] = prev_up;
        LDS_WAIT();
        float vals[32];
#pragma unroll
        for (int i = 0; i < 32; ++i) vals[i] = impL[tokc * 128 + 4 * i + quad];
        const int cur_l = tl >> 6;
#pragma unroll
        for (int i = 0; i < 32; ++i) { const int s = 4 * i + quad; float v = vals[i]; v = (s > cur_l) ? -1.0f : v; v = (s == 0 || s == cur_l) ? 1e9f : v; vals[i] = v; }
        for (int round = 0; round < 16; ++round) {
            float bv = vals[0]; int bi = 0;
#pragma unroll
            for (int i = 1; i < 32; ++i) { const bool gt = vals[i] > bv; bv = gt ? vals[i] : bv; bi = gt ? i : bi; }
            int bs = 4 * bi + quad;
#pragma unroll
            for (int off = 16; off <= 32; off <<= 1) { const float ov = shx(bv, off, lane); const int os = shxi(bs, off, lane); const bool take = (ov > bv) || (ov == bv && os < bs); bv = take ? ov : bv; bs = take ? os : bs; }
            const bool mine = (bs & 3) == quad; const int bi2 = bs >> 2;
#pragma unroll
            for (int i = 0; i < 32; ++i) vals[i] = (mine && i == bi2) ? -3.0f : vals[i];
            const unsigned bit = 1u << (bs & 31); const int wd = bs >> 5;
            m0 |= (wd == 0) ? bit : 0u; m1 |= (wd == 1) ? bit : 0u; m2 |= (wd == 2) ? bit : 0u; m3 |= (wd == 3) ? bit : 0u;
        }
    }
    f32x4 os0[4], os1[4]; float ls0 = 1.f, ls1 = 1.f;
    const bf16* ksl = (const bf16*)(C.ws + WS_KSLC) + (size_t)bg * SEQ * 64;
    const bf16* vst = (const bf16*)(C.ws + WS_VSLCT) + (size_t)bg * 64 * SEQ;
#pragma unroll
    for (int tk = 0; tk < 2; ++tk) {
        const int t = t0 + tk, cur = t >> 6;
        const bf16* qrow = Qn + ((size_t)(b * SEQ + t)) * DM + (g * 8 + head) * 64;
        const bf16x8 qs0 = *(const bf16x8*)(qrow + quad * 8), qs1 = *(const bf16x8*)(qrow + 32 + quad * 8);
        unsigned wmask[4] = {(unsigned)__builtin_amdgcn_readlane((int)m0, tk * 8), (unsigned)__builtin_amdgcn_readlane((int)m1, tk * 8),
                             (unsigned)__builtin_amdgcn_readlane((int)m2, tk * 8), (unsigned)__builtin_amdgcn_readlane((int)m3, tk * 8)};
        f32x4 o[4];
#pragma unroll
        for (int db = 0; db < 4; ++db) o[db] = (f32x4){0.f, 0.f, 0.f, 0.f};
        float mrun = -1e30f, lrun = 0.f;
#pragma unroll
        for (int wd = 0; wd < 4; ++wd) { unsigned word = wmask[wd];
            while (word) { const int bit = __builtin_ctz(word); word &= word - 1u; const int s = wd * 32 + bit; if (s > cur) break;
                f32x4 st[4];
#pragma unroll
                for (int i = 0; i < 4; ++i) { const bf16* kp = ksl + (size_t)(64 * s + 16 * i + r16) * 64 + quad * 8; const bf16x8 k0 = *(const bf16x8*)kp, k1 = *(const bf16x8*)(kp + 32);
                    f32x4 acc = {0.f, 0.f, 0.f, 0.f}; acc = MFMA16(k0, qs0, acc); acc = MFMA16(k1, qs1, acc); st[i] = acc; }
                softmax_pv_step<4>(st, [t](int key) { return key <= t; }, mrun, lrun, o, vst, (size_t)SEQ, 64 * s, r16, quad);
            } }
        if (tk == 0) { ls0 = lrun;
#pragma unroll
            for (int db = 0; db < 4; ++db) os0[db] = o[db]; }
        else { ls1 = lrun;
#pragma unroll
            for (int db = 0; db < 4; ++db) os1[db] = o[db]; }
    }
    f32x4 ow[4]; float lw = 1.f;
    {
        const bf16* qrow = Qn + ((size_t)(b * SEQ + tl)) * DM + (g * 8 + head) * 64;
        const bf16x8 qf0 = *(const bf16x8*)(qrow + quad * 8), qf1 = *(const bf16x8*)(qrow + 32 + quad * 8);
        const bf16* kwn = (const bf16*)(C.ws + WS_KWIN) + (size_t)bg * SEQ * 64;
        const bf16* vwt = (const bf16*)(C.ws + WS_VWINT) + (size_t)bg * 64 * SEQ;
#pragma unroll
        for (int db = 0; db < 4; ++db) ow[db] = (f32x4){0.f, 0.f, 0.f, 0.f};
        float mrun = -1e30f, lrun = 0.f;
        const int klo = ((t0 - 511 > 0) ? (t0 - 511) : 0) & ~31;
        for (int k0 = klo; k0 <= t0 + 1; k0 += 32) {
            f32x4 st[2];
#pragma unroll
            for (int i = 0; i < 2; ++i) { const bf16* kp = kwn + (size_t)(k0 + 16 * i + r16) * 64 + quad * 8; const bf16x8 ka = *(const bf16x8*)kp, kb = *(const bf16x8*)(kp + 32);
                f32x4 acc = {0.f, 0.f, 0.f, 0.f}; acc = MFMA16(ka, qf0, acc); acc = MFMA16(kb, qf1, acc); st[i] = acc; }
            softmax_pv_step<2>(st, [tl](int key) { return key <= tl && key + 511 >= tl; }, mrun, lrun, ow, vwt, (size_t)SEQ, k0, r16, quad);
        }
        lw = lrun;
    }
    {
        const bf16* zg = Z + ((size_t)(b * SEQ + tl)) * ZW + ZC_NG + g * 8 + head;
        const float g0 = sigmoidf_(bf2f(zg[0])), g1 = sigmoidf_(bf2f(zg[16])) / (tokc ? ls1 : ls0), g2 = sigmoidf_(bf2f(zg[32])) / lw;
        bf16* orow = (bf16*)(C.ws + WS_O) + ((size_t)(b * SEQ + tl)) * DM + (g * 8 + head) * 64 + 4 * quad;
#pragma unroll
        for (int db = 0; db < 4; ++db) { const f32x4 osl = tokc ? os1[db] : os0[db]; const f32x4 v = oc[db] * g0 + osl * g1 + ow[db] * g2;
            v2u w; w.x = cvt_pk_bf16(v[0], v[1]); w.y = cvt_pk_bf16(v[2], v[3]); *(v2u*)(orow + 16 * db) = w; }
    }
}
__device__ __forceinline__ void attn_phase(const Ctx& C) {
    const int bgi = C.bx & 7, b = bgi >> 1, g = bgi & 1;
    for (int pair = (C.bx >> 3) * NWAVES + C.wave; pair < SEQ / 2; pair += (C.G >> 3) * NWAVES) attn_item(C, b, g, 2 * pair);
}


constexpr int RW_PITCH = 1028;
__device__ __forceinline__ void norm2_router(const Ctx& C, const Args& a, int l) {
    LAS float* rw = (LAS float*)C.lds; LAS int* hist = (LAS int*)(C.lds + SM_OFF);
    const float* rwg = a.in[I_RW] + (size_t)l * DM * NEXP;
    for (int i = C.tid; i < DM * NEXP; i += NWAVES * 64) rw[(i & 31) * RW_PITCH + (i >> 5)] = rwg[i];
    if (C.tid < 32) hist[C.tid] = 0;
    __syncthreads();
    const float* X = a.out; const float* gain = a.in[I_NORM2] + l * DM; const float* mod_l = (const float*)(C.ws + WS_MOD) + (size_t)l * NB * 6144;
    const float* rb = a.in[I_RB] + l * NEXP; bf16* H = (bf16*)(C.ws + WS_H);
    int* tope = (int*)(C.ws + WS_TOPE); float* topw = (float*)(C.ws + WS_TOPW);
    const int lane = C.lane;
    for (int i = 0; i < 16; ++i) {
        const int m = C.bx * 128 + C.wave * 16 + i, b = m >> 13; const f32x4* xr = (const f32x4*)(X + (size_t)m * DM) + lane;
        f32x4 v[4]; float s = 0.f;
#pragma unroll
        for (int j = 0; j < 4; ++j) { v[j] = xr[64 * j]; s += (v[j].x * v[j].x + v[j].y * v[j].y) + (v[j].z * v[j].z + v[j].w * v[j].w); }
        const float rstd = 1.0f / sqrtf(wave_sum(s, lane) * (1.0f / DM) + 1e-6f);
        const float* mb = mod_l + (size_t)b * 6144; v2u* o8 = (v2u*)(H + (size_t)m * DM) + lane;
#pragma unroll
        for (int j = 0; j < 4; ++j) { const int col = 4 * lane + 256 * j;
            const f32x4 gn = *(const f32x4*)(gain + col), sc = *(const f32x4*)(mb + 4 * DM + col), sh = *(const f32x4*)(mb + 3 * DM + col);
            v[j] = v[j] * rstd * gn * (sc + 1.0f) + sh;
            v2u w; w.x = cvt_pk_bf16(v[j].x, v[j].y); w.y = cvt_pk_bf16(v[j].z, v[j].w); o8[64 * j] = w; }
        float lg[32];
#pragma unroll
        for (int e = 0; e < 32; ++e) { float p = 0.f;
#pragma unroll
            for (int j = 0; j < 4; ++j) { const f32x4 wv = *(const LAS f32x4*)(rw + e * RW_PITCH + 4 * lane + 256 * j); p += (v[j].x * wv.x + v[j].y * wv.y) + (v[j].z * wv.z + v[j].w * wv.w); }
            lg[e] = wave_sum(p, lane) + rb[e]; if ((e & 3) == 3) __builtin_amdgcn_sched_barrier(0); }
        int te[4]; float tv[4];
#pragma unroll
        for (int k = 0; k < 4; ++k) { float bv = lg[0]; int be = 0;
#pragma unroll
            for (int e = 1; e < 32; ++e) { const bool gt = lg[e] > bv; bv = gt ? lg[e] : bv; be = gt ? e : be; }
            te[k] = be; tv[k] = bv;
#pragma unroll
            for (int e = 0; e < 32; ++e) lg[e] = (e == be) ? -3.0e38f : lg[e]; }
        const float e1 = __expf(tv[1] - tv[0]), e2 = __expf(tv[2] - tv[0]), e3 = __expf(tv[3] - tv[0]); const float inv = 1.0f / (1.0f + e1 + e2 + e3);
        if (lane < 4) { const int ek = (lane == 0) ? te[0] : (lane == 1) ? te[1] : (lane == 2) ? te[2] : te[3];
            const float wk = (lane == 0) ? inv : (lane == 1) ? e1 * inv : (lane == 2) ? e2 * inv : e3 * inv;
            tope[m * 4 + lane] = ek; topw[m * 4 + lane] = wk; __hip_atomic_fetch_add(hist + ek, 1, __ATOMIC_RELAXED, __HIP_MEMORY_SCOPE_WORKGROUP); }
    }
    __syncthreads();
    if (C.tid < 32) ((int*)(C.ws + WS_CNT))[C.bx * 32 + C.tid] = hist[C.tid];
    __syncthreads();
}
__device__ __forceinline__ void moe_scatter(const Ctx& C) {
    LAS int* sm = (LAS int*)(C.lds + SM_OFF); LAS int* tot = sm + 32; LAS int* base = sm + 64; LAS int* pstart = sm + 96; LAS int* lcnt = sm + 128;
    const int* cnt = (const int*)(C.ws + WS_CNT); int* tile_e = (int*)(C.ws + WS_TILEE);
    if (C.tid < 32) { int t = 0, bs = 0; for (int bb = 0; bb < C.G; ++bb) { const int c = cnt[bb * 32 + C.tid]; t += c; bs += (bb < C.bx) ? c : 0; } tot[C.tid] = t; base[C.tid] = bs; lcnt[C.tid] = 0; }
    __syncthreads();
    if (C.tid == 0) { int ps = 0; for (int e = 0; e < 32; ++e) { pstart[e] = ps; const int nt = (tot[e] + 255) >> 8; if (C.bx == 0) for (int i = 0; i < nt; ++i) tile_e[(ps >> 8) + i] = e; ps += nt << 8; }
        if (C.bx == 0) tile_e[1023] = ps >> 8; }
    __syncthreads();
    const int* tope = (const int*)(C.ws + WS_TOPE); int* dest = (int*)(C.ws + WS_DEST);
    const bf16* H = (const bf16*)(C.ws + WS_H); bf16* Hs = (bf16*)(C.ws + WS_HS); const int lane = C.lane;
    for (int i = 0; i < 16; ++i) { const int m = C.bx * 128 + C.wave * 16 + i; int row = 0;
        if (lane < 4) { const int e = tope[m * 4 + lane]; const int rank = __hip_atomic_fetch_add(lcnt + e, 1, __ATOMIC_RELAXED, __HIP_MEMORY_SCOPE_WORKGROUP); row = pstart[e] + base[e] + rank; dest[m * 4 + lane] = row; }
        const int r0 = shfi(row, 0), r1 = shfi(row, 1), r2 = shfi(row, 2), r3 = shfi(row, 3);
        const v4u* src = (const v4u*)(H + (size_t)m * DM) + lane; const v4u x0 = src[0], x1 = src[64];
        v4u* d0 = (v4u*)(Hs + (size_t)r0 * DM) + lane; d0[0] = x0; d0[64] = x1;
        v4u* d1 = (v4u*)(Hs + (size_t)r1 * DM) + lane; d1[0] = x0; d1[64] = x1;
        v4u* d2 = (v4u*)(Hs + (size_t)r2 * DM) + lane; d2[0] = x0; d2[64] = x1;
        v4u* d3 = (v4u*)(Hs + (size_t)r3 * DM) + lane; d3[0] = x0; d3[64] = x1; }
    __syncthreads();
}
__device__ __forceinline__ void moe_combine(const Ctx& C, const Args& a, int l) {
    const int gw = C.bx * NWAVES + C.wave, NGW = C.G * NWAVES, lane = C.lane;
    const int* dest = (const int*)(C.ws + WS_DEST); const float* topw = (const float*)(C.ws + WS_TOPW); const bf16* Y = (const bf16*)(C.ws + WS_Y);
    const float* mod_l = (const float*)(C.ws + WS_MOD) + (size_t)l * NB * 6144; float* X = a.out;
    for (int m = gw; m < NTOK; m += NGW) { const int b = m >> 13; const float* g2 = mod_l + (size_t)b * 6144 + 5 * DM;
        int r[4]; float w[4];
#pragma unroll
        for (int k = 0; k < 4; ++k) { r[k] = dest[m * 4 + k]; w[k] = topw[m * 4 + k]; }
        f32x4* xr = (f32x4*)(X + (size_t)m * DM) + lane;
#pragma unroll
        for (int j = 0; j < 4; ++j) { const int col = 4 * lane + 256 * j; f32x4 y = {0.f, 0.f, 0.f, 0.f};
#pragma unroll
            for (int k = 0; k < 4; ++k) { const v2u u = *(const v2u*)(Y + (size_t)r[k] * DM + col); y.x += w[k] * bflo(u.x); y.y += w[k] * bfhi(u.x); y.z += w[k] * bflo(u.y); y.w += w[k] * bfhi(u.y); }
            const f32x4 gv = *(const f32x4*)(g2 + col); xr[64 * j] = xr[64 * j] + gv * y; } }
}


#ifndef MK_ONE_LAUNCH
#define MK_ONE_LAUNCH 1
#endif
template <int l>
__device__ __forceinline__ void layer_body(Ctx& C, const Args& args, const XcdBarrier& bar, const int lo, const int hi) {
    bf16* const H = (bf16*)(C.ws + WS_H); bf16* const Z = (bf16*)(C.ws + WS_Z);
    const float* const MOD = (const float*)(C.ws + WS_MOD);
    const int* const tile_e = (const int*)(C.ws + WS_TILEE);
#define IN(k) (fresh(C), lo <= (k) && (k) < hi)
#define SEAM(k) do { if (IN(k) && IN((k) + 1)) xcd_barrier(bar, C.tid); } while (0)

        const int pb = 2 + l * NPH_LAYER;
        const float* mod_l = MOD + (size_t)l * NB * 6144;
        if (IN(pb + PH_NORM1)) norm_rows(C, l == 0 ? args.in[I_X] : args.out, args.in[I_NORM1] + l * DM, mod_l, 0, 1, H);
        SEAM(pb + PH_NORM1);
        if (IN(pb + PH_GEMM_IN)) {
            pg8::Gemm g{H, (const bf16*)(C.ws + WS_WIN) + (size_t)l * ZW * DM, NTOK, ZW, DM, nullptr, 0}; pg8::StaticOrder S; S.init(NTOK, ZW, C.G, C.bx);
            pg8::EpiStore E{Z, ZW, nullptr};
            pg8::gemm_phase<pg8::EpiStore, pg8::StaticOrder, true, true>(C.lds, g, S, E, C.tid); }
        SEAM(pb + PH_GEMM_IN);
        if (IN(pb + PH_POST)) { post_tokens(C, args, l); __syncthreads(); for (int u = C.bx; u < 512; u += C.G) compress_unit(C, args, l, u); }
        SEAM(pb + PH_POST);
        if (IN(pb + PH_ATTN)) attn_phase(C);
        SEAM(pb + PH_ATTN);
        if (IN(pb + PH_POOLG)) {
            pg8::Gemm g{(const bf16*)(C.ws + WS_PM), (const bf16*)(C.ws + WS_WPOOL) + (size_t)l * 512 * 512, NTOK, 512, 512, nullptr, 0}; pg8::StaticOrder S; S.init(NTOK, 512, C.G, C.bx);
            pg8::EpiStore E{(bf16*)(C.ws + WS_PP), 512, args.in[I_PSCALE] + l * 512};
            pg8::gemm_phase<pg8::EpiStore, pg8::StaticOrder, true, true>(C.lds, g, S, E, C.tid); }
        SEAM(pb + PH_POOLG);
        if (IN(pb + PH_PROJA)) {
            pg8::Gemm g{(const bf16*)(C.ws + WS_PP), (const bf16*)(C.ws + WS_WA) + (size_t)l * 1024 * 512, NTOK, 1024, 512, nullptr, 0}; pg8::StaticOrder S; S.init(NTOK, 1024, C.G, C.bx);
            pg8::EpiGate<false> E{(bf16*)(C.ws + WS_MG), 1024, Z + ZC_MG, ZW};
            pg8::gemm_phase<pg8::EpiGate<false>, pg8::StaticOrder, true, true>(C.lds, g, S, E, C.tid); }
        SEAM(pb + PH_PROJA);
        if (IN(pb + PH_PROJB)) {
            pg8::Gemm g{(const bf16*)(C.ws + WS_O), (const bf16*)(C.ws + WS_WB) + (size_t)l * 1024 * 1024, NTOK, 1024, 1024, nullptr, 0}; pg8::StaticOrder S; S.init(NTOK, 1024, C.G, C.bx);
            pg8::EpiGate<true> E{(bf16*)(C.ws + WS_MG), 1024, Z + ZC_MG + 1024, ZW};
            pg8::gemm_phase<pg8::EpiGate<true>, pg8::StaticOrder, true, true>(C.lds, g, S, E, C.tid); }
        SEAM(pb + PH_PROJB);
        if (IN(pb + PH_OUTG)) {
            pg8::Gemm g{(const bf16*)(C.ws + WS_MG), (const bf16*)(C.ws + WS_WOUT) + (size_t)l * 1024 * 1024, NTOK, 1024, 1024, nullptr, 0}; pg8::StaticOrder S; S.init(NTOK, 1024, C.G, C.bx);
            pg8::EpiResid E{l == 0 ? args.in[I_X] : args.out, args.out, mod_l + 2 * DM, 6144};
            pg8::gemm_phase<pg8::EpiResid, pg8::StaticOrder, true, true>(C.lds, g, S, E, C.tid); }
        SEAM(pb + PH_OUTG);
        if (IN(pb + PH_NORM2R)) norm2_router(C, args, l);
        SEAM(pb + PH_NORM2R);
        if (IN(pb + PH_SCATTER)) moe_scatter(C);
        SEAM(pb + PH_SCATTER);
        if (IN(pb + PH_GATEUP)) { const int R = tile_e[1023];
            pg8::Gemm g{(const bf16*)(C.ws + WS_HS), (const bf16*)(C.ws + WS_WGU) + (size_t)l * NEXP * 2048 * 1024, R * 256, 2048, 1024, tile_e, (size_t)2048 * 1024 * 2}; pg8::StaticOrder S; S.init(R * 256, 2048, C.G, C.bx);
            pg8::EpiSwiglu E{(bf16*)(C.ws + WS_ACT), args.in[I_BGU] + (size_t)l * NEXP * 2048, tile_e};
            pg8::gemm_phase<pg8::EpiSwiglu, pg8::StaticOrder, true, true>(C.lds, g, S, E, C.tid); }
        SEAM(pb + PH_GATEUP);
        if (IN(pb + PH_DOWN)) { const int R = tile_e[1023];
            pg8::Gemm g{(const bf16*)(C.ws + WS_ACT), (const bf16*)(C.ws + WS_WD) + (size_t)l * NEXP * 1024 * 1024, R * 256, 1024, 1024, tile_e, (size_t)1024 * 1024 * 2}; pg8::StaticOrder S; S.init(R * 256, 1024, C.G, C.bx);
            pg8::EpiBiasE E{(bf16*)(C.ws + WS_Y), args.in[I_BD] + (size_t)l * NEXP * 1024, tile_e};
            pg8::gemm_phase<pg8::EpiBiasE, pg8::StaticOrder, true, true>(C.lds, g, S, E, C.tid); }
        SEAM(pb + PH_DOWN);
        if (IN(pb + PH_COMBINE)) moe_combine(C, args, l);
        SEAM(pb + PH_COMBINE);

#undef IN
#undef SEAM
}
__global__ void __launch_bounds__(NWAVES * 64, 2) fwd(Args args) {
    extern __shared__ __attribute__((aligned(16))) unsigned char lds_raw[];
    Ctx C; C.lds = (LAS unsigned char*)lds_raw; C.tid = threadIdx.x; C.lane = C.tid & 63; C.wave = __builtin_amdgcn_readfirstlane(C.tid >> 6); C.bx = blockIdx.x; C.G = gridDim.x; C.ws = args.ws;
    for (int u = C.tid; u < (LDS_BYTES - MISC_OFF) / 4; u += NWAVES * 64) ((LAS unsigned*)(C.lds + MISC_OFF))[u] = 0u;
    __syncthreads();
    const int lo = args.ph_lo, hi = args.ph_hi;
    unsigned* barw = (unsigned*)(C.ws + WS_CTL) + CW_BAR + (size_t)args.li * XCD_BAR_WORDS;
    XcdBarrier bar; bar.bar = barw; bar.x = 0; bar.st = nullptr;
    if (hi - lo > 1) bar = xcd_barrier_post(barw, (volatile LAS unsigned*)(C.lds + MISC_OFF) + 8, C.tid);
#define IN(k) (fresh(C), lo <= (k) && (k) < hi)
#define SEAM(k) do { if (IN(k) && IN((k) + 1)) xcd_barrier(bar, C.tid); } while (0)
    bf16* const H = (bf16*)(C.ws + WS_H); bf16* const Z = (bf16*)(C.ws + WS_Z);
    const float* const MOD = (const float*)(C.ws + WS_MOD);
    const int* const tile_e = (const int*)(C.ws + WS_TILEE);

    if (IN(0)) p0_convert(C, args);
    SEAM(0);
    if (IN(1)) p1_mod(C, args);
    SEAM(1);
    layer_body<0>(C, args, bar, lo, hi); layer_body<1>(C, args, bar, lo, hi); layer_body<2>(C, args, bar, lo, hi); layer_body<3>(C, args, bar, lo, hi);
#undef IN
#undef SEAM
}

extern "C" void kernel_launch(void* const* d_in, const int* in_sizes, int n_in, void* d_out, int out_size, void* d_ws, size_t ws_size, hipStream_t stream) {
    static int grid = 0;
    if (grid == 0) {
        if (n_in != N_IN || out_size != NTOK * DM || ws_size < WS_END) { fprintf(stderr, "kernel_launch: unexpected shapes (n_in %d, out %d, ws %zu < %zu)\n", n_in, out_size, ws_size, (size_t)WS_END); grid = -1; return; }
        int dev = 0, cus = 0;
        if (hipGetDevice(&dev) != hipSuccess || hipDeviceGetAttribute(&cus, hipDeviceAttributeMultiprocessorCount, dev) != hipSuccess) { grid = -1; return; }
        if (hipFuncSetAttribute((const void*)fwd, hipFuncAttributeMaxDynamicSharedMemorySize, LDS_BYTES) != hipSuccess) { fprintf(stderr, "kernel_launch: hipFuncSetAttribute failed\n"); grid = -1; return; }
        int per_cu = 0; (void)hipOccupancyMaxActiveBlocksPerMultiprocessor(&per_cu, (const void*)fwd, NWAVES * 64, LDS_BYTES); (void)hipGetLastError();
        if (cus != 256 || per_cu < 1) fprintf(stderr, "kernel_launch: note: %d CUs, occupancy query %d; this kernel is built for one 512-thread workgroup on each of 256 CUs\n", cus, per_cu);
        grid = 256;
    }
    if (grid < 0) return;
    if (hipMemsetAsync((char*)d_ws + WS_CTL, 0, CTL_ZERO_BYTES, stream) != hipSuccess) return;
    Args a{};
    for (int i = 0; i < N_IN; ++i) a.in[i] = (const float*)d_in[i];
    a.out = (float*)d_out; a.ws = (unsigned char*)d_ws;
#if MK_ONE_LAUNCH
    a.ph_lo = 0; a.ph_hi = NPHASES; a.li = 0; a.pad = 0;
    hipLaunchKernelGGL(fwd, dim3(grid), dim3(NWAVES * 64), LDS_BYTES, stream, a);
#else
    for (int ph = 0; ph < NPHASES; ++ph) { a.ph_lo = ph; a.ph_hi = ph + 1; a.li = 0; a.pad = 0;
        hipLaunchKernelGGL(fwd, dim3(grid), dim3(NWAVES * 64), LDS_BYTES, stream, a); }
#endif
}
```

```cpp
#include <hip/hip_runtime.h>
#include <cstdio>
#include <cstdint>

namespace pg8 {
#define PG8_LAS __attribute__((address_space(3)))
typedef unsigned short bf16_t;
typedef short bf16x8 __attribute__((ext_vector_type(8)));
typedef float f32x4 __attribute__((ext_vector_type(4)));
typedef unsigned u32x4 __attribute__((ext_vector_type(4)));
constexpr int BM = 256, BK = 64, HALF = 128, HTB = HALF * BK * 2  , STAGE_BYTES = 8 * HTB, NXCD = 8, WGM = 8;

__host__ __device__ __forceinline__ int lds_byte(int r, int c) { const int st = (r >> 4) * 2 + (c >> 5), rr = r & 15, cc = c & 31, ob = rr * 64 + cc * 2; return st * 1024 + (ob ^ (((ob >> 9) & 1) << 5)); }
__host__ __device__ __forceinline__ void stage_rc(int b, int& R, int& C) { const int st = b / 1024, sb = b % 1024, swz = sb ^ (((sb >> 9) & 1) << 5); R = (st >> 1) * 16 + swz / 64; C = (st & 1) * 32 + (swz % 64) / 2; }
__host__ __device__ __forceinline__ int perm32(int rho) { const int n = rho >> 4, i = rho & 15; return 8 * (i >> 2) + 4 * n + (i & 3); }

struct Unit { int pm, pn; };
struct Gemm { const bf16_t* A; const bf16_t* Bt; int M, N, K; const int* tile_e; size_t be_stride; };

struct StaticOrder {
    int nM, nN, nwg, G, c;
    __host__ __device__ void init(int M, int N, int G_, int c_) { nM = M / BM; nN = N / BM; nwg = nM * nN; G = G_; c = c_; }
    __host__ __device__ bool next(int i, Unit& u) const {
        const long L = (long)i * G + c; if (L >= nwg) return false;
        int wgid = (int)L; { const int q = nwg / NXCD, r = nwg % NXCD, xcd = wgid % NXCD, off = wgid / NXCD; wgid = (xcd < r ? xcd * (q + 1) : r * (q + 1) + (xcd - r) * q) + off; }
        const int nig = WGM * nN, gid = wgid / nig, fm = gid * WGM, gsz = (nM - fm) < WGM ? (nM - fm) : WGM;
        u.pm = fm + ((wgid % nig) % gsz); u.pn = (wgid % nig) / gsz; return true;
    }
    __device__ __forceinline__ void a_ready(const Unit&) const {}
    __device__ __forceinline__ void done(const Unit&) const {}
};

__device__ __forceinline__ unsigned cvt_pk_bf16(float lo, float hi) { unsigned r; asm volatile("v_cvt_pk_bf16_f32 %0, %1, %2" : "=v"(r) : "v"(lo), "v"(hi)); return r; }
typedef float f32x2 __attribute__((ext_vector_type(2)));


template <class Epi, class Sched, bool ALIGN_EPI = false, bool SP2 = false>
__device__ __forceinline__ void gemm_phase(PG8_LAS unsigned char* lds, const Gemm g, const Sched& S, const Epi& E, const int tid_in  ) {
    int tid_ = tid_in; asm volatile("" : "+v"(tid_));
    float zz = 0.f; asm volatile("" : "+v"(zz));
    const int tid = tid_, wid = __builtin_amdgcn_readfirstlane(tid >> 6), lane = tid & 63, wr = wid >> 2, wc = wid & 3, fr = lane & 15, fq = lane >> 4;
    const int K = g.K, nt = K / BK;
    unsigned voffA[2], voffB[2];
#pragma unroll
    for (int i = 0; i < 2; ++i) { int R, C; stage_rc(tid * 16 + i * 8192, R, C); const int Rb = Epi::PERM ? ((R & ~31) + perm32(R & 31)) : R;
        voffA[i] = (unsigned)(R * K + C) * 2u; voffB[i] = (unsigned)(Rb * K + C) * 2u; }
    const size_t kstep = (size_t)(BK * 2);
    const size_t hstep = (size_t)HALF * K * 2;
    const size_t tstep = 2 * hstep;
    const unsigned ldsw = (unsigned)wid * 1024u;
    const int aoff = lds_byte(wr * 64 + fr, fq * 8), boff = lds_byte(wc * 32 + fr, fq * 8);
#define PG8_SA(b, h) (((b) * 2 + (h)) * HTB)
#define PG8_SB(b, h) ((4 + (b) * 2 + (h)) * HTB)
#define PG8_STAGE(bufoff, gbase, voff) do { _Pragma("unroll") for (int _i = 0; _i < 2; ++_i) \
        __builtin_amdgcn_global_load_lds((const unsigned*)((const char*)(gbase) + (voff)[_i]), (PG8_LAS unsigned*)(lds + (bufoff) + ldsw + _i * 8192), 16, 0, 0); } while (0)
#define PG8_LDA(dst, b, h) do { _Pragma("unroll") for (int m = 0; m < 4; ++m) _Pragma("unroll") for (int k = 0; k < 2; ++k) dst[m][k] = *(const PG8_LAS bf16x8*)(lds + PG8_SA(b, h) + aoff + m * 2048 + k * 1024); } while (0)
#define PG8_LDB(dst, b, h) do { _Pragma("unroll") for (int n = 0; n < 2; ++n) _Pragma("unroll") for (int k = 0; k < 2; ++k) dst[n][k] = *(const PG8_LAS bf16x8*)(lds + PG8_SB(b, h) + boff + n * 2048 + k * 1024); } while (0)
#define PG8_MMA(ai, bj, At, Bt) do { __builtin_amdgcn_s_setprio(1); _Pragma("unroll") for (int m = 0; m < 4; ++m) _Pragma("unroll") for (int n = 0; n < 2; ++n) _Pragma("unroll") for (int k = 0; k < 2; ++k) \
        acc[ai][bj][m][n] = __builtin_amdgcn_mfma_f32_16x16x32_bf16(Bt[n][k], At[m][k], acc[ai][bj][m][n], 0, 0, 0); __builtin_amdgcn_s_setprio(0); } while (0)
#define PG8_WAIT_V(n) asm volatile("s_waitcnt vmcnt(" #n ")" ::: "memory")
#define PG8_WAIT_L(n) asm volatile("s_waitcnt lgkmcnt(" #n ")" ::: "memory")
#define PG8_BAR __builtin_amdgcn_s_barrier()
#define PG8_SCHED __builtin_amdgcn_sched_barrier(0)
    Unit cur, nxt; int ui = 0;
    if (!S.next(0, cur)) return;
    f32x4 acc[2][2][4][2];
#pragma unroll
    for (int a = 0; a < 2; ++a)
#pragma unroll
        for (int b = 0; b < 2; ++b)
#pragma unroll
            for (int m = 0; m < 4; ++m)
#pragma unroll
                for (int n = 0; n < 2; ++n) acc[a][b][m][n] = (f32x4){zz, zz, zz, zz};
    bf16x8 At[4][2], B0[2][2], B1[2][2];
    const char* cA = (const char*)g.A + (size_t)cur.pm * tstep; const char* cB = (const char*)g.Bt + (g.tile_e ? (size_t)g.tile_e[cur.pm] * g.be_stride : (size_t)0) + (size_t)cur.pn * tstep;
    S.a_ready(cur);
    if constexpr (SP2) {
        PG8_STAGE(PG8_SB(0, 0), cB, voffB); PG8_STAGE(PG8_SB(0, 1), cB + hstep, voffB); PG8_STAGE(PG8_SA(0, 0), cA, voffA); PG8_STAGE(PG8_SA(0, 1), cA + hstep, voffA);
        if (wr == 1) PG8_BAR;
        PG8_WAIT_V(2); PG8_BAR;
        PG8_STAGE(PG8_SB(1, 0), cB + kstep, voffB); PG8_STAGE(PG8_SA(1, 0), cA + kstep, voffA); PG8_STAGE(PG8_SB(1, 1), cB + hstep + kstep, voffB);
        PG8_WAIT_V(6); PG8_BAR;
    } else {
        PG8_STAGE(PG8_SB(0, 0), cB, voffB); PG8_STAGE(PG8_SA(0, 0), cA, voffA); PG8_STAGE(PG8_SB(0, 1), cB + hstep, voffB); PG8_STAGE(PG8_SA(0, 1), cA + hstep, voffA);
        if (wr == 1) PG8_BAR;
        PG8_WAIT_V(4); PG8_BAR;
        PG8_STAGE(PG8_SB(1, 0), cB + kstep, voffB); PG8_STAGE(PG8_SA(1, 0), cA + kstep, voffA); PG8_STAGE(PG8_SB(1, 1), cB + hstep + kstep, voffB);
        PG8_WAIT_V(6); PG8_BAR;
    }
    for (;;) {
        const bool has_next = S.next(ui + 1, nxt);
        const char* nA = has_next ? (const char*)g.A + (size_t)nxt.pm * tstep : cA; const char* nB = has_next ? (const char*)g.Bt + (g.tile_e ? (size_t)g.tile_e[nxt.pm] * g.be_stride : (size_t)0) + (size_t)nxt.pn * tstep : cB;
        for (int t = 0; t < nt; t += 2) {
            const bool last = (t == nt - 2);
            const char* a1 = cA + (size_t)(t + 1) * kstep;
            const char* a2 = last ? nA : cA + (size_t)(t + 2) * kstep; const char* b2 = last ? nB : cB + (size_t)(t + 2) * kstep;
            const char* a3 = a2 + kstep; const char* b3 = b2 + kstep;
            if (last && has_next) S.a_ready(nxt);
            if constexpr (SP2) {
            PG8_LDB(B0, 0, 0); PG8_LDB(B1, 0, 1); PG8_SCHED; PG8_LDA(At, 0, 0); PG8_STAGE(PG8_SA(1, 1), a1 + hstep, voffA);
            PG8_WAIT_V(8); PG8_WAIT_L(0); PG8_BAR; PG8_MMA(0, 0, At, B0); PG8_MMA(0, 1, At, B1); PG8_BAR; PG8_SCHED;
            PG8_LDA(At, 0, 1); PG8_STAGE(PG8_SB(0, 0), b2, voffB); PG8_STAGE(PG8_SB(0, 1), b2 + hstep, voffB); PG8_STAGE(PG8_SA(0, 0), a2, voffA);
            PG8_WAIT_V(8); PG8_WAIT_L(0); PG8_BAR; PG8_MMA(1, 0, At, B0); PG8_MMA(1, 1, At, B1); PG8_BAR; PG8_SCHED;
            PG8_LDB(B0, 1, 0); PG8_LDB(B1, 1, 1); PG8_SCHED; PG8_LDA(At, 1, 0); PG8_STAGE(PG8_SA(0, 1), a2 + hstep, voffA);
            PG8_WAIT_V(8); PG8_WAIT_L(0); PG8_BAR; PG8_MMA(0, 0, At, B0); PG8_MMA(0, 1, At, B1); PG8_BAR; PG8_SCHED;
            PG8_LDA(At, 1, 1); PG8_STAGE(PG8_SB(1, 0), b3, voffB); PG8_STAGE(PG8_SB(1, 1), b3 + hstep, voffB); PG8_STAGE(PG8_SA(1, 0), a3, voffA);
            PG8_WAIT_V(8); PG8_WAIT_L(0); PG8_BAR; PG8_MMA(1, 0, At, B0); PG8_MMA(1, 1, At, B1); PG8_BAR; PG8_SCHED;
            } else {
            PG8_LDB(B0, 0, 0); PG8_SCHED; PG8_LDA(At, 0, 0); PG8_STAGE(PG8_SA(1, 1), a1 + hstep, voffA);
            PG8_WAIT_L(8); PG8_BAR; PG8_WAIT_L(0); PG8_MMA(0, 0, At, B0); PG8_BAR; PG8_SCHED;
            PG8_LDB(B1, 0, 1); PG8_STAGE(PG8_SB(0, 0), b2, voffB);
            PG8_BAR; PG8_WAIT_L(0); PG8_MMA(0, 1, At, B1); PG8_BAR;
            PG8_LDA(At, 0, 1); PG8_STAGE(PG8_SA(0, 0), a2, voffA);
            PG8_BAR; PG8_WAIT_L(0); PG8_MMA(1, 0, At, B0); PG8_BAR; PG8_SCHED;
            PG8_STAGE(PG8_SB(0, 1), b2 + hstep, voffB);
            PG8_WAIT_V(6); PG8_BAR; PG8_MMA(1, 1, At, B1); PG8_BAR;
            PG8_LDB(B0, 1, 0); PG8_SCHED; PG8_LDA(At, 1, 0); PG8_STAGE(PG8_SA(0, 1), a2 + hstep, voffA);
            PG8_WAIT_L(8); PG8_BAR; PG8_WAIT_L(0); PG8_MMA(0, 0, At, B0); PG8_BAR; PG8_SCHED;
            PG8_LDB(B1, 1, 1); PG8_STAGE(PG8_SB(1, 0), b3, voffB);
            PG8_BAR; PG8_WAIT_L(0); PG8_MMA(0, 1, At, B1); PG8_BAR;
            PG8_LDA(At, 1, 1); PG8_STAGE(PG8_SA(1, 0), a3, voffA);
            PG8_BAR; PG8_WAIT_L(0); PG8_MMA(1, 0, At, B0); PG8_BAR; PG8_SCHED;
            PG8_STAGE(PG8_SB(1, 1), b3 + hstep, voffB);
            PG8_WAIT_V(6); PG8_BAR; PG8_MMA(1, 1, At, B1); PG8_BAR;
            }
        }
        if constexpr (ALIGN_EPI) { if (wr == 0) PG8_BAR; }
        if constexpr (!Epi::AFTER_DRAIN) { E(acc, cur, wr, wc, fr, fq); S.done(cur); }
        if (!has_next) break;
#pragma unroll
        for (int a = 0; a < 2; ++a)
#pragma unroll
            for (int b = 0; b < 2; ++b)
#pragma unroll
                for (int m = 0; m < 4; ++m)
#pragma unroll
                    for (int n = 0; n < 2; ++n) acc[a][b][m][n] = (f32x4){zz, zz, zz, zz};
        cur = nxt; cA = nA; cB = nB; ++ui;
        if constexpr (ALIGN_EPI) { if (wr == 1) PG8_BAR; }
    }
    PG8_WAIT_V(0);
    if constexpr (!ALIGN_EPI) { if (wr == 0) PG8_BAR; }
    PG8_BAR;
    if constexpr (Epi::AFTER_DRAIN) { E.fused(acc, cur, wr, wc, fr, fq, lds, wid, lane); S.done(cur); }
#undef PG8_SA
#undef PG8_SB
#undef PG8_STAGE
#undef PG8_LDA
#undef PG8_LDB
#undef PG8_MMA
#undef PG8_WAIT_V
#undef PG8_WAIT_L
#undef PG8_BAR
#undef PG8_SCHED
}

__device__ __forceinline__ float sigmoidf_(float x) { return 1.0f / (1.0f + __expf(-x)); }
__device__ __forceinline__ float bflo(unsigned w) { return __uint_as_float(w << 16); }
__device__ __forceinline__ float bfhi(unsigned w) { return __uint_as_float(w & 0xffff0000u); }

struct EpiStore {
    static constexpr bool PERM = true, AFTER_DRAIN = false;
    bf16_t* O; int ldc; const float* cs;
    __device__ __forceinline__ void operator()(const f32x4 (&acc)[2][2][4][2], const Unit& u, int wr, int wc, int fr, int fq) const {
        const int row0 = u.pm * BM + wr * 64 + fr, col0 = u.pn * BM + wc * 32 + 8 * fq;
        f32x4 sv[2][2];
#pragma unroll
        for (int bj = 0; bj < 2; ++bj)
#pragma unroll
            for (int n = 0; n < 2; ++n) sv[bj][n] = cs ? *(const f32x4*)(cs + col0 + bj * HALF + 4 * n) : (f32x4){1.f, 1.f, 1.f, 1.f};
#pragma unroll
        for (int ai = 0; ai < 2; ++ai)
#pragma unroll
            for (int m = 0; m < 4; ++m) { bf16_t* rowp = O + (size_t)(row0 + ai * HALF + m * 16) * ldc + col0;
#pragma unroll
                for (int bj = 0; bj < 2; ++bj) { const f32x4 v0 = acc[ai][bj][m][0] * sv[bj][0], v1 = acc[ai][bj][m][1] * sv[bj][1];
                    u32x4 w; w.x = cvt_pk_bf16(v0[0], v0[1]); w.y = cvt_pk_bf16(v0[2], v0[3]); w.z = cvt_pk_bf16(v1[0], v1[1]); w.w = cvt_pk_bf16(v1[2], v1[3]);
                    *(u32x4*)(rowp + bj * HALF) = w; } }
    }
};
template <bool ADD> struct EpiGate {
    static constexpr bool PERM = true, AFTER_DRAIN = false;
    bf16_t* O; int ldc; const bf16_t* G; int ldg;
    __device__ __forceinline__ void operator()(const f32x4 (&acc)[2][2][4][2], const Unit& u, int wr, int wc, int fr, int fq) const {
        const int row0 = u.pm * BM + wr * 64 + fr, col0 = u.pn * BM + wc * 32 + 8 * fq;
#pragma unroll
        for (int ai = 0; ai < 2; ++ai)
#pragma unroll
            for (int m = 0; m < 4; ++m) { const size_t row = (size_t)(row0 + ai * HALF + m * 16); bf16_t* rowp = O + row * ldc + col0; const bf16_t* gp = G + row * ldg + col0;
#pragma unroll
                for (int bj = 0; bj < 2; ++bj) { const u32x4 gw = *(const u32x4*)(gp + bj * HALF);
                    f32x4 v0 = acc[ai][bj][m][0], v1 = acc[ai][bj][m][1];
                    v0[0] *= sigmoidf_(bflo(gw.x)); v0[1] *= sigmoidf_(bfhi(gw.x)); v0[2] *= sigmoidf_(bflo(gw.y)); v0[3] *= sigmoidf_(bfhi(gw.y));
                    v1[0] *= sigmoidf_(bflo(gw.z)); v1[1] *= sigmoidf_(bfhi(gw.z)); v1[2] *= sigmoidf_(bflo(gw.w)); v1[3] *= sigmoidf_(bfhi(gw.w));
                    if (ADD) { const u32x4 ow = *(const u32x4*)(rowp + bj * HALF);
                        v0[0] += bflo(ow.x); v0[1] += bfhi(ow.x); v0[2] += bflo(ow.y); v0[3] += bfhi(ow.y);
                        v1[0] += bflo(ow.z); v1[1] += bfhi(ow.z); v1[2] += bflo(ow.w); v1[3] += bfhi(ow.w); }
                    u32x4 w; w.x = cvt_pk_bf16(v0[0], v0[1]); w.y = cvt_pk_bf16(v0[2], v0[3]); w.z = cvt_pk_bf16(v1[0], v1[1]); w.w = cvt_pk_bf16(v1[2], v1[3]);
                    *(u32x4*)(rowp + bj * HALF) = w; } }
    }
};
struct EpiResid {
    static constexpr bool PERM = false, AFTER_DRAIN = false;
    const float* Xin; float* Xout; const float* modp; int mod_bstride;
    __device__ __forceinline__ void operator()(const f32x4 (&acc)[2][2][4][2], const Unit& u, int wr, int wc, int fr, int fq) const {
        const int row0 = u.pm * BM + wr * 64 + fr, col0 = u.pn * BM + wc * 32 + 4 * fq;
        const float* gp = modp + (size_t)((u.pm * BM) >> 13) * mod_bstride;
        f32x4 gv[2][2];
#pragma unroll
        for (int bj = 0; bj < 2; ++bj)
#pragma unroll
            for (int n = 0; n < 2; ++n) gv[bj][n] = *(const f32x4*)(gp + col0 + bj * HALF + n * 16);
#pragma unroll
        for (int ai = 0; ai < 2; ++ai)
#pragma unroll
            for (int m = 0; m < 4; ++m) { const size_t off = (size_t)(row0 + ai * HALF + m * 16) * 1024 + col0;
#pragma unroll
                for (int bj = 0; bj < 2; ++bj)
#pragma unroll
                    for (int n = 0; n < 2; ++n) { const f32x4 xo = *(const f32x4*)(Xin + off + bj * HALF + n * 16);
                        *(f32x4*)(Xout + off + bj * HALF + n * 16) = xo + gv[bj][n] * acc[ai][bj][m][n]; } }
    }
};
__device__ __forceinline__ float swiglu_(float g, float u) { g = fminf(g, 7.0f); u = fminf(fmaxf(u, -7.0f), 7.0f); return (u + 1.0f) * g * sigmoidf_(g * 1.702f); }
struct EpiSwiglu {
    static constexpr bool PERM = true, AFTER_DRAIN = false;
    bf16_t* ACT; const float* bias; const int* tile_e;
    __device__ __forceinline__ void operator()(const f32x4 (&acc)[2][2][4][2], const Unit& u, int wr, int wc, int fr, int fq) const {
        const int row0 = u.pm * BM + wr * 64 + fr, col0 = u.pn * BM + wc * 32 + 8 * fq;
        const float* bp = bias + (size_t)tile_e[u.pm] * 2048;
        f32x4 bv[2][2];
#pragma unroll
        for (int bj = 0; bj < 2; ++bj)
#pragma unroll
            for (int n = 0; n < 2; ++n) bv[bj][n] = *(const f32x4*)(bp + col0 + bj * HALF + 4 * n);
#pragma unroll
        for (int ai = 0; ai < 2; ++ai)
#pragma unroll
            for (int m = 0; m < 4; ++m) { bf16_t* rowp = ACT + (size_t)(row0 + ai * HALF + m * 16) * 1024 + (col0 >> 1);
#pragma unroll
                for (int bj = 0; bj < 2; ++bj) { const f32x4 v0 = acc[ai][bj][m][0] + bv[bj][0], v1 = acc[ai][bj][m][1] + bv[bj][1];
                    typedef unsigned u32x2v __attribute__((ext_vector_type(2)));
                    u32x2v w; w.x = cvt_pk_bf16(swiglu_(v0[0], v0[1]), swiglu_(v0[2], v0[3])); w.y = cvt_pk_bf16(swiglu_(v1[0], v1[1]), swiglu_(v1[2], v1[3]));
                    *(u32x2v*)(rowp + bj * (HALF / 2)) = w; } }
    }
};
struct EpiBiasE {
    static constexpr bool PERM = true, AFTER_DRAIN = false;
    bf16_t* O; const float* bias; const int* tile_e;
    __device__ __forceinline__ void operator()(const f32x4 (&acc)[2][2][4][2], const Unit& u, int wr, int wc, int fr, int fq) const {
        const int row0 = u.pm * BM + wr * 64 + fr, col0 = u.pn * BM + wc * 32 + 8 * fq;
        const float* bp = bias + (size_t)tile_e[u.pm] * 1024;
        f32x4 bv[2][2];
#pragma unroll
        for (int bj = 0; bj < 2; ++bj)
#pragma unroll
            for (int n = 0; n < 2; ++n) bv[bj][n] = *(const f32x4*)(bp + col0 + bj * HALF + 4 * n);
#pragma unroll
        for (int ai = 0; ai < 2; ++ai)
#pragma unroll
            for (int m = 0; m < 4; ++m) { bf16_t* rowp = O + (size_t)(row0 + ai * HALF + m * 16) * 1024 + col0;
#pragma unroll
                for (int bj = 0; bj < 2; ++bj) { const f32x4 v0 = acc[ai][bj][m][0] + bv[bj][0], v1 = acc[ai][bj][m][1] + bv[bj][1];
                    u32x4 w; w.x = cvt_pk_bf16(v0[0], v0[1]); w.y = cvt_pk_bf16(v0[2], v0[3]); w.z = cvt_pk_bf16(v1[0], v1[1]); w.w = cvt_pk_bf16(v1[2], v1[3]);
                    *(u32x4*)(rowp + bj * HALF) = w; } }
    }
};
}


constexpr int NL = 4, NB = 4, SEQ = 8192, DM = 1024, NTOK = NB * SEQ;
constexpr int ZW = 4608;
constexpr int ZC_U = 0, ZC_Q = 512, ZC_KCM = 1536, ZC_VCM = 1664, ZC_KSL = 1792, ZC_VSL = 1920, ZC_KWN = 2048, ZC_VWN = 2176, ZC_MG = 2304, ZC_NG = 4352;
constexpr int IN_W = 4400;
constexpr int NEXP = 32, MOE_ROWS_MAX = (NTOK * 4 / 256 + NEXP) * 256;
constexpr int NPH_LAYER = 13, NPHASES = 2 + NL * NPH_LAYER;
enum { PH_NORM1 = 0, PH_GEMM_IN, PH_POST, PH_ATTN, PH_POOLG, PH_PROJA, PH_PROJB, PH_OUTG, PH_NORM2R, PH_SCATTER, PH_GATEUP, PH_DOWN, PH_COMBINE };

constexpr size_t alignup(size_t x) { return (x + 255) & ~(size_t)255; }
constexpr size_t WS_CTL = 0, CTL_ZERO_BYTES = 1u << 20;
constexpr size_t WS_MOD = WS_CTL + CTL_ZERO_BYTES;
constexpr size_t WS_MODP = WS_MOD + alignup((size_t)NL * NB * 6144 * 4);
constexpr size_t WS_ROPE = WS_MODP + alignup((size_t)4 * NL * NB * 6144 * 4);
constexpr size_t WS_WIN = WS_ROPE + alignup((size_t)SEQ * 16 * 4);
constexpr size_t WS_WPOOL = WS_WIN + alignup((size_t)NL * ZW * DM * 2);
constexpr size_t WS_WA = WS_WPOOL + alignup((size_t)NL * 512 * 512 * 2);
constexpr size_t WS_WB = WS_WA + alignup((size_t)NL * 1024 * 512 * 2);
constexpr size_t WS_WOUT = WS_WB + alignup((size_t)NL * 1024 * 1024 * 2);
constexpr size_t WS_W1 = WS_WOUT + alignup((size_t)NL * 1024 * 1024 * 2);
constexpr size_t WS_W2 = WS_W1 + alignup((size_t)NL * 2 * 256 * 2048 * 2);
constexpr size_t WS_WGU = WS_W2 + alignup((size_t)NL * 2 * 64 * 256 * 2);
constexpr size_t WS_WD = WS_WGU + alignup((size_t)NL * NEXP * 2048 * 1024 * 2);
constexpr size_t WS_H = WS_WD + alignup((size_t)NL * NEXP * 1024 * 1024 * 2);
constexpr size_t WS_Z = WS_H + alignup((size_t)NTOK * DM * 2);
constexpr size_t WS_QN = WS_Z + alignup((size_t)NTOK * ZW * 2);
constexpr size_t WS_KSLC = WS_QN + alignup((size_t)NTOK * DM * 2);
constexpr size_t WS_KWIN = WS_KSLC + alignup((size_t)NB * 2 * SEQ * 64 * 2);
constexpr size_t WS_VSLCT = WS_KWIN + alignup((size_t)NB * 2 * SEQ * 64 * 2);
constexpr size_t WS_VWINT = WS_VSLCT + alignup((size_t)NB * 2 * SEQ * 64 * 2);
constexpr size_t WS_KC = WS_VWINT + alignup((size_t)NB * 2 * SEQ * 64 * 2);
constexpr size_t WS_VCT = WS_KC + alignup((size_t)NB * 2 * 512 * 64 * 2);
constexpr size_t WS_PM = WS_VCT + alignup((size_t)NB * 2 * 512 * 64 * 2);
constexpr size_t WS_PP = WS_PM + alignup((size_t)NTOK * 512 * 2);
constexpr size_t WS_O = WS_PP + alignup((size_t)NTOK * 512 * 2);
constexpr size_t WS_MG = WS_O + alignup((size_t)NTOK * DM * 2);
constexpr size_t WS_TOPE = WS_MG + alignup((size_t)NTOK * DM * 2);
constexpr size_t WS_TOPW = WS_TOPE + alignup((size_t)NTOK * 4 * 4);
constexpr size_t WS_DEST = WS_TOPW + alignup((size_t)NTOK * 4 * 4);
constexpr size_t WS_CNT = WS_DEST + alignup((size_t)NTOK * 4 * 4);
constexpr size_t WS_TILEE = WS_CNT + alignup((size_t)1024 * 32 * 4);
constexpr size_t WS_HS = WS_TILEE + alignup((size_t)1024 * 4);
constexpr size_t WS_ACT = WS_HS + alignup((size_t)MOE_ROWS_MAX * 1024 * 2);
constexpr size_t WS_Y = WS_ACT + alignup((size_t)MOE_ROWS_MAX * 1024 * 2);
constexpr size_t WS_SCR = WS_Y + alignup((size_t)MOE_ROWS_MAX * 1024 * 2);
constexpr size_t WS_END = WS_SCR + alignup((size_t)1024 * 8 * 4096 * 4);
constexpr int CW_BAR = 4096;

constexpr int RING_BYTES = 131584;
constexpr int MISC_OFF = 135168;
constexpr int SM_OFF = 136192;
constexpr int LDS_BYTES = 147456;
constexpr int NWAVES = 8;

#define GAS __attribute__((address_space(1)))
#define LAS __attribute__((address_space(3)))
typedef unsigned short bf16;
typedef unsigned v4u __attribute__((ext_vector_type(4)));
typedef unsigned v2u __attribute__((ext_vector_type(2)));
typedef float f32x4 __attribute__((ext_vector_type(4)));
typedef short bf16x8 __attribute__((ext_vector_type(8)));
typedef GAS unsigned gu32;
#define RLX_AGENT __ATOMIC_RELAXED, __HIP_MEMORY_SCOPE_AGENT
#define LDS_WAIT() asm volatile("s_waitcnt lgkmcnt(0)" ::: "memory")
#define VM_WAIT() asm volatile("s_waitcnt vmcnt(0)" ::: "memory")
using pg8::cvt_pk_bf16; using pg8::bflo; using pg8::bfhi; using pg8::sigmoidf_;
__device__ __forceinline__ float bf2f(bf16 h) { return __uint_as_float((unsigned)h << 16); }
__device__ __forceinline__ bf16 f2bf(float f) { return (bf16)(cvt_pk_bf16(f, 0.f) & 0xffffu); }
__device__ __forceinline__ float shx(float v, int mask, int lane) { return __int_as_float(__builtin_amdgcn_ds_bpermute((lane ^ mask) << 2, __float_as_int(v))); }
__device__ __forceinline__ int shxi(int v, int mask, int lane) { return __builtin_amdgcn_ds_bpermute((lane ^ mask) << 2, v); }
__device__ __forceinline__ float shf(float v, int src) { return __int_as_float(__builtin_amdgcn_ds_bpermute(src << 2, __float_as_int(v))); }
__device__ __forceinline__ int shfi(int v, int src) { return __builtin_amdgcn_ds_bpermute(src << 2, v); }
__device__ __forceinline__ float wave_sum(float v, int lane) {
#pragma unroll
    for (int o = 1; o < 64; o <<= 1) v += shx(v, o, lane);
    return v;
}

#define XB_TMO      128
#define XB_XCNT(j)  (256  + 64 * (j))
#define XB_XSUB(j)  (1280 + 64 * (j))
#define XB_XGEN(j)  (2304 + 64 * (j))
#define XB_TOP      3328
#define XB_TOPGEN   3392
#define XCD_BAR_WORDS 3456
#define XB_SPIN_CAP (1u << 18)

__device__ __forceinline__ unsigned xb_ld(unsigned* p)              { return __hip_atomic_load(p, __ATOMIC_RELAXED, __HIP_MEMORY_SCOPE_AGENT); }
__device__ __forceinline__ unsigned xb_add(unsigned* p, unsigned v) { return __hip_atomic_fetch_add(p, v, __ATOMIC_RELAXED, __HIP_MEMORY_SCOPE_AGENT); }
__device__ __forceinline__ unsigned xb_xcc_id() { return (unsigned)__builtin_amdgcn_s_getreg((3 << 11) | 20) & 0xFu; }
#define XB_SPIN(cond, bar) do { unsigned _sp = 0; while (cond) { __builtin_amdgcn_s_sleep(1); \
    if ((++_sp & 255u) == 0u) { if (xb_ld(&(bar)[XB_TMO])) break; if (_sp > XB_SPIN_CAP) { atomicAdd(&(bar)[XB_TMO], 1u); break; } } } } while (0)

struct XcdBarrier {
    unsigned* bar; unsigned x;
    volatile LAS unsigned* st;
};

__device__ __forceinline__ XcdBarrier xcd_barrier_post(unsigned* bar, volatile LAS unsigned* st, const int tid_x  ) {
    XcdBarrier b; b.bar = bar; b.x = xb_xcc_id(); b.st = st;
    if (tid_x == 0) (void)xb_add(&bar[XB_XCNT(b.x)], 1u);
    return b;
}
__device__ __forceinline__ void xcd_barrier_complete(unsigned* bar, unsigned x, unsigned& nloc, unsigned& nx) {
    const unsigned G = gridDim.x * gridDim.y * gridDim.z;
    unsigned sum, cnt, mine, sp = 0u;
    for (;;) {
        sum = 0u; cnt = 0u; mine = 0u;
#pragma unroll
        for (unsigned j = 0; j < 16; ++j) { const unsigned c = xb_ld(&bar[XB_XCNT(j)]); sum += c; cnt += (c > 0u) ? 1u : 0u; mine = (j == x) ? c : mine; }
        if (sum == G) break;
        __builtin_amdgcn_s_sleep(1);
        if ((++sp & 255u) == 0u) { if (xb_ld(&bar[XB_TMO])) break; if (sp > XB_SPIN_CAP) { atomicAdd(&bar[XB_TMO], 1u); break; } }
    }
    nloc = mine > 0u ? mine : 1u; nx = cnt > 0u ? cnt : 1u;
}

__device__ __forceinline__ void xcd_barrier(const XcdBarrier& b, const int tid_x) {
    asm volatile("s_waitcnt vmcnt(0)" ::: "memory");
    __syncthreads();
    if (tid_x == 0) {
        unsigned* bar = b.bar;
        __builtin_amdgcn_s_waitcnt(0);
        unsigned nloc = b.st[0], nx = b.st[1];
        if (nloc == 0u) { xcd_barrier_complete(bar, b.x, nloc, nx); b.st[0] = nloc; b.st[1] = nx; }
        const unsigned old = xb_add(&bar[XB_XSUB(b.x)], 1u);
        const unsigned gen = old / nloc;
        if (old + 1u == (gen + 1u) * nloc) {
            __builtin_amdgcn_fence(__ATOMIC_RELEASE, "agent");
            asm volatile("s_waitcnt vmcnt(0)" ::: "memory");
            const unsigned og = xb_add(&bar[XB_TOP], 1u);
            const unsigned tg = og / nx;
            if (og + 1u == (tg + 1u) * nx) xb_add(&bar[XB_TOPGEN], 1u);
            else XB_SPIN(xb_ld(&bar[XB_TOPGEN]) == tg, bar);
            __builtin_amdgcn_fence(__ATOMIC_ACQUIRE, "agent");
            xb_add(&bar[XB_XGEN(b.x)], 1u);
            asm volatile("s_waitcnt vmcnt(0)" ::: "memory");
        } else {
            XB_SPIN(xb_ld(&bar[XB_XGEN(b.x)]) == gen, bar);
            __builtin_amdgcn_fence(__ATOMIC_ACQUIRE, "agent");
            asm volatile("s_waitcnt vmcnt(0)" ::: "memory");
        }
    }
    __syncthreads();
}


enum { I_X = 0, I_C, I_NORM1, I_NORM2, I_ADAW, I_ADAB, I_WIN, I_WPOOL, I_PSCALE, I_QNORM, I_KNORM, I_CMPPOS, I_CMPW1, I_CMPB1, I_CMPW2, I_WPA, I_WPB, I_WOUT,
       I_RW, I_RB, I_WGU, I_BGU, I_WD, I_BD, N_IN };
struct Args { const float* in[N_IN]; float* out; unsigned char* ws; int ph_lo, ph_hi, li, pad; };

struct Ctx {
    LAS unsigned char* lds;
    int tid, lane, wave, bx, G;
    unsigned char* ws;
};
__device__ __forceinline__ void fresh(Ctx& C) { unsigned z = 0u; asm volatile("" : "+s"(z));   int t = C.wave * 64 + (int)__builtin_amdgcn_mbcnt_hi(~0u, __builtin_amdgcn_mbcnt_lo(~0u, z)); asm volatile("" : "+v"(t)); C.tid = t; C.lane = t & 63; int bx = blockIdx.x, G = gridDim.x; asm volatile("" : "+s"(bx), "+s"(G)); C.bx = bx; C.G = G; }

__device__ __forceinline__ int inmap(int np) { return np < 2304 ? np : (np < 4352 ? np + 48 : (np < 4400 ? np - 2048 : -1)); }
template <bool MAPIN>
__device__ __forceinline__ void p0_transpose_item(const float* W, int K, int N, int NP, bf16* WT, LAS float* scr, int item, int lane) {
    const int nblk = NP / 32, kb = item / nblk, nb = item % nblk, k0 = 64 * kb, n0 = 32 * nb;
    int sc = n0 + (lane & 31); if (MAPIN) sc = inmap(sc);
#pragma unroll 8
    for (int i = 0; i < 32; ++i) { const int kk = 2 * i + (lane >> 5); scr[kk * 33 + (lane & 31)] = (sc >= 0) ? W[(size_t)(k0 + kk) * N + sc] : 0.f; }
    LDS_WAIT(); asm volatile("" ::: "memory");
    const int c = lane & 7;
#pragma unroll
    for (int j = 0; j < 4; ++j) { const int n = (lane >> 3) + 8 * j; const LAS float* s = scr + (8 * c) * 33 + n;
        v4u o; o.x = cvt_pk_bf16(s[0 * 33], s[1 * 33]); o.y = cvt_pk_bf16(s[2 * 33], s[3 * 33]); o.z = cvt_pk_bf16(s[4 * 33], s[5 * 33]); o.w = cvt_pk_bf16(s[6 * 33], s[7 * 33]);
        *(v4u*)(WT + (size_t)(n0 + n) * K + k0 + 8 * c) = o; }
    LDS_WAIT(); asm volatile("" ::: "memory");
}
__device__ __forceinline__ void p0_convert(const Ctx& C, const Args& a) {
    LAS float* scr = (LAS float*)(C.lds + C.wave * 16384);
    const int gw = C.bx * NWAVES + C.wave, NGW = C.G * NWAVES;
    constexpr int IT_IN = 16 * (ZW / 32), IT_A = 8 * 32, IT_B = 16 * 32, IT_O = 16 * 32, IT_W1 = 32 * 8, IT_W2 = 4 * 2, IT_GU = 16 * 64, IT_D = 16 * 32;
    constexpr int IT_LAYER = IT_IN + IT_A + IT_B + IT_O + 2 * IT_W1 + 2 * IT_W2 + NEXP * IT_GU + NEXP * IT_D;
    for (int it = gw; it < NL * IT_LAYER; it += NGW) {
        const int l = it / IT_LAYER; int r = it % IT_LAYER;
        if (r < IT_IN) { p0_transpose_item<true>(a.in[I_WIN] + (size_t)l * DM * IN_W, DM, IN_W, ZW, (bf16*)(C.ws + WS_WIN) + (size_t)l * ZW * DM, scr, r, C.lane); continue; } r -= IT_IN;
        if (r < IT_A) { p0_transpose_item<false>(a.in[I_WPA] + (size_t)l * 512 * 1024, 512, 1024, 1024, (bf16*)(C.ws + WS_WA) + (size_t)l * 1024 * 512, scr, r, C.lane); continue; } r -= IT_A;
        if (r < IT_B) { p0_transpose_item<false>(a.in[I_WPB] + (size_t)l * 1024 * 1024, 1024, 1024, 1024, (bf16*)(C.ws + WS_WB) + (size_t)l * 1024 * 1024, scr, r, C.lane); continue; } r -= IT_B;
        if (r < IT_O) { p0_transpose_item<false>(a.in[I_WOUT] + (size_t)l * 1024 * 1024, 1024, 1024, 1024, (bf16*)(C.ws + WS_WOUT) + (size_t)l * 1024 * 1024, scr, r, C.lane); continue; } r -= IT_O;
        if (r < 2 * IT_W1) { const int kv = r / IT_W1; p0_transpose_item<false>(a.in[I_CMPW1] + (size_t)(l * 2 + kv) * 2048 * 256, 2048, 256, 256, (bf16*)(C.ws + WS_W1) + (size_t)(l * 2 + kv) * 256 * 2048, scr, r % IT_W1, C.lane); continue; } r -= 2 * IT_W1;
        if (r < 2 * IT_W2) { const int kv = r / IT_W2; p0_transpose_item<false>(a.in[I_CMPW2] + (size_t)(l * 2 + kv) * 256 * 64, 256, 64, 64, (bf16*)(C.ws + WS_W2) + (size_t)(l * 2 + kv) * 64 * 256, scr, r % IT_W2, C.lane); continue; } r -= 2 * IT_W2;
        if (r < NEXP * IT_GU) { const int e = r / IT_GU; p0_transpose_item<false>(a.in[I_WGU] + (size_t)(l * NEXP + e) * 1024 * 2048, 1024, 2048, 2048, (bf16*)(C.ws + WS_WGU) + (size_t)(l * NEXP + e) * 2048 * 1024, scr, r % IT_GU, C.lane); continue; } r -= NEXP * IT_GU;
        { const int e = r / IT_D; p0_transpose_item<false>(a.in[I_WD] + (size_t)(l * NEXP + e) * 1024 * 1024, 1024, 1024, 1024, (bf16*)(C.ws + WS_WD) + (size_t)(l * NEXP + e) * 1024 * 1024, scr, r % IT_D, C.lane); }
    }
    const int gt = C.bx * (NWAVES * 64) + C.tid, NGT = C.G * NWAVES * 64;
    { bf16* wp = (bf16*)(C.ws + WS_WPOOL);
      for (int i = gt; i < NL * 512 * 512; i += NGT) { const int l = i >> 18, ep = (i >> 9) & 511, cp = i & 511; float v = 0.f;
          if ((ep >> 7) == (cp >> 7)) v = a.in[I_WPOOL][(((size_t)l * 4 + (ep >> 7)) * 128 + (cp & 127)) * 128 + (ep & 127)];
          wp[i] = f2bf(v); } }
    { float* rp = (float*)(C.ws + WS_ROPE);
      for (int i = gt; i < SEQ * 8; i += NGT) { const int pos = i >> 3, fi = i & 7;
          const float invf[8] = {1.0f, 0.1939227432012558f, 0.03760603070259094f, 0.007292664609849453f, 0.0014142135623842478f, 0.00027424818836152554f, 5.318296098266728e-05f, 1.0313386155758053e-05f};
          float f = invf[0];
#pragma unroll
          for (int q = 1; q < 8; ++q) f = (fi == q) ? invf[q] : f;
          const float ang = (float)pos * f; const double rev = (double)ang * 0.15915494309189535; const float fr = (float)(rev - __builtin_rint(rev));
          rp[pos * 16 + fi] = __builtin_amdgcn_cosf(fr); rp[pos * 16 + 8 + fi] = __builtin_amdgcn_sinf(fr); } }
    __syncthreads();
    { LAS float* sc = (LAS float*)C.lds;
      for (int i = C.tid; i < NB * DM; i += NWAVES * 64) { const float cv = a.in[I_C][i]; sc[i] = cv * sigmoidf_(cv); }
      __syncthreads();
      float* mp = (float*)(C.ws + WS_MODP);
      for (int i = gt; i < 4 * NL * 6144; i += NGT) { const int j = i % 6144, l = (i / 6144) % NL, ks = i / (6144 * NL);
          const float* w = a.in[I_ADAW] + ((size_t)l * DM + ks * 256) * 6144 + j; float a0 = 0.f, a1 = 0.f, a2 = 0.f, a3 = 0.f;
#pragma unroll 8
          for (int k = 0; k < 256; ++k) { const float wv = w[(size_t)k * 6144]; const int kk = ks * 256 + k;
              a0 += sc[kk] * wv; a1 += sc[DM + kk] * wv; a2 += sc[2 * DM + kk] * wv; a3 += sc[3 * DM + kk] * wv; }
          float* o = mp + ((size_t)(ks * NL + l) * NB) * 6144 + j; o[0] = a0; o[6144] = a1; o[2 * 6144] = a2; o[3 * 6144] = a3; }
      __syncthreads(); }
}
__device__ __forceinline__ void p1_mod(const Ctx& C, const Args& a) {
    const int gt = C.bx * (NWAVES * 64) + C.tid, NGT = C.G * NWAVES * 64;
    const float* mp = (const float*)(C.ws + WS_MODP); float* mo = (float*)(C.ws + WS_MOD);
    for (int i = gt; i < NL * NB * 6144; i += NGT) { const int j = i % 6144, l = i / (NB * 6144);
        float s = a.in[I_ADAB][l * 6144 + j];
#pragma unroll
        for (int ks = 0; ks < 4; ++ks) s += mp[(size_t)ks * NL * NB * 6144 + i];
        mo[i] = s; }
}


__device__ __forceinline__ void norm_rows(const Ctx& C, const float* X, const float* gain, const float* mod_l  , int shift_i, int scale_i, bf16* H) {
    const int gw = C.bx * NWAVES + C.wave, NGW = C.G * NWAVES;
    for (int m = gw; m < NTOK; m += NGW) {
        const int b = m >> 13; const f32x4* xr = (const f32x4*)(X + (size_t)m * DM) + C.lane;
        f32x4 v[4]; float s = 0.f;
#pragma unroll
        for (int j = 0; j < 4; ++j) { v[j] = xr[64 * j]; s += (v[j].x * v[j].x + v[j].y * v[j].y) + (v[j].z * v[j].z + v[j].w * v[j].w); }
        const float rstd = 1.0f / sqrtf(wave_sum(s, C.lane) * (1.0f / DM) + 1e-6f);
        const float* mb = mod_l + (size_t)b * 6144; v2u* o8 = (v2u*)(H + (size_t)m * DM) + C.lane;
#pragma unroll
        for (int j = 0; j < 4; ++j) { const int col = 4 * C.lane + 256 * j;
            const f32x4 g = *(const f32x4*)(gain + col), sc = *(const f32x4*)(mb + scale_i * DM + col), sh = *(const f32x4*)(mb + shift_i * DM + col);
            const f32x4 h = v[j] * rstd * g * (sc + 1.0f) + sh;
            v2u w; w.x = cvt_pk_bf16(h.x, h.y); w.y = cvt_pk_bf16(h.z, h.w); o8[64 * j] = w; }
    }
}

__device__ __forceinline__ void post_tokens(const Ctx& C, const Args& a, int l) {
    const int gw = C.bx * NWAVES + C.wave, NGW = C.G * NWAVES, lane = C.lane;
    const bf16* Z = (const bf16*)(C.ws + WS_Z); const float* rope = (const float*)(C.ws + WS_ROPE);
    bf16* Qn = (bf16*)(C.ws + WS_QN); bf16* Kslc = (bf16*)(C.ws + WS_KSLC); bf16* Kwin = (bf16*)(C.ws + WS_KWIN); bf16* Pm = (bf16*)(C.ws + WS_PM);
    const float* qn = a.in[I_QNORM] + l * 64; const float* kn = a.in[I_KNORM] + l * 192;
    for (int m = gw; m < NTOK; m += NGW) {
        const int b = m >> 13, t = m & (SEQ - 1); const bf16* zr = Z + (size_t)m * ZW; const float* rp = rope + t * 16;
        { const int head = lane >> 2, dq = (lane & 3) * 16; const v4u w0 = *(const v4u*)(zr + ZC_Q + head * 64 + dq), w1 = *(const v4u*)(zr + ZC_Q + head * 64 + dq + 8);
          float y[16]; y[0] = bflo(w0.x); y[1] = bfhi(w0.x); y[2] = bflo(w0.y); y[3] = bfhi(w0.y); y[4] = bflo(w0.z); y[5] = bfhi(w0.z); y[6] = bflo(w0.w); y[7] = bfhi(w0.w);
          y[8] = bflo(w1.x); y[9] = bfhi(w1.x); y[10] = bflo(w1.y); y[11] = bfhi(w1.y); y[12] = bflo(w1.z); y[13] = bfhi(w1.z); y[14] = bflo(w1.w); y[15] = bfhi(w1.w);
          float s = 0.f;
#pragma unroll
          for (int i = 0; i < 16; ++i) s += y[i] * y[i];
          s += shx(s, 1, lane); s += shx(s, 2, lane);
          const float rstd = 1.0f / sqrtf(s * (1.0f / 64.0f) + 1e-6f);
#pragma unroll
          for (int i = 0; i < 16; ++i) y[i] = y[i] * rstd * qn[dq + i];
          if ((lane & 3) == 0) {
#pragma unroll
              for (int i = 0; i < 8; ++i) { const float c = rp[i], sn = rp[8 + i], x1 = y[i], x2 = y[8 + i]; y[i] = x1 * c - x2 * sn; y[8 + i] = x2 * c + x1 * sn; } }
          v4u o0, o1; o0.x = cvt_pk_bf16(y[0], y[1]); o0.y = cvt_pk_bf16(y[2], y[3]); o0.z = cvt_pk_bf16(y[4], y[5]); o0.w = cvt_pk_bf16(y[6], y[7]);
          o1.x = cvt_pk_bf16(y[8], y[9]); o1.y = cvt_pk_bf16(y[10], y[11]); o1.z = cvt_pk_bf16(y[12], y[13]); o1.w = cvt_pk_bf16(y[14], y[15]);
          bf16* qo = Qn + (size_t)m * DM + head * 64 + dq; *(v4u*)qo = o0; *(v4u*)(qo + 8) = o1; }
        { const int which = lane >> 4, g = which & 1, li = lane & 15, dk = li * 4; const int sec = (which < 2) ? ZC_KSL : ZC_KWN;
          const v2u w = *(const v2u*)(zr + sec + g * 64 + dk); float y[4] = {bflo(w.x), bfhi(w.x), bflo(w.y), bfhi(w.y)};
          float s = y[0] * y[0] + y[1] * y[1] + y[2] * y[2] + y[3] * y[3];
          s += shx(s, 1, lane); s += shx(s, 2, lane); s += shx(s, 4, lane); s += shx(s, 8, lane);
          const float rstd = 1.0f / sqrtf(s * (1.0f / 64.0f) + 1e-6f); const float* gk = kn + ((which < 2) ? 64 : 128) + dk;
#pragma unroll
          for (int i = 0; i < 4; ++i) y[i] = y[i] * rstd * gk[i];
          float pz[4];
#pragma unroll
          for (int i = 0; i < 4; ++i) pz[i] = shx(y[i], 2, lane);
          if (li < 4) { const int fi = (li & 1) * 4;
#pragma unroll
              for (int i = 0; i < 4; ++i) { const float c = rp[fi + i], sn = rp[8 + fi + i]; y[i] = (li < 2) ? (y[i] * c - pz[i] * sn) : (y[i] * c + pz[i] * sn); } }
          v2u o; o.x = cvt_pk_bf16(y[0], y[1]); o.y = cvt_pk_bf16(y[2], y[3]);
          bf16* ko = ((which < 2) ? Kslc : Kwin) + ((size_t)(b * 2 + g) * SEQ + t) * 64 + dk; *(v2u*)ko = o; }
        { const int ch = lane * 8, w = 2 << (lane >> 4), cnt = (t + 1 < w) ? (t + 1) : w; float sum[8] = {0.f, 0.f, 0.f, 0.f, 0.f, 0.f, 0.f, 0.f}; float self[8];
          for (int k = 0; k < cnt; ++k) { const v4u u = *(const v4u*)(zr - (size_t)k * ZW + ZC_U + ch);
              const float f[8] = {bflo(u.x), bfhi(u.x), bflo(u.y), bfhi(u.y), bflo(u.z), bfhi(u.z), bflo(u.w), bfhi(u.w)};
#pragma unroll
              for (int i = 0; i < 8; ++i) { sum[i] += f[i]; if (k == 0) self[i] = f[i]; } }
          const float inv = 1.0f / (float)cnt; v4u o;
          o.x = cvt_pk_bf16(sum[0] * inv - self[0], sum[1] * inv - self[1]); o.y = cvt_pk_bf16(sum[2] * inv - self[2], sum[3] * inv - self[3]);
          o.z = cvt_pk_bf16(sum[4] * inv - self[4], sum[5] * inv - self[5]); o.w = cvt_pk_bf16(sum[6] * inv - self[6], sum[7] * inv - self[7]);
          *(v4u*)(Pm + (size_t)m * 512 + ch) = o; }
    }
    { bf16* VsT = (bf16*)(C.ws + WS_VSLCT); bf16* VwT = (bf16*)(C.ws + WS_VWINT);
      for (int it = gw; it < 2 * NB * 2 * (SEQ / 64); it += NGW) { const int tt = it & 127, g = (it >> 7) & 1, b = (it >> 8) & 3, which = it >> 10;
          const bf16* src = Z + ((size_t)(b * SEQ + tt * 64 + lane)) * ZW + (which ? ZC_VWN : ZC_VSL) + g * 64;
          bf16* dst = (which ? VwT : VsT) + ((size_t)(b * 2 + g) * 64) * SEQ + tt * 64 + lane;
#pragma unroll
          for (int c = 0; c < 8; ++c) { const v4u u = *(const v4u*)(src + 8 * c); bf16* d = dst + (size_t)(8 * c) * SEQ;
              d[0] = (bf16)(u.x & 0xffff); d[SEQ] = (bf16)(u.x >> 16); d[2 * SEQ] = (bf16)(u.y & 0xffff); d[3 * SEQ] = (bf16)(u.y >> 16);
              d[4 * SEQ] = (bf16)(u.z & 0xffff); d[5 * SEQ] = (bf16)(u.z >> 16); d[6 * SEQ] = (bf16)(u.w & 0xffff); d[7 * SEQ] = (bf16)(u.w >> 16); } } }
}

__device__ __forceinline__ void compress_unit(const Ctx& C, const Args& a, int l, int u) {
    const int kv = u & 1, nt = (u >> 1) & 31, bg = u >> 6, b = bg >> 1, g = bg & 1, n0 = nt * 16;
    const int lane = C.lane, r16 = lane & 15, quad = lane >> 4, w = C.wave;
    const bf16* Z = (const bf16*)(C.ws + WS_Z);
    const bf16* W1t = (const bf16*)(C.ws + WS_W1) + (size_t)(l * 2 + kv) * 256 * 2048;
    const bf16* W2t = (const bf16*)(C.ws + WS_W2) + (size_t)(l * 2 + kv) * 64 * 256;
    const float* pos = a.in[I_CMPPOS] + (size_t)(l * 2 + kv) * 32 * 64;
    const float* b1 = a.in[I_CMPB1] + (size_t)(l * 2 + kv) * 256;
    LAS bf16* hidL = (LAS bf16*)C.lds;
    LAS float* outL = (LAS float*)(C.lds + 16 * 264 * 2);
    const int nl = (n0 + r16 > 510) ? 510 : (n0 + r16);
    const bf16* arow = Z + ((size_t)(b * SEQ + 16 * nl)) * ZW + (kv ? ZC_VCM : ZC_KCM) + g * 64;
    f32x4 acc0 = {0.f, 0.f, 0.f, 0.f}, acc1 = {0.f, 0.f, 0.f, 0.f};
    const bf16* wb0 = W1t + (size_t)(32 * w + r16) * 2048 + quad * 8; const bf16* wb1 = wb0 + (size_t)16 * 2048;
#pragma unroll 4
    for (int ks = 0; ks < 64; ++ks) { const int lrow = ks >> 1, d = (ks & 1) * 32 + quad * 8;
        const v4u zv = *(const v4u*)(arow + (size_t)lrow * ZW + d); const f32x4 p0 = *(const f32x4*)(pos + lrow * 64 + d), p1 = *(const f32x4*)(pos + lrow * 64 + d + 4);
        v4u av; av.x = cvt_pk_bf16(bflo(zv.x) + p0.x, bfhi(zv.x) + p0.y); av.y = cvt_pk_bf16(bflo(zv.y) + p0.z, bfhi(zv.y) + p0.w);
        av.z = cvt_pk_bf16(bflo(zv.z) + p1.x, bfhi(zv.z) + p1.y); av.w = cvt_pk_bf16(bflo(zv.w) + p1.z, bfhi(zv.w) + p1.w);
        const bf16x8 af = __builtin_bit_cast(bf16x8, av);
        const bf16x8 bf0 = *(const bf16x8*)(wb0 + ks * 32), bf1 = *(const bf16x8*)(wb1 + ks * 32);
        acc0 = __builtin_amdgcn_mfma_f32_16x16x32_bf16(af, bf0, acc0, 0, 0, 0);
        acc1 = __builtin_amdgcn_mfma_f32_16x16x32_bf16(af, bf1, acc1, 0, 0, 0); }
    { const float bb0 = b1[32 * w + r16], bb1 = b1[32 * w + 16 + r16];
#pragma unroll
      for (int r = 0; r < 4; ++r) { float h0 = acc0[r] + bb0, h1 = acc1[r] + bb1; h0 = h0 * sigmoidf_(h0); h1 = h1 * sigmoidf_(h1);
          hidL[(4 * quad + r) * 264 + 32 * w + r16] = f2bf(h0); hidL[(4 * quad + r) * 264 + 32 * w + 16 + r16] = f2bf(h1); } }
    __syncthreads();
    if (w < 4) { f32x4 o = {0.f, 0.f, 0.f, 0.f}; const bf16* w2 = W2t + (size_t)(16 * w + r16) * 256 + quad * 8;
#pragma unroll
        for (int ks = 0; ks < 8; ++ks) { const bf16x8 af = *(const LAS bf16x8*)(hidL + r16 * 264 + ks * 32 + quad * 8); const bf16x8 bfr = *(const bf16x8*)(w2 + ks * 32);
            o = __builtin_amdgcn_mfma_f32_16x16x32_bf16(af, bfr, o, 0, 0, 0); }
#pragma unroll
        for (int r = 0; r < 4; ++r) outL[(4 * quad + r) * 68 + 16 * w + r16] = o[r]; }
    __syncthreads();
    if (w == 0) { const int i = lane >> 2, c0 = (lane & 3) * 16, n = n0 + i; float y[16];
#pragma unroll
        for (int j = 0; j < 16; ++j) y[j] = outL[i * 68 + c0 + j];
        if (kv == 0) { float s = 0.f;
#pragma unroll
            for (int j = 0; j < 16; ++j) s += y[j] * y[j];
            s += shx(s, 1, lane); s += shx(s, 2, lane);
            const float rstd = 1.0f / sqrtf(s * (1.0f / 64.0f) + 1e-6f); const float* gk = a.in[I_KNORM] + l * 192 + c0;
#pragma unroll
            for (int j = 0; j < 16; ++j) y[j] = y[j] * rstd * gk[j];
            if ((lane & 3) == 0 && n <= 510) { const float* rp = (const float*)(C.ws + WS_ROPE) + (16 * n + 31) * 16;
#pragma unroll
                for (int j = 0; j < 8; ++j) { const float c = rp[j], sn = rp[8 + j], x1 = y[j], x2 = y[8 + j]; y[j] = x1 * c - x2 * sn; y[8 + j] = x2 * c + x1 * sn; } }
            if (n > 510) {
#pragma unroll
                for (int j = 0; j < 16; ++j) y[j] = 0.f; }
            v4u o0, o1; o0.x = cvt_pk_bf16(y[0], y[1]); o0.y = cvt_pk_bf16(y[2], y[3]); o0.z = cvt_pk_bf16(y[4], y[5]); o0.w = cvt_pk_bf16(y[6], y[7]);
            o1.x = cvt_pk_bf16(y[8], y[9]); o1.y = cvt_pk_bf16(y[10], y[11]); o1.z = cvt_pk_bf16(y[12], y[13]); o1.w = cvt_pk_bf16(y[14], y[15]);
            bf16* ko = (bf16*)(C.ws + WS_KC) + ((size_t)bg * 512 + n) * 64 + c0; *(v4u*)ko = o0; *(v4u*)(ko + 8) = o1;
        } else { bf16* vo = (bf16*)(C.ws + WS_VCT) + ((size_t)bg * 64 + c0) * 512 + n;
#pragma unroll
            for (int j = 0; j < 16; ++j) vo[(size_t)j * 512] = (n > 510) ? (bf16)0 : f2bf(y[j]); } }
    __syncthreads();
}


#define MFMA16(a, b, c) __builtin_amdgcn_mfma_f32_16x16x32_bf16(a, b, c, 0, 0, 0)
constexpr float SM_SCALE = 0.125f * 1.4426950408889634f;
constexpr int AT_SLOT = 16384, AT_NSLOT = 4, AT_PF = 3;
constexpr int AT_IMP_OFF = AT_SLOT * AT_NSLOT;
constexpr int AT_MASK_OFF = AT_IMP_OFF + 8 * 8 * 128 * 4;
__device__ __forceinline__ bf16x8 pack_p(const f32x4& p0, const f32x4& p1) {
    v4u w; w.x = cvt_pk_bf16(p0[0], p0[1]); w.y = cvt_pk_bf16(p0[2], p0[3]); w.z = cvt_pk_bf16(p1[0], p1[1]); w.w = cvt_pk_bf16(p1[2], p1[3]); return __builtin_bit_cast(bf16x8, w);
}
__device__ __forceinline__ int tile_off(int row, int chunk) { return row * 128 + ((chunk ^ ((row >> 1) & 7)) << 4); }
struct AtJob { const bf16* k; const bf16* v; int vpitch; };
struct AtUnit { int b, g, c, bg, nct, njobs, wlo; };
__device__ __forceinline__ AtJob at_job(const Ctx& C, const AtUnit& U, int k) {
    AtJob J; const int k2 = k - 2 * U.nct;
    if (k2 < 0) { const int j = (k < U.nct) ? k : k - U.nct; J.k = (const bf16*)(C.ws + WS_KC) + ((size_t)U.bg * 512 + 64 * j) * 64; J.v = (const bf16*)(C.ws + WS_VCT) + (size_t)U.bg * 64 * 512 + 64 * j; J.vpitch = 512; }
    else if (k2 <= U.c) { J.k = (const bf16*)(C.ws + WS_KSLC) + ((size_t)U.bg * SEQ + 64 * k2) * 64; J.v = (const bf16*)(C.ws + WS_VSLCT) + (size_t)U.bg * 64 * SEQ + 64 * k2; J.vpitch = SEQ; }
    else { const int w = U.wlo + (k2 - U.c - 1); J.k = (const bf16*)(C.ws + WS_KWIN) + ((size_t)U.bg * SEQ + 64 * w) * 64; J.v = (const bf16*)(C.ws + WS_VWINT) + (size_t)U.bg * 64 * SEQ + 64 * w; J.vpitch = SEQ; }
    return J;
}
__device__ __forceinline__ void at_stage(const Ctx& C, const AtJob& J, int slot) {
    const int row = 8 * C.wave + (C.lane >> 3), chunk = (C.lane & 7) ^ ((row >> 1) & 7);
    __builtin_amdgcn_global_load_lds((const unsigned*)(J.k + (size_t)row * 64 + chunk * 8), (LAS unsigned*)(C.lds + slot * AT_SLOT + C.wave * 1024), 16, 0, 0);
    __builtin_amdgcn_global_load_lds((const unsigned*)(J.v + (size_t)row * J.vpitch + chunk * 8), (LAS unsigned*)(C.lds + slot * AT_SLOT + 8192 + C.wave * 1024), 16, 0, 0);
}
__device__ __forceinline__ void at_load_k(LAS unsigned char* sl, int jp, int r16, int quad, bf16x8 (&kf)[2][2]) {
#pragma unroll
    for (int h = 0; h < 2; ++h)
#pragma unroll
        for (int kh = 0; kh < 2; ++kh) kf[h][kh] = *(const LAS bf16x8*)(sl + tile_off(32 * jp + 16 * h + r16, kh * 4 + quad));
}
__device__ __forceinline__ void at_load_v(LAS unsigned char* sl, int jp, int r16, int quad, bf16x8 (&vf)[4]) {
#pragma unroll
    for (int db = 0; db < 4; ++db) { const int row = 16 * db + r16;
        const v2u lo = *(const LAS v2u*)(sl + 8192 + tile_off(row, 4 * jp + (quad >> 1)) + (quad & 1) * 8), hi = *(const LAS v2u*)(sl + 8192 + tile_off(row, 4 * jp + 2 + (quad >> 1)) + (quad & 1) * 8);
        v4u w; w.x = lo.x; w.y = lo.y; w.z = hi.x; w.w = hi.y; vf[db] = __builtin_bit_cast(bf16x8, w); }
}
template <class Valid>
__device__ __forceinline__ void at_online(f32x4& s0, f32x4& s1, const Valid& valid, float& mrun, float& lrun, f32x4 (&o)[4], const bf16x8 (&vf)[4], int lane) {
    float bmax = -1e30f;
#pragma unroll
    for (int r = 0; r < 4; ++r) { bmax = valid(0, r) ? fmaxf(bmax, s0[r]) : bmax; bmax = valid(1, r) ? fmaxf(bmax, s1[r]) : bmax; }
    bmax = fmaxf(bmax, shx(bmax, 16, lane)); bmax = fmaxf(bmax, shx(bmax, 32, lane));
    const float mnew = fmaxf(mrun, bmax), alpha = __builtin_amdgcn_exp2f((mrun - mnew) * SM_SCALE);
    float ps = 0.f;
#pragma unroll
    for (int r = 0; r < 4; ++r) { const float p0 = valid(0, r) ? __builtin_amdgcn_exp2f((s0[r] - mnew) * SM_SCALE) : 0.f, p1 = valid(1, r) ? __builtin_amdgcn_exp2f((s1[r] - mnew) * SM_SCALE) : 0.f; s0[r] = p0; s1[r] = p1; ps += p0 + p1; }
    lrun = lrun * alpha + ps; mrun = mnew;
    const bf16x8 pb = pack_p(s0, s1);
#pragma unroll
    for (int db = 0; db < 4; ++db) { o[db] = o[db] * alpha; o[db] = MFMA16(vf[db], pb, o[db]); }
}

__device__ __forceinline__ void attn_unit(const Ctx& C, const AtUnit& U, float* scr  ) {
    const int lane0 = C.lane, wv = C.wave;
    const int ta = 64 * U.c + 8 * wv;
    const bf16* Qn = (const bf16*)(C.ws + WS_QN); const bf16* Z = (const bf16*)(C.ws + WS_Z);
    bf16x8 q[4][2]; f32x4 O[4][4]; float mrun[4], lrun[4], pup[4];
    { const int lane = lane0, r16 = lane & 15, quad = lane >> 4, tokc = r16 >> 3, head = r16 & 7; LAS float* impL = (LAS float*)(C.lds + AT_IMP_OFF + wv * 4096);
#pragma unroll
    for (int cb = 0; cb < 4; ++cb) { const bf16* qrow = Qn + ((size_t)(U.b * SEQ + ta + 2 * cb + tokc)) * DM + (U.g * 8 + head) * 64;
        q[cb][0] = *(const bf16x8*)(qrow + quad * 8); q[cb][1] = *(const bf16x8*)(qrow + 32 + quad * 8);
        mrun[cb] = -1e30f; lrun[cb] = 0.f; pup[cb] = 0.f;
#pragma unroll
        for (int db = 0; db < 4; ++db) O[cb][db] = (f32x4){0.f, 0.f, 0.f, 0.f}; }
#pragma unroll
    for (int i = 0; i < 4; ++i) *(LAS f32x4*)(impL + 4 * lane + 256 * i) = (f32x4){0.f, 0.f, 0.f, 0.f};
    }
    const int nvw = ((ta + 7 - 31) >= 0) ? (((ta + 7 - 31) >> 4) + 1) : 0;
    const int nsp = (nvw + 31) >> 5;
    const int j_c2 = U.nct, j_sl = 2 * U.nct, j_wn = 2 * U.nct + U.c + 1;
#pragma unroll
    for (int k = 0; k < AT_PF; ++k) { const int kk = (k < U.njobs) ? k : U.njobs - 1; at_stage(C, at_job(C, U, kk), k % AT_NSLOT); }
    int k = 0;
    for (; k < j_c2; ++k) {
        asm volatile("s_waitcnt vmcnt(4)" ::: "memory");
        __builtin_amdgcn_s_barrier(); asm volatile("" ::: "memory");
        { const int kn = k + AT_PF; const int kk = (kn < U.njobs) ? kn : U.njobs - 1; at_stage(C, at_job(C, U, kk), kn % AT_NSLOT); }
        LAS unsigned char* sl = C.lds + (k % AT_NSLOT) * AT_SLOT;
        int lane_ = lane0; asm volatile("" : "+v"(lane_));
        const int lane = lane_, r16 = lane & 15, quad = lane >> 4, tokc = r16 >> 3, head = r16 & 7;
        f32x4* scr4 = (f32x4*)(scr + lane * 64);
        LAS float* impL = (LAS float*)(C.lds + AT_IMP_OFF + wv * 4096); LAS unsigned* maskL = (LAS unsigned*)(C.lds + AT_MASK_OFF + wv * 128);
        {
            const int j = k;
#pragma unroll
            for (int jp = 0; jp < 2; ++jp) { if (2 * j + jp >= nsp) break;
                bf16x8 kf[2][2]; at_load_k(sl, jp, r16, quad, kf);
#pragma unroll
                for (int cb = 0; cb < 4; ++cb) { const int tl = ta + 2 * cb + tokc; const int nvl = (tl >= 31) ? (((tl - 31) >> 4) + 1) : 0;
                    f32x4 s0 = {0.f, 0.f, 0.f, 0.f}, s1 = {0.f, 0.f, 0.f, 0.f};
                    s0 = MFMA16(kf[0][0], q[cb][0], s0); s0 = MFMA16(kf[0][1], q[cb][1], s0); s1 = MFMA16(kf[1][0], q[cb][0], s1); s1 = MFMA16(kf[1][1], q[cb][1], s1);
                    const int n0 = 64 * j + 32 * jp + 4 * quad; float bm = mrun[cb];
#pragma unroll
                    for (int r = 0; r < 4; ++r) { bm = (n0 + r < nvl) ? fmaxf(bm, s0[r]) : bm; bm = (n0 + 16 + r < nvl) ? fmaxf(bm, s1[r]) : bm; }
                    float ps = 0.f;
#pragma unroll
                    for (int r = 0; r < 4; ++r) { ps += (n0 + r < nvl) ? __builtin_amdgcn_exp2f((s0[r] - bm) * SM_SCALE) : 0.f; ps += (n0 + 16 + r < nvl) ? __builtin_amdgcn_exp2f((s1[r] - bm) * SM_SCALE) : 0.f; }
                    lrun[cb] = lrun[cb] * __builtin_amdgcn_exp2f((mrun[cb] - bm) * SM_SCALE) + ps; mrun[cb] = bm; } }
        }
        asm volatile("s_waitcnt lgkmcnt(0)" ::: "memory");
    }
    {
    int lane_ = lane0; asm volatile("" : "+v"(lane_));
    const int lane = lane_, r16 = lane & 15, quad = lane >> 4, tokc = r16 >> 3, head = r16 & 7; f32x4* scr4 = (f32x4*)(scr + lane * 64);
    LAS float* impL = (LAS float*)(C.lds + AT_IMP_OFF + wv * 4096); LAS unsigned* maskL = (LAS unsigned*)(C.lds + AT_MASK_OFF + wv * 128); (void)scr4; (void)impL; (void)maskL; (void)head; (void)tokc; (void)quad;
    {
#pragma unroll
            for (int cb = 0; cb < 4; ++cb) { float mall = fmaxf(mrun[cb], shx(mrun[cb], 16, lane)); mall = fmaxf(mall, shx(mall, 32, lane));
                float ls = lrun[cb] * __builtin_amdgcn_exp2f((mrun[cb] - mall) * SM_SCALE); ls += shx(ls, 16, lane); ls += shx(ls, 32, lane);
                mrun[cb] = mall; lrun[cb] = (ls > 0.f) ? 1.0f / ls : 0.f; }
        }
    }
    for (; k < j_sl; ++k) {
        asm volatile("s_waitcnt vmcnt(4)" ::: "memory");
        __builtin_amdgcn_s_barrier(); asm volatile("" ::: "memory");
        { const int kn = k + AT_PF; const int kk = (kn < U.njobs) ? kn : U.njobs - 1; at_stage(C, at_job(C, U, kk), kn % AT_NSLOT); }
        LAS unsigned char* sl = C.lds + (k % AT_NSLOT) * AT_SLOT;
        int lane_ = lane0; asm volatile("" : "+v"(lane_));
        const int lane = lane_, r16 = lane & 15, quad = lane >> 4, tokc = r16 >> 3, head = r16 & 7;
        f32x4* scr4 = (f32x4*)(scr + lane * 64);
        LAS float* impL = (LAS float*)(C.lds + AT_IMP_OFF + wv * 4096); LAS unsigned* maskL = (LAS unsigned*)(C.lds + AT_MASK_OFF + wv * 128);
        {
            const int j = k - j_c2;
#pragma unroll
            for (int jp = 0; jp < 2; ++jp) { if (2 * j + jp >= nsp) break;
                bf16x8 kf[2][2]; at_load_k(sl, jp, r16, quad, kf); bf16x8 vf[4]; at_load_v(sl, jp, r16, quad, vf);
#pragma unroll
                for (int cb = 0; cb < 4; ++cb) { const int tok8 = 2 * cb + tokc, tl = ta + tok8; const int nvl = (tl >= 31) ? (((tl - 31) >> 4) + 1) : 0;
                    f32x4 s0 = {0.f, 0.f, 0.f, 0.f}, s1 = {0.f, 0.f, 0.f, 0.f};
                    s0 = MFMA16(kf[0][0], q[cb][0], s0); s0 = MFMA16(kf[0][1], q[cb][1], s0); s1 = MFMA16(kf[1][0], q[cb][0], s1); s1 = MFMA16(kf[1][1], q[cb][1], s1);
                    const int n0 = 64 * j + 32 * jp + 4 * quad;
#pragma unroll
                    for (int r = 0; r < 4; ++r) { s0[r] = (n0 + r < nvl) ? __builtin_amdgcn_exp2f((s0[r] - mrun[cb]) * SM_SCALE) * lrun[cb] : 0.f; s1[r] = (n0 + 16 + r < nvl) ? __builtin_amdgcn_exp2f((s1[r] - mrun[cb]) * SM_SCALE) * lrun[cb] : 0.f; }
                    const bf16x8 pb = pack_p(s0, s1);
#pragma unroll
                    for (int db = 0; db < 4; ++db) O[cb][db] = MFMA16(vf[db], pb, O[cb][db]);
#pragma unroll
                    for (int h = 0; h < 2; ++h) { const f32x4& st = h ? s1 : s0; float h3 = st[3], hs = (st[0] + st[1]) + (st[2] + st[3]);
                        hs += shx(hs, 1, lane); hs += shx(hs, 2, lane); hs += shx(hs, 4, lane);
                        h3 += shx(h3, 1, lane); h3 += shx(h3, 2, lane); h3 += shx(h3, 4, lane);
                        const float up = shf(h3, (lane + 48) & 63);
                        const float val = hs + ((quad == 0) ? pup[cb] : up); pup[cb] = up;
                        if (head == 0) impL[tok8 * 128 + 4 * (4 * j + 2 * jp + h) + quad] = val; } } }
        }
        asm volatile("s_waitcnt lgkmcnt(0)" ::: "memory");
    }
    {
    int lane_ = lane0; asm volatile("" : "+v"(lane_));
    const int lane = lane_, r16 = lane & 15, quad = lane >> 4, tokc = r16 >> 3, head = r16 & 7; f32x4* scr4 = (f32x4*)(scr + lane * 64);
    LAS float* impL = (LAS float*)(C.lds + AT_IMP_OFF + wv * 4096); LAS unsigned* maskL = (LAS unsigned*)(C.lds + AT_MASK_OFF + wv * 128); (void)scr4; (void)impL; (void)maskL; (void)head; (void)tokc; (void)quad;
    {
            asm volatile("s_waitcnt lgkmcnt(0)" ::: "memory");
#pragma unroll
            for (int cb = 0; cb < 4; ++cb) { const int tok8 = 2 * cb + tokc, tl = ta + tok8;
                if (2 * nsp < 32 && head == 0 && quad == 0) impL[tok8 * 128 + 8 * nsp] = pup[cb];
                const float g0 = sigmoidf_(bf2f(Z[((size_t)(U.b * SEQ + tl)) * ZW + ZC_NG + U.g * 8 + head]));
#pragma unroll
                for (int db = 0; db < 4; ++db) { scr4[cb * 4 + db] = O[cb][db] * g0; O[cb][db] = (f32x4){0.f, 0.f, 0.f, 0.f}; }
                mrun[cb] = -1e30f; lrun[cb] = 0.f; }
            asm volatile("s_waitcnt lgkmcnt(0)" ::: "memory");
#pragma unroll
            for (int cb = 0; cb < 4; ++cb) { const int tok8 = 2 * cb + tokc, cur = U.c, lam = head * 4 + quad;
                unsigned mk0 = 0u, mk1 = 0u, mk2 = 0u, mk3 = 0u;
                if (cur <= 15) { mk0 = (2u << cur) - 1u; }
                else {
                    f32x4 v = *(const LAS f32x4*)(impL + tok8 * 128 + 4 * lam);
#pragma unroll
                    for (int jx = 0; jx < 4; ++jx) { const int s = 4 * lam + jx; float x = v[jx]; x = (s > cur) ? -1.0f : x; x = (s == 0 || s == cur) ? 1e9f : x; v[jx] = x; }
                    for (int round = 0; round < 16; ++round) {
                        float bv = v[0]; int bs = 4 * lam;
#pragma unroll
                        for (int jx = 1; jx < 4; ++jx) { const bool gt = v[jx] > bv; bv = gt ? v[jx] : bv; bs = gt ? 4 * lam + jx : bs; }
#pragma unroll
                        for (int st = 0; st < 5; ++st) { const int off = (st < 3) ? (1 << st) : (st == 3 ? 16 : 32);
                            const float ov = shx(bv, off, lane); const int os = shxi(bs, off, lane); const bool take = (ov > bv) || (ov == bv && os < bs); bv = take ? ov : bv; bs = take ? os : bs; }
#pragma unroll
                        for (int jx = 0; jx < 4; ++jx) v[jx] = (bs == 4 * lam + jx) ? -3.0f : v[jx];
                        const unsigned bit = 1u << (bs & 31); const int wd = bs >> 5;
                        mk0 |= (wd == 0) ? bit : 0u; mk1 |= (wd == 1) ? bit : 0u; mk2 |= (wd == 2) ? bit : 0u; mk3 |= (wd == 3) ? bit : 0u;
                    }
                }
                if (head == 0 && quad == 0) { maskL[0 * 8 + tok8] = mk0; maskL[1 * 8 + tok8] = mk1; maskL[2 * 8 + tok8] = mk2; maskL[3 * 8 + tok8] = mk3; }
            }
            asm volatile("s_waitcnt lgkmcnt(0)" ::: "memory");
        }
    }
    for (; k < j_wn; ++k) {
        asm volatile("s_waitcnt vmcnt(4)" ::: "memory");
        __builtin_amdgcn_s_barrier(); asm volatile("" ::: "memory");
        { const int kn = k + AT_PF; const int kk = (kn < U.njobs) ? kn : U.njobs - 1; at_stage(C, at_job(C, U, kk), kn % AT_NSLOT); }
        LAS unsigned char* sl = C.lds + (k % AT_NSLOT) * AT_SLOT;
        int lane_ = lane0; asm volatile("" : "+v"(lane_));
        const int lane = lane_, r16 = lane & 15, quad = lane >> 4, tokc = r16 >> 3, head = r16 & 7;
        f32x4* scr4 = (f32x4*)(scr + lane * 64);
        LAS float* impL = (LAS float*)(C.lds + AT_IMP_OFF + wv * 4096); LAS unsigned* maskL = (LAS unsigned*)(C.lds + AT_MASK_OFF + wv * 128);
        {
            const int s = k - j_sl; unsigned selw[4]; bool need[4]; bool any = false;
#pragma unroll
            for (int cb = 0; cb < 4; ++cb) { selw[cb] = (maskL[(s >> 5) * 8 + 2 * cb + tokc] >> (s & 31)) & 1u; need[cb] = __builtin_amdgcn_ballot_w64(selw[cb] != 0u) != 0ull; any = any || need[cb]; }
            if (any) {
#pragma unroll
                for (int jp = 0; jp < 2; ++jp) { bf16x8 kf[2][2]; at_load_k(sl, jp, r16, quad, kf); bf16x8 vf[4]; at_load_v(sl, jp, r16, quad, vf);
#pragma unroll
                    for (int cb = 0; cb < 4; ++cb) if (need[cb]) { const int tl = ta + 2 * cb + tokc; const bool sel = selw[cb] != 0u; const int key0 = 64 * s + 32 * jp + 4 * quad;
                        f32x4 s0 = {0.f, 0.f, 0.f, 0.f}, s1 = {0.f, 0.f, 0.f, 0.f};
                        s0 = MFMA16(kf[0][0], q[cb][0], s0); s0 = MFMA16(kf[0][1], q[cb][1], s0); s1 = MFMA16(kf[1][0], q[cb][0], s1); s1 = MFMA16(kf[1][1], q[cb][1], s1);
                        at_online(s0, s1, [=](int h, int r) { return sel && (key0 + 16 * h + r <= tl); }, mrun[cb], lrun[cb], O[cb], vf, lane); } }
            }
        }
        asm volatile("s_waitcnt lgkmcnt(0)" ::: "memory");
    }
    {
    int lane_ = lane0; asm volatile("" : "+v"(lane_));
    const int lane = lane_, r16 = lane & 15, quad = lane >> 4, tokc = r16 >> 3, head = r16 & 7; f32x4* scr4 = (f32x4*)(scr + lane * 64);
    LAS float* impL = (LAS float*)(C.lds + AT_IMP_OFF + wv * 4096); LAS unsigned* maskL = (LAS unsigned*)(C.lds + AT_MASK_OFF + wv * 128); (void)scr4; (void)impL; (void)maskL; (void)head; (void)tokc; (void)quad;
    {
#pragma unroll
            for (int cb = 0; cb < 4; ++cb) { const int tl = ta + 2 * cb + tokc;
                float ls = lrun[cb]; ls += shx(ls, 16, lane); ls += shx(ls, 32, lane);
                const float g1 = sigmoidf_(bf2f(Z[((size_t)(U.b * SEQ + tl)) * ZW + ZC_NG + 16 + U.g * 8 + head])) / ls;
#pragma unroll
                for (int db = 0; db < 4; ++db) { scr4[cb * 4 + db] = scr4[cb * 4 + db] + O[cb][db] * g1; O[cb][db] = (f32x4){0.f, 0.f, 0.f, 0.f}; }
                mrun[cb] = -1e30f; lrun[cb] = 0.f; }
        }
    }
    for (; k < U.njobs; ++k) {
        asm volatile("s_waitcnt vmcnt(4)" ::: "memory");
        __builtin_amdgcn_s_barrier(); asm volatile("" ::: "memory");
        { const int kn = k + AT_PF; const int kk = (kn < U.njobs) ? kn : U.njobs - 1; at_stage(C, at_job(C, U, kk), kn % AT_NSLOT); }
        LAS unsigned char* sl = C.lds + (k % AT_NSLOT) * AT_SLOT;
        int lane_ = lane0; asm volatile("" : "+v"(lane_));
        const int lane = lane_, r16 = lane & 15, quad = lane >> 4, tokc = r16 >> 3, head = r16 & 7;
        f32x4* scr4 = (f32x4*)(scr + lane * 64);
        LAS float* impL = (LAS float*)(C.lds + AT_IMP_OFF + wv * 4096); LAS unsigned* maskL = (LAS unsigned*)(C.lds + AT_MASK_OFF + wv * 128);
        {
            const int w = U.wlo + (k - j_wn);
#pragma unroll
            for (int jp = 0; jp < 2; ++jp) { const int kb = 64 * w + 32 * jp; if (kb > ta + 7 || kb + 31 + 511 < ta) continue;
                bf16x8 kf[2][2]; at_load_k(sl, jp, r16, quad, kf); bf16x8 vf[4]; at_load_v(sl, jp, r16, quad, vf);
#pragma unroll
                for (int cb = 0; cb < 4; ++cb) { const int tl = ta + 2 * cb + tokc; const int key0 = kb + 4 * quad;
                    f32x4 s0 = {0.f, 0.f, 0.f, 0.f}, s1 = {0.f, 0.f, 0.f, 0.f};
                    s0 = MFMA16(kf[0][0], q[cb][0], s0); s0 = MFMA16(kf[0][1], q[cb][1], s0); s1 = MFMA16(kf[1][0], q[cb][0], s1); s1 = MFMA16(kf[1][1], q[cb][1], s1);
                    at_online(s0, s1, [=](int h, int r) { const int key = key0 + 16 * h + r; return key <= tl && key + 511 >= tl; }, mrun[cb], lrun[cb], O[cb], vf, lane); } }
        }
        asm volatile("s_waitcnt lgkmcnt(0)" ::: "memory");
    }
    int lane_ = lane0; asm volatile("" : "+v"(lane_));
    const int lane = lane_, r16 = lane & 15, quad = lane >> 4, tokc = r16 >> 3, head = r16 & 7; f32x4* scr4 = (f32x4*)(scr + lane * 64);
#pragma unroll
    for (int cb = 0; cb < 4; ++cb) { const int tl = ta + 2 * cb + tokc;
        float ls = lrun[cb]; ls += shx(ls, 16, lane); ls += shx(ls, 32, lane);
        const float g2 = sigmoidf_(bf2f(Z[((size_t)(U.b * SEQ + tl)) * ZW + ZC_NG + 32 + U.g * 8 + head])) / ls;
        bf16* orow = (bf16*)(C.ws + WS_O) + ((size_t)(U.b * SEQ + tl)) * DM + (U.g * 8 + head) * 64 + 4 * quad;
#pragma unroll
        for (int db = 0; db < 4; ++db) { const f32x4 v = scr4[cb * 4 + db] + O[cb][db] * g2;
            v2u wv2; wv2.x = cvt_pk_bf16(v[0], v[1]); wv2.y = cvt_pk_bf16(v[2], v[3]); *(v2u*)(orow + 16 * db) = wv2; } }
    asm volatile("s_waitcnt vmcnt(0)" ::: "memory");
    __builtin_amdgcn_s_barrier(); asm volatile("" ::: "memory");
}
__device__ __forceinline__ void attn_phase(const Ctx& C) {
    float* scr = (float*)(C.ws + WS_SCR) + ((size_t)C.bx * NWAVES + C.wave) * 4096;
    for (int uu = C.bx; uu < 8 * 128; uu += C.G) { const int bgi = uu & 7, kk = uu >> 3, rnd = kk >> 5, sub = kk & 31;
        AtUnit U; U.b = bgi >> 1; U.g = bgi & 1; U.bg = bgi; U.c = (rnd == 0) ? 127 - sub : (rnd == 1) ? 64 + sub : (rnd == 2) ? 63 - sub : sub;
        U.nct = (4 * U.c + 3 + 63) >> 6; U.wlo = (U.c >= 8) ? U.c - 8 : 0; U.njobs = 2 * U.nct + (U.c + 1) + (U.c - U.wlo + 1);
        attn_unit(C, U, scr); }
}


constexpr int RW_PITCH = 1028;
__device__ __forceinline__ void norm2_router(const Ctx& C, const Args& a, int l) {
    LAS float* rw = (LAS float*)C.lds; LAS int* hist = (LAS int*)(C.lds + SM_OFF);
    const float* rwg = a.in[I_RW] + (size_t)l * DM * NEXP;
    for (int i = C.tid; i < DM * NEXP; i += NWAVES * 64) rw[(i & 31) * RW_PITCH + (i >> 5)] = rwg[i];
    if (C.tid < 32) hist[C.tid] = 0;
    __syncthreads();
    const float* X = a.out; const float* gain = a.in[I_NORM2] + l * DM; const float* mod_l = (const float*)(C.ws + WS_MOD) + (size_t)l * NB * 6144;
    const float* rb = a.in[I_RB] + l * NEXP; bf16* H = (bf16*)(C.ws + WS_H);
    int* tope = (int*)(C.ws + WS_TOPE); float* topw = (float*)(C.ws + WS_TOPW);
    const int lane = C.lane;
    for (int i = 0; i < 16; ++i) {
        const int m = C.bx * 128 + C.wave * 16 + i, b = m >> 13; const f32x4* xr = (const f32x4*)(X + (size_t)m * DM) + lane;
        f32x4 v[4]; float s = 0.f;
#pragma unroll
        for (int j = 0; j < 4; ++j) { v[j] = xr[64 * j]; s += (v[j].x * v[j].x + v[j].y * v[j].y) + (v[j].z * v[j].z + v[j].w * v[j].w); }
        const float rstd = 1.0f / sqrtf(wave_sum(s, lane) * (1.0f / DM) + 1e-6f);
        const float* mb = mod_l + (size_t)b * 6144; v2u* o8 = (v2u*)(H + (size_t)m * DM) + lane;
#pragma unroll
        for (int j = 0; j < 4; ++j) { const int col = 4 * lane + 256 * j;
            const f32x4 gn = *(const f32x4*)(gain + col), sc = *(const f32x4*)(mb + 4 * DM + col), sh = *(const f32x4*)(mb + 3 * DM + col);
            v[j] = v[j] * rstd * gn * (sc + 1.0f) + sh;
            v2u w; w.x = cvt_pk_bf16(v[j].x, v[j].y); w.y = cvt_pk_bf16(v[j].z, v[j].w); o8[64 * j] = w; }
        float lg[32];
#pragma unroll
        for (int e = 0; e < 32; ++e) { float p = 0.f;
#pragma unroll
            for (int j = 0; j < 4; ++j) { const f32x4 wv = *(const LAS f32x4*)(rw + e * RW_PITCH + 4 * lane + 256 * j); p += (v[j].x * wv.x + v[j].y * wv.y) + (v[j].z * wv.z + v[j].w * wv.w); }
            lg[e] = wave_sum(p, lane) + rb[e]; if ((e & 3) == 3) __builtin_amdgcn_sched_barrier(0); }
        int te[4]; float tv[4];
#pragma unroll
        for (int k = 0; k < 4; ++k) { float bv = lg[0]; int be = 0;
#pragma unroll
            for (int e = 1; e < 32; ++e) { const bool gt = lg[e] > bv; bv = gt ? lg[e] : bv; be = gt ? e : be; }
            te[k] = be; tv[k] = bv;
#pragma unroll
            for (int e = 0; e < 32; ++e) lg[e] = (e == be) ? -3.0e38f : lg[e]; }
        const float e1 = __expf(tv[1] - tv[0]), e2 = __expf(tv[2] - tv[0]), e3 = __expf(tv[3] - tv[0]); const float inv = 1.0f / (1.0f + e1 + e2 + e3);
        if (lane < 4) { const int ek = (lane == 0) ? te[0] : (lane == 1) ? te[1] : (lane == 2) ? te[2] : te[3];
            const float wk = (lane == 0) ? inv : (lane == 1) ? e1 * inv : (lane == 2) ? e2 * inv : e3 * inv;
            tope[m * 4 + lane] = ek; topw[m * 4 + lane] = wk; __hip_atomic_fetch_add(hist + ek, 1, __ATOMIC_RELAXED, __HIP_MEMORY_SCOPE_WORKGROUP); }
    }
    __syncthreads();
    if (C.tid < 32) ((int*)(C.ws + WS_CNT))[C.bx * 32 + C.tid] = hist[C.tid];
    __syncthreads();
}
__device__ __forceinline__ void moe_scatter(const Ctx& C) {
    LAS int* sm = (LAS int*)(C.lds + SM_OFF); LAS int* tot = sm + 32; LAS int* base = sm + 64; LAS int* pstart = sm + 96; LAS int* lcnt = sm + 128;
    const int* cnt = (const int*)(C.ws + WS_CNT); int* tile_e = (int*)(C.ws + WS_TILEE);
    if (C.tid < 32) { int t = 0, bs = 0; for (int bb = 0; bb < C.G; ++bb) { const int c = cnt[bb * 32 + C.tid]; t += c; bs += (bb < C.bx) ? c : 0; } tot[C.tid] = t; base[C.tid] = bs; lcnt[C.tid] = 0; }
    __syncthreads();
    if (C.tid == 0) { int ps = 0; for (int e = 0; e < 32; ++e) { pstart[e] = ps; const int nt = (tot[e] + 255) >> 8; if (C.bx == 0) for (int i = 0; i < nt; ++i) tile_e[(ps >> 8) + i] = e; ps += nt << 8; }
        if (C.bx == 0) tile_e[1023] = ps >> 8; }
    __syncthreads();
    const int* tope = (const int*)(C.ws + WS_TOPE); int* dest = (int*)(C.ws + WS_DEST);
    const bf16* H = (const bf16*)(C.ws + WS_H); bf16* Hs = (bf16*)(C.ws + WS_HS); const int lane = C.lane;
    for (int i = 0; i < 16; ++i) { const int m = C.bx * 128 + C.wave * 16 + i; int row = 0;
        if (lane < 4) { const int e = tope[m * 4 + lane]; const int rank = __hip_atomic_fetch_add(lcnt + e, 1, __ATOMIC_RELAXED, __HIP_MEMORY_SCOPE_WORKGROUP); row = pstart[e] + base[e] + rank; dest[m * 4 + lane] = row; }
        const int r0 = shfi(row, 0), r1 = shfi(row, 1), r2 = shfi(row, 2), r3 = shfi(row, 3);
        const v4u* src = (const v4u*)(H + (size_t)m * DM) + lane; const v4u x0 = src[0], x1 = src[64];
        v4u* d0 = (v4u*)(Hs + (size_t)r0 * DM) + lane; d0[0] = x0; d0[64] = x1;
        v4u* d1 = (v4u*)(Hs + (size_t)r1 * DM) + lane; d1[0] = x0; d1[64] = x1;
        v4u* d2 = (v4u*)(Hs + (size_t)r2 * DM) + lane; d2[0] = x0; d2[64] = x1;
        v4u* d3 = (v4u*)(Hs + (size_t)r3 * DM) + lane; d3[0] = x0; d3[64] = x1; }
    __syncthreads();
}
__device__ __forceinline__ void moe_combine(const Ctx& C, const Args& a, int l) {
    const int gw = C.bx * NWAVES + C.wave, NGW = C.G * NWAVES, lane = C.lane;
    const int* dest = (const int*)(C.ws + WS_DEST); const float* topw = (const float*)(C.ws + WS_TOPW); const bf16* Y = (const bf16*)(C.ws + WS_Y);
    const float* mod_l = (const float*)(C.ws + WS_MOD) + (size_t)l * NB * 6144; float* X = a.out;
    for (int m = gw; m < NTOK; m += NGW) { const int b = m >> 13; const float* g2 = mod_l + (size_t)b * 6144 + 5 * DM;
        int r[4]; float w[4];
#pragma unroll
        for (int k = 0; k < 4; ++k) { r[k] = dest[m * 4 + k]; w[k] = topw[m * 4 + k]; }
        f32x4* xr = (f32x4*)(X + (size_t)m * DM) + lane;
#pragma unroll
        for (int j = 0; j < 4; ++j) { const int col = 4 * lane + 256 * j; f32x4 y = {0.f, 0.f, 0.f, 0.f};
#pragma unroll
            for (int k = 0; k < 4; ++k) { const v2u u = *(const v2u*)(Y + (size_t)r[k] * DM + col); y.x += w[k] * bflo(u.x); y.y += w[k] * bfhi(u.x); y.z += w[k] * bflo(u.y); y.w += w[k] * bfhi(u.y); }
            const f32x4 gv = *(const f32x4*)(g2 + col); xr[64 * j] = xr[64 * j] + gv * y; } }
}


#ifndef MK_ONE_LAUNCH
#define MK_ONE_LAUNCH 1
#endif
#ifndef REP_P0
#define REP_P0 1
#endif
#ifndef REP_ATTN
#define REP_ATTN 1
#endif
#ifndef REP_POST
#define REP_POST 1
#endif
#ifndef REP_N2R
#define REP_N2R 1
#endif
#ifndef REP_GEMMIN
#define REP_GEMMIN 1
#endif
#ifndef REP_MOE
#define REP_MOE 1
#endif
#ifndef REP_SCAT
#define REP_SCAT 1
#endif
template <int l>
__device__ __forceinline__ void layer_body(Ctx& C, const Args& args, const XcdBarrier& bar, const int lo, const int hi) {
    bf16* const H = (bf16*)(C.ws + WS_H); bf16* const Z = (bf16*)(C.ws + WS_Z);
    const float* const MOD = (const float*)(C.ws + WS_MOD);
    const int* const tile_e = (const int*)(C.ws + WS_TILEE);
#define IN(k) (fresh(C), lo <= (k) && (k) < hi)
#define SEAM(k) do { if (IN(k) && IN((k) + 1)) xcd_barrier(bar, C.tid); } while (0)

        const int pb = 2 + l * NPH_LAYER;
        const float* mod_l = MOD + (size_t)l * NB * 6144;
        if (IN(pb + PH_NORM1)) norm_rows(C, l == 0 ? args.in[I_X] : args.out, args.in[I_NORM1] + l * DM, mod_l, 0, 1, H);
        SEAM(pb + PH_NORM1);
        if (IN(pb + PH_GEMM_IN)) for (int rep = 0; rep < REP_GEMMIN; ++rep) {
            pg8::Gemm g{H, (const bf16*)(C.ws + WS_WIN) + (size_t)l * ZW * DM, NTOK, ZW, DM, nullptr, 0}; pg8::StaticOrder S; S.init(NTOK, ZW, C.G, C.bx);
            pg8::EpiStore E{Z, ZW, nullptr};
            pg8::gemm_phase<pg8::EpiStore, pg8::StaticOrder, true, true>(C.lds, g, S, E, C.tid); }
        SEAM(pb + PH_GEMM_IN);
        if (IN(pb + PH_POST)) for (int rep = 0; rep < REP_POST; ++rep) { post_tokens(C, args, l); __syncthreads(); for (int u = C.bx; u < 512; u += C.G) compress_unit(C, args, l, u); }
        SEAM(pb + PH_POST);
        if (IN(pb + PH_ATTN)) for (int rep = 0; rep < REP_ATTN; ++rep) attn_phase(C);
        SEAM(pb + PH_ATTN);
        if (IN(pb + PH_POOLG)) {
            pg8::Gemm g{(const bf16*)(C.ws + WS_PM), (const bf16*)(C.ws + WS_WPOOL) + (size_t)l * 512 * 512, NTOK, 512, 512, nullptr, 0}; pg8::StaticOrder S; S.init(NTOK, 512, C.G, C.bx);
            pg8::EpiStore E{(bf16*)(C.ws + WS_PP), 512, args.in[I_PSCALE] + l * 512};
            pg8::gemm_phase<pg8::EpiStore, pg8::StaticOrder, true, true>(C.lds, g, S, E, C.tid); }
        SEAM(pb + PH_POOLG);
        if (IN(pb + PH_PROJA)) {
            pg8::Gemm g{(const bf16*)(C.ws + WS_PP), (const bf16*)(C.ws + WS_WA) + (size_t)l * 1024 * 512, NTOK, 1024, 512, nullptr, 0}; pg8::StaticOrder S; S.init(NTOK, 1024, C.G, C.bx);
            pg8::EpiGate<false> E{(bf16*)(C.ws + WS_MG), 1024, Z + ZC_MG, ZW};
            pg8::gemm_phase<pg8::EpiGate<false>, pg8::StaticOrder, true, true>(C.lds, g, S, E, C.tid); }
        SEAM(pb + PH_PROJA);
        if (IN(pb + PH_PROJB)) {
            pg8::Gemm g{(const bf16*)(C.ws + WS_O), (const bf16*)(C.ws + WS_WB) + (size_t)l * 1024 * 1024, NTOK, 1024, 1024, nullptr, 0}; pg8::StaticOrder S; S.init(NTOK, 1024, C.G, C.bx);
            pg8::EpiGate<true> E{(bf16*)(C.ws + WS_MG), 1024, Z + ZC_MG + 1024, ZW};
            pg8::gemm_phase<pg8::EpiGate<true>, pg8::StaticOrder, true, true>(C.lds, g, S, E, C.tid); }
        SEAM(pb + PH_PROJB);
        if (IN(pb + PH_OUTG)) {
            pg8::Gemm g{(const bf16*)(C.ws + WS_MG), (const bf16*)(C.ws + WS_WOUT) + (size_t)l * 1024 * 1024, NTOK, 1024, 1024, nullptr, 0}; pg8::StaticOrder S; S.init(NTOK, 1024, C.G, C.bx);
            pg8::EpiResid E{l == 0 ? args.in[I_X] : args.out, args.out, mod_l + 2 * DM, 6144};
            pg8::gemm_phase<pg8::EpiResid, pg8::StaticOrder, true, true>(C.lds, g, S, E, C.tid); }
        SEAM(pb + PH_OUTG);
        if (IN(pb + PH_NORM2R)) for (int rep = 0; rep < REP_N2R; ++rep) norm2_router(C, args, l);
        SEAM(pb + PH_NORM2R);
        if (IN(pb + PH_SCATTER)) for (int rep = 0; rep < REP_SCAT; ++rep) moe_scatter(C);
        SEAM(pb + PH_SCATTER);
        if (IN(pb + PH_GATEUP)) for (int rep = 0; rep < REP_MOE; ++rep) { const int R = tile_e[1023];
            pg8::Gemm g{(const bf16*)(C.ws + WS_HS), (const bf16*)(C.ws + WS_WGU) + (size_t)l * NEXP * 2048 * 1024, R * 256, 2048, 1024, tile_e, (size_t)2048 * 1024 * 2}; pg8::StaticOrder S; S.init(R * 256, 2048, C.G, C.bx);
            pg8::EpiSwiglu E{(bf16*)(C.ws + WS_ACT), args.in[I_BGU] + (size_t)l * NEXP * 2048, tile_e};
            pg8::gemm_phase<pg8::EpiSwiglu, pg8::StaticOrder, true, true>(C.lds, g, S, E, C.tid); }
        SEAM(pb + PH_GATEUP);
        if (IN(pb + PH_DOWN)) for (int rep = 0; rep < REP_MOE; ++rep) { const int R = tile_e[1023];
            pg8::Gemm g{(const bf16*)(C.ws + WS_ACT), (const bf16*)(C.ws + WS_WD) + (size_t)l * NEXP * 1024 * 1024, R * 256, 1024, 1024, tile_e, (size_t)1024 * 1024 * 2}; pg8::StaticOrder S; S.init(R * 256, 1024, C.G, C.bx);
            pg8::EpiBiasE E{(bf16*)(C.ws + WS_Y), args.in[I_BD] + (size_t)l * NEXP * 1024, tile_e};
            pg8::gemm_phase<pg8::EpiBiasE, pg8::StaticOrder, true, true>(C.lds, g, S, E, C.tid); }
        SEAM(pb + PH_DOWN);
        if (IN(pb + PH_COMBINE)) moe_combine(C, args, l);
        SEAM(pb + PH_COMBINE);

#undef IN
#undef SEAM
}
__global__ void __launch_bounds__(NWAVES * 64, 2) fwd(Args args) {
    extern __shared__ __attribute__((aligned(16))) unsigned char lds_raw[];
    Ctx C; C.lds = (LAS unsigned char*)lds_raw; C.tid = threadIdx.x; C.lane = C.tid & 63; C.wave = __builtin_amdgcn_readfirstlane(C.tid >> 6); C.bx = blockIdx.x; C.G = gridDim.x; C.ws = args.ws;
    for (int u = C.tid; u < (LDS_BYTES - MISC_OFF) / 4; u += NWAVES * 64) ((LAS unsigned*)(C.lds + MISC_OFF))[u] = 0u;
    __syncthreads();
    const int lo = args.ph_lo, hi = args.ph_hi;
    unsigned* barw = (unsigned*)(C.ws + WS_CTL) + CW_BAR + (size_t)args.li * XCD_BAR_WORDS;
    XcdBarrier bar; bar.bar = barw; bar.x = 0; bar.st = nullptr;
    if (hi - lo > 1) bar = xcd_barrier_post(barw, (volatile LAS unsigned*)(C.lds + MISC_OFF) + 8, C.tid);
#define IN(k) (fresh(C), lo <= (k) && (k) < hi)
#define SEAM(k) do { if (IN(k) && IN((k) + 1)) xcd_barrier(bar, C.tid); } while (0)
    bf16* const H = (bf16*)(C.ws + WS_H); bf16* const Z = (bf16*)(C.ws + WS_Z);
    const float* const MOD = (const float*)(C.ws + WS_MOD);
    const int* const tile_e = (const int*)(C.ws + WS_TILEE);

    if (IN(0)) for (int rep = 0; rep < REP_P0; ++rep) p0_convert(C, args);
    SEAM(0);
    if (IN(1)) p1_mod(C, args);
    SEAM(1);
    layer_body<0>(C, args, bar, lo, hi); layer_body<1>(C, args, bar, lo, hi); layer_body<2>(C, args, bar, lo, hi); layer_body<3>(C, args, bar, lo, hi);
#undef IN
#undef SEAM
}

extern "C" void kernel_launch(void* const* d_in, const int* in_sizes, int n_in, void* d_out, int out_size, void* d_ws, size_t ws_size, hipStream_t stream) {
    static int grid = 0;
    if (grid == 0) {
        if (n_in != N_IN || out_size != NTOK * DM || ws_size < WS_END) { fprintf(stderr, "kernel_launch: unexpected shapes (n_in %d, out %d, ws %zu < %zu)\n", n_in, out_size, ws_size, (size_t)WS_END); grid = -1; return; }
        int dev = 0, cus = 0;
        if (hipGetDevice(&dev) != hipSuccess || hipDeviceGetAttribute(&cus, hipDeviceAttributeMultiprocessorCount, dev) != hipSuccess) { grid = -1; return; }
        if (hipFuncSetAttribute((const void*)fwd, hipFuncAttributeMaxDynamicSharedMemorySize, LDS_BYTES) != hipSuccess) { fprintf(stderr, "kernel_launch: hipFuncSetAttribute failed\n"); grid = -1; return; }
        int per_cu = 0; (void)hipOccupancyMaxActiveBlocksPerMultiprocessor(&per_cu, (const void*)fwd, NWAVES * 64, LDS_BYTES); (void)hipGetLastError();
        if (cus != 256 || per_cu < 1) fprintf(stderr, "kernel_launch: note: %d CUs, occupancy query %d; this kernel is built for one 512-thread workgroup on each of 256 CUs\n", cus, per_cu);
        grid = 256;
    }
    if (grid < 0) return;
    if (hipMemsetAsync((char*)d_ws + WS_CTL, 0, CTL_ZERO_BYTES, stream) != hipSuccess) return;
    Args a{};
    for (int i = 0; i < N_IN; ++i) a.in[i] = (const float*)d_in[i];
    a.out = (float*)d_out; a.ws = (unsigned char*)d_ws;
#if MK_ONE_LAUNCH
    a.ph_lo = 0; a.ph_hi = NPHASES; a.li = 0; a.pad = 0;
    hipLaunchKernelGGL(fwd, dim3(grid), dim3(NWAVES * 64), LDS_BYTES, stream, a);
#else
    for (int ph = 0; ph < NPHASES; ++ph) { a.ph_lo = ph; a.ph_hi = ph + 1; a.li = 0; a.pad = 0;
        hipLaunchKernelGGL(fwd, dim3(grid), dim3(NWAVES * 64), LDS_BYTES, stream, a); }
#endif
}
```

```cpp
#include <hip/hip_runtime.h>
#include <cstdio>
#include <cstdint>

namespace pg8 {
#define PG8_LAS __attribute__((address_space(3)))
typedef unsigned short bf16_t;
typedef short bf16x8 __attribute__((ext_vector_type(8)));
typedef float f32x4 __attribute__((ext_vector_type(4)));
typedef unsigned u32x4 __attribute__((ext_vector_type(4)));
constexpr int BM = 256, BK = 64, HALF = 128, HTB = HALF * BK * 2  , STAGE_BYTES = 8 * HTB, NXCD = 8, WGM = 8;

__host__ __device__ __forceinline__ int lds_byte(int r, int c) { const int st = (r >> 4) * 2 + (c >> 5), rr = r & 15, cc = c & 31, ob = rr * 64 + cc * 2; return st * 1024 + (ob ^ (((ob >> 9) & 1) << 5)); }
__host__ __device__ __forceinline__ void stage_rc(int b, int& R, int& C) { const int st = b / 1024, sb = b % 1024, swz = sb ^ (((sb >> 9) & 1) << 5); R = (st >> 1) * 16 + swz / 64; C = (st & 1) * 32 + (swz % 64) / 2; }
__host__ __device__ __forceinline__ int perm32(int rho) { const int n = rho >> 4, i = rho & 15; return 8 * (i >> 2) + 4 * n + (i & 3); }

struct Unit { int pm, pn; };
struct Gemm { const bf16_t* A; const bf16_t* Bt; int M, N, K; const int* tile_e; size_t be_stride; };

struct StaticOrder {
    int nM, nN, nwg, G, c;
    __host__ __device__ void init(int M, int N, int G_, int c_) { nM = M / BM; nN = N / BM; nwg = nM * nN; G = G_; c = c_; }
    __host__ __device__ bool next(int i, Unit& u) const {
        const long L = (long)i * G + c; if (L >= nwg) return false;
        int wgid = (int)L; { const int q = nwg / NXCD, r = nwg % NXCD, xcd = wgid % NXCD, off = wgid / NXCD; wgid = (xcd < r ? xcd * (q + 1) : r * (q + 1) + (xcd - r) * q) + off; }
        const int nig = WGM * nN, gid = wgid / nig, fm = gid * WGM, gsz = (nM - fm) < WGM ? (nM - fm) : WGM;
        u.pm = fm + ((wgid % nig) % gsz); u.pn = (wgid % nig) / gsz; return true;
    }
    __device__ __forceinline__ void a_ready(const Unit&) const {}
    __device__ __forceinline__ void done(const Unit&) const {}
};

__device__ __forceinline__ unsigned cvt_pk_bf16(float lo, float hi) { unsigned r; asm volatile("v_cvt_pk_bf16_f32 %0, %1, %2" : "=v"(r) : "v"(lo), "v"(hi)); return r; }
typedef float f32x2 __attribute__((ext_vector_type(2)));


template <class Epi, class Sched, bool ALIGN_EPI = false, bool SP2 = false>
__device__ __forceinline__ void gemm_phase(PG8_LAS unsigned char* lds, const Gemm g, const Sched& S, const Epi& E, const int tid_in  ) {
    int tid_ = tid_in; asm volatile("" : "+v"(tid_));
    float zz = 0.f; asm volatile("" : "+v"(zz));
    const int tid = tid_, wid = __builtin_amdgcn_readfirstlane(tid >> 6), lane = tid & 63, wr = wid >> 2, wc = wid & 3, fr = lane & 15, fq = lane >> 4;
    const int K = g.K, nt = K / BK;
    unsigned voffA[2], voffB[2];
#pragma unroll
    for (int i = 0; i < 2; ++i) { int R, C; stage_rc(tid * 16 + i * 8192, R, C); const int Rb = Epi::PERM ? ((R & ~31) + perm32(R & 31)) : R;
        voffA[i] = (unsigned)(R * K + C) * 2u; voffB[i] = (unsigned)(Rb * K + C) * 2u; }
    const size_t kstep = (size_t)(BK * 2);
    const size_t hstep = (size_t)HALF * K * 2;
    const size_t tstep = 2 * hstep;
    const unsigned ldsw = (unsigned)wid * 1024u;
    const int aoff = lds_byte(wr * 64 + fr, fq * 8), boff = lds_byte(wc * 32 + fr, fq * 8);
#define PG8_SA(b, h) (((b) * 2 + (h)) * HTB)
#define PG8_SB(b, h) ((4 + (b) * 2 + (h)) * HTB)
#define PG8_STAGE(bufoff, gbase, voff) do { _Pragma("unroll") for (int _i = 0; _i < 2; ++_i) \
        __builtin_amdgcn_global_load_lds((const unsigned*)((const char*)(gbase) + (voff)[_i]), (PG8_LAS unsigned*)(lds + (bufoff) + ldsw + _i * 8192), 16, 0, 0); } while (0)
#define PG8_LDA(dst, b, h) do { _Pragma("unroll") for (int m = 0; m < 4; ++m) _Pragma("unroll") for (int k = 0; k < 2; ++k) dst[m][k] = *(const PG8_LAS bf16x8*)(lds + PG8_SA(b, h) + aoff + m * 2048 + k * 1024); } while (0)
#define PG8_LDB(dst, b, h) do { _Pragma("unroll") for (int n = 0; n < 2; ++n) _Pragma("unroll") for (int k = 0; k < 2; ++k) dst[n][k] = *(const PG8_LAS bf16x8*)(lds + PG8_SB(b, h) + boff + n * 2048 + k * 1024); } while (0)
#define PG8_MMA(ai, bj, At, Bt) do { __builtin_amdgcn_s_setprio(1); _Pragma("unroll") for (int m = 0; m < 4; ++m) _Pragma("unroll") for (int n = 0; n < 2; ++n) _Pragma("unroll") for (int k = 0; k < 2; ++k) \
        acc[ai][bj][m][n] = __builtin_amdgcn_mfma_f32_16x16x32_bf16(Bt[n][k], At[m][k], acc[ai][bj][m][n], 0, 0, 0); __builtin_amdgcn_s_setprio(0); } while (0)
#define PG8_WAIT_V(n) asm volatile("s_waitcnt vmcnt(" #n ")" ::: "memory")
#define PG8_WAIT_L(n) asm volatile("s_waitcnt lgkmcnt(" #n ")" ::: "memory")
#define PG8_BAR __builtin_amdgcn_s_barrier()
#define PG8_SCHED __builtin_amdgcn_sched_barrier(0)
    Unit cur, nxt; int ui = 0;
    if (!S.next(0, cur)) return;
    f32x4 acc[2][2][4][2];
#pragma unroll
    for (int a = 0; a < 2; ++a)
#pragma unroll
        for (int b = 0; b < 2; ++b)
#pragma unroll
            for (int m = 0; m < 4; ++m)
#pragma unroll
                for (int n = 0; n < 2; ++n) acc[a][b][m][n] = (f32x4){zz, zz, zz, zz};
    bf16x8 At[4][2], B0[2][2], B1[2][2];
    const char* cA = (const char*)g.A + (size_t)cur.pm * tstep; const char* cB = (const char*)g.Bt + (g.tile_e ? (size_t)g.tile_e[cur.pm] * g.be_stride : (size_t)0) + (size_t)cur.pn * tstep;
    S.a_ready(cur);
    if constexpr (SP2) {
        PG8_STAGE(PG8_SB(0, 0), cB, voffB); PG8_STAGE(PG8_SB(0, 1), cB + hstep, voffB); PG8_STAGE(PG8_SA(0, 0), cA, voffA); PG8_STAGE(PG8_SA(0, 1), cA + hstep, voffA);
        if (wr == 1) PG8_BAR;
        PG8_WAIT_V(2); PG8_BAR;
        PG8_STAGE(PG8_SB(1, 0), cB + kstep, voffB); PG8_STAGE(PG8_SA(1, 0), cA + kstep, voffA); PG8_STAGE(PG8_SB(1, 1), cB + hstep + kstep, voffB);
        PG8_WAIT_V(6); PG8_BAR;
    } else {
        PG8_STAGE(PG8_SB(0, 0), cB, voffB); PG8_STAGE(PG8_SA(0, 0), cA, voffA); PG8_STAGE(PG8_SB(0, 1), cB + hstep, voffB); PG8_STAGE(PG8_SA(0, 1), cA + hstep, voffA);
        if (wr == 1) PG8_BAR;
        PG8_WAIT_V(4); PG8_BAR;
        PG8_STAGE(PG8_SB(1, 0), cB + kstep, voffB); PG8_STAGE(PG8_SA(1, 0), cA + kstep, voffA); PG8_STAGE(PG8_SB(1, 1), cB + hstep + kstep, voffB);
        PG8_WAIT_V(6); PG8_BAR;
    }
    for (;;) {
        const bool has_next = S.next(ui + 1, nxt);
        const char* nA = has_next ? (const char*)g.A + (size_t)nxt.pm * tstep : cA; const char* nB = has_next ? (const char*)g.Bt + (g.tile_e ? (size_t)g.tile_e[nxt.pm] * g.be_stride : (size_t)0) + (size_t)nxt.pn * tstep : cB;
        for (int t = 0; t < nt; t += 2) {
            const bool last = (t == nt - 2);
            const char* a1 = cA + (size_t)(t + 1) * kstep;
            const char* a2 = last ? nA : cA + (size_t)(t + 2) * kstep; const char* b2 = last ? nB : cB + (size_t)(t + 2) * kstep;
            const char* a3 = a2 + kstep; const char* b3 = b2 + kstep;
            if (last && has_next) S.a_ready(nxt);
            if constexpr (SP2) {
            PG8_LDB(B0, 0, 0); PG8_LDB(B1, 0, 1); PG8_SCHED; PG8_LDA(At, 0, 0); PG8_STAGE(PG8_SA(1, 1), a1 + hstep, voffA);
            PG8_WAIT_V(8); PG8_WAIT_L(0); PG8_BAR; PG8_MMA(0, 0, At, B0); PG8_MMA(0, 1, At, B1); PG8_BAR; PG8_SCHED;
            PG8_LDA(At, 0, 1); PG8_STAGE(PG8_SB(0, 0), b2, voffB); PG8_STAGE(PG8_SB(0, 1), b2 + hstep, voffB); PG8_STAGE(PG8_SA(0, 0), a2, voffA);
            PG8_WAIT_V(8); PG8_WAIT_L(0); PG8_BAR; PG8_MMA(1, 0, At, B0); PG8_MMA(1, 1, At, B1); PG8_BAR; PG8_SCHED;
            PG8_LDB(B0, 1, 0); PG8_LDB(B1, 1, 1); PG8_SCHED; PG8_LDA(At, 1, 0); PG8_STAGE(PG8_SA(0, 1), a2 + hstep, voffA);
            PG8_WAIT_V(8); PG8_WAIT_L(0); PG8_BAR; PG8_MMA(0, 0, At, B0); PG8_MMA(0, 1, At, B1); PG8_BAR; PG8_SCHED;
            PG8_LDA(At, 1, 1); PG8_STAGE(PG8_SB(1, 0), b3, voffB); PG8_STAGE(PG8_SB(1, 1), b3 + hstep, voffB); PG8_STAGE(PG8_SA(1, 0), a3, voffA);
            PG8_WAIT_V(8); PG8_WAIT_L(0); PG8_BAR; PG8_MMA(1, 0, At, B0); PG8_MMA(1, 1, At, B1); PG8_BAR; PG8_SCHED;
            } else {
            PG8_LDB(B0, 0, 0); PG8_SCHED; PG8_LDA(At, 0, 0); PG8_STAGE(PG8_SA(1, 1), a1 + hstep, voffA);
            PG8_WAIT_L(8); PG8_BAR; PG8_WAIT_L(0); PG8_MMA(0, 0, At, B0); PG8_BAR; PG8_SCHED;
            PG8_LDB(B1, 0, 1); PG8_STAGE(PG8_SB(0, 0), b2, voffB);
            PG8_BAR; PG8_WAIT_L(0); PG8_MMA(0, 1, At, B1); PG8_BAR;
            PG8_LDA(At, 0, 1); PG8_STAGE(PG8_SA(0, 0), a2, voffA);
            PG8_BAR; PG8_WAIT_L(0); PG8_MMA(1, 0, At, B0); PG8_BAR; PG8_SCHED;
            PG8_STAGE(PG8_SB(0, 1), b2 + hstep, voffB);
            PG8_WAIT_V(6); PG8_BAR; PG8_MMA(1, 1, At, B1); PG8_BAR;
            PG8_LDB(B0, 1, 0); PG8_SCHED; PG8_LDA(At, 1, 0); PG8_STAGE(PG8_SA(0, 1), a2 + hstep, voffA);
            PG8_WAIT_L(8); PG8_BAR; PG8_WAIT_L(0); PG8_MMA(0, 0, At, B0); PG8_BAR; PG8_SCHED;
            PG8_LDB(B1, 1, 1); PG8_STAGE(PG8_SB(1, 0), b3, voffB);
            PG8_BAR; PG8_WAIT_L(0); PG8_MMA(0, 1, At, B1); PG8_BAR;
            PG8_LDA(At, 1, 1); PG8_STAGE(PG8_SA(1, 0), a3, voffA);
            PG8_BAR; PG8_WAIT_L(0); PG8_MMA(1, 0, At, B0); PG8_BAR; PG8_SCHED;
            PG8_STAGE(PG8_SB(1, 1), b3 + hstep, voffB);
            PG8_WAIT_V(6); PG8_BAR; PG8_MMA(1, 1, At, B1); PG8_BAR;
            }
        }
        if constexpr (ALIGN_EPI) { if (wr == 0) PG8_BAR; }
        if constexpr (!Epi::AFTER_DRAIN) { E(acc, cur, wr, wc, fr, fq); S.done(cur); }
        if (!has_next) break;
#pragma unroll
        for (int a = 0; a < 2; ++a)
#pragma unroll
            for (int b = 0; b < 2; ++b)
#pragma unroll
                for (int m = 0; m < 4; ++m)
#pragma unroll
                    for (int n = 0; n < 2; ++n) acc[a][b][m][n] = (f32x4){zz, zz, zz, zz};
        cur = nxt; cA = nA; cB = nB; ++ui;
        if constexpr (ALIGN_EPI) { if (wr == 1) PG8_BAR; }
    }
    PG8_WAIT_V(0);
    if constexpr (!ALIGN_EPI) { if (wr == 0) PG8_BAR; }
    PG8_BAR;
    if constexpr (Epi::AFTER_DRAIN) { E.fused(acc, cur, wr, wc, fr, fq, lds, wid, lane); S.done(cur); }
#undef PG8_SA
#undef PG8_SB
#undef PG8_STAGE
#undef PG8_LDA
#undef PG8_LDB
#undef PG8_MMA
#undef PG8_WAIT_V
#undef PG8_WAIT_L
#undef PG8_BAR
#undef PG8_SCHED
}

__device__ __forceinline__ float sigmoidf_(float x) { return 1.0f / (1.0f + __expf(-x)); }
__device__ __forceinline__ float bflo(unsigned w) { return __uint_as_float(w << 16); }
__device__ __forceinline__ float bfhi(unsigned w) { return __uint_as_float(w & 0xffff0000u); }

struct EpiStore {
    static constexpr bool PERM = true, AFTER_DRAIN = false;
    bf16_t* O; int ldc; const float* cs;
    __device__ __forceinline__ void operator()(const f32x4 (&acc)[2][2][4][2], const Unit& u, int wr, int wc, int fr, int fq) const {
        const int row0 = u.pm * BM + wr * 64 + fr, col0 = u.pn * BM + wc * 32 + 8 * fq;
        f32x4 sv[2][2];
#pragma unroll
        for (int bj = 0; bj < 2; ++bj)
#pragma unroll
            for (int n = 0; n < 2; ++n) sv[bj][n] = cs ? *(const f32x4*)(cs + col0 + bj * HALF + 4 * n) : (f32x4){1.f, 1.f, 1.f, 1.f};
#pragma unroll
        for (int ai = 0; ai < 2; ++ai)
#pragma unroll
            for (int m = 0; m < 4; ++m) { bf16_t* rowp = O + (size_t)(row0 + ai * HALF + m * 16) * ldc + col0;
#pragma unroll
                for (int bj = 0; bj < 2; ++bj) { const f32x4 v0 = acc[ai][bj][m][0] * sv[bj][0], v1 = acc[ai][bj][m][1] * sv[bj][1];
                    u32x4 w; w.x = cvt_pk_bf16(v0[0], v0[1]); w.y = cvt_pk_bf16(v0[2], v0[3]); w.z = cvt_pk_bf16(v1[0], v1[1]); w.w = cvt_pk_bf16(v1[2], v1[3]);
                    *(u32x4*)(rowp + bj * HALF) = w; } }
    }
};
template <bool ADD> struct EpiGate {
    static constexpr bool PERM = true, AFTER_DRAIN = false;
    bf16_t* O; int ldc; const bf16_t* G; int ldg;
    __device__ __forceinline__ void operator()(const f32x4 (&acc)[2][2][4][2], const Unit& u, int wr, int wc, int fr, int fq) const {
        const int row0 = u.pm * BM + wr * 64 + fr, col0 = u.pn * BM + wc * 32 + 8 * fq;
#pragma unroll
        for (int ai = 0; ai < 2; ++ai)
#pragma unroll
            for (int m = 0; m < 4; ++m) { const size_t row = (size_t)(row0 + ai * HALF + m * 16); bf16_t* rowp = O + row * ldc + col0; const bf16_t* gp = G + row * ldg + col0;
#pragma unroll
                for (int bj = 0; bj < 2; ++bj) { const u32x4 gw = *(const u32x4*)(gp + bj * HALF);
                    f32x4 v0 = acc[ai][bj][m][0], v1 = acc[ai][bj][m][1];
                    v0[0] *= sigmoidf_(bflo(gw.x)); v0[1] *= sigmoidf_(bfhi(gw.x)); v0[2] *= sigmoidf_(bflo(gw.y)); v0[3] *= sigmoidf_(bfhi(gw.y));
                    v1[0] *= sigmoidf_(bflo(gw.z)); v1[1] *= sigmoidf_(bfhi(gw.z)); v1[2] *= sigmoidf_(bflo(gw.w)); v1[3] *= sigmoidf_(bfhi(gw.w));
                    if (ADD) { const u32x4 ow = *(const u32x4*)(rowp + bj * HALF);
                        v0[0] += bflo(ow.x); v0[1] += bfhi(ow.x); v0[2] += bflo(ow.y); v0[3] += bfhi(ow.y);
                        v1[0] += bflo(ow.z); v1[1] += bfhi(ow.z); v1[2] += bflo(ow.w); v1[3] += bfhi(ow.w); }
                    u32x4 w; w.x = cvt_pk_bf16(v0[0], v0[1]); w.y = cvt_pk_bf16(v0[2], v0[3]); w.z = cvt_pk_bf16(v1[0], v1[1]); w.w = cvt_pk_bf16(v1[2], v1[3]);
                    *(u32x4*)(rowp + bj * HALF) = w; } }
    }
};
struct EpiResid {
    static constexpr bool PERM = false, AFTER_DRAIN = false;
    const float* Xin; float* Xout; const float* modp; int mod_bstride;
    __device__ __forceinline__ void operator()(const f32x4 (&acc)[2][2][4][2], const Unit& u, int wr, int wc, int fr, int fq) const {
        const int row0 = u.pm * BM + wr * 64 + fr, col0 = u.pn * BM + wc * 32 + 4 * fq;
        const float* gp = modp + (size_t)((u.pm * BM) >> 13) * mod_bstride;
        f32x4 gv[2][2];
#pragma unroll
        for (int bj = 0; bj < 2; ++bj)
#pragma unroll
            for (int n = 0; n < 2; ++n) gv[bj][n] = *(const f32x4*)(gp + col0 + bj * HALF + n * 16);
#pragma unroll
        for (int ai = 0; ai < 2; ++ai)
#pragma unroll
            for (int m = 0; m < 4; ++m) { const size_t off = (size_t)(row0 + ai * HALF + m * 16) * 1024 + col0;
#pragma unroll
                for (int bj = 0; bj < 2; ++bj)
#pragma unroll
                    for (int n = 0; n < 2; ++n) { const f32x4 xo = *(const f32x4*)(Xin + off + bj * HALF + n * 16);
                        *(f32x4*)(Xout + off + bj * HALF + n * 16) = xo + gv[bj][n] * acc[ai][bj][m][n]; } }
    }
};
__device__ __forceinline__ float swiglu_(float g, float u) { g = fminf(g, 7.0f); u = fminf(fmaxf(u, -7.0f), 7.0f); return (u + 1.0f) * g * sigmoidf_(g * 1.702f); }
struct EpiSwiglu {
    static constexpr bool PERM = true, AFTER_DRAIN = false;
    bf16_t* ACT; const float* bias; const int* tile_e;
    __device__ __forceinline__ void operator()(const f32x4 (&acc)[2][2][4][2], const Unit& u, int wr, int wc, int fr, int fq) const {
        const int row0 = u.pm * BM + wr * 64 + fr, col0 = u.pn * BM + wc * 32 + 8 * fq;
        const float* bp = bias + (size_t)tile_e[u.pm] * 2048;
        f32x4 bv[2][2];
#pragma unroll
        for (int bj = 0; bj < 2; ++bj)
#pragma unroll
            for (int n = 0; n < 2; ++n) bv[bj][n] = *(const f32x4*)(bp + col0 + bj * HALF + 4 * n);
#pragma unroll
        for (int ai = 0; ai < 2; ++ai)
#pragma unroll
            for (int m = 0; m < 4; ++m) { bf16_t* rowp = ACT + (size_t)(row0 + ai * HALF + m * 16) * 1024 + (col0 >> 1);
#pragma unroll
                for (int bj = 0; bj < 2; ++bj) { const f32x4 v0 = acc[ai][bj][m][0] + bv[bj][0], v1 = acc[ai][bj][m][1] + bv[bj][1];
                    typedef unsigned u32x2v __attribute__((ext_vector_type(2)));
                    u32x2v w; w.x = cvt_pk_bf16(swiglu_(v0[0], v0[1]), swiglu_(v0[2], v0[3])); w.y = cvt_pk_bf16(swiglu_(v1[0], v1[1]), swiglu_(v1[2], v1[3]));
                    *(u32x2v*)(rowp + bj * (HALF / 2)) = w; } }
    }
};
struct EpiBiasE {
    static constexpr bool PERM = true, AFTER_DRAIN = false;
    bf16_t* O; const float* bias; const int* tile_e;
    __device__ __forceinline__ void operator()(const f32x4 (&acc)[2][2][4][2], const Unit& u, int wr, int wc, int fr, int fq) const {
        const int row0 = u.pm * BM + wr * 64 + fr, col0 = u.pn * BM + wc * 32 + 8 * fq;
        const float* bp = bias + (size_t)tile_e[u.pm] * 1024;
        f32x4 bv[2][2];
#pragma unroll
        for (int bj = 0; bj < 2; ++bj)
#pragma unroll
            for (int n = 0; n < 2; ++n) bv[bj][n] = *(const f32x4*)(bp + col0 + bj * HALF + 4 * n);
#pragma unroll
        for (int ai = 0; ai < 2; ++ai)
#pragma unroll
            for (int m = 0; m < 4; ++m) { bf16_t* rowp = O + (size_t)(row0 + ai * HALF + m * 16) * 1024 + col0;
#pragma unroll
                for (int bj = 0; bj < 2; ++bj) { const f32x4 v0 = acc[ai][bj][m][0] + bv[bj][0], v1 = acc[ai][bj][m][1] + bv[bj][1];
                    u32x4 w; w.x = cvt_pk_bf16(v0[0], v0[1]); w.y = cvt_pk_bf16(v0[2], v0[3]); w.z = cvt_pk_bf16(v1[0], v1[1]); w.w = cvt_pk_bf16(v1[2], v1[3]);
                    *(u32x4*)(rowp + bj * HALF) = w; } }
    }
};
}


constexpr int NL = 4, NB = 4, SEQ = 8192, DM = 1024, NTOK = NB * SEQ;
constexpr int ZW = 4608;
constexpr int ZC_U = 0, ZC_Q = 512, ZC_KCM = 1536, ZC_VCM = 1664, ZC_KSL = 1792, ZC_VSL = 1920, ZC_KWN = 2048, ZC_VWN = 2176, ZC_MG = 2304, ZC_NG = 4352;
constexpr int IN_W = 4400;
constexpr int NEXP = 32, MOE_ROWS_MAX = (NTOK * 4 / 256 + NEXP) * 256;
constexpr int NPH_LAYER = 13, NPHASES = 2 + NL * NPH_LAYER;
enum { PH_NORM1 = 0, PH_GEMM_IN, PH_POST, PH_ATTN, PH_POOLG, PH_PROJA, PH_PROJB, PH_OUTG, PH_NORM2R, PH_SCATTER, PH_GATEUP, PH_DOWN, PH_COMBINE };

constexpr size_t alignup(size_t x) { return (x + 255) & ~(size_t)255; }
constexpr size_t WS_CTL = 0, CTL_ZERO_BYTES = 1u << 20;
constexpr size_t WS_MOD = WS_CTL + CTL_ZERO_BYTES;
constexpr size_t WS_MODP = WS_MOD + alignup((size_t)NL * NB * 6144 * 4);
constexpr size_t WS_ROPE = WS_MODP + alignup((size_t)4 * NL * NB * 6144 * 4);
constexpr size_t WS_WIN = WS_ROPE + alignup((size_t)SEQ * 16 * 4);
constexpr size_t WS_WPOOL = WS_WIN + alignup((size_t)NL * ZW * DM * 2);
constexpr size_t WS_WA = WS_WPOOL + alignup((size_t)NL * 512 * 512 * 2);
constexpr size_t WS_WB = WS_WA + alignup((size_t)NL * 1024 * 512 * 2);
constexpr size_t WS_WOUT = WS_WB + alignup((size_t)NL * 1024 * 1024 * 2);
constexpr size_t WS_W1 = WS_WOUT + alignup((size_t)NL * 1024 * 1024 * 2);
constexpr size_t WS_W2 = WS_W1 + alignup((size_t)NL * 2 * 256 * 2048 * 2);
constexpr size_t WS_WGU = WS_W2 + alignup((size_t)NL * 2 * 64 * 256 * 2);
constexpr size_t WS_WD = WS_WGU + alignup((size_t)NL * NEXP * 2048 * 1024 * 2);
constexpr size_t WS_H = WS_WD + alignup((size_t)NL * NEXP * 1024 * 1024 * 2);
constexpr size_t WS_Z = WS_H + alignup((size_t)NTOK * DM * 2);
constexpr size_t WS_QN = WS_Z + alignup((size_t)NTOK * ZW * 2);
constexpr size_t WS_KSLC = WS_QN + alignup((size_t)NTOK * DM * 2);
constexpr size_t WS_KWIN = WS_KSLC + alignup((size_t)NB * 2 * SEQ * 64 * 2);
constexpr size_t WS_VSLCT = WS_KWIN + alignup((size_t)NB * 2 * SEQ * 64 * 2);
constexpr size_t WS_VWINT = WS_VSLCT + alignup((size_t)NB * 2 * SEQ * 64 * 2);
constexpr size_t WS_KC = WS_VWINT + alignup((size_t)NB * 2 * SEQ * 64 * 2);
constexpr size_t WS_VCT = WS_KC + alignup((size_t)NB * 2 * 512 * 64 * 2);
constexpr size_t WS_PM = WS_VCT + alignup((size_t)NB * 2 * 512 * 64 * 2);
constexpr size_t WS_PP = WS_PM + alignup((size_t)NTOK * 512 * 2);
constexpr size_t WS_O = WS_PP + alignup((size_t)NTOK * 512 * 2);
constexpr size_t WS_MG = WS_O + alignup((size_t)NTOK * DM * 2);
constexpr size_t WS_TOPE = WS_MG + alignup((size_t)NTOK * DM * 2);
constexpr size_t WS_TOPW = WS_TOPE + alignup((size_t)NTOK * 4 * 4);
constexpr size_t WS_DEST = WS_TOPW + alignup((size_t)NTOK * 4 * 4);
constexpr size_t WS_CNT = WS_DEST + alignup((size_t)NTOK * 4 * 4);
constexpr size_t WS_TILEE = WS_CNT + alignup((size_t)1024 * 32 * 4);
constexpr size_t WS_HS = WS_TILEE + alignup((size_t)1024 * 4);
constexpr size_t WS_ACT = WS_HS + alignup((size_t)MOE_ROWS_MAX * 1024 * 2);
constexpr size_t WS_Y = WS_ACT + alignup((size_t)MOE_ROWS_MAX * 1024 * 2);
constexpr size_t WS_SCR = WS_Y + alignup((size_t)MOE_ROWS_MAX * 1024 * 2);
constexpr size_t WS_END = WS_SCR + alignup((size_t)1024 * 8 * 4096 * 4);
constexpr int CW_BAR = 4096;

constexpr int RING_BYTES = 131584;
constexpr int MISC_OFF = 135168;
constexpr int SM_OFF = 136192;
constexpr int LDS_BYTES = 147456;
constexpr int NWAVES = 8;

#define GAS __attribute__((address_space(1)))
#define LAS __attribute__((address_space(3)))
typedef unsigned short bf16;
typedef unsigned v4u __attribute__((ext_vector_type(4)));
typedef unsigned v2u __attribute__((ext_vector_type(2)));
typedef float f32x4 __attribute__((ext_vector_type(4)));
typedef short bf16x8 __attribute__((ext_vector_type(8)));
typedef GAS unsigned gu32;
#define RLX_AGENT __ATOMIC_RELAXED, __HIP_MEMORY_SCOPE_AGENT
#define LDS_WAIT() asm volatile("s_waitcnt lgkmcnt(0)" ::: "memory")
#define VM_WAIT() asm volatile("s_waitcnt vmcnt(0)" ::: "memory")
using pg8::cvt_pk_bf16; using pg8::bflo; using pg8::bfhi; using pg8::sigmoidf_;
__device__ __forceinline__ float bf2f(bf16 h) { return __uint_as_float((unsigned)h << 16); }
__device__ __forceinline__ bf16 f2bf(float f) { return (bf16)(cvt_pk_bf16(f, 0.f) & 0xffffu); }
__device__ __forceinline__ float shx(float v, int mask, int lane) { return __int_as_float(__builtin_amdgcn_ds_bpermute((lane ^ mask) << 2, __float_as_int(v))); }
__device__ __forceinline__ int shxi(int v, int mask, int lane) { return __builtin_amdgcn_ds_bpermute((lane ^ mask) << 2, v); }
__device__ __forceinline__ float shf(float v, int src) { return __int_as_float(__builtin_amdgcn_ds_bpermute(src << 2, __float_as_int(v))); }
__device__ __forceinline__ int shfi(int v, int src) { return __builtin_amdgcn_ds_bpermute(src << 2, v); }
__device__ __forceinline__ float wave_sum(float v, int lane) {
#pragma unroll
    for (int o = 1; o < 64; o <<= 1) v += shx(v, o, lane);
    return v;
}

#define XB_TMO      128
#define XB_XCNT(j)  (256  + 64 * (j))
#define XB_XSUB(j)  (1280 + 64 * (j))
#define XB_XGEN(j)  (2304 + 64 * (j))
#define XB_TOP      3328
#define XB_TOPGEN   3392
#define XCD_BAR_WORDS 3456
#define XB_SPIN_CAP (1u << 18)

__device__ __forceinline__ unsigned xb_ld(unsigned* p)              { return __hip_atomic_load(p, __ATOMIC_RELAXED, __HIP_MEMORY_SCOPE_AGENT); }
__device__ __forceinline__ unsigned xb_add(unsigned* p, unsigned v) { return __hip_atomic_fetch_add(p, v, __ATOMIC_RELAXED, __HIP_MEMORY_SCOPE_AGENT); }
__device__ __forceinline__ unsigned xb_xcc_id() { return (unsigned)__builtin_amdgcn_s_getreg((3 << 11) | 20) & 0xFu; }
#define XB_SPIN(cond, bar) do { unsigned _sp = 0; while (cond) { __builtin_amdgcn_s_sleep(1); \
    if ((++_sp & 255u) == 0u) { if (xb_ld(&(bar)[XB_TMO])) break; if (_sp > XB_SPIN_CAP) { atomicAdd(&(bar)[XB_TMO], 1u); break; } } } } while (0)

struct XcdBarrier {
    unsigned* bar; unsigned x;
    volatile LAS unsigned* st;
};

__device__ __forceinline__ XcdBarrier xcd_barrier_post(unsigned* bar, volatile LAS unsigned* st, const int tid_x  ) {
    XcdBarrier b; b.bar = bar; b.x = xb_xcc_id(); b.st = st;
    if (tid_x == 0) (void)xb_add(&bar[XB_XCNT(b.x)], 1u);
    return b;
}
__device__ __forceinline__ void xcd_barrier_complete(unsigned* bar, unsigned x, unsigned& nloc, unsigned& nx) {
    const unsigned G = gridDim.x * gridDim.y * gridDim.z;
    unsigned sum, cnt, mine, sp = 0u;
    for (;;) {
        sum = 0u; cnt = 0u; mine = 0u;
#pragma unroll
        for (unsigned j = 0; j < 16; ++j) { const unsigned c = xb_ld(&bar[XB_XCNT(j)]); sum += c; cnt += (c > 0u) ? 1u : 0u; mine = (j == x) ? c : mine; }
        if (sum == G) break;
        __builtin_amdgcn_s_sleep(1);
        if ((++sp & 255u) == 0u) { if (xb_ld(&bar[XB_TMO])) break; if (sp > XB_SPIN_CAP) { atomicAdd(&bar[XB_TMO], 1u); break; } }
    }
    nloc = mine > 0u ? mine : 1u; nx = cnt > 0u ? cnt : 1u;
}

__device__ __forceinline__ void xcd_barrier(const XcdBarrier& b, const int tid_x) {
    asm volatile("s_waitcnt vmcnt(0)" ::: "memory");
    __syncthreads();
    if (tid_x == 0) {
        unsigned* bar = b.bar;
        __builtin_amdgcn_s_waitcnt(0);
        unsigned nloc = b.st[0], nx = b.st[1];
        if (nloc == 0u) { xcd_barrier_complete(bar, b.x, nloc, nx); b.st[0] = nloc; b.st[1] = nx; }
        const unsigned old = xb_add(&bar[XB_XSUB(b.x)], 1u);
        const unsigned gen = old / nloc;
        if (old + 1u == (gen + 1u) * nloc) {
            __builtin_amdgcn_fence(__ATOMIC_RELEASE, "agent");
            asm volatile("s_waitcnt vmcnt(0)" ::: "memory");
            const unsigned og = xb_add(&bar[XB_TOP], 1u);
            const unsigned tg = og / nx;
            if (og + 1u == (tg + 1u) * nx) xb_add(&bar[XB_TOPGEN], 1u);
            else XB_SPIN(xb_ld(&bar[XB_TOPGEN]) == tg, bar);
            __builtin_amdgcn_fence(__ATOMIC_ACQUIRE, "agent");
            xb_add(&bar[XB_XGEN(b.x)], 1u);
            asm volatile("s_waitcnt vmcnt(0)" ::: "memory");
        } else {
            XB_SPIN(xb_ld(&bar[XB_XGEN(b.x)]) == gen, bar);
            __builtin_amdgcn_fence(__ATOMIC_ACQUIRE, "agent");
            asm volatile("s_waitcnt vmcnt(0)" ::: "memory");
        }
    }
    __syncthreads();
}


enum { I_X = 0, I_C, I_NORM1, I_NORM2, I_ADAW, I_ADAB, I_WIN, I_WPOOL, I_PSCALE, I_QNORM, I_KNORM, I_CMPPOS, I_CMPW1, I_CMPB1, I_CMPW2, I_WPA, I_WPB, I_WOUT,
       I_RW, I_RB, I_WGU, I_BGU, I_WD, I_BD, N_IN };
struct Args { const float* in[N_IN]; float* out; unsigned char* ws; int ph_lo, ph_hi, li, pad; };

struct Ctx {
    LAS unsigned char* lds;
    int tid, lane, wave, bx, G;
    unsigned char* ws;
};
__device__ __forceinline__ void fresh(Ctx& C) { unsigned z = 0u; asm volatile("" : "+s"(z));   int t = C.wave * 64 + (int)__builtin_amdgcn_mbcnt_hi(~0u, __builtin_amdgcn_mbcnt_lo(~0u, z)); asm volatile("" : "+v"(t)); C.tid = t; C.lane = t & 63; int bx = blockIdx.x, G = gridDim.x; asm volatile("" : "+s"(bx), "+s"(G)); C.bx = bx; C.G = G; }

__device__ __forceinline__ int inmap(int np) { return np < 2304 ? np : (np < 4352 ? np + 48 : (np < 4400 ? np - 2048 : -1)); }
template <bool MAPIN>
__device__ __forceinline__ void p0_transpose_item(const float* W, int K, int N, int NP, bf16* WT, LAS float* scr, int item, int lane) {
    const int nblk = NP / 32, kb = item / nblk, nb = item % nblk, k0 = 64 * kb, n0 = 32 * nb;
    int sc = n0 + (lane & 31); if (MAPIN) sc = inmap(sc);
#pragma unroll 8
    for (int i = 0; i < 32; ++i) { const int kk = 2 * i + (lane >> 5); scr[kk * 33 + (lane & 31)] = (sc >= 0) ? W[(size_t)(k0 + kk) * N + sc] : 0.f; }
    LDS_WAIT(); asm volatile("" ::: "memory");
    const int c = lane & 7;
#pragma unroll
    for (int j = 0; j < 4; ++j) { const int n = (lane >> 3) + 8 * j; const LAS float* s = scr + (8 * c) * 33 + n;
        v4u o; o.x = cvt_pk_bf16(s[0 * 33], s[1 * 33]); o.y = cvt_pk_bf16(s[2 * 33], s[3 * 33]); o.z = cvt_pk_bf16(s[4 * 33], s[5 * 33]); o.w = cvt_pk_bf16(s[6 * 33], s[7 * 33]);
        *(v4u*)(WT + (size_t)(n0 + n) * K + k0 + 8 * c) = o; }
    LDS_WAIT(); asm volatile("" ::: "memory");
}
__device__ __forceinline__ void p0_convert(const Ctx& C, const Args& a) {
    LAS float* scr = (LAS float*)(C.lds + C.wave * 16384);
    const int gw = C.bx * NWAVES + C.wave, NGW = C.G * NWAVES;
    constexpr int IT_IN = 16 * (ZW / 32), IT_A = 8 * 32, IT_B = 16 * 32, IT_O = 16 * 32, IT_W1 = 32 * 8, IT_W2 = 4 * 2, IT_GU = 16 * 64, IT_D = 16 * 32;
    constexpr int IT_LAYER = IT_IN + IT_A + IT_B + IT_O + 2 * IT_W1 + 2 * IT_W2 + NEXP * IT_GU + NEXP * IT_D;
    for (int it = gw; it < NL * IT_LAYER; it += NGW) {
        const int l = it / IT_LAYER; int r = it % IT_LAYER;
        if (r < IT_IN) { p0_transpose_item<true>(a.in[I_WIN] + (size_t)l * DM * IN_W, DM, IN_W, ZW, (bf16*)(C.ws + WS_WIN) + (size_t)l * ZW * DM, scr, r, C.lane); continue; } r -= IT_IN;
        if (r < IT_A) { p0_transpose_item<false>(a.in[I_WPA] + (size_t)l * 512 * 1024, 512, 1024, 1024, (bf16*)(C.ws + WS_WA) + (size_t)l * 1024 * 512, scr, r, C.lane); continue; } r -= IT_A;
        if (r < IT_B) { p0_transpose_item<false>(a.in[I_WPB] + (size_t)l * 1024 * 1024, 1024, 1024, 1024, (bf16*)(C.ws + WS_WB) + (size_t)l * 1024 * 1024, scr, r, C.lane); continue; } r -= IT_B;
        if (r < IT_O) { p0_transpose_item<false>(a.in[I_WOUT] + (size_t)l * 1024 * 1024, 1024, 1024, 1024, (bf16*)(C.ws + WS_WOUT) + (size_t)l * 1024 * 1024, scr, r, C.lane); continue; } r -= IT_O;
        if (r < 2 * IT_W1) { const int kv = r / IT_W1; p0_transpose_item<false>(a.in[I_CMPW1] + (size_t)(l * 2 + kv) * 2048 * 256, 2048, 256, 256, (bf16*)(C.ws + WS_W1) + (size_t)(l * 2 + kv) * 256 * 2048, scr, r % IT_W1, C.lane); continue; } r -= 2 * IT_W1;
        if (r < 2 * IT_W2) { const int kv = r / IT_W2; p0_transpose_item<false>(a.in[I_CMPW2] + (size_t)(l * 2 + kv) * 256 * 64, 256, 64, 64, (bf16*)(C.ws + WS_W2) + (size_t)(l * 2 + kv) * 64 * 256, scr, r % IT_W2, C.lane); continue; } r -= 2 * IT_W2;
        if (r < NEXP * IT_GU) { const int e = r / IT_GU; p0_transpose_item<false>(a.in[I_WGU] + (size_t)(l * NEXP + e) * 1024 * 2048, 1024, 2048, 2048, (bf16*)(C.ws + WS_WGU) + (size_t)(l * NEXP + e) * 2048 * 1024, scr, r % IT_GU, C.lane); continue; } r -= NEXP * IT_GU;
        { const int e = r / IT_D; p0_transpose_item<false>(a.in[I_WD] + (size_t)(l * NEXP + e) * 1024 * 1024, 1024, 1024, 1024, (bf16*)(C.ws + WS_WD) + (size_t)(l * NEXP + e) * 1024 * 1024, scr, r % IT_D, C.lane); }
    }
    const int gt = C.bx * (NWAVES * 64) + C.tid, NGT = C.G * NWAVES * 64;
    { bf16* wp = (bf16*)(C.ws + WS_WPOOL);
      for (int i = gt; i < NL * 512 * 512; i += NGT) { const int l = i >> 18, ep = (i >> 9) & 511, cp = i & 511; float v = 0.f;
          if ((ep >> 7) == (cp >> 7)) v = a.in[I_WPOOL][(((size_t)l * 4 + (ep >> 7)) * 128 + (cp & 127)) * 128 + (ep & 127)];
          wp[i] = f2bf(v); } }
    { float* rp = (float*)(C.ws + WS_ROPE);
      for (int i = gt; i < SEQ * 8; i += NGT) { const int pos = i >> 3, fi = i & 7;
          const float invf[8] = {1.0f, 0.1939227432012558f, 0.03760603070259094f, 0.007292664609849453f, 0.0014142135623842478f, 0.00027424818836152554f, 5.318296098266728e-05f, 1.0313386155758053e-05f};
          float f = invf[0];
#pragma unroll
          for (int q = 1; q < 8; ++q) f = (fi == q) ? invf[q] : f;
          const float ang = (float)pos * f; const double rev = (double)ang * 0.15915494309189535; const float fr = (float)(rev - __builtin_rint(rev));
          rp[pos * 16 + fi] = __builtin_amdgcn_cosf(fr); rp[pos * 16 + 8 + fi] = __builtin_amdgcn_sinf(fr); } }
    __syncthreads();
    { LAS float* sc = (LAS float*)C.lds;
      for (int i = C.tid; i < NB * DM; i += NWAVES * 64) { const float cv = a.in[I_C][i]; sc[i] = cv * sigmoidf_(cv); }
      __syncthreads();
      float* mp = (float*)(C.ws + WS_MODP);
      for (int i = gt; i < 4 * NL * 6144; i += NGT) { const int j = i % 6144, l = (i / 6144) % NL, ks = i / (6144 * NL);
          const float* w = a.in[I_ADAW] + ((size_t)l * DM + ks * 256) * 6144 + j; float a0 = 0.f, a1 = 0.f, a2 = 0.f, a3 = 0.f;
#pragma unroll 8
          for (int k = 0; k < 256; ++k) { const float wv = w[(size_t)k * 6144]; const int kk = ks * 256 + k;
              a0 += sc[kk] * wv; a1 += sc[DM + kk] * wv; a2 += sc[2 * DM + kk] * wv; a3 += sc[3 * DM + kk] * wv; }
          float* o = mp + ((size_t)(ks * NL + l) * NB) * 6144 + j; o[0] = a0; o[6144] = a1; o[2 * 6144] = a2; o[3 * 6144] = a3; }
      __syncthreads(); }
}
__device__ __forceinline__ void p1_mod(const Ctx& C, const Args& a) {
    const int gt = C.bx * (NWAVES * 64) + C.tid, NGT = C.G * NWAVES * 64;
    const float* mp = (const float*)(C.ws + WS_MODP); float* mo = (float*)(C.ws + WS_MOD);
    for (int i = gt; i < NL * NB * 6144; i += NGT) { const int j = i % 6144, l = i / (NB * 6144);
        float s = a.in[I_ADAB][l * 6144 + j];
#pragma unroll
        for (int ks = 0; ks < 4; ++ks) s += mp[(size_t)ks * NL * NB * 6144 + i];
        mo[i] = s; }
}


__device__ __forceinline__ void norm_rows(const Ctx& C, const float* X, const float* gain, const float* mod_l  , int shift_i, int scale_i, bf16* H) {
    const int gw = C.bx * NWAVES + C.wave, NGW = C.G * NWAVES;
    for (int m = gw; m < NTOK; m += NGW) {
        const int b = m >> 13; const f32x4* xr = (const f32x4*)(X + (size_t)m * DM) + C.lane;
        f32x4 v[4]; float s = 0.f;
#pragma unroll
        for (int j = 0; j < 4; ++j) { v[j] = xr[64 * j]; s += (v[j].x * v[j].x + v[j].y * v[j].y) + (v[j].z * v[j].z + v[j].w * v[j].w); }
        const float rstd = 1.0f / sqrtf(wave_sum(s, C.lane) * (1.0f / DM) + 1e-6f);
        const float* mb = mod_l + (size_t)b * 6144; v2u* o8 = (v2u*)(H + (size_t)m * DM) + C.lane;
#pragma unroll
        for (int j = 0; j < 4; ++j) { const int col = 4 * C.lane + 256 * j;
            const f32x4 g = *(const f32x4*)(gain + col), sc = *(const f32x4*)(mb + scale_i * DM + col), sh = *(const f32x4*)(mb + shift_i * DM + col);
            const f32x4 h = v[j] * rstd * g * (sc + 1.0f) + sh;
            v2u w; w.x = cvt_pk_bf16(h.x, h.y); w.y = cvt_pk_bf16(h.z, h.w); o8[64 * j] = w; }
    }
}

__device__ __forceinline__ void post_tokens(const Ctx& C, const Args& a, int l) {
    const int gw = C.bx * NWAVES + C.wave, NGW = C.G * NWAVES, lane = C.lane;
    const bf16* Z = (const bf16*)(C.ws + WS_Z); const float* rope = (const float*)(C.ws + WS_ROPE);
    bf16* Qn = (bf16*)(C.ws + WS_QN); bf16* Kslc = (bf16*)(C.ws + WS_KSLC); bf16* Kwin = (bf16*)(C.ws + WS_KWIN); bf16* Pm = (bf16*)(C.ws + WS_PM);
    const float* qn = a.in[I_QNORM] + l * 64; const float* kn = a.in[I_KNORM] + l * 192;
    for (int m = gw; m < NTOK; m += NGW) {
        const int b = m >> 13, t = m & (SEQ - 1); const bf16* zr = Z + (size_t)m * ZW; const float* rp = rope + t * 16;
        { const int head = lane >> 2, dq = (lane & 3) * 16; const v4u w0 = *(const v4u*)(zr + ZC_Q + head * 64 + dq), w1 = *(const v4u*)(zr + ZC_Q + head * 64 + dq + 8);
          float y[16]; y[0] = bflo(w0.x); y[1] = bfhi(w0.x); y[2] = bflo(w0.y); y[3] = bfhi(w0.y); y[4] = bflo(w0.z); y[5] = bfhi(w0.z); y[6] = bflo(w0.w); y[7] = bfhi(w0.w);
          y[8] = bflo(w1.x); y[9] = bfhi(w1.x); y[10] = bflo(w1.y); y[11] = bfhi(w1.y); y[12] = bflo(w1.z); y[13] = bfhi(w1.z); y[14] = bflo(w1.w); y[15] = bfhi(w1.w);
          float s = 0.f;
#pragma unroll
          for (int i = 0; i < 16; ++i) s += y[i] * y[i];
          s += shx(s, 1, lane); s += shx(s, 2, lane);
          const float rstd = 1.0f / sqrtf(s * (1.0f / 64.0f) + 1e-6f);
#pragma unroll
          for (int i = 0; i < 16; ++i) y[i] = y[i] * (rstd * 0.18033688011112042f) * qn[dq + i];
          if ((lane & 3) == 0) {
#pragma unroll
              for (int i = 0; i < 8; ++i) { const float c = rp[i], sn = rp[8 + i], x1 = y[i], x2 = y[8 + i]; y[i] = x1 * c - x2 * sn; y[8 + i] = x2 * c + x1 * sn; } }
          v4u o0, o1; o0.x = cvt_pk_bf16(y[0], y[1]); o0.y = cvt_pk_bf16(y[2], y[3]); o0.z = cvt_pk_bf16(y[4], y[5]); o0.w = cvt_pk_bf16(y[6], y[7]);
          o1.x = cvt_pk_bf16(y[8], y[9]); o1.y = cvt_pk_bf16(y[10], y[11]); o1.z = cvt_pk_bf16(y[12], y[13]); o1.w = cvt_pk_bf16(y[14], y[15]);
          bf16* qo = Qn + (size_t)m * DM + head * 64 + dq; *(v4u*)qo = o0; *(v4u*)(qo + 8) = o1; }
        { const int which = lane >> 4, g = which & 1, li = lane & 15, dk = li * 4; const int sec = (which < 2) ? ZC_KSL : ZC_KWN;
          const v2u w = *(const v2u*)(zr + sec + g * 64 + dk); float y[4] = {bflo(w.x), bfhi(w.x), bflo(w.y), bfhi(w.y)};
          float s = y[0] * y[0] + y[1] * y[1] + y[2] * y[2] + y[3] * y[3];
          s += shx(s, 1, lane); s += shx(s, 2, lane); s += shx(s, 4, lane); s += shx(s, 8, lane);
          const float rstd = 1.0f / sqrtf(s * (1.0f / 64.0f) + 1e-6f); const float* gk = kn + ((which < 2) ? 64 : 128) + dk;
#pragma unroll
          for (int i = 0; i < 4; ++i) y[i] = y[i] * rstd * gk[i];
          float pz[4];
#pragma unroll
          for (int i = 0; i < 4; ++i) pz[i] = shx(y[i], 2, lane);
          if (li < 4) { const int fi = (li & 1) * 4;
#pragma unroll
              for (int i = 0; i < 4; ++i) { const float c = rp[fi + i], sn = rp[8 + fi + i]; y[i] = (li < 2) ? (y[i] * c - pz[i] * sn) : (y[i] * c + pz[i] * sn); } }
          v2u o; o.x = cvt_pk_bf16(y[0], y[1]); o.y = cvt_pk_bf16(y[2], y[3]);
          bf16* ko = ((which < 2) ? Kslc : Kwin) + ((size_t)(b * 2 + g) * SEQ + t) * 64 + dk; *(v2u*)ko = o; }
        { const int ch = lane * 8, w = 2 << (lane >> 4), cnt = (t + 1 < w) ? (t + 1) : w; float sum[8] = {0.f, 0.f, 0.f, 0.f, 0.f, 0.f, 0.f, 0.f}; float self[8];
          for (int k = 0; k < cnt; ++k) { const v4u u = *(const v4u*)(zr - (size_t)k * ZW + ZC_U + ch);
              const float f[8] = {bflo(u.x), bfhi(u.x), bflo(u.y), bfhi(u.y), bflo(u.z), bfhi(u.z), bflo(u.w), bfhi(u.w)};
#pragma unroll
              for (int i = 0; i < 8; ++i) { sum[i] += f[i]; if (k == 0) self[i] = f[i]; } }
          const float inv = 1.0f / (float)cnt; v4u o;
          o.x = cvt_pk_bf16(sum[0] * inv - self[0], sum[1] * inv - self[1]); o.y = cvt_pk_bf16(sum[2] * inv - self[2], sum[3] * inv - self[3]);
          o.z = cvt_pk_bf16(sum[4] * inv - self[4], sum[5] * inv - self[5]); o.w = cvt_pk_bf16(sum[6] * inv - self[6], sum[7] * inv - self[7]);
          *(v4u*)(Pm + (size_t)m * 512 + ch) = o; }
    }
    { bf16* VsT = (bf16*)(C.ws + WS_VSLCT); bf16* VwT = (bf16*)(C.ws + WS_VWINT);
      for (int it = gw; it < 2 * NB * 2 * (SEQ / 64); it += NGW) { const int tt = it & 127, g = (it >> 7) & 1, b = (it >> 8) & 3, which = it >> 10;
          const bf16* src = Z + ((size_t)(b * SEQ + tt * 64 + lane)) * ZW + (which ? ZC_VWN : ZC_VSL) + g * 64;
          bf16* dst = (which ? VwT : VsT) + ((size_t)(b * 2 + g) * 64) * SEQ + tt * 64 + lane;
#pragma unroll
          for (int c = 0; c < 8; ++c) { const v4u u = *(const v4u*)(src + 8 * c); bf16* d = dst + (size_t)(8 * c) * SEQ;
              d[0] = (bf16)(u.x & 0xffff); d[SEQ] = (bf16)(u.x >> 16); d[2 * SEQ] = (bf16)(u.y & 0xffff); d[3 * SEQ] = (bf16)(u.y >> 16);
              d[4 * SEQ] = (bf16)(u.z & 0xffff); d[5 * SEQ] = (bf16)(u.z >> 16); d[6 * SEQ] = (bf16)(u.w & 0xffff); d[7 * SEQ] = (bf16)(u.w >> 16); } } }
}

__device__ __forceinline__ void compress_unit(const Ctx& C, const Args& a, int l, int u) {
    const int kv = u & 1, nt = (u >> 1) & 31, bg = u >> 6, b = bg >> 1, g = bg & 1, n0 = nt * 16;
    const int lane = C.lane, r16 = lane & 15, quad = lane >> 4, w = C.wave;
    const bf16* Z = (const bf16*)(C.ws + WS_Z);
    const bf16* W1t = (const bf16*)(C.ws + WS_W1) + (size_t)(l * 2 + kv) * 256 * 2048;
    const bf16* W2t = (const bf16*)(C.ws + WS_W2) + (size_t)(l * 2 + kv) * 64 * 256;
    const float* pos = a.in[I_CMPPOS] + (size_t)(l * 2 + kv) * 32 * 64;
    const float* b1 = a.in[I_CMPB1] + (size_t)(l * 2 + kv) * 256;
    LAS bf16* hidL = (LAS bf16*)C.lds;
    LAS float* outL = (LAS float*)(C.lds + 16 * 264 * 2);
    const int nl = (n0 + r16 > 510) ? 510 : (n0 + r16);
    const bf16* arow = Z + ((size_t)(b * SEQ + 16 * nl)) * ZW + (kv ? ZC_VCM : ZC_KCM) + g * 64;
    f32x4 acc0 = {0.f, 0.f, 0.f, 0.f}, acc1 = {0.f, 0.f, 0.f, 0.f};
    const bf16* wb0 = W1t + (size_t)(32 * w + r16) * 2048 + quad * 8; const bf16* wb1 = wb0 + (size_t)16 * 2048;
#pragma unroll 4
    for (int ks = 0; ks < 64; ++ks) { const int lrow = ks >> 1, d = (ks & 1) * 32 + quad * 8;
        const v4u zv = *(const v4u*)(arow + (size_t)lrow * ZW + d); const f32x4 p0 = *(const f32x4*)(pos + lrow * 64 + d), p1 = *(const f32x4*)(pos + lrow * 64 + d + 4);
        v4u av; av.x = cvt_pk_bf16(bflo(zv.x) + p0.x, bfhi(zv.x) + p0.y); av.y = cvt_pk_bf16(bflo(zv.y) + p0.z, bfhi(zv.y) + p0.w);
        av.z = cvt_pk_bf16(bflo(zv.z) + p1.x, bfhi(zv.z) + p1.y); av.w = cvt_pk_bf16(bflo(zv.w) + p1.z, bfhi(zv.w) + p1.w);
        const bf16x8 af = __builtin_bit_cast(bf16x8, av);
        const bf16x8 bf0 = *(const bf16x8*)(wb0 + ks * 32), bf1 = *(const bf16x8*)(wb1 + ks * 32);
        acc0 = __builtin_amdgcn_mfma_f32_16x16x32_bf16(af, bf0, acc0, 0, 0, 0);
        acc1 = __builtin_amdgcn_mfma_f32_16x16x32_bf16(af, bf1, acc1, 0, 0, 0); }
    { const float bb0 = b1[32 * w + r16], bb1 = b1[32 * w + 16 + r16];
#pragma unroll
      for (int r = 0; r < 4; ++r) { float h0 = acc0[r] + bb0, h1 = acc1[r] + bb1; h0 = h0 * sigmoidf_(h0); h1 = h1 * sigmoidf_(h1);
          hidL[(4 * quad + r) * 264 + 32 * w + r16] = f2bf(h0); hidL[(4 * quad + r) * 264 + 32 * w + 16 + r16] = f2bf(h1); } }
    __syncthreads();
    if (w < 4) { f32x4 o = {0.f, 0.f, 0.f, 0.f}; const bf16* w2 = W2t + (size_t)(16 * w + r16) * 256 + quad * 8;
#pragma unroll
        for (int ks = 0; ks < 8; ++ks) { const bf16x8 af = *(const LAS bf16x8*)(hidL + r16 * 264 + ks * 32 + quad * 8); const bf16x8 bfr = *(const bf16x8*)(w2 + ks * 32);
            o = __builtin_amdgcn_mfma_f32_16x16x32_bf16(af, bfr, o, 0, 0, 0); }
#pragma unroll
        for (int r = 0; r < 4; ++r) outL[(4 * quad + r) * 68 + 16 * w + r16] = o[r]; }
    __syncthreads();
    if (w == 0) { const int i = lane >> 2, c0 = (lane & 3) * 16, n = n0 + i; float y[16];
#pragma unroll
        for (int j = 0; j < 16; ++j) y[j] = outL[i * 68 + c0 + j];
        if (kv == 0) { float s = 0.f;
#pragma unroll
            for (int j = 0; j < 16; ++j) s += y[j] * y[j];
            s += shx(s, 1, lane); s += shx(s, 2, lane);
            const float rstd = 1.0f / sqrtf(s * (1.0f / 64.0f) + 1e-6f); const float* gk = a.in[I_KNORM] + l * 192 + c0;
#pragma unroll
            for (int j = 0; j < 16; ++j) y[j] = y[j] * rstd * gk[j];
            if ((lane & 3) == 0 && n <= 510) { const float* rp = (const float*)(C.ws + WS_ROPE) + (16 * n + 31) * 16;
#pragma unroll
                for (int j = 0; j < 8; ++j) { const float c = rp[j], sn = rp[8 + j], x1 = y[j], x2 = y[8 + j]; y[j] = x1 * c - x2 * sn; y[8 + j] = x2 * c + x1 * sn; } }
            if (n > 510) {
#pragma unroll
                for (int j = 0; j < 16; ++j) y[j] = 0.f; }
            v4u o0, o1; o0.x = cvt_pk_bf16(y[0], y[1]); o0.y = cvt_pk_bf16(y[2], y[3]); o0.z = cvt_pk_bf16(y[4], y[5]); o0.w = cvt_pk_bf16(y[6], y[7]);
            o1.x = cvt_pk_bf16(y[8], y[9]); o1.y = cvt_pk_bf16(y[10], y[11]); o1.z = cvt_pk_bf16(y[12], y[13]); o1.w = cvt_pk_bf16(y[14], y[15]);
            bf16* ko = (bf16*)(C.ws + WS_KC) + ((size_t)bg * 512 + n) * 64 + c0; *(v4u*)ko = o0; *(v4u*)(ko + 8) = o1;
        } else { bf16* vo = (bf16*)(C.ws + WS_VCT) + ((size_t)bg * 64 + c0) * 512 + n;
#pragma unroll
            for (int j = 0; j < 16; ++j) vo[(size_t)j * 512] = (n > 510) ? (bf16)0 : f2bf(y[j]); } }
    __syncthreads();
}


#define MFMA16(a, b, c) __builtin_amdgcn_mfma_f32_16x16x32_bf16(a, b, c, 0, 0, 0)
constexpr float SM_SCALE = 0.125f * 1.4426950408889634f;
constexpr int AT_SLOT = 16384, AT_NSLOT = 4, AT_PF = 3;
constexpr int AT_IMP_OFF = AT_SLOT * AT_NSLOT;
constexpr int AT_MASK_OFF = AT_IMP_OFF + 8 * 8 * 128 * 4;
__device__ __forceinline__ bf16x8 pack_p(const f32x4& p0, const f32x4& p1) {
    v4u w; w.x = cvt_pk_bf16(p0[0], p0[1]); w.y = cvt_pk_bf16(p0[2], p0[3]); w.z = cvt_pk_bf16(p1[0], p1[1]); w.w = cvt_pk_bf16(p1[2], p1[3]); return __builtin_bit_cast(bf16x8, w);
}
__device__ __forceinline__ int tile_off(int row, int chunk) { return row * 128 + ((chunk ^ ((row >> 1) & 7)) << 4); }
struct AtJob { const bf16* k; const bf16* v; int vpitch; };
struct AtUnit { int b, g, c, bg, nct, njobs, wlo; };
__device__ __forceinline__ AtJob at_job(const Ctx& C, const AtUnit& U, int k) {
    AtJob J; const int k2 = k - 2 * U.nct;
    if (k2 < 0) { const int j = (k < U.nct) ? k : k - U.nct; J.k = (const bf16*)(C.ws + WS_KC) + ((size_t)U.bg * 512 + 64 * j) * 64; J.v = (const bf16*)(C.ws + WS_VCT) + (size_t)U.bg * 64 * 512 + 64 * j; J.vpitch = 512; }
    else if (k2 <= U.c) { J.k = (const bf16*)(C.ws + WS_KSLC) + ((size_t)U.bg * SEQ + 64 * k2) * 64; J.v = (const bf16*)(C.ws + WS_VSLCT) + (size_t)U.bg * 64 * SEQ + 64 * k2; J.vpitch = SEQ; }
    else { const int w = U.wlo + (k2 - U.c - 1); J.k = (const bf16*)(C.ws + WS_KWIN) + ((size_t)U.bg * SEQ + 64 * w) * 64; J.v = (const bf16*)(C.ws + WS_VWINT) + (size_t)U.bg * 64 * SEQ + 64 * w; J.vpitch = SEQ; }
    return J;
}
__device__ __forceinline__ void at_stage(const Ctx& C, const AtJob& J, int slot) {
    const int row = 8 * C.wave + (C.lane >> 3), chunk = (C.lane & 7) ^ ((row >> 1) & 7);
    __builtin_amdgcn_global_load_lds((const unsigned*)(J.k + (size_t)row * 64 + chunk * 8), (LAS unsigned*)(C.lds + slot * AT_SLOT + C.wave * 1024), 16, 0, 0);
    __builtin_amdgcn_global_load_lds((const unsigned*)(J.v + (size_t)row * J.vpitch + chunk * 8), (LAS unsigned*)(C.lds + slot * AT_SLOT + 8192 + C.wave * 1024), 16, 0, 0);
}
__device__ __forceinline__ void at_load_k(LAS unsigned char* sl, int jp, int r16, int quad, bf16x8 (&kf)[2][2]) {
#pragma unroll
    for (int h = 0; h < 2; ++h)
#pragma unroll
        for (int kh = 0; kh < 2; ++kh) kf[h][kh] = *(const LAS bf16x8*)(sl + tile_off(32 * jp + 16 * h + r16, kh * 4 + quad));
}
__device__ __forceinline__ void at_load_v(LAS unsigned char* sl, int jp, int r16, int quad, bf16x8 (&vf)[4]) {
#pragma unroll
    for (int db = 0; db < 4; ++db) { const int row = 16 * db + r16;
        const v2u lo = *(const LAS v2u*)(sl + 8192 + tile_off(row, 4 * jp + (quad >> 1)) + (quad & 1) * 8), hi = *(const LAS v2u*)(sl + 8192 + tile_off(row, 4 * jp + 2 + (quad >> 1)) + (quad & 1) * 8);
        v4u w; w.x = lo.x; w.y = lo.y; w.z = hi.x; w.w = hi.y; vf[db] = __builtin_bit_cast(bf16x8, w); }
}
constexpr float AT_DEFER = 6.0f;
template <bool MASK, class Valid>
__device__ __forceinline__ void at_online(f32x4& s0, f32x4& s1, const Valid& valid, float& mrun, float& lrun, f32x4 (&o)[4], const bf16x8 (&vf)[4], int lane) {
    float bm;
    if (MASK) { bm = -1e30f;
#pragma unroll
        for (int r = 0; r < 4; ++r) { bm = valid(0, r) ? fmaxf(bm, s0[r]) : bm; bm = valid(1, r) ? fmaxf(bm, s1[r]) : bm; } }
    else bm = fmaxf(fmaxf(fmaxf(s0[0], s0[1]), fmaxf(s0[2], s0[3])), fmaxf(fmaxf(s1[0], s1[1]), fmaxf(s1[2], s1[3])));
    if (__builtin_amdgcn_ballot_w64(bm > mrun + AT_DEFER) != 0ull) {
        bm = fmaxf(bm, shx(bm, 16, lane)); bm = fmaxf(bm, shx(bm, 32, lane));
        const float mnew = fmaxf(mrun, bm), alpha = __builtin_amdgcn_exp2f(mrun - mnew);
        lrun *= alpha; mrun = mnew;
#pragma unroll
        for (int db = 0; db < 4; ++db) o[db] = o[db] * alpha;
    }
    float ps = 0.f;
#pragma unroll
    for (int r = 0; r < 4; ++r) { float p0 = __builtin_amdgcn_exp2f(s0[r] - mrun), p1 = __builtin_amdgcn_exp2f(s1[r] - mrun);
        if (MASK) { p0 = valid(0, r) ? p0 : 0.f; p1 = valid(1, r) ? p1 : 0.f; }
        s0[r] = p0; s1[r] = p1; ps += p0 + p1; }
    lrun += ps;
    const bf16x8 pb = pack_p(s0, s1);
#pragma unroll
    for (int db = 0; db < 4; ++db) o[db] = MFMA16(vf[db], pb, o[db]);
}

__device__ __forceinline__ void attn_unit(const Ctx& C, const AtUnit& U, float* scr  ) {
    const int lane0 = C.lane, wv = C.wave;
    const int ta = 64 * U.c + 8 * wv;
    const bf16* Qn = (const bf16*)(C.ws + WS_QN); const bf16* Z = (const bf16*)(C.ws + WS_Z);
    bf16x8 q[4][2]; f32x4 O[4][4]; float mrun[4], lrun[4], pup[4];
    { const int lane = lane0, r16 = lane & 15, quad = lane >> 4, tokc = r16 >> 3, head = r16 & 7; LAS float* impL = (LAS float*)(C.lds + AT_IMP_OFF + wv * 4096);
#pragma unroll
    for (int cb = 0; cb < 4; ++cb) { const bf16* qrow = Qn + ((size_t)(U.b * SEQ + ta + 2 * cb + tokc)) * DM + (U.g * 8 + head) * 64;
        q[cb][0] = *(const bf16x8*)(qrow + quad * 8); q[cb][1] = *(const bf16x8*)(qrow + 32 + quad * 8);
        mrun[cb] = -1e30f; lrun[cb] = 0.f; pup[cb] = 0.f;
#pragma unroll
        for (int db = 0; db < 4; ++db) O[cb][db] = (f32x4){0.f, 0.f, 0.f, 0.f}; }
#pragma unroll
    for (int i = 0; i < 4; ++i) *(LAS f32x4*)(impL + 4 * lane + 256 * i) = (f32x4){0.f, 0.f, 0.f, 0.f};
    }
    const int nvw = ((ta + 7 - 31) >= 0) ? (((ta + 7 - 31) >> 4) + 1) : 0;
    const int nsp = (nvw + 31) >> 5;
    const int j_c2 = U.nct, j_sl = 2 * U.nct, j_wn = 2 * U.nct + U.c + 1;
#pragma unroll
    for (int k = 0; k < AT_PF; ++k) { const int kk = (k < U.njobs) ? k : U.njobs - 1; at_stage(C, at_job(C, U, kk), k % AT_NSLOT); }
    int k = 0;
    for (; k < j_c2; ++k) {
        asm volatile("s_waitcnt vmcnt(4)" ::: "memory");
        __builtin_amdgcn_s_barrier(); asm volatile("" ::: "memory");
        { const int kn = k + AT_PF; const int kk = (kn < U.njobs) ? kn : U.njobs - 1; at_stage(C, at_job(C, U, kk), kn % AT_NSLOT); }
        LAS unsigned char* sl = C.lds + (k % AT_NSLOT) * AT_SLOT;
        int lane_ = lane0; asm volatile("" : "+v"(lane_));
        const int lane = lane_, r16 = lane & 15, quad = lane >> 4, tokc = r16 >> 3, head = r16 & 7;
        f32x4* scr4 = (f32x4*)(scr + lane * 64);
        LAS float* impL = (LAS float*)(C.lds + AT_IMP_OFF + wv * 4096); LAS unsigned* maskL = (LAS unsigned*)(C.lds + AT_MASK_OFF + wv * 128);
        {
            const int j = k;
#pragma unroll
            for (int jp = 0; jp < 2; ++jp) { if (2 * j + jp >= nsp) break;
                bf16x8 kf[2][2]; at_load_k(sl, jp, r16, quad, kf);
#pragma unroll
                for (int cb = 0; cb < 4; ++cb) { const int tl = ta + 2 * cb + tokc; const int nvl = (tl >= 31) ? (((tl - 31) >> 4) + 1) : 0;
                    f32x4 s0 = {0.f, 0.f, 0.f, 0.f}, s1 = {0.f, 0.f, 0.f, 0.f};
                    s0 = MFMA16(kf[0][0], q[cb][0], s0); s0 = MFMA16(kf[0][1], q[cb][1], s0); s1 = MFMA16(kf[1][0], q[cb][0], s1); s1 = MFMA16(kf[1][1], q[cb][1], s1);
                    const int n0 = 64 * j + 32 * jp + 4 * quad; float bm = mrun[cb];
#pragma unroll
                    for (int r = 0; r < 4; ++r) { bm = (n0 + r < nvl) ? fmaxf(bm, s0[r]) : bm; bm = (n0 + 16 + r < nvl) ? fmaxf(bm, s1[r]) : bm; }
                    float ps = 0.f;
#pragma unroll
                    for (int r = 0; r < 4; ++r) { ps += (n0 + r < nvl) ? __builtin_amdgcn_exp2f(s0[r] - bm) : 0.f; ps += (n0 + 16 + r < nvl) ? __builtin_amdgcn_exp2f(s1[r] - bm) : 0.f; }
                    lrun[cb] = lrun[cb] * __builtin_amdgcn_exp2f(mrun[cb] - bm) + ps; mrun[cb] = bm; } }
        }
        asm volatile("s_waitcnt lgkmcnt(0)" ::: "memory");
    }
    {
    int lane_ = lane0; asm volatile("" : "+v"(lane_));
    const int lane = lane_, r16 = lane & 15, quad = lane >> 4, tokc = r16 >> 3, head = r16 & 7; f32x4* scr4 = (f32x4*)(scr + lane * 64);
    LAS float* impL = (LAS float*)(C.lds + AT_IMP_OFF + wv * 4096); LAS unsigned* maskL = (LAS unsigned*)(C.lds + AT_MASK_OFF + wv * 128); (void)scr4; (void)impL; (void)maskL; (void)head; (void)tokc; (void)quad;
    {
#pragma unroll
            for (int cb = 0; cb < 4; ++cb) { float mall = fmaxf(mrun[cb], shx(mrun[cb], 16, lane)); mall = fmaxf(mall, shx(mall, 32, lane));
                float ls = lrun[cb] * __builtin_amdgcn_exp2f(mrun[cb] - mall); ls += shx(ls, 16, lane); ls += shx(ls, 32, lane);
                mrun[cb] = mall; lrun[cb] = (ls > 0.f) ? 1.0f / ls : 0.f; }
        }
    }
    for (; k < j_sl; ++k) {
        asm volatile("s_waitcnt vmcnt(4)" ::: "memory");
        __builtin_amdgcn_s_barrier(); asm volatile("" ::: "memory");
        { const int kn = k + AT_PF; const int kk = (kn < U.njobs) ? kn : U.njobs - 1; at_stage(C, at_job(C, U, kk), kn % AT_NSLOT); }
        LAS unsigned char* sl = C.lds + (k % AT_NSLOT) * AT_SLOT;
        int lane_ = lane0; asm volatile("" : "+v"(lane_));
        const int lane = lane_, r16 = lane & 15, quad = lane >> 4, tokc = r16 >> 3, head = r16 & 7;
        f32x4* scr4 = (f32x4*)(scr + lane * 64);
        LAS float* impL = (LAS float*)(C.lds + AT_IMP_OFF + wv * 4096); LAS unsigned* maskL = (LAS unsigned*)(C.lds + AT_MASK_OFF + wv * 128);
        {
            const int j = k - j_c2;
#pragma unroll
            for (int jp = 0; jp < 2; ++jp) { if (2 * j + jp >= nsp) break;
                bf16x8 kf[2][2]; at_load_k(sl, jp, r16, quad, kf); bf16x8 vf[4]; at_load_v(sl, jp, r16, quad, vf);
#pragma unroll
                for (int cb = 0; cb < 4; ++cb) { const int tok8 = 2 * cb + tokc, tl = ta + tok8; const int nvl = (tl >= 31) ? (((tl - 31) >> 4) + 1) : 0;
                    f32x4 s0 = {0.f, 0.f, 0.f, 0.f}, s1 = {0.f, 0.f, 0.f, 0.f};
                    s0 = MFMA16(kf[0][0], q[cb][0], s0); s0 = MFMA16(kf[0][1], q[cb][1], s0); s1 = MFMA16(kf[1][0], q[cb][0], s1); s1 = MFMA16(kf[1][1], q[cb][1], s1);
                    const int n0 = 64 * j + 32 * jp + 4 * quad;
#pragma unroll
                    for (int r = 0; r < 4; ++r) { s0[r] = (n0 + r < nvl) ? __builtin_amdgcn_exp2f(s0[r] - mrun[cb]) * lrun[cb] : 0.f; s1[r] = (n0 + 16 + r < nvl) ? __builtin_amdgcn_exp2f(s1[r] - mrun[cb]) * lrun[cb] : 0.f; }
                    const bf16x8 pb = pack_p(s0, s1);
#pragma unroll
                    for (int db = 0; db < 4; ++db) O[cb][db] = MFMA16(vf[db], pb, O[cb][db]);
#pragma unroll
                    for (int h = 0; h < 2; ++h) { const f32x4& st = h ? s1 : s0; float h3 = st[3], hs = (st[0] + st[1]) + (st[2] + st[3]);
                        hs += shx(hs, 1, lane); hs += shx(hs, 2, lane); hs += shx(hs, 4, lane);
                        h3 += shx(h3, 1, lane); h3 += shx(h3, 2, lane); h3 += shx(h3, 4, lane);
                        const float up = shf(h3, (lane + 48) & 63);
                        const float val = hs + ((quad == 0) ? pup[cb] : up); pup[cb] = up;
                        if (head == 0) impL[tok8 * 128 + 4 * (4 * j + 2 * jp + h) + quad] = val; } } }
        }
        asm volatile("s_waitcnt lgkmcnt(0)" ::: "memory");
    }
    {
    int lane_ = lane0; asm volatile("" : "+v"(lane_));
    const int lane = lane_, r16 = lane & 15, quad = lane >> 4, tokc = r16 >> 3, head = r16 & 7; f32x4* scr4 = (f32x4*)(scr + lane * 64);
    LAS float* impL = (LAS float*)(C.lds + AT_IMP_OFF + wv * 4096); LAS unsigned* maskL = (LAS unsigned*)(C.lds + AT_MASK_OFF + wv * 128); (void)scr4; (void)impL; (void)maskL; (void)head; (void)tokc; (void)quad;
    {
            asm volatile("s_waitcnt lgkmcnt(0)" ::: "memory");
#pragma unroll
            for (int cb = 0; cb < 4; ++cb) { const int tok8 = 2 * cb + tokc, tl = ta + tok8;
                if (2 * nsp < 32 && head == 0 && quad == 0) impL[tok8 * 128 + 8 * nsp] = pup[cb];
                const float g0 = sigmoidf_(bf2f(Z[((size_t)(U.b * SEQ + tl)) * ZW + ZC_NG + U.g * 8 + head]));
#pragma unroll
                for (int db = 0; db < 4; ++db) { scr4[cb * 4 + db] = O[cb][db] * g0; O[cb][db] = (f32x4){0.f, 0.f, 0.f, 0.f}; }
                mrun[cb] = -1e30f; lrun[cb] = 0.f; }
            asm volatile("s_waitcnt lgkmcnt(0)" ::: "memory");
            { const int cur = U.c, lam = head * 4 + quad;
              unsigned mk[4][4];
#pragma unroll
              for (int cb = 0; cb < 4; ++cb) { mk[cb][0] = 0u; mk[cb][1] = 0u; mk[cb][2] = 0u; mk[cb][3] = 0u; }
              if (cur <= 15) {
#pragma unroll
                  for (int cb = 0; cb < 4; ++cb) mk[cb][0] = (2u << cur) - 1u;
              } else {
                  unsigned key[4][4];
#pragma unroll
                  for (int cb = 0; cb < 4; ++cb) { const f32x4 v = *(const LAS f32x4*)(impL + (2 * cb + tokc) * 128 + 4 * lam);
#pragma unroll
                      for (int jx = 0; jx < 4; ++jx) { const int sb = 4 * lam + jx; unsigned kk = ((__float_as_uint(v[jx]) & 0xFFFFFF80u) + 0x80u) | (unsigned)(127 - sb);
                          kk = (sb > cur) ? 0u : kk; kk = (sb == 0 || sb == cur) ? (0x7F000000u | (unsigned)(127 - sb)) : kk; key[cb][jx] = kk; } }
                  for (int round = 0; round < 16; ++round) {
                      unsigned bk[4];
#pragma unroll
                      for (int cb = 0; cb < 4; ++cb) { const unsigned a = key[cb][0] > key[cb][1] ? key[cb][0] : key[cb][1], b2 = key[cb][2] > key[cb][3] ? key[cb][2] : key[cb][3]; bk[cb] = a > b2 ? a : b2; }
#pragma unroll
                      for (int st = 0; st < 5; ++st) { const int off = (st < 3) ? (1 << st) : (st == 3 ? 16 : 32);
#pragma unroll
                          for (int cb = 0; cb < 4; ++cb) { const unsigned o = (unsigned)shxi((int)bk[cb], off, lane); bk[cb] = o > bk[cb] ? o : bk[cb]; } }
#pragma unroll
                      for (int cb = 0; cb < 4; ++cb) { const unsigned b = bk[cb]; const int bs = 127 - (int)(b & 127u);
#pragma unroll
                          for (int jx = 0; jx < 4; ++jx) key[cb][jx] = (key[cb][jx] == b) ? 0u : key[cb][jx];
                          const unsigned bit = 1u << (bs & 31); const int wd = bs >> 5;
                          mk[cb][0] |= (wd == 0) ? bit : 0u; mk[cb][1] |= (wd == 1) ? bit : 0u; mk[cb][2] |= (wd == 2) ? bit : 0u; mk[cb][3] |= (wd == 3) ? bit : 0u; }
                  }
              }
              if (head == 0 && quad == 0) {
#pragma unroll
                  for (int cb = 0; cb < 4; ++cb) { const int tok8 = 2 * cb + tokc; maskL[0 * 8 + tok8] = mk[cb][0]; maskL[1 * 8 + tok8] = mk[cb][1]; maskL[2 * 8 + tok8] = mk[cb][2]; maskL[3 * 8 + tok8] = mk[cb][3]; } }
            }
            asm volatile("s_waitcnt lgkmcnt(0)" ::: "memory");
        }
    }
    for (; k < j_wn; ++k) {
        asm volatile("s_waitcnt vmcnt(4)" ::: "memory");
        __builtin_amdgcn_s_barrier(); asm volatile("" ::: "memory");
        { const int kn = k + AT_PF; const int kk = (kn < U.njobs) ? kn : U.njobs - 1; at_stage(C, at_job(C, U, kk), kn % AT_NSLOT); }
        LAS unsigned char* sl = C.lds + (k % AT_NSLOT) * AT_SLOT;
        int lane_ = lane0; asm volatile("" : "+v"(lane_));
        const int lane = lane_, r16 = lane & 15, quad = lane >> 4, tokc = r16 >> 3, head = r16 & 7;
        f32x4* scr4 = (f32x4*)(scr + lane * 64);
        LAS float* impL = (LAS float*)(C.lds + AT_IMP_OFF + wv * 4096); LAS unsigned* maskL = (LAS unsigned*)(C.lds + AT_MASK_OFF + wv * 128);
        {
            const int s = k - j_sl; unsigned selw[4]; bool need[4], both[4]; bool any = false;
#pragma unroll
            for (int cb = 0; cb < 4; ++cb) { selw[cb] = (maskL[(s >> 5) * 8 + 2 * cb + tokc] >> (s & 31)) & 1u; const unsigned long long bl = __builtin_amdgcn_ballot_w64(selw[cb] != 0u); need[cb] = bl != 0ull; both[cb] = bl == ~0ull; any = any || need[cb]; }
            if (any) {
#pragma unroll
                for (int jp = 0; jp < 2; ++jp) { bf16x8 kf[2][2]; at_load_k(sl, jp, r16, quad, kf); bf16x8 vf[4]; at_load_v(sl, jp, r16, quad, vf);
#pragma unroll
                    for (int cb = 0; cb < 4; ++cb) if (need[cb]) { const int tl = ta + 2 * cb + tokc; const bool sel = selw[cb] != 0u; const int key0 = 64 * s + 32 * jp + 4 * quad;
                        f32x4 s0 = {0.f, 0.f, 0.f, 0.f}, s1 = {0.f, 0.f, 0.f, 0.f};
                        s0 = MFMA16(kf[0][0], q[cb][0], s0); s0 = MFMA16(kf[0][1], q[cb][1], s0); s1 = MFMA16(kf[1][0], q[cb][0], s1); s1 = MFMA16(kf[1][1], q[cb][1], s1);
                        if (s == U.c || !both[cb]) at_online<true>(s0, s1, [=](int h, int r) { return sel && (key0 + 16 * h + r <= tl); }, mrun[cb], lrun[cb], O[cb], vf, lane);
                        else at_online<false>(s0, s1, [=](int, int) { return true; }, mrun[cb], lrun[cb], O[cb], vf, lane); } }
            }
        }
        asm volatile("s_waitcnt lgkmcnt(0)" ::: "memory");
    }
    {
    int lane_ = lane0; asm volatile("" : "+v"(lane_));
    const int lane = lane_, r16 = lane & 15, quad = lane >> 4, tokc = r16 >> 3, head = r16 & 7; f32x4* scr4 = (f32x4*)(scr + lane * 64);
    LAS float* impL = (LAS float*)(C.lds + AT_IMP_OFF + wv * 4096); LAS unsigned* maskL = (LAS unsigned*)(C.lds + AT_MASK_OFF + wv * 128); (void)scr4; (void)impL; (void)maskL; (void)head; (void)tokc; (void)quad;
    {
#pragma unroll
            for (int cb = 0; cb < 4; ++cb) { const int tl = ta + 2 * cb + tokc;
                float ls = lrun[cb]; ls += shx(ls, 16, lane); ls += shx(ls, 32, lane);
                const float g1 = sigmoidf_(bf2f(Z[((size_t)(U.b * SEQ + tl)) * ZW + ZC_NG + 16 + U.g * 8 + head])) / ls;
#pragma unroll
                for (int db = 0; db < 4; ++db) { scr4[cb * 4 + db] = scr4[cb * 4 + db] + O[cb][db] * g1; O[cb][db] = (f32x4){0.f, 0.f, 0.f, 0.f}; }
                mrun[cb] = -1e30f; lrun[cb] = 0.f; }
        }
    }
    for (; k < U.njobs; ++k) {
        asm volatile("s_waitcnt vmcnt(4)" ::: "memory");
        __builtin_amdgcn_s_barrier(); asm volatile("" ::: "memory");
        { const int kn = k + AT_PF; const int kk = (kn < U.njobs) ? kn : U.njobs - 1; at_stage(C, at_job(C, U, kk), kn % AT_NSLOT); }
        LAS unsigned char* sl = C.lds + (k % AT_NSLOT) * AT_SLOT;
        int lane_ = lane0; asm volatile("" : "+v"(lane_));
        const int lane = lane_, r16 = lane & 15, quad = lane >> 4, tokc = r16 >> 3, head = r16 & 7;
        f32x4* scr4 = (f32x4*)(scr + lane * 64);
        LAS float* impL = (LAS float*)(C.lds + AT_IMP_OFF + wv * 4096); LAS unsigned* maskL = (LAS unsigned*)(C.lds + AT_MASK_OFF + wv * 128);
        {
            const int w = U.wlo + (k - j_wn);
#pragma unroll
            for (int jp = 0; jp < 2; ++jp) { const int kb = 64 * w + 32 * jp; if (kb > ta + 7 || kb + 31 + 511 < ta) continue;
                bf16x8 kf[2][2]; at_load_k(sl, jp, r16, quad, kf); bf16x8 vf[4]; at_load_v(sl, jp, r16, quad, vf);
#pragma unroll
                for (int cb = 0; cb < 4; ++cb) { const int tl = ta + 2 * cb + tokc; const int key0 = kb + 4 * quad;
                    f32x4 s0 = {0.f, 0.f, 0.f, 0.f}, s1 = {0.f, 0.f, 0.f, 0.f};
                    s0 = MFMA16(kf[0][0], q[cb][0], s0); s0 = MFMA16(kf[0][1], q[cb][1], s0); s1 = MFMA16(kf[1][0], q[cb][0], s1); s1 = MFMA16(kf[1][1], q[cb][1], s1);
                    if (kb + 31 <= ta && kb + 511 >= ta + 7) at_online<false>(s0, s1, [=](int, int) { return true; }, mrun[cb], lrun[cb], O[cb], vf, lane);
                    else at_online<true>(s0, s1, [=](int h, int r) { const int key = key0 + 16 * h + r; return key <= tl && key + 511 >= tl; }, mrun[cb], lrun[cb], O[cb], vf, lane); } }
        }
        asm volatile("s_waitcnt lgkmcnt(0)" ::: "memory");
    }
    int lane_ = lane0; asm volatile("" : "+v"(lane_));
    const int lane = lane_, r16 = lane & 15, quad = lane >> 4, tokc = r16 >> 3, head = r16 & 7; f32x4* scr4 = (f32x4*)(scr + lane * 64);
#pragma unroll
    for (int cb = 0; cb < 4; ++cb) { const int tl = ta + 2 * cb + tokc;
        float ls = lrun[cb]; ls += shx(ls, 16, lane); ls += shx(ls, 32, lane);
        const float g2 = sigmoidf_(bf2f(Z[((size_t)(U.b * SEQ + tl)) * ZW + ZC_NG + 32 + U.g * 8 + head])) / ls;
        bf16* orow = (bf16*)(C.ws + WS_O) + ((size_t)(U.b * SEQ + tl)) * DM + (U.g * 8 + head) * 64 + 4 * quad;
#pragma unroll
        for (int db = 0; db < 4; ++db) { const f32x4 v = scr4[cb * 4 + db] + O[cb][db] * g2;
            v2u wv2; wv2.x = cvt_pk_bf16(v[0], v[1]); wv2.y = cvt_pk_bf16(v[2], v[3]); *(v2u*)(orow + 16 * db) = wv2; } }
    asm volatile("s_waitcnt vmcnt(0)" ::: "memory");
    __builtin_amdgcn_s_barrier(); asm volatile("" ::: "memory");
}
__device__ __forceinline__ void attn_phase(const Ctx& C) {
    float* scr = (float*)(C.ws + WS_SCR) + ((size_t)C.bx * NWAVES + C.wave) * 4096;
    for (int uu = C.bx; uu < 8 * 128; uu += C.G) { const int bgi = uu & 7, kk = uu >> 3, rnd = kk >> 5, sub = kk & 31;
        AtUnit U; U.b = bgi >> 1; U.g = bgi & 1; U.bg = bgi; U.c = (rnd == 0) ? 127 - sub : (rnd == 1) ? 64 + sub : (rnd == 2) ? 63 - sub : sub;
        U.nct = (4 * U.c + 3 + 63) >> 6; U.wlo = (U.c >= 8) ? U.c - 8 : 0; U.njobs = 2 * U.nct + (U.c + 1) + (U.c - U.wlo + 1);
        attn_unit(C, U, scr); }
}


constexpr int RW_PITCH = 1028;
__device__ __forceinline__ void norm2_router(const Ctx& C, const Args& a, int l) {
    LAS float* rw = (LAS float*)C.lds; LAS int* hist = (LAS int*)(C.lds + SM_OFF);
    const float* rwg = a.in[I_RW] + (size_t)l * DM * NEXP;
    for (int i = C.tid; i < DM * NEXP; i += NWAVES * 64) rw[(i & 31) * RW_PITCH + (i >> 5)] = rwg[i];
    if (C.tid < 32) hist[C.tid] = 0;
    __syncthreads();
    const float* X = a.out; const float* gain = a.in[I_NORM2] + l * DM; const float* mod_l = (const float*)(C.ws + WS_MOD) + (size_t)l * NB * 6144;
    const float* rb = a.in[I_RB] + l * NEXP; bf16* H = (bf16*)(C.ws + WS_H);
    int* tope = (int*)(C.ws + WS_TOPE); float* topw = (float*)(C.ws + WS_TOPW);
    const int lane = C.lane;
    for (int i = 0; i < 16; ++i) {
        const int m = C.bx * 128 + C.wave * 16 + i, b = m >> 13; const f32x4* xr = (const f32x4*)(X + (size_t)m * DM) + lane;
        f32x4 v[4]; float s = 0.f;
#pragma unroll
        for (int j = 0; j < 4; ++j) { v[j] = xr[64 * j]; s += (v[j].x * v[j].x + v[j].y * v[j].y) + (v[j].z * v[j].z + v[j].w * v[j].w); }
        const float rstd = 1.0f / sqrtf(wave_sum(s, lane) * (1.0f / DM) + 1e-6f);
        const float* mb = mod_l + (size_t)b * 6144; v2u* o8 = (v2u*)(H + (size_t)m * DM) + lane;
#pragma unroll
        for (int j = 0; j < 4; ++j) { const int col = 4 * lane + 256 * j;
            const f32x4 gn = *(const f32x4*)(gain + col), sc = *(const f32x4*)(mb + 4 * DM + col), sh = *(const f32x4*)(mb + 3 * DM + col);
            v[j] = v[j] * rstd * gn * (sc + 1.0f) + sh;
            v2u w; w.x = cvt_pk_bf16(v[j].x, v[j].y); w.y = cvt_pk_bf16(v[j].z, v[j].w); o8[64 * j] = w; }
        float lg[32];
#pragma unroll
        for (int e = 0; e < 32; ++e) { float p = 0.f;
#pragma unroll
            for (int j = 0; j < 4; ++j) { const f32x4 wv = *(const LAS f32x4*)(rw + e * RW_PITCH + 4 * lane + 256 * j); p += (v[j].x * wv.x + v[j].y * wv.y) + (v[j].z * wv.z + v[j].w * wv.w); }
            lg[e] = wave_sum(p, lane) + rb[e]; if ((e & 3) == 3) __builtin_amdgcn_sched_barrier(0); }
        int te[4]; float tv[4];
#pragma unroll
        for (int k = 0; k < 4; ++k) { float bv = lg[0]; int be = 0;
#pragma unroll
            for (int e = 1; e < 32; ++e) { const bool gt = lg[e] > bv; bv = gt ? lg[e] : bv; be = gt ? e : be; }
            te[k] = be; tv[k] = bv;
#pragma unroll
            for (int e = 0; e < 32; ++e) lg[e] = (e == be) ? -3.0e38f : lg[e]; }
        const float e1 = __expf(tv[1] - tv[0]), e2 = __expf(tv[2] - tv[0]), e3 = __expf(tv[3] - tv[0]); const float inv = 1.0f / (1.0f + e1 + e2 + e3);
        if (lane < 4) { const int ek = (lane == 0) ? te[0] : (lane == 1) ? te[1] : (lane == 2) ? te[2] : te[3];
            const float wk = (lane == 0) ? inv : (lane == 1) ? e1 * inv : (lane == 2) ? e2 * inv : e3 * inv;
            tope[m * 4 + lane] = ek; topw[m * 4 + lane] = wk; __hip_atomic_fetch_add(hist + ek, 1, __ATOMIC_RELAXED, __HIP_MEMORY_SCOPE_WORKGROUP); }
    }
    __syncthreads();
    if (C.tid < 32) ((int*)(C.ws + WS_CNT))[C.bx * 32 + C.tid] = hist[C.tid];
    __syncthreads();
}
__device__ __forceinline__ void moe_scatter(const Ctx& C) {
    LAS int* sm = (LAS int*)(C.lds + SM_OFF); LAS int* tot = sm + 32; LAS int* base = sm + 64; LAS int* pstart = sm + 96; LAS int* lcnt = sm + 128;
    const int* cnt = (const int*)(C.ws + WS_CNT); int* tile_e = (int*)(C.ws + WS_TILEE);
    if (C.tid < 32) { int t = 0, bs = 0; for (int bb = 0; bb < C.G; ++bb) { const int c = cnt[bb * 32 + C.tid]; t += c; bs += (bb < C.bx) ? c : 0; } tot[C.tid] = t; base[C.tid] = bs; lcnt[C.tid] = 0; }
    __syncthreads();
    if (C.tid == 0) { int ps = 0; for (int e = 0; e < 32; ++e) { pstart[e] = ps; const int nt = (tot[e] + 255) >> 8; if (C.bx == 0) for (int i = 0; i < nt; ++i) tile_e[(ps >> 8) + i] = e; ps += nt << 8; }
        if (C.bx == 0) tile_e[1023] = ps >> 8; }
    __syncthreads();
    const int* tope = (const int*)(C.ws + WS_TOPE); int* dest = (int*)(C.ws + WS_DEST);
    const bf16* H = (const bf16*)(C.ws + WS_H); bf16* Hs = (bf16*)(C.ws + WS_HS); const int lane = C.lane;
    for (int i = 0; i < 16; ++i) { const int m = C.bx * 128 + C.wave * 16 + i; int row = 0;
        if (lane < 4) { const int e = tope[m * 4 + lane]; const int rank = __hip_atomic_fetch_add(lcnt + e, 1, __ATOMIC_RELAXED, __HIP_MEMORY_SCOPE_WORKGROUP); row = pstart[e] + base[e] + rank; dest[m * 4 + lane] = row; }
        const int r0 = shfi(row, 0), r1 = shfi(row, 1), r2 = shfi(row, 2), r3 = shfi(row, 3);
        const v4u* src = (const v4u*)(H + (size_t)m * DM) + lane; const v4u x0 = src[0], x1 = src[64];
        v4u* d0 = (v4u*)(Hs + (size_t)r0 * DM) + lane; d0[0] = x0; d0[64] = x1;
        v4u* d1 = (v4u*)(Hs + (size_t)r1 * DM) + lane; d1[0] = x0; d1[64] = x1;
        v4u* d2 = (v4u*)(Hs + (size_t)r2 * DM) + lane; d2[0] = x0; d2[64] = x1;
        v4u* d3 = (v4u*)(Hs + (size_t)r3 * DM) + lane; d3[0] = x0; d3[64] = x1; }
    __syncthreads();
}
__device__ __forceinline__ void moe_combine(const Ctx& C, const Args& a, int l, float* Xout) {
    const int gw = C.bx * NWAVES + C.wave, NGW = C.G * NWAVES, lane = C.lane;
    const int* dest = (const int*)(C.ws + WS_DEST); const float* topw = (const float*)(C.ws + WS_TOPW); const bf16* Y = (const bf16*)(C.ws + WS_Y);
    const float* mod_l = (const float*)(C.ws + WS_MOD) + (size_t)l * NB * 6144; const float* X = a.out;
    for (int m = gw; m < NTOK; m += NGW) { const int b = m >> 13; const float* g2 = mod_l + (size_t)b * 6144 + 5 * DM;
        int r[4]; float w[4];
#pragma unroll
        for (int k = 0; k < 4; ++k) { r[k] = dest[m * 4 + k]; w[k] = topw[m * 4 + k]; }
        const f32x4* xr = (const f32x4*)(X + (size_t)m * DM) + lane; f32x4* xo = (f32x4*)(Xout + (size_t)m * DM) + lane;
#pragma unroll
        for (int j = 0; j < 4; ++j) { const int col = 4 * lane + 256 * j; f32x4 y = {0.f, 0.f, 0.f, 0.f};
#pragma unroll
            for (int k = 0; k < 4; ++k) { const v2u u = *(const v2u*)(Y + (size_t)r[k] * DM + col); y.x += w[k] * bflo(u.x); y.y += w[k] * bfhi(u.x); y.z += w[k] * bflo(u.y); y.w += w[k] * bfhi(u.y); }
            const f32x4 gv = *(const f32x4*)(g2 + col); xo[64 * j] = xr[64 * j] + gv * y; } }
}


#ifndef MK_ONE_LAUNCH
#define MK_ONE_LAUNCH 1
#endif
#ifndef REP_NORM1
#define REP_NORM1 1
#endif
#ifndef REP_PROJ
#define REP_PROJ 1
#endif
#ifndef REP_OUTG
#define REP_OUTG 1
#endif
#ifndef REP_COMB
#define REP_COMB 1
#endif
#ifndef REP_P0
#define REP_P0 1
#endif
#ifndef REP_ATTN
#define REP_ATTN 1
#endif
#ifndef REP_POST
#define REP_POST 1
#endif
#ifndef REP_N2R
#define REP_N2R 1
#endif
#ifndef REP_GEMMIN
#define REP_GEMMIN 1
#endif
#ifndef REP_MOE
#define REP_MOE 1
#endif
#ifndef REP_SCAT
#define REP_SCAT 1
#endif
template <int l>
__device__ __forceinline__ void layer_body(Ctx& C, const Args& args, const XcdBarrier& bar, const int lo, const int hi) {
    bf16* const H = (bf16*)(C.ws + WS_H); bf16* const Z = (bf16*)(C.ws + WS_Z);
    const float* const MOD = (const float*)(C.ws + WS_MOD);
    const int* const tile_e = (const int*)(C.ws + WS_TILEE);
#define IN(k) (fresh(C), lo <= (k) && (k) < hi)
#define SEAM(k) do { if (IN(k) && IN((k) + 1)) xcd_barrier(bar, C.tid); } while (0)

        const int pb = 2 + l * NPH_LAYER;
        const float* mod_l = MOD + (size_t)l * NB * 6144;
        if (IN(pb + PH_NORM1)) for (int rep = 0; rep < REP_NORM1; ++rep) norm_rows(C, l == 0 ? args.in[I_X] : args.out, args.in[I_NORM1] + l * DM, mod_l, 0, 1, H);
        SEAM(pb + PH_NORM1);
        if (IN(pb + PH_GEMM_IN)) for (int rep = 0; rep < REP_GEMMIN; ++rep) {
            pg8::Gemm g{H, (const bf16*)(C.ws + WS_WIN) + (size_t)l * ZW * DM, NTOK, ZW, DM, nullptr, 0}; pg8::StaticOrder S; S.init(NTOK, ZW, C.G, C.bx);
            pg8::EpiStore E{Z, ZW, nullptr};
            pg8::gemm_phase<pg8::EpiStore, pg8::StaticOrder, true, true>(C.lds, g, S, E, C.tid); }
        SEAM(pb + PH_GEMM_IN);
        if (IN(pb + PH_POST)) for (int rep = 0; rep < REP_POST; ++rep) { post_tokens(C, args, l); __syncthreads(); for (int u = C.bx; u < 512; u += C.G) compress_unit(C, args, l, u); }
        SEAM(pb + PH_POST);
        if (IN(pb + PH_ATTN)) for (int rep = 0; rep < REP_ATTN; ++rep) attn_phase(C);
        SEAM(pb + PH_ATTN);
        if (IN(pb + PH_POOLG)) for (int rep = 0; rep < REP_PROJ; ++rep) {
            pg8::Gemm g{(const bf16*)(C.ws + WS_PM), (const bf16*)(C.ws + WS_WPOOL) + (size_t)l * 512 * 512, NTOK, 512, 512, nullptr, 0}; pg8::StaticOrder S; S.init(NTOK, 512, C.G, C.bx);
            pg8::EpiStore E{(bf16*)(C.ws + WS_PP), 512, args.in[I_PSCALE] + l * 512};
            pg8::gemm_phase<pg8::EpiStore, pg8::StaticOrder, true, true>(C.lds, g, S, E, C.tid); }
        SEAM(pb + PH_POOLG);
        if (IN(pb + PH_PROJA)) {
            pg8::Gemm g{(const bf16*)(C.ws + WS_PP), (const bf16*)(C.ws + WS_WA) + (size_t)l * 1024 * 512, NTOK, 1024, 512, nullptr, 0}; pg8::StaticOrder S; S.init(NTOK, 1024, C.G, C.bx);
            pg8::EpiGate<false> E{(bf16*)(C.ws + WS_MG), 1024, Z + ZC_MG, ZW};
            pg8::gemm_phase<pg8::EpiGate<false>, pg8::StaticOrder, true, true>(C.lds, g, S, E, C.tid); }
        SEAM(pb + PH_PROJA);
        if (IN(pb + PH_PROJB)) { for (int rep = 1; rep < REP_PROJ; ++rep) { {
            pg8::Gemm g{(const bf16*)(C.ws + WS_O), (const bf16*)(C.ws + WS_WB) + (size_t)l * 1024 * 1024, NTOK, 1024, 1024, nullptr, 0}; pg8::StaticOrder S; S.init(NTOK, 1024, C.G, C.bx);
            pg8::EpiGate<true> E{(bf16*)(C.ws + WS_MG), 1024, Z + ZC_MG + 1024, ZW};
            pg8::gemm_phase<pg8::EpiGate<true>, pg8::StaticOrder, true, true>(C.lds, g, S, E, C.tid); } {
            pg8::Gemm g{(const bf16*)(C.ws + WS_PP), (const bf16*)(C.ws + WS_WA) + (size_t)l * 1024 * 512, NTOK, 1024, 512, nullptr, 0}; pg8::StaticOrder S; S.init(NTOK, 1024, C.G, C.bx);
            pg8::EpiGate<false> E{(bf16*)(C.ws + WS_MG), 1024, Z + ZC_MG, ZW};
            pg8::gemm_phase<pg8::EpiGate<false>, pg8::StaticOrder, true, true>(C.lds, g, S, E, C.tid); } }
            {
            pg8::Gemm g{(const bf16*)(C.ws + WS_O), (const bf16*)(C.ws + WS_WB) + (size_t)l * 1024 * 1024, NTOK, 1024, 1024, nullptr, 0}; pg8::StaticOrder S; S.init(NTOK, 1024, C.G, C.bx);
            pg8::EpiGate<true> E{(bf16*)(C.ws + WS_MG), 1024, Z + ZC_MG + 1024, ZW};
            pg8::gemm_phase<pg8::EpiGate<true>, pg8::StaticOrder, true, true>(C.lds, g, S, E, C.tid); } }
        SEAM(pb + PH_PROJB);
        if (IN(pb + PH_OUTG)) { for (int rep = 1; rep < REP_OUTG; ++rep) {
            pg8::Gemm g{(const bf16*)(C.ws + WS_MG), (const bf16*)(C.ws + WS_WOUT) + (size_t)l * 1024 * 1024, NTOK, 1024, 1024, nullptr, 0}; pg8::StaticOrder S; S.init(NTOK, 1024, C.G, C.bx);
            pg8::EpiResid E{l == 0 ? args.in[I_X] : args.out, (float*)(C.ws + WS_SCR), mod_l + 2 * DM, 6144};
            pg8::gemm_phase<pg8::EpiResid, pg8::StaticOrder, true, true>(C.lds, g, S, E, C.tid); }
            {
            pg8::Gemm g{(const bf16*)(C.ws + WS_MG), (const bf16*)(C.ws + WS_WOUT) + (size_t)l * 1024 * 1024, NTOK, 1024, 1024, nullptr, 0}; pg8::StaticOrder S; S.init(NTOK, 1024, C.G, C.bx);
            pg8::EpiResid E{l == 0 ? args.in[I_X] : args.out, args.out, mod_l + 2 * DM, 6144};
            pg8::gemm_phase<pg8::EpiResid, pg8::StaticOrder, true, true>(C.lds, g, S, E, C.tid); } }
        SEAM(pb + PH_OUTG);
        if (IN(pb + PH_NORM2R)) for (int rep = 0; rep < REP_N2R; ++rep) norm2_router(C, args, l);
        SEAM(pb + PH_NORM2R);
        if (IN(pb + PH_SCATTER)) for (int rep = 0; rep < REP_SCAT; ++rep) moe_scatter(C);
        SEAM(pb + PH_SCATTER);
        if (IN(pb + PH_GATEUP)) for (int rep = 0; rep < REP_MOE; ++rep) { const int R = tile_e[1023];
            pg8::Gemm g{(const bf16*)(C.ws + WS_HS), (const bf16*)(C.ws + WS_WGU) + (size_t)l * NEXP * 2048 * 1024, R * 256, 2048, 1024, tile_e, (size_t)2048 * 1024 * 2}; pg8::StaticOrder S; S.init(R * 256, 2048, C.G, C.bx);
            pg8::EpiSwiglu E{(bf16*)(C.ws + WS_ACT), args.in[I_BGU] + (size_t)l * NEXP * 2048, tile_e};
            pg8::gemm_phase<pg8::EpiSwiglu, pg8::StaticOrder, true, true>(C.lds, g, S, E, C.tid); }
        SEAM(pb + PH_GATEUP);
        if (IN(pb + PH_DOWN)) for (int rep = 0; rep < REP_MOE; ++rep) { const int R = tile_e[1023];
            pg8::Gemm g{(const bf16*)(C.ws + WS_ACT), (const bf16*)(C.ws + WS_WD) + (size_t)l * NEXP * 1024 * 1024, R * 256, 1024, 1024, tile_e, (size_t)1024 * 1024 * 2}; pg8::StaticOrder S; S.init(R * 256, 1024, C.G, C.bx);
            pg8::EpiBiasE E{(bf16*)(C.ws + WS_Y), args.in[I_BD] + (size_t)l * NEXP * 1024, tile_e};
            pg8::gemm_phase<pg8::EpiBiasE, pg8::StaticOrder, true, true>(C.lds, g, S, E, C.tid); }
        SEAM(pb + PH_DOWN);
        if (IN(pb + PH_COMBINE)) { for (int rep = 1; rep < REP_COMB; ++rep) moe_combine(C, args, l, (float*)(C.ws + WS_SCR)); moe_combine(C, args, l, args.out); }
        SEAM(pb + PH_COMBINE);

#undef IN
#undef SEAM
}
__global__ void __launch_bounds__(NWAVES * 64, 2) fwd(Args args) {
    extern __shared__ __attribute__((aligned(16))) unsigned char lds_raw[];
    Ctx C; C.lds = (LAS unsigned char*)lds_raw; C.tid = threadIdx.x; C.lane = C.tid & 63; C.wave = __builtin_amdgcn_readfirstlane(C.tid >> 6); C.bx = blockIdx.x; C.G = gridDim.x; C.ws = args.ws;
    for (int u = C.tid; u < (LDS_BYTES - MISC_OFF) / 4; u += NWAVES * 64) ((LAS unsigned*)(C.lds + MISC_OFF))[u] = 0u;
    __syncthreads();
    const int lo = args.ph_lo, hi = args.ph_hi;
    unsigned* barw = (unsigned*)(C.ws + WS_CTL) + CW_BAR + (size_t)args.li * XCD_BAR_WORDS;
    XcdBarrier bar; bar.bar = barw; bar.x = 0; bar.st = nullptr;
    if (hi - lo > 1) bar = xcd_barrier_post(barw, (volatile LAS unsigned*)(C.lds + MISC_OFF) + 8, C.tid);
#define IN(k) (fresh(C), lo <= (k) && (k) < hi)
#define SEAM(k) do { if (IN(k) && IN((k) + 1)) xcd_barrier(bar, C.tid); } while (0)
    bf16* const H = (bf16*)(C.ws + WS_H); bf16* const Z = (bf16*)(C.ws + WS_Z);
    const float* const MOD = (const float*)(C.ws + WS_MOD);
    const int* const tile_e = (const int*)(C.ws + WS_TILEE);

    if (IN(0)) for (int rep = 0; rep < REP_P0; ++rep) p0_convert(C, args);
    SEAM(0);
    if (IN(1)) p1_mod(C, args);
    SEAM(1);
    layer_body<0>(C, args, bar, lo, hi); layer_body<1>(C, args, bar, lo, hi); layer_body<2>(C, args, bar, lo, hi); layer_body<3>(C, args, bar, lo, hi);
#undef IN
#undef SEAM
}

extern "C" void kernel_launch(void* const* d_in, const int* in_sizes, int n_in, void* d_out, int out_size, void* d_ws, size_t ws_size, hipStream_t stream) {
    static int grid = 0;
    if (grid == 0) {
        if (n_in != N_IN || out_size != NTOK * DM || ws_size < WS_END) { fprintf(stderr, "kernel_launch: unexpected shapes (n_in %d, out %d, ws %zu < %zu)\n", n_in, out_size, ws_size, (size_t)WS_END); grid = -1; return; }
        int dev = 0, cus = 0;
        if (hipGetDevice(&dev) != hipSuccess || hipDeviceGetAttribute(&cus, hipDeviceAttributeMultiprocessorCount, dev) != hipSuccess) { grid = -1; return; }
        if (hipFuncSetAttribute((const void*)fwd, hipFuncAttributeMaxDynamicSharedMemorySize, LDS_BYTES) != hipSuccess) { fprintf(stderr, "kernel_launch: hipFuncSetAttribute failed\n"); grid = -1; return; }
        int per_cu = 0; (void)hipOccupancyMaxActiveBlocksPerMultiprocessor(&per_cu, (const void*)fwd, NWAVES * 64, LDS_BYTES); (void)hipGetLastError();
        if (cus != 256 || per_cu < 1) fprintf(stderr, "kernel_launch: note: %d CUs, occupancy query %d; this kernel is built for one 512-thread workgroup on each of 256 CUs\n", cus, per_cu);
        grid = 256;
    }
    if (grid < 0) return;
    if (hipMemsetAsync((char*)d_ws + WS_CTL, 0, CTL_ZERO_BYTES, stream) != hipSuccess) return;
    Args a{};
    for (int i = 0; i < N_IN; ++i) a.in[i] = (const float*)d_in[i];
    a.out = (float*)d_out; a.ws = (unsigned char*)d_ws;
#if MK_ONE_LAUNCH
    a.ph_lo = 0; a.ph_hi = NPHASES; a.li = 0; a.pad = 0;
    hipLaunchKernelGGL(fwd, dim3(grid), dim3(NWAVES * 64), LDS_BYTES, stream, a);
#else
    for (int ph = 0; ph < NPHASES; ++ph) { a.ph_lo = ph; a.ph_hi = ph + 1; a.li = 0; a.pad = 0;
        hipLaunchKernelGGL(fwd, dim3(grid), dim3(NWAVES * 64), LDS_BYTES, stream, a); }
#endif
}
```

```cpp
#include <hip/hip_runtime.h>
#include <cstdio>
#include <cstdint>

namespace pg8 {
#define PG8_LAS __attribute__((address_space(3)))
typedef unsigned short bf16_t;
typedef short bf16x8 __attribute__((ext_vector_type(8)));
typedef float f32x4 __attribute__((ext_vector_type(4)));
typedef unsigned u32x4 __attribute__((ext_vector_type(4)));
constexpr int BM = 256, BK = 64, HALF = 128, HTB = HALF * BK * 2  , STAGE_BYTES = 8 * HTB, NXCD = 8, WGM = 8;

__host__ __device__ __forceinline__ int lds_byte(int r, int c) { const int st = (r >> 4) * 2 + (c >> 5), rr = r & 15, cc = c & 31, ob = rr * 64 + cc * 2; return st * 1024 + (ob ^ (((ob >> 9) & 1) << 5)); }
__host__ __device__ __forceinline__ void stage_rc(int b, int& R, int& C) { const int st = b / 1024, sb = b % 1024, swz = sb ^ (((sb >> 9) & 1) << 5); R = (st >> 1) * 16 + swz / 64; C = (st & 1) * 32 + (swz % 64) / 2; }
__host__ __device__ __forceinline__ int perm32(int rho) { const int n = rho >> 4, i = rho & 15; return 8 * (i >> 2) + 4 * n + (i & 3); }

struct Unit { int pm, pn; };
struct Gemm { const bf16_t* A; const bf16_t* Bt; int M, N, K; const int* tile_e; size_t be_stride; const int* row_tok; };

struct StaticOrder {
    int nM, nN, nwg, G, c;
    __host__ __device__ void init(int M, int N, int G_, int c_) { nM = M / BM; nN = N / BM; nwg = nM * nN; G = G_; c = c_; }
    __host__ __device__ bool next(int i, Unit& u) const {
        const long L = (long)i * G + c; if (L >= nwg) return false;
        int wgid = (int)L; { const int q = nwg / NXCD, r = nwg % NXCD, xcd = wgid % NXCD, off = wgid / NXCD; wgid = (xcd < r ? xcd * (q + 1) : r * (q + 1) + (xcd - r) * q) + off; }
        const int nig = WGM * nN, gid = wgid / nig, fm = gid * WGM, gsz = (nM - fm) < WGM ? (nM - fm) : WGM;
        u.pm = fm + ((wgid % nig) % gsz); u.pn = (wgid % nig) / gsz; return true;
    }
    __device__ __forceinline__ void a_ready(const Unit&) const {}
    __device__ __forceinline__ void done(const Unit&) const {}
};

__device__ __forceinline__ unsigned cvt_pk_bf16(float lo, float hi) { unsigned r; asm volatile("v_cvt_pk_bf16_f32 %0, %1, %2" : "=v"(r) : "v"(lo), "v"(hi)); return r; }
typedef float f32x2 __attribute__((ext_vector_type(2)));


template <class Epi, class Sched, bool ALIGN_EPI = false, bool SP2 = false, bool GATHER = false  >
__device__ __forceinline__ void gemm_phase(PG8_LAS unsigned char* lds, const Gemm g, const Sched& S, const Epi& E, const int tid_in  ) {
    int tid_ = tid_in; asm volatile("" : "+v"(tid_));
    float zz = 0.f; asm volatile("" : "+v"(zz));
    const int tid = tid_, wid = __builtin_amdgcn_readfirstlane(tid >> 6), lane = tid & 63, wr = wid >> 2, wc = wid & 3, fr = lane & 15, fq = lane >> 4;
    const int K = g.K, nt = K / BK;
    unsigned voffA[2], voffB[2];
    unsigned vgC[2][2], vgN[2][2], vgS[2][2];
#pragma unroll
    for (int i = 0; i < 2; ++i) { int R, C; stage_rc(tid * 16 + i * 8192, R, C); const int Rb = Epi::PERM ? ((R & ~31) + perm32(R & 31)) : R;
        voffA[i] = (unsigned)(R * K + C) * 2u; voffB[i] = (unsigned)(Rb * K + C) * 2u; }
    const size_t kstep = (size_t)(BK * 2);
    const size_t hstep = (size_t)HALF * K * 2;
    const size_t tstep = 2 * hstep;
    const unsigned ldsw = (unsigned)wid * 1024u;
    const int aoff = lds_byte(wr * 64 + fr, fq * 8), boff = lds_byte(wc * 32 + fr, fq * 8);
#define PG8_SA(b, h) (((b) * 2 + (h)) * HTB)
#define PG8_SB(b, h) ((4 + (b) * 2 + (h)) * HTB)
#define PG8_STAGE(bufoff, gbase, voff) do { _Pragma("unroll") for (int _i = 0; _i < 2; ++_i) \
        __builtin_amdgcn_global_load_lds((const unsigned*)((const char*)(gbase) + (voff)[_i]), (PG8_LAS unsigned*)(lds + (bufoff) + ldsw + _i * 8192), 16, 0, 0); } while (0)
#define PG8_STAGE_A(bufoff, ptr, h, VG) do { if constexpr (GATHER) { PG8_STAGE(bufoff, ptr, VG[h]); } else { PG8_STAGE(bufoff, (ptr) + (h) * hstep, voffA); } } while (0)
#define PG8_ROWS(u, VG) do { _Pragma("unroll") for (int _h = 0; _h < 2; ++_h) _Pragma("unroll") for (int _i = 0; _i < 2; ++_i) { int _R, _C; stage_rc(tid * 16 + _i * 8192, _R, _C); \
        VG[_h][_i] = ((unsigned)g.row_tok[(u).pm * BM + _h * HALF + _R] * (unsigned)K + (unsigned)_C) * 2u; } } while (0)
#define PG8_LDA(dst, b, h) do { _Pragma("unroll") for (int m = 0; m < 4; ++m) _Pragma("unroll") for (int k = 0; k < 2; ++k) dst[m][k] = *(const PG8_LAS bf16x8*)(lds + PG8_SA(b, h) + aoff + m * 2048 + k * 1024); } while (0)
#define PG8_LDB(dst, b, h) do { _Pragma("unroll") for (int n = 0; n < 2; ++n) _Pragma("unroll") for (int k = 0; k < 2; ++k) dst[n][k] = *(const PG8_LAS bf16x8*)(lds + PG8_SB(b, h) + boff + n * 2048 + k * 1024); } while (0)
#define PG8_MMA(ai, bj, At, Bt) do { __builtin_amdgcn_s_setprio(1); _Pragma("unroll") for (int m = 0; m < 4; ++m) _Pragma("unroll") for (int n = 0; n < 2; ++n) _Pragma("unroll") for (int k = 0; k < 2; ++k) \
        acc[ai][bj][m][n] = __builtin_amdgcn_mfma_f32_16x16x32_bf16(Bt[n][k], At[m][k], acc[ai][bj][m][n], 0, 0, 0); __builtin_amdgcn_s_setprio(0); } while (0)
#define PG8_WAIT_V(n) asm volatile("s_waitcnt vmcnt(" #n ")" ::: "memory")
#define PG8_WAIT_L(n) asm volatile("s_waitcnt lgkmcnt(" #n ")" ::: "memory")
#define PG8_BAR __builtin_amdgcn_s_barrier()
#define PG8_SCHED __builtin_amdgcn_sched_barrier(0)
    Unit cur, nxt; int ui = 0;
    if (!S.next(0, cur)) return;
    f32x4 acc[2][2][4][2];
#pragma unroll
    for (int a = 0; a < 2; ++a)
#pragma unroll
        for (int b = 0; b < 2; ++b)
#pragma unroll
            for (int m = 0; m < 4; ++m)
#pragma unroll
                for (int n = 0; n < 2; ++n) acc[a][b][m][n] = (f32x4){zz, zz, zz, zz};
    bf16x8 At[4][2], B0[2][2], B1[2][2];
    const char* cA = (const char*)g.A + (GATHER ? (size_t)0 : (size_t)cur.pm * tstep); const char* cB = (const char*)g.Bt + (g.tile_e ? (size_t)g.tile_e[cur.pm] * g.be_stride : (size_t)0) + (size_t)cur.pn * tstep;
    if constexpr (GATHER) { PG8_ROWS(cur, vgC); }
    S.a_ready(cur);
    if constexpr (SP2) {
        PG8_STAGE(PG8_SB(0, 0), cB, voffB); PG8_STAGE(PG8_SB(0, 1), cB + hstep, voffB); PG8_STAGE_A(PG8_SA(0, 0), cA, 0, vgC); PG8_STAGE_A(PG8_SA(0, 1), cA, 1, vgC);
        if (wr == 1) PG8_BAR;
        PG8_WAIT_V(2); PG8_BAR;
        PG8_STAGE(PG8_SB(1, 0), cB + kstep, voffB); PG8_STAGE_A(PG8_SA(1, 0), cA + kstep, 0, vgC); PG8_STAGE(PG8_SB(1, 1), cB + hstep + kstep, voffB);
        PG8_WAIT_V(6); PG8_BAR;
    } else {
        PG8_STAGE(PG8_SB(0, 0), cB, voffB); PG8_STAGE_A(PG8_SA(0, 0), cA, 0, vgC); PG8_STAGE(PG8_SB(0, 1), cB + hstep, voffB); PG8_STAGE_A(PG8_SA(0, 1), cA, 1, vgC);
        if (wr == 1) PG8_BAR;
        PG8_WAIT_V(4); PG8_BAR;
        PG8_STAGE(PG8_SB(1, 0), cB + kstep, voffB); PG8_STAGE_A(PG8_SA(1, 0), cA + kstep, 0, vgC); PG8_STAGE(PG8_SB(1, 1), cB + hstep + kstep, voffB);
        PG8_WAIT_V(6); PG8_BAR;
    }
    for (;;) {
        const bool has_next = S.next(ui + 1, nxt);
        if constexpr (GATHER) { if (has_next) { PG8_ROWS(nxt, vgN); } else { _Pragma("unroll") for (int _h = 0; _h < 2; ++_h) _Pragma("unroll") for (int _i = 0; _i < 2; ++_i) vgN[_h][_i] = vgC[_h][_i]; } }
        const char* nA = (has_next && !GATHER) ? (const char*)g.A + (size_t)nxt.pm * tstep : cA; const char* nB = has_next ? (const char*)g.Bt + (g.tile_e ? (size_t)g.tile_e[nxt.pm] * g.be_stride : (size_t)0) + (size_t)nxt.pn * tstep : cB;
        for (int t = 0; t < nt; t += 2) {
            const bool last = (t == nt - 2);
            if constexpr (GATHER) { _Pragma("unroll") for (int _h = 0; _h < 2; ++_h) _Pragma("unroll") for (int _i = 0; _i < 2; ++_i) vgS[_h][_i] = last ? vgN[_h][_i] : vgC[_h][_i]; }
            const char* a1 = cA + (size_t)(t + 1) * kstep;
            const char* a2 = last ? nA : cA + (size_t)(t + 2) * kstep; const char* b2 = last ? nB : cB + (size_t)(t + 2) * kstep;
            const char* a3 = a2 + kstep; const char* b3 = b2 + kstep;
            if (last && has_next) S.a_ready(nxt);
            if constexpr (SP2) {
            PG8_LDB(B0, 0, 0); PG8_LDB(B1, 0, 1); PG8_SCHED; PG8_LDA(At, 0, 0); PG8_STAGE_A(PG8_SA(1, 1), a1, 1, vgC);
            PG8_WAIT_V(8); PG8_WAIT_L(0); PG8_BAR; PG8_MMA(0, 0, At, B0); PG8_MMA(0, 1, At, B1); PG8_BAR; PG8_SCHED;
            PG8_LDA(At, 0, 1); PG8_STAGE(PG8_SB(0, 0), b2, voffB); PG8_STAGE(PG8_SB(0, 1), b2 + hstep, voffB); PG8_STAGE_A(PG8_SA(0, 0), a2, 0, vgS);
            PG8_WAIT_V(8); PG8_WAIT_L(0); PG8_BAR; PG8_MMA(1, 0, At, B0); PG8_MMA(1, 1, At, B1); PG8_BAR; PG8_SCHED;
            PG8_LDB(B0, 1, 0); PG8_LDB(B1, 1, 1); PG8_SCHED; PG8_LDA(At, 1, 0); PG8_STAGE_A(PG8_SA(0, 1), a2, 1, vgS);
            PG8_WAIT_V(8); PG8_WAIT_L(0); PG8_BAR; PG8_MMA(0, 0, At, B0); PG8_MMA(0, 1, At, B1); PG8_BAR; PG8_SCHED;
            PG8_LDA(At, 1, 1); PG8_STAGE(PG8_SB(1, 0), b3, voffB); PG8_STAGE(PG8_SB(1, 1), b3 + hstep, voffB); PG8_STAGE_A(PG8_SA(1, 0), a3, 0, vgS);
            PG8_WAIT_V(8); PG8_WAIT_L(0); PG8_BAR; PG8_MMA(1, 0, At, B0); PG8_MMA(1, 1, At, B1); PG8_BAR; PG8_SCHED;
            } else {
            PG8_LDB(B0, 0, 0); PG8_SCHED; PG8_LDA(At, 0, 0); PG8_STAGE_A(PG8_SA(1, 1), a1, 1, vgC);
            PG8_WAIT_L(8); PG8_BAR; PG8_WAIT_L(0); PG8_MMA(0, 0, At, B0); PG8_BAR; PG8_SCHED;
            PG8_LDB(B1, 0, 1); PG8_STAGE(PG8_SB(0, 0), b2, voffB);
            PG8_BAR; PG8_WAIT_L(0); PG8_MMA(0, 1, At, B1); PG8_BAR;
            PG8_LDA(At, 0, 1); PG8_STAGE_A(PG8_SA(0, 0), a2, 0, vgS);
            PG8_BAR; PG8_WAIT_L(0); PG8_MMA(1, 0, At, B0); PG8_BAR; PG8_SCHED;
            PG8_STAGE(PG8_SB(0, 1), b2 + hstep, voffB);
            PG8_WAIT_V(6); PG8_BAR; PG8_MMA(1, 1, At, B1); PG8_BAR;
            PG8_LDB(B0, 1, 0); PG8_SCHED; PG8_LDA(At, 1, 0); PG8_STAGE_A(PG8_SA(0, 1), a2, 1, vgS);
            PG8_WAIT_L(8); PG8_BAR; PG8_WAIT_L(0); PG8_MMA(0, 0, At, B0); PG8_BAR; PG8_SCHED;
            PG8_LDB(B1, 1, 1); PG8_STAGE(PG8_SB(1, 0), b3, voffB);
            PG8_BAR; PG8_WAIT_L(0); PG8_MMA(0, 1, At, B1); PG8_BAR;
            PG8_LDA(At, 1, 1); PG8_STAGE_A(PG8_SA(1, 0), a3, 0, vgS);
            PG8_BAR; PG8_WAIT_L(0); PG8_MMA(1, 0, At, B0); PG8_BAR; PG8_SCHED;
            PG8_STAGE(PG8_SB(1, 1), b3 + hstep, voffB);
            PG8_WAIT_V(6); PG8_BAR; PG8_MMA(1, 1, At, B1); PG8_BAR;
            }
        }
        if constexpr (ALIGN_EPI) { if (wr == 0) PG8_BAR; }
        if constexpr (!Epi::AFTER_DRAIN) { E(acc, cur, wr, wc, fr, fq); S.done(cur); }
        if (!has_next) break;
#pragma unroll
        for (int a = 0; a < 2; ++a)
#pragma unroll
            for (int b = 0; b < 2; ++b)
#pragma unroll
                for (int m = 0; m < 4; ++m)
#pragma unroll
                    for (int n = 0; n < 2; ++n) acc[a][b][m][n] = (f32x4){zz, zz, zz, zz};
        cur = nxt; cA = nA; cB = nB; ++ui; if constexpr (GATHER) { _Pragma("unroll") for (int _h = 0; _h < 2; ++_h) _Pragma("unroll") for (int _i = 0; _i < 2; ++_i) vgC[_h][_i] = vgN[_h][_i]; }
        if constexpr (ALIGN_EPI) { if (wr == 1) PG8_BAR; }
    }
    PG8_WAIT_V(0);
    if constexpr (!ALIGN_EPI) { if (wr == 0) PG8_BAR; }
    PG8_BAR;
    if constexpr (Epi::AFTER_DRAIN) { E.fused(acc, cur, wr, wc, fr, fq, lds, wid, lane); S.done(cur); }
#undef PG8_SA
#undef PG8_SB
#undef PG8_STAGE
#undef PG8_STAGE_A
#undef PG8_ROWS
#undef PG8_LDA
#undef PG8_LDB
#undef PG8_MMA
#undef PG8_WAIT_V
#undef PG8_WAIT_L
#undef PG8_BAR
#undef PG8_SCHED
}

__device__ __forceinline__ float sigmoidf_(float x) { return 1.0f / (1.0f + __expf(-x)); }
__device__ __forceinline__ float bflo(unsigned w) { return __uint_as_float(w << 16); }
__device__ __forceinline__ float bfhi(unsigned w) { return __uint_as_float(w & 0xffff0000u); }

struct EpiStore {
    static constexpr bool PERM = true, AFTER_DRAIN = false;
    bf16_t* O; int ldc; const float* cs;
    __device__ __forceinline__ void operator()(const f32x4 (&acc)[2][2][4][2], const Unit& u, int wr, int wc, int fr, int fq) const {
        const int row0 = u.pm * BM + wr * 64 + fr, col0 = u.pn * BM + wc * 32 + 8 * fq;
        f32x4 sv[2][2];
#pragma unroll
        for (int bj = 0; bj < 2; ++bj)
#pragma unroll
            for (int n = 0; n < 2; ++n) sv[bj][n] = cs ? *(const f32x4*)(cs + col0 + bj * HALF + 4 * n) : (f32x4){1.f, 1.f, 1.f, 1.f};
#pragma unroll
        for (int ai = 0; ai < 2; ++ai)
#pragma unroll
            for (int m = 0; m < 4; ++m) { bf16_t* rowp = O + (size_t)(row0 + ai * HALF + m * 16) * ldc + col0;
#pragma unroll
                for (int bj = 0; bj < 2; ++bj) { const f32x4 v0 = acc[ai][bj][m][0] * sv[bj][0], v1 = acc[ai][bj][m][1] * sv[bj][1];
                    u32x4 w; w.x = cvt_pk_bf16(v0[0], v0[1]); w.y = cvt_pk_bf16(v0[2], v0[3]); w.z = cvt_pk_bf16(v1[0], v1[1]); w.w = cvt_pk_bf16(v1[2], v1[3]);
                    *(u32x4*)(rowp + bj * HALF) = w; } }
    }
};
template <bool ADD> struct EpiGate {
    static constexpr bool PERM = true, AFTER_DRAIN = false;
    bf16_t* O; int ldc; const bf16_t* G; int ldg;
    __device__ __forceinline__ void operator()(const f32x4 (&acc)[2][2][4][2], const Unit& u, int wr, int wc, int fr, int fq) const {
        const int row0 = u.pm * BM + wr * 64 + fr, col0 = u.pn * BM + wc * 32 + 8 * fq;
#pragma unroll
        for (int ai = 0; ai < 2; ++ai)
#pragma unroll
            for (int m = 0; m < 4; ++m) { const size_t row = (size_t)(row0 + ai * HALF + m * 16); bf16_t* rowp = O + row * ldc + col0; const bf16_t* gp = G + row * ldg + col0;
#pragma unroll
                for (int bj = 0; bj < 2; ++bj) { const u32x4 gw = *(const u32x4*)(gp + bj * HALF);
                    f32x4 v0 = acc[ai][bj][m][0], v1 = acc[ai][bj][m][1];
                    v0[0] *= sigmoidf_(bflo(gw.x)); v0[1] *= sigmoidf_(bfhi(gw.x)); v0[2] *= sigmoidf_(bflo(gw.y)); v0[3] *= sigmoidf_(bfhi(gw.y));
                    v1[0] *= sigmoidf_(bflo(gw.z)); v1[1] *= sigmoidf_(bfhi(gw.z)); v1[2] *= sigmoidf_(bflo(gw.w)); v1[3] *= sigmoidf_(bfhi(gw.w));
                    if (ADD) { const u32x4 ow = *(const u32x4*)(rowp + bj * HALF);
                        v0[0] += bflo(ow.x); v0[1] += bfhi(ow.x); v0[2] += bflo(ow.y); v0[3] += bfhi(ow.y);
                        v1[0] += bflo(ow.z); v1[1] += bfhi(ow.z); v1[2] += bflo(ow.w); v1[3] += bfhi(ow.w); }
                    u32x4 w; w.x = cvt_pk_bf16(v0[0], v0[1]); w.y = cvt_pk_bf16(v0[2], v0[3]); w.z = cvt_pk_bf16(v1[0], v1[1]); w.w = cvt_pk_bf16(v1[2], v1[3]);
                    *(u32x4*)(rowp + bj * HALF) = w; } }
    }
};
struct EpiResid {
    static constexpr bool PERM = false, AFTER_DRAIN = false;
    const float* Xin; float* Xout; const float* modp; int mod_bstride;
    __device__ __forceinline__ void operator()(const f32x4 (&acc)[2][2][4][2], const Unit& u, int wr, int wc, int fr, int fq) const {
        const int row0 = u.pm * BM + wr * 64 + fr, col0 = u.pn * BM + wc * 32 + 4 * fq;
        const float* gp = modp + (size_t)((u.pm * BM) >> 13) * mod_bstride;
        f32x4 gv[2][2];
#pragma unroll
        for (int bj = 0; bj < 2; ++bj)
#pragma unroll
            for (int n = 0; n < 2; ++n) gv[bj][n] = *(const f32x4*)(gp + col0 + bj * HALF + n * 16);
#pragma unroll
        for (int ai = 0; ai < 2; ++ai)
#pragma unroll
            for (int m = 0; m < 4; ++m) { const size_t off = (size_t)(row0 + ai * HALF + m * 16) * 1024 + col0;
#pragma unroll
                for (int bj = 0; bj < 2; ++bj)
#pragma unroll
                    for (int n = 0; n < 2; ++n) { const f32x4 xo = *(const f32x4*)(Xin + off + bj * HALF + n * 16);
                        *(f32x4*)(Xout + off + bj * HALF + n * 16) = xo + gv[bj][n] * acc[ai][bj][m][n]; } }
    }
};
__device__ __forceinline__ float swiglu_(float g, float u) { g = fminf(g, 7.0f); u = fminf(fmaxf(u, -7.0f), 7.0f); return (u + 1.0f) * g * sigmoidf_(g * 1.702f); }
struct EpiSwiglu {
    static constexpr bool PERM = true, AFTER_DRAIN = false;
    bf16_t* ACT; const float* bias; const int* tile_e;
    __device__ __forceinline__ void operator()(const f32x4 (&acc)[2][2][4][2], const Unit& u, int wr, int wc, int fr, int fq) const {
        const int row0 = u.pm * BM + wr * 64 + fr, col0 = u.pn * BM + wc * 32 + 8 * fq;
        const float* bp = bias + (size_t)tile_e[u.pm] * 2048;
        f32x4 bv[2][2];
#pragma unroll
        for (int bj = 0; bj < 2; ++bj)
#pragma unroll
            for (int n = 0; n < 2; ++n) bv[bj][n] = *(const f32x4*)(bp + col0 + bj * HALF + 4 * n);
#pragma unroll
        for (int ai = 0; ai < 2; ++ai)
#pragma unroll
            for (int m = 0; m < 4; ++m) { bf16_t* rowp = ACT + (size_t)(row0 + ai * HALF + m * 16) * 1024 + (col0 >> 1);
#pragma unroll
                for (int bj = 0; bj < 2; ++bj) { const f32x4 v0 = acc[ai][bj][m][0] + bv[bj][0], v1 = acc[ai][bj][m][1] + bv[bj][1];
                    typedef unsigned u32x2v __attribute__((ext_vector_type(2)));
                    u32x2v w; w.x = cvt_pk_bf16(swiglu_(v0[0], v0[1]), swiglu_(v0[2], v0[3])); w.y = cvt_pk_bf16(swiglu_(v1[0], v1[1]), swiglu_(v1[2], v1[3]));
                    *(u32x2v*)(rowp + bj * (HALF / 2)) = w; } }
    }
};
struct EpiBiasE {
    static constexpr bool PERM = true, AFTER_DRAIN = false;
    bf16_t* O; const float* bias; const int* tile_e;
    __device__ __forceinline__ void operator()(const f32x4 (&acc)[2][2][4][2], const Unit& u, int wr, int wc, int fr, int fq) const {
        const int row0 = u.pm * BM + wr * 64 + fr, col0 = u.pn * BM + wc * 32 + 8 * fq;
        const float* bp = bias + (size_t)tile_e[u.pm] * 1024;
        f32x4 bv[2][2];
#pragma unroll
        for (int bj = 0; bj < 2; ++bj)
#pragma unroll
            for (int n = 0; n < 2; ++n) bv[bj][n] = *(const f32x4*)(bp + col0 + bj * HALF + 4 * n);
#pragma unroll
        for (int ai = 0; ai < 2; ++ai)
#pragma unroll
            for (int m = 0; m < 4; ++m) { bf16_t* rowp = O + (size_t)(row0 + ai * HALF + m * 16) * 1024 + col0;
#pragma unroll
                for (int bj = 0; bj < 2; ++bj) { const f32x4 v0 = acc[ai][bj][m][0] + bv[bj][0], v1 = acc[ai][bj][m][1] + bv[bj][1];
                    u32x4 w; w.x = cvt_pk_bf16(v0[0], v0[1]); w.y = cvt_pk_bf16(v0[2], v0[3]); w.z = cvt_pk_bf16(v1[0], v1[1]); w.w = cvt_pk_bf16(v1[2], v1[3]);
                    *(u32x4*)(rowp + bj * HALF) = w; } }
    }
};
}


constexpr int NL = 4, NB = 4, SEQ = 8192, DM = 1024, NTOK = NB * SEQ;
constexpr int ZW = 4608;
constexpr int ZC_U = 0, ZC_Q = 512, ZC_KCM = 1536, ZC_VCM = 1664, ZC_KSL = 1792, ZC_VSL = 1920, ZC_KWN = 2048, ZC_VWN = 2176, ZC_MG = 2304, ZC_NG = 4352;
constexpr int IN_W = 4400;
constexpr int NEXP = 32, MOE_ROWS_MAX = (NTOK * 4 / 256 + NEXP) * 256;
constexpr int NPH_LAYER = 13, NPHASES = 2 + NL * NPH_LAYER;
enum { PH_NORM1 = 0, PH_GEMM_IN, PH_POST, PH_ATTN, PH_POOLG, PH_PROJA, PH_PROJB, PH_OUTG, PH_NORM2R, PH_SCATTER, PH_GATEUP, PH_DOWN, PH_COMBINE };

constexpr size_t alignup(size_t x) { return (x + 255) & ~(size_t)255; }
constexpr size_t WS_CTL = 0, CTL_ZERO_BYTES = 1u << 20;
constexpr size_t WS_MOD = WS_CTL + CTL_ZERO_BYTES;
constexpr size_t WS_MODP = WS_MOD + alignup((size_t)NL * NB * 6144 * 4);
constexpr size_t WS_ROPE = WS_MODP + alignup((size_t)4 * NL * NB * 6144 * 4);
constexpr size_t WS_WIN = WS_ROPE + alignup((size_t)SEQ * 16 * 4);
constexpr size_t WS_WPOOL = WS_WIN + alignup((size_t)NL * ZW * DM * 2);
constexpr size_t WS_WA = WS_WPOOL + alignup((size_t)NL * 512 * 512 * 2);
constexpr size_t WS_WB = WS_WA + alignup((size_t)NL * 1024 * 512 * 2);
constexpr size_t WS_WOUT = WS_WB + alignup((size_t)NL * 1024 * 1024 * 2);
constexpr size_t WS_W1 = WS_WOUT + alignup((size_t)NL * 1024 * 1024 * 2);
constexpr size_t WS_W2 = WS_W1 + alignup((size_t)NL * 2 * 256 * 2048 * 2);
constexpr size_t WS_WGU = WS_W2 + alignup((size_t)NL * 2 * 64 * 256 * 2);
constexpr size_t WS_WD = WS_WGU + alignup((size_t)NL * NEXP * 2048 * 1024 * 2);
constexpr size_t WS_H = WS_WD + alignup((size_t)NL * NEXP * 1024 * 1024 * 2);
constexpr size_t WS_Z = WS_H + alignup((size_t)NTOK * DM * 2);
constexpr size_t WS_QN = WS_Z + alignup((size_t)NTOK * ZW * 2);
constexpr size_t WS_KSLC = WS_QN + alignup((size_t)NTOK * DM * 2);
constexpr size_t WS_KWIN = WS_KSLC + alignup((size_t)NB * 2 * SEQ * 64 * 2);
constexpr size_t WS_VSLCT = WS_KWIN + alignup((size_t)NB * 2 * SEQ * 64 * 2);
constexpr size_t WS_VWINT = WS_VSLCT + alignup((size_t)NB * 2 * SEQ * 64 * 2);
constexpr size_t WS_KC = WS_VWINT + alignup((size_t)NB * 2 * SEQ * 64 * 2);
constexpr size_t WS_VCT = WS_KC + alignup((size_t)NB * 2 * 512 * 64 * 2);
constexpr size_t WS_PM = WS_VCT + alignup((size_t)NB * 2 * 512 * 64 * 2);
constexpr size_t WS_PP = WS_PM + alignup((size_t)NTOK * 512 * 2);
constexpr size_t WS_O = WS_PP + alignup((size_t)NTOK * 512 * 2);
constexpr size_t WS_MG = WS_O + alignup((size_t)NTOK * DM * 2);
constexpr size_t WS_TOPE = WS_MG + alignup((size_t)NTOK * DM * 2);
constexpr size_t WS_TOPW = WS_TOPE + alignup((size_t)NTOK * 4 * 4);
constexpr size_t WS_DEST = WS_TOPW + alignup((size_t)NTOK * 4 * 4);
constexpr size_t WS_CNT = WS_DEST + alignup((size_t)NTOK * 4 * 4);
constexpr size_t WS_TILEE = WS_CNT + alignup((size_t)1024 * 32 * 4);
constexpr size_t WS_ROWTOK = WS_TILEE + alignup((size_t)1024 * 4);
constexpr size_t WS_ACT = WS_ROWTOK + alignup((size_t)MOE_ROWS_MAX * 4);
constexpr size_t WS_Y = WS_ACT + alignup((size_t)MOE_ROWS_MAX * 1024 * 2);
constexpr size_t WS_RWT = WS_Y + alignup((size_t)MOE_ROWS_MAX * 1024 * 2);
constexpr size_t WS_SCR = WS_RWT + alignup((size_t)NL * 2 * 32 * 1024 * 2);
constexpr size_t WS_END = WS_SCR + alignup((size_t)1024 * 8 * 4096 * 4);
constexpr int CW_BAR = 4096;

constexpr int RING_BYTES = 131584;
constexpr int MISC_OFF = 135168;
constexpr int SM_OFF = 136192;
constexpr int LDS_BYTES = 147456;
constexpr int NWAVES = 8;

#define GAS __attribute__((address_space(1)))
#define LAS __attribute__((address_space(3)))
typedef unsigned short bf16;
typedef unsigned v4u __attribute__((ext_vector_type(4)));
typedef unsigned v2u __attribute__((ext_vector_type(2)));
typedef float f32x4 __attribute__((ext_vector_type(4)));
typedef short bf16x8 __attribute__((ext_vector_type(8)));
typedef GAS unsigned gu32;
#define RLX_AGENT __ATOMIC_RELAXED, __HIP_MEMORY_SCOPE_AGENT
#define LDS_WAIT() asm volatile("s_waitcnt lgkmcnt(0)" ::: "memory")
#define VM_WAIT() asm volatile("s_waitcnt vmcnt(0)" ::: "memory")
using pg8::cvt_pk_bf16; using pg8::bflo; using pg8::bfhi; using pg8::sigmoidf_;
__device__ __forceinline__ float bf2f(bf16 h) { return __uint_as_float((unsigned)h << 16); }
__device__ __forceinline__ bf16 f2bf(float f) { return (bf16)(cvt_pk_bf16(f, 0.f) & 0xffffu); }
__device__ __forceinline__ float shx(float v, int mask, int lane) { return __int_as_float(__builtin_amdgcn_ds_bpermute((lane ^ mask) << 2, __float_as_int(v))); }
__device__ __forceinline__ int shxi(int v, int mask, int lane) { return __builtin_amdgcn_ds_bpermute((lane ^ mask) << 2, v); }
__device__ __forceinline__ float shf(float v, int src) { return __int_as_float(__builtin_amdgcn_ds_bpermute(src << 2, __float_as_int(v))); }
__device__ __forceinline__ int shfi(int v, int src) { return __builtin_amdgcn_ds_bpermute(src << 2, v); }
__device__ __forceinline__ float wave_sum(float v, int lane) {
#pragma unroll
    for (int o = 1; o < 64; o <<= 1) v += shx(v, o, lane);
    return v;
}

#define XB_TMO      128
#define XB_XCNT(j)  (256  + 64 * (j))
#define XB_XSUB(j)  (1280 + 64 * (j))
#define XB_XGEN(j)  (2304 + 64 * (j))
#define XB_TOP      3328
#define XB_TOPGEN   3392
#define XCD_BAR_WORDS 3456
#define XB_SPIN_CAP (1u << 18)

__device__ __forceinline__ unsigned xb_ld(unsigned* p)              { return __hip_atomic_load(p, __ATOMIC_RELAXED, __HIP_MEMORY_SCOPE_AGENT); }
__device__ __forceinline__ unsigned xb_add(unsigned* p, unsigned v) { return __hip_atomic_fetch_add(p, v, __ATOMIC_RELAXED, __HIP_MEMORY_SCOPE_AGENT); }
__device__ __forceinline__ unsigned xb_xcc_id() { return (unsigned)__builtin_amdgcn_s_getreg((3 << 11) | 20) & 0xFu; }
#define XB_SPIN(cond, bar) do { unsigned _sp = 0; while (cond) { __builtin_amdgcn_s_sleep(1); \
    if ((++_sp & 255u) == 0u) { if (xb_ld(&(bar)[XB_TMO])) break; if (_sp > XB_SPIN_CAP) { atomicAdd(&(bar)[XB_TMO], 1u); break; } } } } while (0)

struct XcdBarrier {
    unsigned* bar; unsigned x;
    volatile LAS unsigned* st;
};

__device__ __forceinline__ XcdBarrier xcd_barrier_post(unsigned* bar, volatile LAS unsigned* st, const int tid_x  ) {
    XcdBarrier b; b.bar = bar; b.x = xb_xcc_id(); b.st = st;
    if (tid_x == 0) (void)xb_add(&bar[XB_XCNT(b.x)], 1u);
    return b;
}
__device__ __forceinline__ void xcd_barrier_complete(unsigned* bar, unsigned x, unsigned& nloc, unsigned& nx) {
    const unsigned G = gridDim.x * gridDim.y * gridDim.z;
    unsigned sum, cnt, mine, sp = 0u;
    for (;;) {
        sum = 0u; cnt = 0u; mine = 0u;
#pragma unroll
        for (unsigned j = 0; j < 16; ++j) { const unsigned c = xb_ld(&bar[XB_XCNT(j)]); sum += c; cnt += (c > 0u) ? 1u : 0u; mine = (j == x) ? c : mine; }
        if (sum == G) break;
        __builtin_amdgcn_s_sleep(1);
        if ((++sp & 255u) == 0u) { if (xb_ld(&bar[XB_TMO])) break; if (sp > XB_SPIN_CAP) { atomicAdd(&bar[XB_TMO], 1u); break; } }
    }
    nloc = mine > 0u ? mine : 1u; nx = cnt > 0u ? cnt : 1u;
}

__device__ __forceinline__ void xcd_barrier(const XcdBarrier& b, const int tid_x) {
    asm volatile("s_waitcnt vmcnt(0)" ::: "memory");
    __syncthreads();
    if (tid_x == 0) {
        unsigned* bar = b.bar;
        __builtin_amdgcn_s_waitcnt(0);
        unsigned nloc = b.st[0], nx = b.st[1];
        if (nloc == 0u) { xcd_barrier_complete(bar, b.x, nloc, nx); b.st[0] = nloc; b.st[1] = nx; }
        const unsigned old = xb_add(&bar[XB_XSUB(b.x)], 1u);
        const unsigned gen = old / nloc;
        if (old + 1u == (gen + 1u) * nloc) {
            __builtin_amdgcn_fence(__ATOMIC_RELEASE, "agent");
            asm volatile("s_waitcnt vmcnt(0)" ::: "memory");
            const unsigned og = xb_add(&bar[XB_TOP], 1u);
            const unsigned tg = og / nx;
            if (og + 1u == (tg + 1u) * nx) xb_add(&bar[XB_TOPGEN], 1u);
            else XB_SPIN(xb_ld(&bar[XB_TOPGEN]) == tg, bar);
            __builtin_amdgcn_fence(__ATOMIC_ACQUIRE, "agent");
            xb_add(&bar[XB_XGEN(b.x)], 1u);
            asm volatile("s_waitcnt vmcnt(0)" ::: "memory");
        } else {
            XB_SPIN(xb_ld(&bar[XB_XGEN(b.x)]) == gen, bar);
            __builtin_amdgcn_fence(__ATOMIC_ACQUIRE, "agent");
            asm volatile("s_waitcnt vmcnt(0)" ::: "memory");
        }
    }
    __syncthreads();
}


enum { I_X = 0, I_C, I_NORM1, I_NORM2, I_ADAW, I_ADAB, I_WIN, I_WPOOL, I_PSCALE, I_QNORM, I_KNORM, I_CMPPOS, I_CMPW1, I_CMPB1, I_CMPW2, I_WPA, I_WPB, I_WOUT,
       I_RW, I_RB, I_WGU, I_BGU, I_WD, I_BD, N_IN };
struct Args { const float* in[N_IN]; float* out; unsigned char* ws; int ph_lo, ph_hi, li, pad; };

struct Ctx {
    LAS unsigned char* lds;
    int tid, lane, wave, bx, G;
    unsigned char* ws;
};
__device__ __forceinline__ void fresh(Ctx& C) { unsigned z = 0u; asm volatile("" : "+s"(z));   int t = C.wave * 64 + (int)__builtin_amdgcn_mbcnt_hi(~0u, __builtin_amdgcn_mbcnt_lo(~0u, z)); asm volatile("" : "+v"(t)); C.tid = t; C.lane = t & 63; int bx = blockIdx.x, G = gridDim.x; asm volatile("" : "+s"(bx), "+s"(G)); C.bx = bx; C.G = G; }

__device__ __forceinline__ int inmap(int np) { return np < 2304 ? np : (np < 4352 ? np + 48 : (np < 4400 ? np - 2048 : -1)); }
template <bool MAPIN>
__device__ __forceinline__ void p0_transpose_item(const float* W, int K, int N, int NP, bf16* WT, LAS float* scr, int item, int lane) {
    const int nblk = NP / 32, kb = item / nblk, nb = item % nblk, k0 = 64 * kb, n0 = 32 * nb;
    int sc = n0 + (lane & 31); if (MAPIN) sc = inmap(sc);
#pragma unroll 8
    for (int i = 0; i < 32; ++i) { const int kk = 2 * i + (lane >> 5); scr[kk * 33 + (lane & 31)] = (sc >= 0) ? W[(size_t)(k0 + kk) * N + sc] : 0.f; }
    LDS_WAIT(); asm volatile("" ::: "memory");
    const int c = lane & 7;
#pragma unroll
    for (int j = 0; j < 4; ++j) { const int n = (lane >> 3) + 8 * j; const LAS float* s = scr + (8 * c) * 33 + n;
        v4u o; o.x = cvt_pk_bf16(s[0 * 33], s[1 * 33]); o.y = cvt_pk_bf16(s[2 * 33], s[3 * 33]); o.z = cvt_pk_bf16(s[4 * 33], s[5 * 33]); o.w = cvt_pk_bf16(s[6 * 33], s[7 * 33]);
        *(v4u*)(WT + (size_t)(n0 + n) * K + k0 + 8 * c) = o; }
    LDS_WAIT(); asm volatile("" ::: "memory");
}
__device__ __forceinline__ void p0_convert(const Ctx& C, const Args& a) {
    LAS float* scr = (LAS float*)(C.lds + C.wave * 16384);
    const int gw = C.bx * NWAVES + C.wave, NGW = C.G * NWAVES;
    constexpr int IT_IN = 16 * (ZW / 32), IT_A = 8 * 32, IT_B = 16 * 32, IT_O = 16 * 32, IT_W1 = 32 * 8, IT_W2 = 4 * 2, IT_GU = 16 * 64, IT_D = 16 * 32;
    constexpr int IT_LAYER = IT_IN + IT_A + IT_B + IT_O + 2 * IT_W1 + 2 * IT_W2 + NEXP * IT_GU + NEXP * IT_D;
    for (int it = gw; it < NL * IT_LAYER; it += NGW) {
        const int l = it / IT_LAYER; int r = it % IT_LAYER;
        if (r < IT_IN) { p0_transpose_item<true>(a.in[I_WIN] + (size_t)l * DM * IN_W, DM, IN_W, ZW, (bf16*)(C.ws + WS_WIN) + (size_t)l * ZW * DM, scr, r, C.lane); continue; } r -= IT_IN;
        if (r < IT_A) { p0_transpose_item<false>(a.in[I_WPA] + (size_t)l * 512 * 1024, 512, 1024, 1024, (bf16*)(C.ws + WS_WA) + (size_t)l * 1024 * 512, scr, r, C.lane); continue; } r -= IT_A;
        if (r < IT_B) { p0_transpose_item<false>(a.in[I_WPB] + (size_t)l * 1024 * 1024, 1024, 1024, 1024, (bf16*)(C.ws + WS_WB) + (size_t)l * 1024 * 1024, scr, r, C.lane); continue; } r -= IT_B;
        if (r < IT_O) { p0_transpose_item<false>(a.in[I_WOUT] + (size_t)l * 1024 * 1024, 1024, 1024, 1024, (bf16*)(C.ws + WS_WOUT) + (size_t)l * 1024 * 1024, scr, r, C.lane); continue; } r -= IT_O;
        if (r < 2 * IT_W1) { const int kv = r / IT_W1; p0_transpose_item<false>(a.in[I_CMPW1] + (size_t)(l * 2 + kv) * 2048 * 256, 2048, 256, 256, (bf16*)(C.ws + WS_W1) + (size_t)(l * 2 + kv) * 256 * 2048, scr, r % IT_W1, C.lane); continue; } r -= 2 * IT_W1;
        if (r < 2 * IT_W2) { const int kv = r / IT_W2; p0_transpose_item<false>(a.in[I_CMPW2] + (size_t)(l * 2 + kv) * 256 * 64, 256, 64, 64, (bf16*)(C.ws + WS_W2) + (size_t)(l * 2 + kv) * 64 * 256, scr, r % IT_W2, C.lane); continue; } r -= 2 * IT_W2;
        if (r < NEXP * IT_GU) { const int e = r / IT_GU; p0_transpose_item<false>(a.in[I_WGU] + (size_t)(l * NEXP + e) * 1024 * 2048, 1024, 2048, 2048, (bf16*)(C.ws + WS_WGU) + (size_t)(l * NEXP + e) * 2048 * 1024, scr, r % IT_GU, C.lane); continue; } r -= NEXP * IT_GU;
        { const int e = r / IT_D; p0_transpose_item<false>(a.in[I_WD] + (size_t)(l * NEXP + e) * 1024 * 1024, 1024, 1024, 1024, (bf16*)(C.ws + WS_WD) + (size_t)(l * NEXP + e) * 1024 * 1024, scr, r % IT_D, C.lane); }
    }
    const int gt = C.bx * (NWAVES * 64) + C.tid, NGT = C.G * NWAVES * 64;
    { bf16* wp = (bf16*)(C.ws + WS_WPOOL);
      for (int i = gt; i < NL * 512 * 512; i += NGT) { const int l = i >> 18, ep = (i >> 9) & 511, cp = i & 511; float v = 0.f;
          if ((ep >> 7) == (cp >> 7)) v = a.in[I_WPOOL][(((size_t)l * 4 + (ep >> 7)) * 128 + (cp & 127)) * 128 + (ep & 127)];
          wp[i] = f2bf(v); } }
    { bf16* rwt = (bf16*)(C.ws + WS_RWT);
      for (int i = gt; i < NL * 32 * 1024; i += NGT) { const int l = i >> 15, e = (i >> 10) & 31, k = i & 1023; const float w = a.in[I_RW][((size_t)l * DM + k) * NEXP + e];
          const bf16 hi = f2bf(w); rwt[(size_t)(l * 2) * 32768 + e * 1024 + k] = hi; rwt[(size_t)(l * 2 + 1) * 32768 + e * 1024 + k] = f2bf(w - bf2f(hi)); } }
    { float* rp = (float*)(C.ws + WS_ROPE);
      for (int i = gt; i < SEQ * 8; i += NGT) { const int pos = i >> 3, fi = i & 7;
          const float invf[8] = {1.0f, 0.1939227432012558f, 0.03760603070259094f, 0.007292664609849453f, 0.0014142135623842478f, 0.00027424818836152554f, 5.318296098266728e-05f, 1.0313386155758053e-05f};
          float f = invf[0];
#pragma unroll
          for (int q = 1; q < 8; ++q) f = (fi == q) ? invf[q] : f;
          const float ang = (float)pos * f; const double rev = (double)ang * 0.15915494309189535; const float fr = (float)(rev - __builtin_rint(rev));
          rp[pos * 16 + fi] = __builtin_amdgcn_cosf(fr); rp[pos * 16 + 8 + fi] = __builtin_amdgcn_sinf(fr); } }
    __syncthreads();
    { LAS float* sc = (LAS float*)C.lds;
      for (int i = C.tid; i < NB * DM; i += NWAVES * 64) { const float cv = a.in[I_C][i]; sc[i] = cv * sigmoidf_(cv); }
      __syncthreads();
      float* mp = (float*)(C.ws + WS_MODP);
      for (int i = gt; i < 4 * NL * 6144; i += NGT) { const int j = i % 6144, l = (i / 6144) % NL, ks = i / (6144 * NL);
          const float* w = a.in[I_ADAW] + ((size_t)l * DM + ks * 256) * 6144 + j; float a0 = 0.f, a1 = 0.f, a2 = 0.f, a3 = 0.f;
#pragma unroll 8
          for (int k = 0; k < 256; ++k) { const float wv = w[(size_t)k * 6144]; const int kk = ks * 256 + k;
              a0 += sc[kk] * wv; a1 += sc[DM + kk] * wv; a2 += sc[2 * DM + kk] * wv; a3 += sc[3 * DM + kk] * wv; }
          float* o = mp + ((size_t)(ks * NL + l) * NB) * 6144 + j; o[0] = a0; o[6144] = a1; o[2 * 6144] = a2; o[3 * 6144] = a3; }
      __syncthreads(); }
}
__device__ __forceinline__ void p1_mod(const Ctx& C, const Args& a) {
    const int gt = C.bx * (NWAVES * 64) + C.tid, NGT = C.G * NWAVES * 64;
    const float* mp = (const float*)(C.ws + WS_MODP); float* mo = (float*)(C.ws + WS_MOD);
    for (int i = gt; i < NL * NB * 6144; i += NGT) { const int j = i % 6144, l = i / (NB * 6144);
        float s = a.in[I_ADAB][l * 6144 + j];
#pragma unroll
        for (int ks = 0; ks < 4; ++ks) s += mp[(size_t)ks * NL * NB * 6144 + i];
        mo[i] = s; }
}


__device__ __forceinline__ void norm_rows(const Ctx& C, const float* X, const float* gain, const float* mod_l  , int shift_i, int scale_i, bf16* H) {
    const int gw = C.bx * NWAVES + C.wave, NGW = C.G * NWAVES;
    for (int m = gw; m < NTOK; m += NGW) {
        const int b = m >> 13; const f32x4* xr = (const f32x4*)(X + (size_t)m * DM) + C.lane;
        f32x4 v[4]; float s = 0.f;
#pragma unroll
        for (int j = 0; j < 4; ++j) { v[j] = xr[64 * j]; s += (v[j].x * v[j].x + v[j].y * v[j].y) + (v[j].z * v[j].z + v[j].w * v[j].w); }
        const float rstd = 1.0f / sqrtf(wave_sum(s, C.lane) * (1.0f / DM) + 1e-6f);
        const float* mb = mod_l + (size_t)b * 6144; v2u* o8 = (v2u*)(H + (size_t)m * DM) + C.lane;
#pragma unroll
        for (int j = 0; j < 4; ++j) { const int col = 4 * C.lane + 256 * j;
            const f32x4 g = *(const f32x4*)(gain + col), sc = *(const f32x4*)(mb + scale_i * DM + col), sh = *(const f32x4*)(mb + shift_i * DM + col);
            const f32x4 h = v[j] * rstd * g * (sc + 1.0f) + sh;
            v2u w; w.x = cvt_pk_bf16(h.x, h.y); w.y = cvt_pk_bf16(h.z, h.w); o8[64 * j] = w; }
    }
}

__device__ __forceinline__ void post_tokens(const Ctx& C, const Args& a, int l) {
    const int gw = C.bx * NWAVES + C.wave, NGW = C.G * NWAVES, lane = C.lane;
    const bf16* Z = (const bf16*)(C.ws + WS_Z); const float* rope = (const float*)(C.ws + WS_ROPE);
    bf16* Qn = (bf16*)(C.ws + WS_QN); bf16* Kslc = (bf16*)(C.ws + WS_KSLC); bf16* Kwin = (bf16*)(C.ws + WS_KWIN); bf16* Pm = (bf16*)(C.ws + WS_PM);
    const float* qn = a.in[I_QNORM] + l * 64; const float* kn = a.in[I_KNORM] + l * 192;
    for (int m = gw; m < NTOK; m += NGW) {
        const int b = m >> 13, t = m & (SEQ - 1); const bf16* zr = Z + (size_t)m * ZW; const float* rp = rope + t * 16;
        { const int head = lane >> 2, dq = (lane & 3) * 16; const v4u w0 = *(const v4u*)(zr + ZC_Q + head * 64 + dq), w1 = *(const v4u*)(zr + ZC_Q + head * 64 + dq + 8);
          float y[16]; y[0] = bflo(w0.x); y[1] = bfhi(w0.x); y[2] = bflo(w0.y); y[3] = bfhi(w0.y); y[4] = bflo(w0.z); y[5] = bfhi(w0.z); y[6] = bflo(w0.w); y[7] = bfhi(w0.w);
          y[8] = bflo(w1.x); y[9] = bfhi(w1.x); y[10] = bflo(w1.y); y[11] = bfhi(w1.y); y[12] = bflo(w1.z); y[13] = bfhi(w1.z); y[14] = bflo(w1.w); y[15] = bfhi(w1.w);
          float s = 0.f;
#pragma unroll
          for (int i = 0; i < 16; ++i) s += y[i] * y[i];
          s += shx(s, 1, lane); s += shx(s, 2, lane);
          const float rstd = 1.0f / sqrtf(s * (1.0f / 64.0f) + 1e-6f);
#pragma unroll
          for (int i = 0; i < 16; ++i) y[i] = y[i] * (rstd * 0.18033688011112042f) * qn[dq + i];
          if ((lane & 3) == 0) {
#pragma unroll
              for (int i = 0; i < 8; ++i) { const float c = rp[i], sn = rp[8 + i], x1 = y[i], x2 = y[8 + i]; y[i] = x1 * c - x2 * sn; y[8 + i] = x2 * c + x1 * sn; } }
          v4u o0, o1; o0.x = cvt_pk_bf16(y[0], y[1]); o0.y = cvt_pk_bf16(y[2], y[3]); o0.z = cvt_pk_bf16(y[4], y[5]); o0.w = cvt_pk_bf16(y[6], y[7]);
          o1.x = cvt_pk_bf16(y[8], y[9]); o1.y = cvt_pk_bf16(y[10], y[11]); o1.z = cvt_pk_bf16(y[12], y[13]); o1.w = cvt_pk_bf16(y[14], y[15]);
          bf16* qo = Qn + (size_t)m * DM + head * 64 + dq; *(v4u*)qo = o0; *(v4u*)(qo + 8) = o1; }
        { const int which = lane >> 4, g = which & 1, li = lane & 15, dk = li * 4; const int sec = (which < 2) ? ZC_KSL : ZC_KWN;
          const v2u w = *(const v2u*)(zr + sec + g * 64 + dk); float y[4] = {bflo(w.x), bfhi(w.x), bflo(w.y), bfhi(w.y)};
          float s = y[0] * y[0] + y[1] * y[1] + y[2] * y[2] + y[3] * y[3];
          s += shx(s, 1, lane); s += shx(s, 2, lane); s += shx(s, 4, lane); s += shx(s, 8, lane);
          const float rstd = 1.0f / sqrtf(s * (1.0f / 64.0f) + 1e-6f); const float* gk = kn + ((which < 2) ? 64 : 128) + dk;
#pragma unroll
          for (int i = 0; i < 4; ++i) y[i] = y[i] * rstd * gk[i];
          float pz[4];
#pragma unroll
          for (int i = 0; i < 4; ++i) pz[i] = shx(y[i], 2, lane);
          if (li < 4) { const int fi = (li & 1) * 4;
#pragma unroll
              for (int i = 0; i < 4; ++i) { const float c = rp[fi + i], sn = rp[8 + fi + i]; y[i] = (li < 2) ? (y[i] * c - pz[i] * sn) : (y[i] * c + pz[i] * sn); } }
          v2u o; o.x = cvt_pk_bf16(y[0], y[1]); o.y = cvt_pk_bf16(y[2], y[3]);
          bf16* ko = ((which < 2) ? Kslc : Kwin) + ((size_t)(b * 2 + g) * SEQ + t) * 64 + dk; *(v2u*)ko = o; }
        { const int ch = lane * 8, w = 2 << (lane >> 4), cnt = (t + 1 < w) ? (t + 1) : w; float sum[8] = {0.f, 0.f, 0.f, 0.f, 0.f, 0.f, 0.f, 0.f}; float self[8];
          for (int k = 0; k < cnt; ++k) { const v4u u = *(const v4u*)(zr - (size_t)k * ZW + ZC_U + ch);
              const float f[8] = {bflo(u.x), bfhi(u.x), bflo(u.y), bfhi(u.y), bflo(u.z), bfhi(u.z), bflo(u.w), bfhi(u.w)};
#pragma unroll
              for (int i = 0; i < 8; ++i) { sum[i] += f[i]; if (k == 0) self[i] = f[i]; } }
          const float inv = 1.0f / (float)cnt; v4u o;
          o.x = cvt_pk_bf16(sum[0] * inv - self[0], sum[1] * inv - self[1]); o.y = cvt_pk_bf16(sum[2] * inv - self[2], sum[3] * inv - self[3]);
          o.z = cvt_pk_bf16(sum[4] * inv - self[4], sum[5] * inv - self[5]); o.w = cvt_pk_bf16(sum[6] * inv - self[6], sum[7] * inv - self[7]);
          *(v4u*)(Pm + (size_t)m * 512 + ch) = o; }
    }
    { bf16* VsT = (bf16*)(C.ws + WS_VSLCT); bf16* VwT = (bf16*)(C.ws + WS_VWINT);
      for (int it = gw; it < 2 * NB * 2 * (SEQ / 64); it += NGW) { const int tt = it & 127, g = (it >> 7) & 1, b = (it >> 8) & 3, which = it >> 10;
          const bf16* src = Z + ((size_t)(b * SEQ + tt * 64 + lane)) * ZW + (which ? ZC_VWN : ZC_VSL) + g * 64;
          bf16* dst = (which ? VwT : VsT) + ((size_t)(b * 2 + g) * 64) * SEQ + tt * 64 + lane;
#pragma unroll
          for (int c = 0; c < 8; ++c) { const v4u u = *(const v4u*)(src + 8 * c); bf16* d = dst + (size_t)(8 * c) * SEQ;
              d[0] = (bf16)(u.x & 0xffff); d[SEQ] = (bf16)(u.x >> 16); d[2 * SEQ] = (bf16)(u.y & 0xffff); d[3 * SEQ] = (bf16)(u.y >> 16);
              d[4 * SEQ] = (bf16)(u.z & 0xffff); d[5 * SEQ] = (bf16)(u.z >> 16); d[6 * SEQ] = (bf16)(u.w & 0xffff); d[7 * SEQ] = (bf16)(u.w >> 16); } } }
}

__device__ __forceinline__ void compress_unit(const Ctx& C, const Args& a, int l, int u) {
    const int kv = u & 1, nt = (u >> 1) & 31, bg = u >> 6, b = bg >> 1, g = bg & 1, n0 = nt * 16;
    const int lane = C.lane, r16 = lane & 15, quad = lane >> 4, w = C.wave;
    const bf16* Z = (const bf16*)(C.ws + WS_Z);
    const bf16* W1t = (const bf16*)(C.ws + WS_W1) + (size_t)(l * 2 + kv) * 256 * 2048;
    const bf16* W2t = (const bf16*)(C.ws + WS_W2) + (size_t)(l * 2 + kv) * 64 * 256;
    const float* pos = a.in[I_CMPPOS] + (size_t)(l * 2 + kv) * 32 * 64;
    const float* b1 = a.in[I_CMPB1] + (size_t)(l * 2 + kv) * 256;
    LAS bf16* hidL = (LAS bf16*)C.lds;
    LAS float* outL = (LAS float*)(C.lds + 16 * 264 * 2);
    const int nl = (n0 + r16 > 510) ? 510 : (n0 + r16);
    const bf16* arow = Z + ((size_t)(b * SEQ + 16 * nl)) * ZW + (kv ? ZC_VCM : ZC_KCM) + g * 64;
    f32x4 acc0 = {0.f, 0.f, 0.f, 0.f}, acc1 = {0.f, 0.f, 0.f, 0.f};
    const bf16* wb0 = W1t + (size_t)(32 * w + r16) * 2048 + quad * 8; const bf16* wb1 = wb0 + (size_t)16 * 2048;
#pragma unroll 4
    for (int ks = 0; ks < 64; ++ks) { const int lrow = ks >> 1, d = (ks & 1) * 32 + quad * 8;
        const v4u zv = *(const v4u*)(arow + (size_t)lrow * ZW + d); const f32x4 p0 = *(const f32x4*)(pos + lrow * 64 + d), p1 = *(const f32x4*)(pos + lrow * 64 + d + 4);
        v4u av; av.x = cvt_pk_bf16(bflo(zv.x) + p0.x, bfhi(zv.x) + p0.y); av.y = cvt_pk_bf16(bflo(zv.y) + p0.z, bfhi(zv.y) + p0.w);
        av.z = cvt_pk_bf16(bflo(zv.z) + p1.x, bfhi(zv.z) + p1.y); av.w = cvt_pk_bf16(bflo(zv.w) + p1.z, bfhi(zv.w) + p1.w);
        const bf16x8 af = __builtin_bit_cast(bf16x8, av);
        const bf16x8 bf0 = *(const bf16x8*)(wb0 + ks * 32), bf1 = *(const bf16x8*)(wb1 + ks * 32);
        acc0 = __builtin_amdgcn_mfma_f32_16x16x32_bf16(af, bf0, acc0, 0, 0, 0);
        acc1 = __builtin_amdgcn_mfma_f32_16x16x32_bf16(af, bf1, acc1, 0, 0, 0); }
    { const float bb0 = b1[32 * w + r16], bb1 = b1[32 * w + 16 + r16];
#pragma unroll
      for (int r = 0; r < 4; ++r) { float h0 = acc0[r] + bb0, h1 = acc1[r] + bb1; h0 = h0 * sigmoidf_(h0); h1 = h1 * sigmoidf_(h1);
          hidL[(4 * quad + r) * 264 + 32 * w + r16] = f2bf(h0); hidL[(4 * quad + r) * 264 + 32 * w + 16 + r16] = f2bf(h1); } }
    __syncthreads();
    if (w < 4) { f32x4 o = {0.f, 0.f, 0.f, 0.f}; const bf16* w2 = W2t + (size_t)(16 * w + r16) * 256 + quad * 8;
#pragma unroll
        for (int ks = 0; ks < 8; ++ks) { const bf16x8 af = *(const LAS bf16x8*)(hidL + r16 * 264 + ks * 32 + quad * 8); const bf16x8 bfr = *(const bf16x8*)(w2 + ks * 32);
            o = __builtin_amdgcn_mfma_f32_16x16x32_bf16(af, bfr, o, 0, 0, 0); }
#pragma unroll
        for (int r = 0; r < 4; ++r) outL[(4 * quad + r) * 68 + 16 * w + r16] = o[r]; }
    __syncthreads();
    if (w == 0) { const int i = lane >> 2, c0 = (lane & 3) * 16, n = n0 + i; float y[16];
#pragma unroll
        for (int j = 0; j < 16; ++j) y[j] = outL[i * 68 + c0 + j];
        if (kv == 0) { float s = 0.f;
#pragma unroll
            for (int j = 0; j < 16; ++j) s += y[j] * y[j];
            s += shx(s, 1, lane); s += shx(s, 2, lane);
            const float rstd = 1.0f / sqrtf(s * (1.0f / 64.0f) + 1e-6f); const float* gk = a.in[I_KNORM] + l * 192 + c0;
#pragma unroll
            for (int j = 0; j < 16; ++j) y[j] = y[j] * rstd * gk[j];
            if ((lane & 3) == 0 && n <= 510) { const float* rp = (const float*)(C.ws + WS_ROPE) + (16 * n + 31) * 16;
#pragma unroll
                for (int j = 0; j < 8; ++j) { const float c = rp[j], sn = rp[8 + j], x1 = y[j], x2 = y[8 + j]; y[j] = x1 * c - x2 * sn; y[8 + j] = x2 * c + x1 * sn; } }
            if (n > 510) {
#pragma unroll
                for (int j = 0; j < 16; ++j) y[j] = 0.f; }
            v4u o0, o1; o0.x = cvt_pk_bf16(y[0], y[1]); o0.y = cvt_pk_bf16(y[2], y[3]); o0.z = cvt_pk_bf16(y[4], y[5]); o0.w = cvt_pk_bf16(y[6], y[7]);
            o1.x = cvt_pk_bf16(y[8], y[9]); o1.y = cvt_pk_bf16(y[10], y[11]); o1.z = cvt_pk_bf16(y[12], y[13]); o1.w = cvt_pk_bf16(y[14], y[15]);
            bf16* ko = (bf16*)(C.ws + WS_KC) + ((size_t)bg * 512 + n) * 64 + c0; *(v4u*)ko = o0; *(v4u*)(ko + 8) = o1;
        } else { bf16* vo = (bf16*)(C.ws + WS_VCT) + ((size_t)bg * 64 + c0) * 512 + n;
#pragma unroll
            for (int j = 0; j < 16; ++j) vo[(size_t)j * 512] = (n > 510) ? (bf16)0 : f2bf(y[j]); } }
    __syncthreads();
}


#define MFMA16(a, b, c) __builtin_amdgcn_mfma_f32_16x16x32_bf16(a, b, c, 0, 0, 0)
constexpr float SM_SCALE = 0.125f * 1.4426950408889634f;
constexpr int AT_SLOT = 16384, AT_NSLOT = 6, AT_G = 3;
constexpr int AT_IMP_OFF = AT_SLOT * AT_NSLOT;
constexpr int AT_MASK_OFF = AT_IMP_OFF + 8 * 8 * 128 * 4;
__device__ __forceinline__ bf16x8 pack_p(const f32x4& p0, const f32x4& p1) {
    v4u w; w.x = cvt_pk_bf16(p0[0], p0[1]); w.y = cvt_pk_bf16(p0[2], p0[3]); w.z = cvt_pk_bf16(p1[0], p1[1]); w.w = cvt_pk_bf16(p1[2], p1[3]); return __builtin_bit_cast(bf16x8, w);
}
__device__ __forceinline__ int tile_off(int row, int chunk) { return row * 128 + ((chunk ^ ((row >> 1) & 7)) << 4); }
struct AtJob { const bf16* k; const bf16* v; int vpitch; };
struct AtUnit { int b, g, c, bg, nct, njobs, wlo, nssc, nsss, nssw; };
__device__ __forceinline__ AtJob at_job(const Ctx& C, const AtUnit& U, int k) {
    AtJob J; const int k2 = k - 2 * U.nct;
    if (k2 < 0) { const int j = (k < U.nct) ? k : k - U.nct; J.k = (const bf16*)(C.ws + WS_KC) + ((size_t)U.bg * 512 + 64 * j) * 64; J.v = (const bf16*)(C.ws + WS_VCT) + (size_t)U.bg * 64 * 512 + 64 * j; J.vpitch = 512; }
    else if (k2 <= U.c) { J.k = (const bf16*)(C.ws + WS_KSLC) + ((size_t)U.bg * SEQ + 64 * k2) * 64; J.v = (const bf16*)(C.ws + WS_VSLCT) + (size_t)U.bg * 64 * SEQ + 64 * k2; J.vpitch = SEQ; }
    else { const int w = U.wlo + (k2 - U.c - 1); J.k = (const bf16*)(C.ws + WS_KWIN) + ((size_t)U.bg * SEQ + 64 * w) * 64; J.v = (const bf16*)(C.ws + WS_VWINT) + (size_t)U.bg * 64 * SEQ + 64 * w; J.vpitch = SEQ; }
    return J;
}
__device__ __forceinline__ void at_stage(const Ctx& C, const AtJob& J, int slot) {
    const int row = 8 * C.wave + (C.lane >> 3), chunk = (C.lane & 7) ^ ((row >> 1) & 7);
    __builtin_amdgcn_global_load_lds((const unsigned*)(J.k + (size_t)row * 64 + chunk * 8), (LAS unsigned*)(C.lds + slot * AT_SLOT + C.wave * 1024), 16, 0, 0);
    __builtin_amdgcn_global_load_lds((const unsigned*)(J.v + (size_t)row * J.vpitch + chunk * 8), (LAS unsigned*)(C.lds + slot * AT_SLOT + 8192 + C.wave * 1024), 16, 0, 0);
}
__device__ __forceinline__ void at_stage_ss(const Ctx& C, const AtUnit& U, int sg) {
    int lss = sg, jbase = 0, nj = U.nct;
    if (lss >= U.nssc) { lss -= U.nssc; jbase = U.nct; }
    if (jbase == U.nct && lss >= U.nssc) { lss -= U.nssc; jbase = 2 * U.nct; nj = U.c + 1;
        if (lss >= U.nsss) { lss -= U.nsss; jbase = 2 * U.nct + U.c + 1; nj = U.c - U.wlo + 1; } }
#pragma unroll
    for (int i3 = 0; i3 < AT_G; ++i3) { const int jl = AT_G * lss + i3; if (jl < nj) at_stage(C, at_job(C, U, jbase + jl), AT_G * (sg & 1) + i3); }
}
__device__ __forceinline__ void at_load_k(LAS unsigned char* sl, int jp, int r16, int quad, bf16x8 (&kf)[2][2]) {
#pragma unroll
    for (int h = 0; h < 2; ++h)
#pragma unroll
        for (int kh = 0; kh < 2; ++kh) kf[h][kh] = *(const LAS bf16x8*)(sl + tile_off(32 * jp + 16 * h + r16, kh * 4 + quad));
}
__device__ __forceinline__ void at_load_v(LAS unsigned char* sl, int jp, int r16, int quad, bf16x8 (&vf)[4]) {
#pragma unroll
    for (int db = 0; db < 4; ++db) { const int row = 16 * db + r16;
        const v2u lo = *(const LAS v2u*)(sl + 8192 + tile_off(row, 4 * jp + (quad >> 1)) + (quad & 1) * 8), hi = *(const LAS v2u*)(sl + 8192 + tile_off(row, 4 * jp + 2 + (quad >> 1)) + (quad & 1) * 8);
        v4u w; w.x = lo.x; w.y = lo.y; w.z = hi.x; w.w = hi.y; vf[db] = __builtin_bit_cast(bf16x8, w); }
}
constexpr float AT_DEFER = 6.0f;
template <bool MASK, class Valid>
__device__ __forceinline__ void at_online(f32x4& s0, f32x4& s1, const Valid& valid, float& mrun, float& lrun, f32x4 (&o)[4], const bf16x8 (&vf)[4], int lane) {
    float bm;
    if (MASK) { bm = -1e30f;
#pragma unroll
        for (int r = 0; r < 4; ++r) { bm = valid(0, r) ? fmaxf(bm, s0[r]) : bm; bm = valid(1, r) ? fmaxf(bm, s1[r]) : bm; } }
    else bm = fmaxf(fmaxf(fmaxf(s0[0], s0[1]), fmaxf(s0[2], s0[3])), fmaxf(fmaxf(s1[0], s1[1]), fmaxf(s1[2], s1[3])));
    if (__builtin_amdgcn_ballot_w64(bm > mrun + AT_DEFER) != 0ull) {
        bm = fmaxf(bm, shx(bm, 16, lane)); bm = fmaxf(bm, shx(bm, 32, lane));
        const float mnew = fmaxf(mrun, bm), alpha = __builtin_amdgcn_exp2f(mrun - mnew);
        lrun *= alpha; mrun = mnew;
#pragma unroll
        for (int db = 0; db < 4; ++db) o[db] = o[db] * alpha;
    }
    float ps = 0.f;
#pragma unroll
    for (int r = 0; r < 4; ++r) { float p0 = __builtin_amdgcn_exp2f(s0[r] - mrun), p1 = __builtin_amdgcn_exp2f(s1[r] - mrun);
        if (MASK) { p0 = valid(0, r) ? p0 : 0.f; p1 = valid(1, r) ? p1 : 0.f; }
        s0[r] = p0; s1[r] = p1; ps += p0 + p1; }
    lrun += ps;
    const bf16x8 pb = pack_p(s0, s1);
#pragma unroll
    for (int db = 0; db < 4; ++db) o[db] = MFMA16(vf[db], pb, o[db]);
}

__device__ __forceinline__ void attn_unit(const Ctx& C, const AtUnit& U, const int abl  , float* scr  ) {
    const int lane0 = C.lane, wv = C.wave;
    const int ta = 64 * U.c + 8 * wv;
    const bf16* Qn = (const bf16*)(C.ws + WS_QN); const bf16* Z = (const bf16*)(C.ws + WS_Z);
    bf16x8 q[4][2]; f32x4 O[4][4]; float mrun[4], lrun[4], pup[4];
    { const int lane = lane0, r16 = lane & 15, quad = lane >> 4, tokc = r16 >> 3, head = r16 & 7; LAS float* impL = (LAS float*)(C.lds + AT_IMP_OFF + wv * 4096);
#pragma unroll
    for (int cb = 0; cb < 4; ++cb) { const bf16* qrow = Qn + ((size_t)(U.b * SEQ + ta + 2 * cb + tokc)) * DM + (U.g * 8 + head) * 64;
        q[cb][0] = *(const bf16x8*)(qrow + quad * 8); q[cb][1] = *(const bf16x8*)(qrow + 32 + quad * 8);
        mrun[cb] = -1e30f; lrun[cb] = 0.f; pup[cb] = 0.f;
#pragma unroll
        for (int db = 0; db < 4; ++db) O[cb][db] = (f32x4){0.f, 0.f, 0.f, 0.f}; }
#pragma unroll
    for (int i = 0; i < 4; ++i) *(LAS f32x4*)(impL + 4 * lane + 256 * i) = (f32x4){0.f, 0.f, 0.f, 0.f};
    }
    const int nvw = ((ta + 7 - 31) >= 0) ? (((ta + 7 - 31) >> 4) + 1) : 0;
    const int nsp = (nvw + 31) >> 5;
    const int j_c2 = U.nct, j_sl = 2 * U.nct, j_wn = 2 * U.nct + U.c + 1;
    at_stage_ss(C, U, 0);
    int sg = 0; const int nss_total = 2 * U.nssc + U.nsss + U.nssw;
    for (int lss = 0; lss < U.nssc; ++lss, ++sg) {
        asm volatile("s_waitcnt vmcnt(0)" ::: "memory");
        __builtin_amdgcn_s_barrier(); asm volatile("" ::: "memory");
        if (sg + 1 < nss_total) at_stage_ss(C, U, sg + 1);
        for (int i3 = 0; i3 < AT_G; ++i3) { const int jl = AT_G * lss + i3; if (jl >= U.nct) break; const int k = 0 + jl;
        LAS unsigned char* sl = C.lds + (AT_G * (sg & 1) + i3) * AT_SLOT;
        int lane_ = lane0; asm volatile("" : "+v"(lane_));
        const int lane = lane_, r16 = lane & 15, quad = lane >> 4, tokc = r16 >> 3, head = r16 & 7;
        f32x4* scr4 = (f32x4*)(scr + lane * 64);
        LAS float* impL = (LAS float*)(C.lds + AT_IMP_OFF + wv * 4096); LAS unsigned* maskL = (LAS unsigned*)(C.lds + AT_MASK_OFF + wv * 128);
        {
            const int j = k; if (abl & 1) continue;
#pragma unroll
            for (int jp = 0; jp < 2; ++jp) { if (2 * j + jp >= nsp) break;
                bf16x8 kf[2][2]; at_load_k(sl, jp, r16, quad, kf);
#pragma unroll
                for (int cb = 0; cb < 4; ++cb) { const int tl = ta + 2 * cb + tokc; const int nvl = (tl >= 31) ? (((tl - 31) >> 4) + 1) : 0;
                    f32x4 s0 = {0.f, 0.f, 0.f, 0.f}, s1 = {0.f, 0.f, 0.f, 0.f};
                    s0 = MFMA16(kf[0][0], q[cb][0], s0); s0 = MFMA16(kf[0][1], q[cb][1], s0); s1 = MFMA16(kf[1][0], q[cb][0], s1); s1 = MFMA16(kf[1][1], q[cb][1], s1);
                    const int n0 = 64 * j + 32 * jp + 4 * quad; float bm = mrun[cb];
#pragma unroll
                    for (int r = 0; r < 4; ++r) { bm = (n0 + r < nvl) ? fmaxf(bm, s0[r]) : bm; bm = (n0 + 16 + r < nvl) ? fmaxf(bm, s1[r]) : bm; }
                    float ps = 0.f;
#pragma unroll
                    for (int r = 0; r < 4; ++r) { ps += (n0 + r < nvl) ? __builtin_amdgcn_exp2f(s0[r] - bm) : 0.f; ps += (n0 + 16 + r < nvl) ? __builtin_amdgcn_exp2f(s1[r] - bm) : 0.f; }
                    lrun[cb] = lrun[cb] * __builtin_amdgcn_exp2f(mrun[cb] - bm) + ps; mrun[cb] = bm; } }
        }
        }
        asm volatile("s_waitcnt lgkmcnt(0)" ::: "memory");
    }
    {
    int lane_ = lane0; asm volatile("" : "+v"(lane_));
    const int lane = lane_, r16 = lane & 15, quad = lane >> 4, tokc = r16 >> 3, head = r16 & 7; f32x4* scr4 = (f32x4*)(scr + lane * 64);
    LAS float* impL = (LAS float*)(C.lds + AT_IMP_OFF + wv * 4096); LAS unsigned* maskL = (LAS unsigned*)(C.lds + AT_MASK_OFF + wv * 128); (void)scr4; (void)impL; (void)maskL; (void)head; (void)tokc; (void)quad;
    {
#pragma unroll
            for (int cb = 0; cb < 4; ++cb) { float mall = fmaxf(mrun[cb], shx(mrun[cb], 16, lane)); mall = fmaxf(mall, shx(mall, 32, lane));
                float ls = lrun[cb] * __builtin_amdgcn_exp2f(mrun[cb] - mall); ls += shx(ls, 16, lane); ls += shx(ls, 32, lane);
                mrun[cb] = mall; lrun[cb] = (ls > 0.f) ? 1.0f / ls : 0.f; }
        }
    }
    for (int lss = 0; lss < U.nssc; ++lss, ++sg) {
        asm volatile("s_waitcnt vmcnt(0)" ::: "memory");
        __builtin_amdgcn_s_barrier(); asm volatile("" ::: "memory");
        if (sg + 1 < nss_total) at_stage_ss(C, U, sg + 1);
        for (int i3 = 0; i3 < AT_G; ++i3) { const int jl = AT_G * lss + i3; if (jl >= U.nct) break; const int k = j_c2 + jl;
        LAS unsigned char* sl = C.lds + (AT_G * (sg & 1) + i3) * AT_SLOT;
        int lane_ = lane0; asm volatile("" : "+v"(lane_));
        const int lane = lane_, r16 = lane & 15, quad = lane >> 4, tokc = r16 >> 3, head = r16 & 7;
        f32x4* scr4 = (f32x4*)(scr + lane * 64);
        LAS float* impL = (LAS float*)(C.lds + AT_IMP_OFF + wv * 4096); LAS unsigned* maskL = (LAS unsigned*)(C.lds + AT_MASK_OFF + wv * 128);
        {
            const int j = k - j_c2; if (abl & 1) continue;
#pragma unroll
            for (int jp = 0; jp < 2; ++jp) { if (2 * j + jp >= nsp) break;
                bf16x8 kf[2][2]; at_load_k(sl, jp, r16, quad, kf); bf16x8 vf[4]; at_load_v(sl, jp, r16, quad, vf);
#pragma unroll
                for (int cb = 0; cb < 4; ++cb) { const int tok8 = 2 * cb + tokc, tl = ta + tok8; const int nvl = (tl >= 31) ? (((tl - 31) >> 4) + 1) : 0;
                    f32x4 s0 = {0.f, 0.f, 0.f, 0.f}, s1 = {0.f, 0.f, 0.f, 0.f};
                    s0 = MFMA16(kf[0][0], q[cb][0], s0); s0 = MFMA16(kf[0][1], q[cb][1], s0); s1 = MFMA16(kf[1][0], q[cb][0], s1); s1 = MFMA16(kf[1][1], q[cb][1], s1);
                    const int n0 = 64 * j + 32 * jp + 4 * quad;
#pragma unroll
                    for (int r = 0; r < 4; ++r) { s0[r] = (n0 + r < nvl) ? __builtin_amdgcn_exp2f(s0[r] - mrun[cb]) * lrun[cb] : 0.f; s1[r] = (n0 + 16 + r < nvl) ? __builtin_amdgcn_exp2f(s1[r] - mrun[cb]) * lrun[cb] : 0.f; }
                    const bf16x8 pb = pack_p(s0, s1);
#pragma unroll
                    for (int db = 0; db < 4; ++db) O[cb][db] = MFMA16(vf[db], pb, O[cb][db]);
#pragma unroll
                    for (int h = 0; h < 2; ++h) { const f32x4& st = h ? s1 : s0; float h3 = st[3], hs = (st[0] + st[1]) + (st[2] + st[3]);
                        hs += shx(hs, 1, lane); hs += shx(hs, 2, lane); hs += shx(hs, 4, lane);
                        h3 += shx(h3, 1, lane); h3 += shx(h3, 2, lane); h3 += shx(h3, 4, lane);
                        const float up = shf(h3, (lane + 48) & 63);
                        const float val = hs + ((quad == 0) ? pup[cb] : up); pup[cb] = up;
                        if (head == 0) impL[tok8 * 128 + 4 * (4 * j + 2 * jp + h) + quad] = val; } } }
        }
        }
        asm volatile("s_waitcnt lgkmcnt(0)" ::: "memory");
    }
    {
    int lane_ = lane0; asm volatile("" : "+v"(lane_));
    const int lane = lane_, r16 = lane & 15, quad = lane >> 4, tokc = r16 >> 3, head = r16 & 7; f32x4* scr4 = (f32x4*)(scr + lane * 64);
    LAS float* impL = (LAS float*)(C.lds + AT_IMP_OFF + wv * 4096); LAS unsigned* maskL = (LAS unsigned*)(C.lds + AT_MASK_OFF + wv * 128); (void)scr4; (void)impL; (void)maskL; (void)head; (void)tokc; (void)quad;
    {
            asm volatile("s_waitcnt lgkmcnt(0)" ::: "memory");
#pragma unroll
            for (int cb = 0; cb < 4; ++cb) { const int tok8 = 2 * cb + tokc, tl = ta + tok8;
                if (2 * nsp < 32 && head == 0 && quad == 0) impL[tok8 * 128 + 8 * nsp] = pup[cb];
                const float g0 = sigmoidf_(bf2f(Z[((size_t)(U.b * SEQ + tl)) * ZW + ZC_NG + U.g * 8 + head]));
#pragma unroll
                for (int db = 0; db < 4; ++db) { scr4[cb * 4 + db] = O[cb][db] * g0; O[cb][db] = (f32x4){0.f, 0.f, 0.f, 0.f}; }
                mrun[cb] = -1e30f; lrun[cb] = 0.f; }
            asm volatile("s_waitcnt lgkmcnt(0)" ::: "memory");
            { const int cur = U.c, lam = head * 4 + quad;
              unsigned mk[4][4];
#pragma unroll
              for (int cb = 0; cb < 4; ++cb) { mk[cb][0] = 0u; mk[cb][1] = 0u; mk[cb][2] = 0u; mk[cb][3] = 0u; }
              if (cur <= 15 || (abl & 8)) {
#pragma unroll
                  for (int cb = 0; cb < 4; ++cb) mk[cb][0] = (2u << cur) - 1u;
              } else {
                  unsigned key[4][4];
#pragma unroll
                  for (int cb = 0; cb < 4; ++cb) { const f32x4 v = *(const LAS f32x4*)(impL + (2 * cb + tokc) * 128 + 4 * lam);
#pragma unroll
                      for (int jx = 0; jx < 4; ++jx) { const int sb = 4 * lam + jx; unsigned kk = ((__float_as_uint(v[jx]) & 0xFFFFFF80u) + 0x80u) | (unsigned)(127 - sb);
                          kk = (sb > cur) ? 0u : kk; kk = (sb == 0 || sb == cur) ? (0x7F000000u | (unsigned)(127 - sb)) : kk; key[cb][jx] = kk; } }
                  for (int round = 0; round < 16; ++round) {
                      unsigned bk[4];
#pragma unroll
                      for (int cb = 0; cb < 4; ++cb) { const unsigned a = key[cb][0] > key[cb][1] ? key[cb][0] : key[cb][1], b2 = key[cb][2] > key[cb][3] ? key[cb][2] : key[cb][3]; bk[cb] = a > b2 ? a : b2; }
#pragma unroll
                      for (int st = 0; st < 5; ++st) { const int off = (st < 3) ? (1 << st) : (st == 3 ? 16 : 32);
#pragma unroll
                          for (int cb = 0; cb < 4; ++cb) { const unsigned o = (unsigned)shxi((int)bk[cb], off, lane); bk[cb] = o > bk[cb] ? o : bk[cb]; } }
#pragma unroll
                      for (int cb = 0; cb < 4; ++cb) { const unsigned b = bk[cb]; const int bs = 127 - (int)(b & 127u);
#pragma unroll
                          for (int jx = 0; jx < 4; ++jx) key[cb][jx] = (key[cb][jx] == b) ? 0u : key[cb][jx];
                          const unsigned bit = 1u << (bs & 31); const int wd = bs >> 5;
                          mk[cb][0] |= (wd == 0) ? bit : 0u; mk[cb][1] |= (wd == 1) ? bit : 0u; mk[cb][2] |= (wd == 2) ? bit : 0u; mk[cb][3] |= (wd == 3) ? bit : 0u; }
                  }
              }
              if (head == 0 && quad == 0) {
#pragma unroll
                  for (int cb = 0; cb < 4; ++cb) { const int tok8 = 2 * cb + tokc; maskL[0 * 8 + tok8] = mk[cb][0]; maskL[1 * 8 + tok8] = mk[cb][1]; maskL[2 * 8 + tok8] = mk[cb][2]; maskL[3 * 8 + tok8] = mk[cb][3]; } }
            }
            asm volatile("s_waitcnt lgkmcnt(0)" ::: "memory");
        }
    }
    for (int lss = 0; lss < U.nsss; ++lss, ++sg) {
        asm volatile("s_waitcnt vmcnt(0)" ::: "memory");
        __builtin_amdgcn_s_barrier(); asm volatile("" ::: "memory");
        if (sg + 1 < nss_total) at_stage_ss(C, U, sg + 1);
        for (int i3 = 0; i3 < AT_G; ++i3) { const int jl = AT_G * lss + i3; if (jl >= (U.c + 1)) break; const int k = j_sl + jl;
        LAS unsigned char* sl = C.lds + (AT_G * (sg & 1) + i3) * AT_SLOT;
        int lane_ = lane0; asm volatile("" : "+v"(lane_));
        const int lane = lane_, r16 = lane & 15, quad = lane >> 4, tokc = r16 >> 3, head = r16 & 7;
        f32x4* scr4 = (f32x4*)(scr + lane * 64);
        LAS float* impL = (LAS float*)(C.lds + AT_IMP_OFF + wv * 4096); LAS unsigned* maskL = (LAS unsigned*)(C.lds + AT_MASK_OFF + wv * 128);
        {
            const int s = k - j_sl; unsigned selw[4]; bool need[4], both[4]; bool any = false;
#pragma unroll
            for (int cb = 0; cb < 4; ++cb) { selw[cb] = (maskL[(s >> 5) * 8 + 2 * cb + tokc] >> (s & 31)) & 1u; const unsigned long long bl = __builtin_amdgcn_ballot_w64(selw[cb] != 0u); need[cb] = bl != 0ull; both[cb] = bl == ~0ull; any = any || need[cb]; }
            if (any && !(abl & 2)) {
#pragma unroll
                for (int jp = 0; jp < 2; ++jp) { bf16x8 kf[2][2]; at_load_k(sl, jp, r16, quad, kf); bf16x8 vf[4]; at_load_v(sl, jp, r16, quad, vf);
#pragma unroll
                    for (int cb = 0; cb < 4; ++cb) if (need[cb]) { const int tl = ta + 2 * cb + tokc; const bool sel = selw[cb] != 0u; const int key0 = 64 * s + 32 * jp + 4 * quad;
                        f32x4 s0 = {0.f, 0.f, 0.f, 0.f}, s1 = {0.f, 0.f, 0.f, 0.f};
                        s0 = MFMA16(kf[0][0], q[cb][0], s0); s0 = MFMA16(kf[0][1], q[cb][1], s0); s1 = MFMA16(kf[1][0], q[cb][0], s1); s1 = MFMA16(kf[1][1], q[cb][1], s1);
                        if (s == U.c || !both[cb]) at_online<true>(s0, s1, [=](int h, int r) { return sel && (key0 + 16 * h + r <= tl); }, mrun[cb], lrun[cb], O[cb], vf, lane);
                        else at_online<false>(s0, s1, [=](int, int) { return true; }, mrun[cb], lrun[cb], O[cb], vf, lane); } }
            }
        }
        }
        asm volatile("s_waitcnt lgkmcnt(0)" ::: "memory");
    }
    {
    int lane_ = lane0; asm volatile("" : "+v"(lane_));
    const int lane = lane_, r16 = lane & 15, quad = lane >> 4, tokc = r16 >> 3, head = r16 & 7; f32x4* scr4 = (f32x4*)(scr + lane * 64);
    LAS float* impL = (LAS float*)(C.lds + AT_IMP_OFF + wv * 4096); LAS unsigned* maskL = (LAS unsigned*)(C.lds + AT_MASK_OFF + wv * 128); (void)scr4; (void)impL; (void)maskL; (void)head; (void)tokc; (void)quad;
    {
#pragma unroll
            for (int cb = 0; cb < 4; ++cb) { const int tl = ta + 2 * cb + tokc;
                float ls = lrun[cb]; ls += shx(ls, 16, lane); ls += shx(ls, 32, lane);
                const float g1 = sigmoidf_(bf2f(Z[((size_t)(U.b * SEQ + tl)) * ZW + ZC_NG + 16 + U.g * 8 + head])) / ls;
#pragma unroll
                for (int db = 0; db < 4; ++db) { scr4[cb * 4 + db] = scr4[cb * 4 + db] + O[cb][db] * g1; O[cb][db] = (f32x4){0.f, 0.f, 0.f, 0.f}; }
                mrun[cb] = -1e30f; lrun[cb] = 0.f; }
        }
    }
    for (int lss = 0; lss < U.nssw; ++lss, ++sg) {
        asm volatile("s_waitcnt vmcnt(0)" ::: "memory");
        __builtin_amdgcn_s_barrier(); asm volatile("" ::: "memory");
        if (sg + 1 < nss_total) at_stage_ss(C, U, sg + 1);
        for (int i3 = 0; i3 < AT_G; ++i3) { const int jl = AT_G * lss + i3; if (jl >= (U.c - U.wlo + 1)) break; const int k = j_wn + jl;
        LAS unsigned char* sl = C.lds + (AT_G * (sg & 1) + i3) * AT_SLOT;
        int lane_ = lane0; asm volatile("" : "+v"(lane_));
        const int lane = lane_, r16 = lane & 15, quad = lane >> 4, tokc = r16 >> 3, head = r16 & 7;
        f32x4* scr4 = (f32x4*)(scr + lane * 64);
        LAS float* impL = (LAS float*)(C.lds + AT_IMP_OFF + wv * 4096); LAS unsigned* maskL = (LAS unsigned*)(C.lds + AT_MASK_OFF + wv * 128);
        {
            const int w = U.wlo + (k - j_wn); if (abl & 4) continue;
#pragma unroll
            for (int jp = 0; jp < 2; ++jp) { const int kb = 64 * w + 32 * jp; if (kb > ta + 7 || kb + 31 + 511 < ta) continue;
                bf16x8 kf[2][2]; at_load_k(sl, jp, r16, quad, kf); bf16x8 vf[4]; at_load_v(sl, jp, r16, quad, vf);
#pragma unroll
                for (int cb = 0; cb < 4; ++cb) { const int tl = ta + 2 * cb + tokc; const int key0 = kb + 4 * quad;
                    f32x4 s0 = {0.f, 0.f, 0.f, 0.f}, s1 = {0.f, 0.f, 0.f, 0.f};
                    s0 = MFMA16(kf[0][0], q[cb][0], s0); s0 = MFMA16(kf[0][1], q[cb][1], s0); s1 = MFMA16(kf[1][0], q[cb][0], s1); s1 = MFMA16(kf[1][1], q[cb][1], s1);
                    if (kb + 31 <= ta && kb + 511 >= ta + 7) at_online<false>(s0, s1, [=](int, int) { return true; }, mrun[cb], lrun[cb], O[cb], vf, lane);
                    else at_online<true>(s0, s1, [=](int h, int r) { const int key = key0 + 16 * h + r; return key <= tl && key + 511 >= tl; }, mrun[cb], lrun[cb], O[cb], vf, lane); } }
        }
        }
        asm volatile("s_waitcnt lgkmcnt(0)" ::: "memory");
    }
    int lane_ = lane0; asm volatile("" : "+v"(lane_));
    const int lane = lane_, r16 = lane & 15, quad = lane >> 4, tokc = r16 >> 3, head = r16 & 7; f32x4* scr4 = (f32x4*)(scr + lane * 64);
#pragma unroll
    for (int cb = 0; cb < 4; ++cb) { const int tl = ta + 2 * cb + tokc;
        float ls = lrun[cb]; ls += shx(ls, 16, lane); ls += shx(ls, 32, lane);
        const float g2 = sigmoidf_(bf2f(Z[((size_t)(U.b * SEQ + tl)) * ZW + ZC_NG + 32 + U.g * 8 + head])) / ls;
        bf16* orow = (bf16*)(C.ws + WS_O) + ((size_t)(U.b * SEQ + tl)) * DM + (U.g * 8 + head) * 64 + 4 * quad;
#pragma unroll
        for (int db = 0; db < 4; ++db) { const f32x4 v = scr4[cb * 4 + db] + O[cb][db] * g2;
            v2u wv2; wv2.x = cvt_pk_bf16(v[0], v[1]); wv2.y = cvt_pk_bf16(v[2], v[3]); *(v2u*)(orow + 16 * db) = wv2; } }
    asm volatile("s_waitcnt vmcnt(0)" ::: "memory");
    __builtin_amdgcn_s_barrier(); asm volatile("" ::: "memory");
}
__device__ __forceinline__ void attn_phase(const Ctx& C, const int abl) {
    float* scr = (float*)(C.ws + WS_SCR) + ((size_t)C.bx * NWAVES + C.wave) * 4096;
    for (int uu = C.bx; uu < 8 * 128; uu += C.G) { const int bgi = uu & 7, kk = uu >> 3, rnd = kk >> 5, sub = kk & 31;
        AtUnit U; U.b = bgi >> 1; U.g = bgi & 1; U.bg = bgi; U.c = (rnd == 0) ? 127 - sub : (rnd == 1) ? 64 + sub : (rnd == 2) ? 63 - sub : sub;
        U.nct = (4 * U.c + 3 + 63) >> 6; U.wlo = (U.c >= 8) ? U.c - 8 : 0; U.njobs = 2 * U.nct + (U.c + 1) + (U.c - U.wlo + 1); U.nssc = (U.nct + AT_G - 1) / AT_G; U.nsss = (U.c + AT_G) / AT_G; U.nssw = (U.c - U.wlo + AT_G) / AT_G;
        attn_unit(C, U, abl, scr); }
}


__device__ __forceinline__ unsigned f2key(float f) { const unsigned b = __float_as_uint(f); return (b & 0x80000000u) ? ~b : (b | 0x80000000u); }
__device__ __forceinline__ float key2f(unsigned k) { const unsigned b = (k & 0x80000000u) ? (k & 0x7fffffffu) : ~k; return __uint_as_float(b); }
__device__ __forceinline__ void norm2_router(const Ctx& C, const Args& a, int l) {
    LAS int* hist = (LAS int*)(C.lds + SM_OFF);
    if (C.tid < 32) hist[C.tid] = 0;
    __syncthreads();
    const int lane = C.lane, r16 = lane & 15, quad = lane >> 4;
    const int m = C.bx * 128 + C.wave * 16 + r16, b = m >> 13;
    const float* xrow = a.out + (size_t)m * DM + 8 * quad; const float* gain = a.in[I_NORM2] + l * DM + 8 * quad;
    const float* mb = (const float*)(C.ws + WS_MOD) + ((size_t)l * NB + b) * 6144 + 8 * quad;
    const bf16* wh = (const bf16*)(C.ws + WS_RWT) + (size_t)l * 2 * 32 * 1024 + (size_t)r16 * 1024 + 8 * quad; const bf16* wl = wh + 32 * 1024;
    bf16* hrow = (bf16*)(C.ws + WS_H) + (size_t)m * DM + 8 * quad;
    float ss = 0.f;
#pragma unroll 8
    for (int ks = 0; ks < 32; ++ks) { const f32x4 x0 = *(const f32x4*)(xrow + 32 * ks), x1 = *(const f32x4*)(xrow + 32 * ks + 4);
        ss += (x0.x * x0.x + x0.y * x0.y) + (x0.z * x0.z + x0.w * x0.w) + (x1.x * x1.x + x1.y * x1.y) + (x1.z * x1.z + x1.w * x1.w); }
    ss += shx(ss, 16, lane); ss += shx(ss, 32, lane);
    const float rstd = 1.0f / sqrtf(ss * (1.0f / DM) + 1e-6f);
    f32x4 d0 = {0.f, 0.f, 0.f, 0.f}, d1 = {0.f, 0.f, 0.f, 0.f};
#pragma unroll 2
    for (int ks = 0; ks < 32; ++ks) { const int o = 32 * ks;
        const f32x4 x0 = *(const f32x4*)(xrow + o), x1 = *(const f32x4*)(xrow + o + 4), g0 = *(const f32x4*)(gain + o), g1 = *(const f32x4*)(gain + o + 4);
        const f32x4 c0 = *(const f32x4*)(mb + 4 * DM + o), c1 = *(const f32x4*)(mb + 4 * DM + o + 4), s0 = *(const f32x4*)(mb + 3 * DM + o), s1 = *(const f32x4*)(mb + 3 * DM + o + 4);
        const f32x4 h0 = x0 * rstd * g0 * (c0 + 1.0f) + s0, h1 = x1 * rstd * g1 * (c1 + 1.0f) + s1;
        v4u hi; hi.x = cvt_pk_bf16(h0.x, h0.y); hi.y = cvt_pk_bf16(h0.z, h0.w); hi.z = cvt_pk_bf16(h1.x, h1.y); hi.w = cvt_pk_bf16(h1.z, h1.w);
        *(v4u*)(hrow + o) = hi;
        v4u lo; lo.x = cvt_pk_bf16(h0.x - bflo(hi.x), h0.y - bfhi(hi.x)); lo.y = cvt_pk_bf16(h0.z - bflo(hi.y), h0.w - bfhi(hi.y));
        lo.z = cvt_pk_bf16(h1.x - bflo(hi.z), h1.y - bfhi(hi.z)); lo.w = cvt_pk_bf16(h1.z - bflo(hi.w), h1.w - bfhi(hi.w));
        const bf16x8 bh = __builtin_bit_cast(bf16x8, hi), bl = __builtin_bit_cast(bf16x8, lo);
        const bf16x8 ah0 = *(const bf16x8*)(wh + o), ah1 = *(const bf16x8*)(wh + 16 * 1024 + o), al0 = *(const bf16x8*)(wl + o), al1 = *(const bf16x8*)(wl + 16 * 1024 + o);
        d0 = __builtin_amdgcn_mfma_f32_16x16x32_bf16(ah0, bh, d0, 0, 0, 0); d0 = __builtin_amdgcn_mfma_f32_16x16x32_bf16(ah0, bl, d0, 0, 0, 0); d0 = __builtin_amdgcn_mfma_f32_16x16x32_bf16(al0, bh, d0, 0, 0, 0);
        d1 = __builtin_amdgcn_mfma_f32_16x16x32_bf16(ah1, bh, d1, 0, 0, 0); d1 = __builtin_amdgcn_mfma_f32_16x16x32_bf16(ah1, bl, d1, 0, 0, 0); d1 = __builtin_amdgcn_mfma_f32_16x16x32_bf16(al1, bh, d1, 0, 0, 0); }
    const float* rb = a.in[I_RB] + l * NEXP; unsigned key[8];
#pragma unroll
    for (int r = 0; r < 4; ++r) { const int e0 = 4 * quad + r, e1 = 16 + 4 * quad + r;
        key[r] = (f2key(d0[r] + rb[e0]) & ~31u) | (unsigned)(31 - e0); key[4 + r] = (f2key(d1[r] + rb[e1]) & ~31u) | (unsigned)(31 - e1); }
    unsigned top[4];
#pragma unroll
    for (int k = 0; k < 4; ++k) { unsigned bk = key[0];
#pragma unroll
        for (int i = 1; i < 8; ++i) bk = key[i] > bk ? key[i] : bk;
        { const unsigned o = (unsigned)shxi((int)bk, 16, lane); bk = o > bk ? o : bk; } { const unsigned o = (unsigned)shxi((int)bk, 32, lane); bk = o > bk ? o : bk; }
        top[k] = bk;
#pragma unroll
        for (int i = 0; i < 8; ++i) key[i] = (key[i] == bk) ? 0u : key[i]; }
    if (quad == 0) { const float v0 = key2f(top[0] & ~31u), e1 = __expf(key2f(top[1] & ~31u) - v0), e2 = __expf(key2f(top[2] & ~31u) - v0), e3 = __expf(key2f(top[3] & ~31u) - v0);
        const float inv = 1.0f / (1.0f + e1 + e2 + e3);
        int* tope = (int*)(C.ws + WS_TOPE) + m * 4; float* topw = (float*)(C.ws + WS_TOPW) + m * 4;
        const int x0 = 31 - (int)(top[0] & 31u), x1 = 31 - (int)(top[1] & 31u), x2 = 31 - (int)(top[2] & 31u), x3 = 31 - (int)(top[3] & 31u);
        *(int4*)tope = make_int4(x0, x1, x2, x3); *(float4*)topw = make_float4(inv, e1 * inv, e2 * inv, e3 * inv);
        __hip_atomic_fetch_add(hist + x0, 1, __ATOMIC_RELAXED, __HIP_MEMORY_SCOPE_WORKGROUP); __hip_atomic_fetch_add(hist + x1, 1, __ATOMIC_RELAXED, __HIP_MEMORY_SCOPE_WORKGROUP);
        __hip_atomic_fetch_add(hist + x2, 1, __ATOMIC_RELAXED, __HIP_MEMORY_SCOPE_WORKGROUP); __hip_atomic_fetch_add(hist + x3, 1, __ATOMIC_RELAXED, __HIP_MEMORY_SCOPE_WORKGROUP); }
    __syncthreads();
    if (C.tid < 32) ((int*)(C.ws + WS_CNT))[C.bx * 32 + C.tid] = hist[C.tid];
    __syncthreads();
}
__device__ __forceinline__ void moe_scatter(const Ctx& C) {
    LAS int* sm = (LAS int*)(C.lds + SM_OFF); LAS int* tot = sm + 32; LAS int* base = sm + 64; LAS int* pstart = sm + 96; LAS int* lcnt = sm + 128;
    const int* cnt = (const int*)(C.ws + WS_CNT); int* tile_e = (int*)(C.ws + WS_TILEE); int* rowtok = (int*)(C.ws + WS_ROWTOK);
    if (C.tid < 32) { int t = 0, bs = 0; for (int bb = 0; bb < C.G; ++bb) { const int c = cnt[bb * 32 + C.tid]; t += c; bs += (bb < C.bx) ? c : 0; } tot[C.tid] = t; base[C.tid] = bs; lcnt[C.tid] = 0; }
    __syncthreads();
    if (C.tid == 0) { int ps = 0; for (int e = 0; e < 32; ++e) { pstart[e] = ps; const int nt = (tot[e] + 255) >> 8; if (C.bx == 0) for (int i = 0; i < nt; ++i) tile_e[(ps >> 8) + i] = e; ps += nt << 8; }
        if (C.bx == 0) tile_e[1023] = ps >> 8; }
    __syncthreads();
    if (C.bx == 0 && C.tid < 32) { const int e = C.tid, end = pstart[e] + (((tot[e] + 255) >> 8) << 8); for (int r = pstart[e] + tot[e]; r < end; ++r) rowtok[r] = 0; }
    const int* tope = (const int*)(C.ws + WS_TOPE); int* dest = (int*)(C.ws + WS_DEST);
    const int t = C.tid;
    { const int m = C.bx * 128 + (t >> 2); const int e = tope[m * 4 + (t & 3)]; const int rank = __hip_atomic_fetch_add(lcnt + e, 1, __ATOMIC_RELAXED, __HIP_MEMORY_SCOPE_WORKGROUP);
      const int row = pstart[e] + base[e] + rank; dest[m * 4 + (t & 3)] = row; rowtok[row] = m; }
    __syncthreads();
}
__device__ __forceinline__ void moe_combine(const Ctx& C, const Args& a, int l, float* Xout, const bool next_norm) {
    const int gw = C.bx * NWAVES + C.wave, NGW = C.G * NWAVES, lane = C.lane;
    const int* dest = (const int*)(C.ws + WS_DEST); const float* topw = (const float*)(C.ws + WS_TOPW); const bf16* Y = (const bf16*)(C.ws + WS_Y);
    const float* mod_l = (const float*)(C.ws + WS_MOD) + (size_t)l * NB * 6144; const float* X = a.out;
    const float* gain_n = a.in[I_NORM1] + (l + 1) * DM; bf16* H = (bf16*)(C.ws + WS_H);
    for (int m = gw; m < NTOK; m += NGW) { const int b = m >> 13; const float* g2 = mod_l + (size_t)b * 6144 + 5 * DM;
        int r[4]; float w[4];
#pragma unroll
        for (int k = 0; k < 4; ++k) { r[k] = dest[m * 4 + k]; w[k] = topw[m * 4 + k]; }
        const f32x4* xr = (const f32x4*)(X + (size_t)m * DM) + lane; f32x4* xo = (f32x4*)(Xout + (size_t)m * DM) + lane;
        f32x4 xn[4]; float ss = 0.f;
#pragma unroll
        for (int j = 0; j < 4; ++j) { const int col = 4 * lane + 256 * j; f32x4 y = {0.f, 0.f, 0.f, 0.f};
#pragma unroll
            for (int k = 0; k < 4; ++k) { const v2u u = *(const v2u*)(Y + (size_t)r[k] * DM + col); y.x += w[k] * bflo(u.x); y.y += w[k] * bfhi(u.x); y.z += w[k] * bflo(u.y); y.w += w[k] * bfhi(u.y); }
            const f32x4 gv = *(const f32x4*)(g2 + col); xn[j] = xr[64 * j] + gv * y; xo[64 * j] = xn[j];
            ss += (xn[j].x * xn[j].x + xn[j].y * xn[j].y) + (xn[j].z * xn[j].z + xn[j].w * xn[j].w); }
        if (next_norm) {
            const float rstd = 1.0f / sqrtf(wave_sum(ss, lane) * (1.0f / DM) + 1e-6f); const float* mb = mod_l + (size_t)(NB + b) * 6144; v2u* o8 = (v2u*)(H + (size_t)m * DM) + lane;
#pragma unroll
            for (int j = 0; j < 4; ++j) { const int col = 4 * lane + 256 * j;
                const f32x4 g = *(const f32x4*)(gain_n + col), sc = *(const f32x4*)(mb + 1 * DM + col), sh = *(const f32x4*)(mb + col);
                const f32x4 h = xn[j] * rstd * g * (sc + 1.0f) + sh;
                v2u wv; wv.x = cvt_pk_bf16(h.x, h.y); wv.y = cvt_pk_bf16(h.z, h.w); o8[64 * j] = wv; } }
    }
}


#ifndef MK_ONE_LAUNCH
#define MK_ONE_LAUNCH 1
#endif
#ifndef REP_NORM1
#define REP_NORM1 1
#endif
#ifndef REP_PROJ
#define REP_PROJ 1
#endif
#ifndef REP_OUTG
#define REP_OUTG 1
#endif
#ifndef REP_COMB
#define REP_COMB 1
#endif
#ifndef ABL_ATTN
#define ABL_ATTN 0
#endif
#ifndef REP_P0
#define REP_P0 1
#endif
#ifndef REP_ATTN
#define REP_ATTN 1
#endif
#ifndef REP_POST
#define REP_POST 1
#endif
#ifndef REP_N2R
#define REP_N2R 1
#endif
#ifndef REP_GEMMIN
#define REP_GEMMIN 1
#endif
#ifndef REP_MOE
#define REP_MOE 1
#endif
#ifndef REP_SCAT
#define REP_SCAT 1
#endif
template <int l>
__device__ __forceinline__ void layer_body(Ctx& C, const Args& args, const XcdBarrier& bar, const int lo, const int hi) {
    bf16* const H = (bf16*)(C.ws + WS_H); bf16* const Z = (bf16*)(C.ws + WS_Z);
    const float* const MOD = (const float*)(C.ws + WS_MOD);
    const int* const tile_e = (const int*)(C.ws + WS_TILEE);
#define IN(k) (fresh(C), lo <= (k) && (k) < hi)
#define SEAM(k) do { if (IN(k) && IN((k) + 1)) xcd_barrier(bar, C.tid); } while (0)

        const int pb = 2 + l * NPH_LAYER;
        const float* mod_l = MOD + (size_t)l * NB * 6144;
        if constexpr (l == 0) {
            if (IN(pb + PH_NORM1)) for (int rep = 0; rep < REP_NORM1; ++rep) norm_rows(C, args.in[I_X], args.in[I_NORM1], mod_l, 0, 1, H);
            SEAM(pb + PH_NORM1); }
        if (IN(pb + PH_GEMM_IN)) for (int rep = 0; rep < REP_GEMMIN; ++rep) {
            pg8::Gemm g{H, (const bf16*)(C.ws + WS_WIN) + (size_t)l * ZW * DM, NTOK, ZW, DM, nullptr, 0, nullptr}; pg8::StaticOrder S; S.init(NTOK, ZW, C.G, C.bx);
            pg8::EpiStore E{Z, ZW, nullptr};
            pg8::gemm_phase<pg8::EpiStore, pg8::StaticOrder, true, true>(C.lds, g, S, E, C.tid); }
        SEAM(pb + PH_GEMM_IN);
        if (IN(pb + PH_POST)) for (int rep = 0; rep < REP_POST; ++rep) { post_tokens(C, args, l); __syncthreads(); for (int u = C.bx; u < 512; u += C.G) compress_unit(C, args, l, u); }
        SEAM(pb + PH_POST);
        if (IN(pb + PH_ATTN)) for (int rep = 0; rep < REP_ATTN; ++rep) attn_phase(C, (rep + 1 < REP_ATTN) ? ABL_ATTN : 0);
        if (IN(pb + PH_ATTN)) for (int rep = 0; rep < REP_PROJ; ++rep) {
            pg8::Gemm g{(const bf16*)(C.ws + WS_PM), (const bf16*)(C.ws + WS_WPOOL) + (size_t)l * 512 * 512, NTOK, 512, 512, nullptr, 0, nullptr}; pg8::StaticOrder S; S.init(NTOK, 512, C.G, C.bx);
            pg8::EpiStore E{(bf16*)(C.ws + WS_PP), 512, args.in[I_PSCALE] + l * 512};
            pg8::gemm_phase<pg8::EpiStore, pg8::StaticOrder, true, true>(C.lds, g, S, E, C.tid); }
        SEAM(pb + PH_POOLG);
        if (IN(pb + PH_PROJA)) {
            pg8::Gemm g{(const bf16*)(C.ws + WS_PP), (const bf16*)(C.ws + WS_WA) + (size_t)l * 1024 * 512, NTOK, 1024, 512, nullptr, 0, nullptr}; pg8::StaticOrder S; S.init(NTOK, 1024, C.G, C.bx);
            pg8::EpiGate<false> E{(bf16*)(C.ws + WS_MG), 1024, Z + ZC_MG, ZW};
            pg8::gemm_phase<pg8::EpiGate<false>, pg8::StaticOrder, true, true>(C.lds, g, S, E, C.tid); }
        if (IN(pb + PH_PROJA)) { for (int rep = 1; rep < REP_PROJ; ++rep) { {
            pg8::Gemm g{(const bf16*)(C.ws + WS_O), (const bf16*)(C.ws + WS_WB) + (size_t)l * 1024 * 1024, NTOK, 1024, 1024, nullptr, 0, nullptr}; pg8::StaticOrder S; S.init(NTOK, 1024, C.G, C.bx);
            pg8::EpiGate<true> E{(bf16*)(C.ws + WS_MG), 1024, Z + ZC_MG + 1024, ZW};
            pg8::gemm_phase<pg8::EpiGate<true>, pg8::StaticOrder, true, true>(C.lds, g, S, E, C.tid); } {
            pg8::Gemm g{(const bf16*)(C.ws + WS_PP), (const bf16*)(C.ws + WS_WA) + (size_t)l * 1024 * 512, NTOK, 1024, 512, nullptr, 0, nullptr}; pg8::StaticOrder S; S.init(NTOK, 1024, C.G, C.bx);
            pg8::EpiGate<false> E{(bf16*)(C.ws + WS_MG), 1024, Z + ZC_MG, ZW};
            pg8::gemm_phase<pg8::EpiGate<false>, pg8::StaticOrder, true, true>(C.lds, g, S, E, C.tid); } }
            {
            pg8::Gemm g{(const bf16*)(C.ws + WS_O), (const bf16*)(C.ws + WS_WB) + (size_t)l * 1024 * 1024, NTOK, 1024, 1024, nullptr, 0, nullptr}; pg8::StaticOrder S; S.init(NTOK, 1024, C.G, C.bx);
            pg8::EpiGate<true> E{(bf16*)(C.ws + WS_MG), 1024, Z + ZC_MG + 1024, ZW};
            pg8::gemm_phase<pg8::EpiGate<true>, pg8::StaticOrder, true, true>(C.lds, g, S, E, C.tid); } }
        SEAM(pb + PH_PROJB);
        if (IN(pb + PH_OUTG)) { for (int rep = 1; rep < REP_OUTG; ++rep) {
            pg8::Gemm g{(const bf16*)(C.ws + WS_MG), (const bf16*)(C.ws + WS_WOUT) + (size_t)l * 1024 * 1024, NTOK, 1024, 1024, nullptr, 0, nullptr}; pg8::StaticOrder S; S.init(NTOK, 1024, C.G, C.bx);
            pg8::EpiResid E{l == 0 ? args.in[I_X] : args.out, (float*)(C.ws + WS_SCR), mod_l + 2 * DM, 6144};
            pg8::gemm_phase<pg8::EpiResid, pg8::StaticOrder, true, true>(C.lds, g, S, E, C.tid); }
            {
            pg8::Gemm g{(const bf16*)(C.ws + WS_MG), (const bf16*)(C.ws + WS_WOUT) + (size_t)l * 1024 * 1024, NTOK, 1024, 1024, nullptr, 0, nullptr}; pg8::StaticOrder S; S.init(NTOK, 1024, C.G, C.bx);
            pg8::EpiResid E{l == 0 ? args.in[I_X] : args.out, args.out, mod_l + 2 * DM, 6144};
            pg8::gemm_phase<pg8::EpiResid, pg8::StaticOrder, true, true>(C.lds, g, S, E, C.tid); } }
        SEAM(pb + PH_OUTG);
        if (IN(pb + PH_NORM2R)) for (int rep = 0; rep < REP_N2R; ++rep) norm2_router(C, args, l);
        SEAM(pb + PH_NORM2R);
        if (IN(pb + PH_SCATTER)) for (int rep = 0; rep < REP_SCAT; ++rep) moe_scatter(C);
        SEAM(pb + PH_SCATTER);
        if (IN(pb + PH_GATEUP)) for (int rep = 0; rep < REP_MOE; ++rep) { const int R = tile_e[1023];
            pg8::Gemm g{H, (const bf16*)(C.ws + WS_WGU) + (size_t)l * NEXP * 2048 * 1024, R * 256, 2048, 1024, tile_e, (size_t)2048 * 1024 * 2, (const int*)(C.ws + WS_ROWTOK)}; pg8::StaticOrder S; S.init(R * 256, 2048, C.G, C.bx);
            pg8::EpiSwiglu E{(bf16*)(C.ws + WS_ACT), args.in[I_BGU] + (size_t)l * NEXP * 2048, tile_e};
            pg8::gemm_phase<pg8::EpiSwiglu, pg8::StaticOrder, true, true, true>(C.lds, g, S, E, C.tid); }
        SEAM(pb + PH_GATEUP);
        if (IN(pb + PH_DOWN)) for (int rep = 0; rep < REP_MOE; ++rep) { const int R = tile_e[1023];
            pg8::Gemm g{(const bf16*)(C.ws + WS_ACT), (const bf16*)(C.ws + WS_WD) + (size_t)l * NEXP * 1024 * 1024, R * 256, 1024, 1024, tile_e, (size_t)1024 * 1024 * 2, nullptr}; pg8::StaticOrder S; S.init(R * 256, 1024, C.G, C.bx);
            pg8::EpiBiasE E{(bf16*)(C.ws + WS_Y), args.in[I_BD] + (size_t)l * NEXP * 1024, tile_e};
            pg8::gemm_phase<pg8::EpiBiasE, pg8::StaticOrder, true, true>(C.lds, g, S, E, C.tid); }
        SEAM(pb + PH_DOWN);
        if (IN(pb + PH_COMBINE)) { for (int rep = 1; rep < REP_COMB; ++rep) moe_combine(C, args, l, (float*)(C.ws + WS_SCR), false); moe_combine(C, args, l, args.out, l + 1 < NL); }
        SEAM(pb + PH_COMBINE);

#undef IN
#undef SEAM
}
__global__ void __launch_bounds__(NWAVES * 64, 2) fwd(Args args) {
    extern __shared__ __attribute__((aligned(16))) unsigned char lds_raw[];
    Ctx C; C.lds = (LAS unsigned char*)lds_raw; C.tid = threadIdx.x; C.lane = C.tid & 63; C.wave = __builtin_amdgcn_readfirstlane(C.tid >> 6); C.bx = blockIdx.x; C.G = gridDim.x; C.ws = args.ws;
    for (int u = C.tid; u < (LDS_BYTES - MISC_OFF) / 4; u += NWAVES * 64) ((LAS unsigned*)(C.lds + MISC_OFF))[u] = 0u;
    __syncthreads();
    const int lo = args.ph_lo, hi = args.ph_hi;
    unsigned* barw = (unsigned*)(C.ws + WS_CTL) + CW_BAR + (size_t)args.li * XCD_BAR_WORDS;
    XcdBarrier bar; bar.bar = barw; bar.x = 0; bar.st = nullptr;
    if (hi - lo > 1) bar = xcd_barrier_post(barw, (volatile LAS unsigned*)(C.lds + MISC_OFF) + 8, C.tid);
#define IN(k) (fresh(C), lo <= (k) && (k) < hi)
#define SEAM(k) do { if (IN(k) && IN((k) + 1)) xcd_barrier(bar, C.tid); } while (0)
    bf16* const H = (bf16*)(C.ws + WS_H); bf16* const Z = (bf16*)(C.ws + WS_Z);
    const float* const MOD = (const float*)(C.ws + WS_MOD);
    const int* const tile_e = (const int*)(C.ws + WS_TILEE);

    if (IN(0)) for (int rep = 0; rep < REP_P0; ++rep) p0_convert(C, args);
    SEAM(0);
    if (IN(1)) p1_mod(C, args);
    SEAM(1);
    layer_body<0>(C, args, bar, lo, hi); layer_body<1>(C, args, bar, lo, hi); layer_body<2>(C, args, bar, lo, hi); layer_body<3>(C, args, bar, lo, hi);
#undef IN
#undef SEAM
}

extern "C" void kernel_launch(void* const* d_in, const int* in_sizes, int n_in, void* d_out, int out_size, void* d_ws, size_t ws_size, hipStream_t stream) {
    static int grid = 0;
    if (grid == 0) {
        if (n_in != N_IN || out_size != NTOK * DM || ws_size < WS_END) { fprintf(stderr, "kernel_launch: unexpected shapes (n_in %d, out %d, ws %zu < %zu)\n", n_in, out_size, ws_size, (size_t)WS_END); grid = -1; return; }
        int dev = 0, cus = 0;
        if (hipGetDevice(&dev) != hipSuccess || hipDeviceGetAttribute(&cus, hipDeviceAttributeMultiprocessorCount, dev) != hipSuccess) { grid = -1; return; }
        if (hipFuncSetAttribute((const void*)fwd, hipFuncAttributeMaxDynamicSharedMemorySize, LDS_BYTES) != hipSuccess) { fprintf(stderr, "kernel_launch: hipFuncSetAttribute failed\n"); grid = -1; return; }
        int per_cu = 0; (void)hipOccupancyMaxActiveBlocksPerMultiprocessor(&per_cu, (const void*)fwd, NWAVES * 64, LDS_BYTES); (void)hipGetLastError();
        if (cus != 256 || per_cu < 1) fprintf(stderr, "kernel_launch: note: %d CUs, occupancy query %d; this kernel is built for one 512-thread workgroup on each of 256 CUs\n", cus, per_cu);
        grid = 256;
    }
    if (grid < 0) return;
    if (hipMemsetAsync((char*)d_ws + WS_CTL, 0, CTL_ZERO_BYTES, stream) != hipSuccess) return;
    Args a{};
    for (int i = 0; i < N_IN; ++i) a.in[i] = (const float*)d_in[i];
    a.out = (float*)d_out; a.ws = (unsigned char*)d_ws;
#if MK_ONE_LAUNCH
    a.ph_lo = 0; a.ph_hi = NPHASES; a.li = 0; a.pad = 0;
    hipLaunchKernelGGL(fwd, dim3(grid), dim3(NWAVES * 64), LDS_BYTES, stream, a);
#else
    for (int ph = 0; ph < NPHASES; ++ph) { a.ph_lo = ph; a.ph_hi = ph + 1; a.li = 0; a.pad = 0;
        hipLaunchKernelGGL(fwd, dim3(grid), dim3(NWAVES * 64), LDS_BYTES, stream, a); }
#endif
}
```

```cpp
#include <hip/hip_runtime.h>
#include <cstdio>
#include <cstdint>

namespace pg8 {
#define PG8_LAS __attribute__((address_space(3)))
typedef unsigned short bf16_t;
typedef short bf16x8 __attribute__((ext_vector_type(8)));
typedef float f32x4 __attribute__((ext_vector_type(4)));
typedef unsigned u32x4 __attribute__((ext_vector_type(4)));
typedef float f32x2 __attribute__((ext_vector_type(2)));
constexpr int BM = 256, BK = 64, HALF = 128, HTB = HALF * BK * 2  , STAGE_BYTES = 8 * HTB, NXCD = 8, WGM = 8;

__host__ __device__ __forceinline__ int lds_byte(int r, int c) { const int st = (r >> 4) * 2 + (c >> 5), rr = r & 15, cc = c & 31, ob = rr * 64 + cc * 2; return st * 1024 + (ob ^ (((ob >> 9) & 1) << 5)); }
__host__ __device__ __forceinline__ void stage_rc(int b, int& R, int& C) { const int st = b / 1024, sb = b % 1024, swz = sb ^ (((sb >> 9) & 1) << 5); R = (st >> 1) * 16 + swz / 64; C = (st & 1) * 32 + (swz % 64) / 2; }
__host__ __device__ __forceinline__ int perm32(int rho) { const int n = rho >> 4, i = rho & 15; return 8 * (i >> 2) + 4 * n + (i & 3); }

struct Unit { int pm, pn; };
struct Gemm { const bf16_t* A; const bf16_t* Bt; int M, N, K; const int* tile_e; size_t be_stride; const int* row_tok; };

struct StaticOrder {
    int nM, nN, nwg, G, c;
    __host__ __device__ void init(int M, int N, int G_, int c_) { nM = M / BM; nN = N / BM; nwg = nM * nN; G = G_; c = c_; }
    __host__ __device__ bool next(int i, Unit& u) const {
        const long L = (long)i * G + c; if (L >= nwg) return false;
        int wgid = (int)L; { const int q = nwg / NXCD, r = nwg % NXCD, xcd = wgid % NXCD, off = wgid / NXCD; wgid = (xcd < r ? xcd * (q + 1) : r * (q + 1) + (xcd - r) * q) + off; }
        const int nig = WGM * nN, gid = wgid / nig, fm = gid * WGM, gsz = (nM - fm) < WGM ? (nM - fm) : WGM;
        u.pm = fm + ((wgid % nig) % gsz); u.pn = (wgid % nig) / gsz; return true;
    }
    __device__ __forceinline__ void a_ready(const Unit&) const {}
    __device__ __forceinline__ void done(const Unit&) const {}
};

typedef __bf16 bf16x2_t __attribute__((ext_vector_type(2)));
__device__ __forceinline__ unsigned cvt_pk_bf16(float lo, float hi) { const f32x2 v = {lo, hi}; return __builtin_bit_cast(unsigned, __builtin_convertvector(v, bf16x2_t)); }


template <class Epi, class Sched, bool ALIGN_EPI = false, bool SP2 = false, bool GATHER = false  >
__device__ __forceinline__ void gemm_phase(PG8_LAS unsigned char* lds, const Gemm g, const Sched& S, const Epi& E, const int tid_in  ) {
    int tid_ = tid_in; asm volatile("" : "+v"(tid_));
    float zz = 0.f; asm volatile("" : "+v"(zz));
    const int tid = tid_, wid = __builtin_amdgcn_readfirstlane(tid >> 6), lane = tid & 63, wr = wid >> 2, wc = wid & 3, fr = lane & 15, fq = lane >> 4;
    const int K = g.K, nt = K / BK;
    unsigned voffA[2], voffB[2];
    unsigned vgC[2][2], vgN[2][2], vgS[2][2];
#pragma unroll
    for (int i = 0; i < 2; ++i) { int R, C; stage_rc(tid * 16 + i * 8192, R, C); const int Rb = Epi::PERM ? ((R & ~31) + perm32(R & 31)) : R;
        voffA[i] = (unsigned)(R * K + C) * 2u; voffB[i] = (unsigned)(Rb * K + C) * 2u; }
    const size_t kstep = (size_t)(BK * 2);
    const size_t hstep = (size_t)HALF * K * 2;
    const size_t tstep = 2 * hstep;
    const unsigned ldsw = (unsigned)wid * 1024u;
    const int aoff = lds_byte(wr * 64 + fr, fq * 8), boff = lds_byte(wc * 32 + fr, fq * 8);
#define PG8_SA(b, h) (((b) * 2 + (h)) * HTB)
#define PG8_SB(b, h) ((4 + (b) * 2 + (h)) * HTB)
#define PG8_STAGE(bufoff, gbase, voff) do { _Pragma("unroll") for (int _i = 0; _i < 2; ++_i) \
        __builtin_amdgcn_global_load_lds((const unsigned*)((const char*)(gbase) + (voff)[_i]), (PG8_LAS unsigned*)(lds + (bufoff) + ldsw + _i * 8192), 16, 0, 0); } while (0)
#define PG8_STAGE_A(bufoff, ptr, h, VG) do { if constexpr (GATHER) { PG8_STAGE(bufoff, ptr, VG[h]); } else { PG8_STAGE(bufoff, (ptr) + (h) * hstep, voffA); } } while (0)
#define PG8_ROWS(u, VG) do { _Pragma("unroll") for (int _h = 0; _h < 2; ++_h) _Pragma("unroll") for (int _i = 0; _i < 2; ++_i) { int _R, _C; stage_rc(tid * 16 + _i * 8192, _R, _C); \
        VG[_h][_i] = ((unsigned)g.row_tok[(u).pm * BM + _h * HALF + _R] * (unsigned)K + (unsigned)_C) * 2u; } } while (0)
#define PG8_LDA(dst, b, h) do { _Pragma("unroll") for (int m = 0; m < 4; ++m) _Pragma("unroll") for (int k = 0; k < 2; ++k) dst[m][k] = *(const PG8_LAS bf16x8*)(lds + PG8_SA(b, h) + aoff + m * 2048 + k * 1024); } while (0)
#define PG8_LDB(dst, b, h) do { _Pragma("unroll") for (int n = 0; n < 2; ++n) _Pragma("unroll") for (int k = 0; k < 2; ++k) dst[n][k] = *(const PG8_LAS bf16x8*)(lds + PG8_SB(b, h) + boff + n * 2048 + k * 1024); } while (0)
#define PG8_MMA(ai, bj, At, Bt) do { __builtin_amdgcn_s_setprio(1); _Pragma("unroll") for (int m = 0; m < 4; ++m) _Pragma("unroll") for (int n = 0; n < 2; ++n) _Pragma("unroll") for (int k = 0; k < 2; ++k) \
        acc[ai][bj][m][n] = __builtin_amdgcn_mfma_f32_16x16x32_bf16(Bt[n][k], At[m][k], acc[ai][bj][m][n], 0, 0, 0); __builtin_amdgcn_s_setprio(0); } while (0)
#define PG8_WAIT_V(n) asm volatile("s_waitcnt vmcnt(" #n ")" ::: "memory")
#define PG8_WAIT_L(n) asm volatile("s_waitcnt lgkmcnt(" #n ")" ::: "memory")
#define PG8_BAR __builtin_amdgcn_s_barrier()
#define PG8_SCHED __builtin_amdgcn_sched_barrier(0)
    Unit cur, nxt; int ui = 0;
    if (!S.next(0, cur)) return;
    f32x4 acc[2][2][4][2];
#pragma unroll
    for (int a = 0; a < 2; ++a)
#pragma unroll
        for (int b = 0; b < 2; ++b)
#pragma unroll
            for (int m = 0; m < 4; ++m)
#pragma unroll
                for (int n = 0; n < 2; ++n) acc[a][b][m][n] = (f32x4){zz, zz, zz, zz};
    bf16x8 At[4][2], B0[2][2], B1[2][2];
    const char* cA = (const char*)g.A + (GATHER ? (size_t)0 : (size_t)cur.pm * tstep); const char* cB = (const char*)g.Bt + (g.tile_e ? (size_t)g.tile_e[cur.pm] * g.be_stride : (size_t)0) + (size_t)cur.pn * tstep;
    if constexpr (GATHER) { PG8_ROWS(cur, vgC); }
    S.a_ready(cur);
    if constexpr (SP2) {
        PG8_STAGE(PG8_SB(0, 0), cB, voffB); PG8_STAGE(PG8_SB(0, 1), cB + hstep, voffB); PG8_STAGE_A(PG8_SA(0, 0), cA, 0, vgC); PG8_STAGE_A(PG8_SA(0, 1), cA, 1, vgC);
        if (wr == 1) PG8_BAR;
        PG8_WAIT_V(2); PG8_BAR;
        PG8_STAGE(PG8_SB(1, 0), cB + kstep, voffB); PG8_STAGE_A(PG8_SA(1, 0), cA + kstep, 0, vgC); PG8_STAGE(PG8_SB(1, 1), cB + hstep + kstep, voffB);
        PG8_WAIT_V(6); PG8_BAR;
    } else {
        PG8_STAGE(PG8_SB(0, 0), cB, voffB); PG8_STAGE_A(PG8_SA(0, 0), cA, 0, vgC); PG8_STAGE(PG8_SB(0, 1), cB + hstep, voffB); PG8_STAGE_A(PG8_SA(0, 1), cA, 1, vgC);
        if (wr == 1) PG8_BAR;
        PG8_WAIT_V(4); PG8_BAR;
        PG8_STAGE(PG8_SB(1, 0), cB + kstep, voffB); PG8_STAGE_A(PG8_SA(1, 0), cA + kstep, 0, vgC); PG8_STAGE(PG8_SB(1, 1), cB + hstep + kstep, voffB);
        PG8_WAIT_V(6); PG8_BAR;
    }
    for (;;) {
        const bool has_next = S.next(ui + 1, nxt);
        if constexpr (GATHER) { if (has_next) { PG8_ROWS(nxt, vgN); } else { _Pragma("unroll") for (int _h = 0; _h < 2; ++_h) _Pragma("unroll") for (int _i = 0; _i < 2; ++_i) vgN[_h][_i] = vgC[_h][_i]; } }
        const char* nA = (has_next && !GATHER) ? (const char*)g.A + (size_t)nxt.pm * tstep : cA; const char* nB = has_next ? (const char*)g.Bt + (g.tile_e ? (size_t)g.tile_e[nxt.pm] * g.be_stride : (size_t)0) + (size_t)nxt.pn * tstep : cB;
        for (int t = 0; t < nt; t += 2) {
            const bool last = (t == nt - 2);
            if constexpr (GATHER) { _Pragma("unroll") for (int _h = 0; _h < 2; ++_h) _Pragma("unroll") for (int _i = 0; _i < 2; ++_i) vgS[_h][_i] = last ? vgN[_h][_i] : vgC[_h][_i]; }
            const char* a1 = cA + (size_t)(t + 1) * kstep;
            const char* a2 = last ? nA : cA + (size_t)(t + 2) * kstep; const char* b2 = last ? nB : cB + (size_t)(t + 2) * kstep;
            const char* a3 = a2 + kstep; const char* b3 = b2 + kstep;
            if (last && has_next) S.a_ready(nxt);
            if constexpr (SP2) {
            PG8_LDB(B0, 0, 0); PG8_LDB(B1, 0, 1); PG8_SCHED; PG8_LDA(At, 0, 0); PG8_STAGE_A(PG8_SA(1, 1), a1, 1, vgC);
            PG8_WAIT_V(8); PG8_WAIT_L(0); PG8_BAR; PG8_MMA(0, 0, At, B0); PG8_MMA(0, 1, At, B1); PG8_BAR; PG8_SCHED;
            PG8_LDA(At, 0, 1); PG8_STAGE(PG8_SB(0, 0), b2, voffB); PG8_STAGE(PG8_SB(0, 1), b2 + hstep, voffB); PG8_STAGE_A(PG8_SA(0, 0), a2, 0, vgS);
            PG8_WAIT_V(8); PG8_WAIT_L(0); PG8_BAR; PG8_MMA(1, 0, At, B0); PG8_MMA(1, 1, At, B1); PG8_BAR; PG8_SCHED;
            PG8_LDB(B0, 1, 0); PG8_LDB(B1, 1, 1); PG8_SCHED; PG8_LDA(At, 1, 0); PG8_STAGE_A(PG8_SA(0, 1), a2, 1, vgS);
            PG8_WAIT_V(8); PG8_WAIT_L(0); PG8_BAR; PG8_MMA(0, 0, At, B0); PG8_MMA(0, 1, At, B1); PG8_BAR; PG8_SCHED;
            PG8_LDA(At, 1, 1); PG8_STAGE(PG8_SB(1, 0), b3, voffB); PG8_STAGE(PG8_SB(1, 1), b3 + hstep, voffB); PG8_STAGE_A(PG8_SA(1, 0), a3, 0, vgS);
            PG8_WAIT_V(8); PG8_WAIT_L(0); PG8_BAR; PG8_MMA(1, 0, At, B0); PG8_MMA(1, 1, At, B1); PG8_BAR; PG8_SCHED;
            } else {
            PG8_LDB(B0, 0, 0); PG8_SCHED; PG8_LDA(At, 0, 0); PG8_STAGE_A(PG8_SA(1, 1), a1, 1, vgC);
            PG8_WAIT_L(8); PG8_BAR; PG8_WAIT_L(0); PG8_MMA(0, 0, At, B0); PG8_BAR; PG8_SCHED;
            PG8_LDB(B1, 0, 1); PG8_STAGE(PG8_SB(0, 0), b2, voffB);
            PG8_BAR; PG8_WAIT_L(0); PG8_MMA(0, 1, At, B1); PG8_BAR;
            PG8_LDA(At, 0, 1); PG8_STAGE_A(PG8_SA(0, 0), a2, 0, vgS);
            PG8_BAR; PG8_WAIT_L(0); PG8_MMA(1, 0, At, B0); PG8_BAR; PG8_SCHED;
            PG8_STAGE(PG8_SB(0, 1), b2 + hstep, voffB);
            PG8_WAIT_V(6); PG8_BAR; PG8_MMA(1, 1, At, B1); PG8_BAR;
            PG8_LDB(B0, 1, 0); PG8_SCHED; PG8_LDA(At, 1, 0); PG8_STAGE_A(PG8_SA(0, 1), a2, 1, vgS);
            PG8_WAIT_L(8); PG8_BAR; PG8_WAIT_L(0); PG8_MMA(0, 0, At, B0); PG8_BAR; PG8_SCHED;
            PG8_LDB(B1, 1, 1); PG8_STAGE(PG8_SB(1, 0), b3, voffB);
            PG8_BAR; PG8_WAIT_L(0); PG8_MMA(0, 1, At, B1); PG8_BAR;
            PG8_LDA(At, 1, 1); PG8_STAGE_A(PG8_SA(1, 0), a3, 0, vgS);
            PG8_BAR; PG8_WAIT_L(0); PG8_MMA(1, 0, At, B0); PG8_BAR; PG8_SCHED;
            PG8_STAGE(PG8_SB(1, 1), b3 + hstep, voffB);
            PG8_WAIT_V(6); PG8_BAR; PG8_MMA(1, 1, At, B1); PG8_BAR;
            }
        }
        if constexpr (ALIGN_EPI) { if (wr == 0) PG8_BAR; }
        if constexpr (!Epi::AFTER_DRAIN) { E(acc, cur, wr, wc, fr, fq); S.done(cur); }
        if (!has_next) break;
#pragma unroll
        for (int a = 0; a < 2; ++a)
#pragma unroll
            for (int b = 0; b < 2; ++b)
#pragma unroll
                for (int m = 0; m < 4; ++m)
#pragma unroll
                    for (int n = 0; n < 2; ++n) acc[a][b][m][n] = (f32x4){zz, zz, zz, zz};
        cur = nxt; cA = nA; cB = nB; ++ui; if constexpr (GATHER) { _Pragma("unroll") for (int _h = 0; _h < 2; ++_h) _Pragma("unroll") for (int _i = 0; _i < 2; ++_i) vgC[_h][_i] = vgN[_h][_i]; }
        if constexpr (ALIGN_EPI) { if (wr == 1) PG8_BAR; }
    }
    PG8_WAIT_V(0);
    if constexpr (!ALIGN_EPI) { if (wr == 0) PG8_BAR; }
    PG8_BAR;
    if constexpr (Epi::AFTER_DRAIN) { E.fused(acc, cur, wr, wc, fr, fq, lds, wid, lane); S.done(cur); }
#undef PG8_SA
#undef PG8_SB
#undef PG8_STAGE
#undef PG8_STAGE_A
#undef PG8_ROWS
#undef PG8_LDA
#undef PG8_LDB
#undef PG8_MMA
#undef PG8_WAIT_V
#undef PG8_WAIT_L
#undef PG8_BAR
#undef PG8_SCHED
}

__device__ __forceinline__ float sigmoidf_(float x) { return __builtin_amdgcn_rcpf(1.0f + __builtin_amdgcn_exp2f(x * -1.4426950408889634f)); }
__device__ __forceinline__ float bflo(unsigned w) { return __uint_as_float(w << 16); }
__device__ __forceinline__ float bfhi(unsigned w) { return __uint_as_float(w & 0xffff0000u); }

struct EpiStore {
    static constexpr bool PERM = true, AFTER_DRAIN = false;
    bf16_t* O; int ldc; const float* cs;
    __device__ __forceinline__ void operator()(const f32x4 (&acc)[2][2][4][2], const Unit& u, int wr, int wc, int fr, int fq) const {
        const int row0 = u.pm * BM + wr * 64 + fr, col0 = u.pn * BM + wc * 32 + 8 * fq;
        f32x4 sv[2][2];
#pragma unroll
        for (int bj = 0; bj < 2; ++bj)
#pragma unroll
            for (int n = 0; n < 2; ++n) sv[bj][n] = cs ? *(const f32x4*)(cs + col0 + bj * HALF + 4 * n) : (f32x4){1.f, 1.f, 1.f, 1.f};
#pragma unroll
        for (int ai = 0; ai < 2; ++ai)
#pragma unroll
            for (int m = 0; m < 4; ++m) { bf16_t* rowp = O + (size_t)(row0 + ai * HALF + m * 16) * ldc + col0;
#pragma unroll
                for (int bj = 0; bj < 2; ++bj) { const f32x4 v0 = acc[ai][bj][m][0] * sv[bj][0], v1 = acc[ai][bj][m][1] * sv[bj][1];
                    u32x4 w; w.x = cvt_pk_bf16(v0[0], v0[1]); w.y = cvt_pk_bf16(v0[2], v0[3]); w.z = cvt_pk_bf16(v1[0], v1[1]); w.w = cvt_pk_bf16(v1[2], v1[3]);
                    *(u32x4*)(rowp + bj * HALF) = w; } }
    }
};
struct EpiIn {
    static constexpr bool PERM = true, AFTER_DRAIN = false;
    bf16_t* Z; bf16_t* Qn; bf16_t* Kslc; bf16_t* Kwin; const float* qn; const float* kn  ; const float* rope  ;
    __device__ __forceinline__ void operator()(const f32x4 (&acc)[2][2][4][2], const Unit& u, int wr, int wc, int fr, int fq) const {
        const int row0 = u.pm * BM + wr * 64 + fr, lane = fq * 16 + fr;
        const bool isq = (u.pn >= 2 && u.pn < 6), isk = ((u.pn == 7 || u.pn == 8) && wc < 2);
        if (!isq && !isk) {
            const int col0 = u.pn * BM + wc * 64 + 8 * fq;
#pragma unroll
            for (int ai = 0; ai < 2; ++ai)
#pragma unroll
                for (int m = 0; m < 4; ++m) { bf16_t* rowp = Z + (size_t)(row0 + ai * HALF + m * 16) * 4608 + col0;
#pragma unroll
                    for (int bj = 0; bj < 2; ++bj) { const f32x4 v0 = acc[ai][bj][m][0], v1 = acc[ai][bj][m][1];
                        u32x4 w; w.x = cvt_pk_bf16(v0[0], v0[1]); w.y = cvt_pk_bf16(v0[2], v0[3]); w.z = cvt_pk_bf16(v1[0], v1[1]); w.w = cvt_pk_bf16(v1[2], v1[3]);
                        *(u32x4*)(rowp + bj * 32) = w; } }
            return; }
        const float* gp = isq ? qn : kn + (u.pn == 7 ? 64 : 128); const float gsc = isq ? 0.18033688011112042f : 1.0f;
        f32x4 g[2][2];
#pragma unroll
        for (int bj = 0; bj < 2; ++bj) { g[bj][0] = *(const f32x4*)(gp + 32 * bj + 8 * fq) * gsc; g[bj][1] = *(const f32x4*)(gp + 32 * bj + 8 * fq + 4) * gsc; }
#pragma unroll
        for (int ai = 0; ai < 2; ++ai)
#pragma unroll
            for (int m = 0; m < 4; ++m) { const int row = row0 + ai * HALF + m * 16, t = row & 8191;
                f32x4 x[2][2]; float ss = 0.f;
#pragma unroll
                for (int bj = 0; bj < 2; ++bj)
#pragma unroll
                    for (int n = 0; n < 2; ++n) { x[bj][n] = acc[ai][bj][m][n]; ss += (x[bj][n][0] * x[bj][n][0] + x[bj][n][1] * x[bj][n][1]) + (x[bj][n][2] * x[bj][n][2] + x[bj][n][3] * x[bj][n][3]); }
                ss += __int_as_float(__builtin_amdgcn_ds_bpermute((lane ^ 16) << 2, __float_as_int(ss))); ss += __int_as_float(__builtin_amdgcn_ds_bpermute((lane ^ 32) << 2, __float_as_int(ss)));
                const float rstd = 1.0f / sqrtf(ss * (1.0f / 64.0f) + 1e-6f);
#pragma unroll
                for (int bj = 0; bj < 2; ++bj)
#pragma unroll
                    for (int n = 0; n < 2; ++n) x[bj][n] = x[bj][n] * rstd * g[bj][n];
                f32x4 p0, p1;
#pragma unroll
                for (int i = 0; i < 4; ++i) { p0[i] = __int_as_float(__builtin_amdgcn_ds_bpermute((lane ^ 16) << 2, __float_as_int(x[0][0][i]))); p1[i] = __int_as_float(__builtin_amdgcn_ds_bpermute((lane ^ 16) << 2, __float_as_int(x[0][1][i]))); }
                if (fq < 2) { const float* rp = rope + t * 16; const f32x4 c0 = *(const f32x4*)rp, c1 = *(const f32x4*)(rp + 4), s0 = *(const f32x4*)(rp + 8), s1 = *(const f32x4*)(rp + 12);
                    if (fq == 0) { x[0][0] = x[0][0] * c0 - p0 * s0; x[0][1] = x[0][1] * c1 - p1 * s1; } else { x[0][0] = x[0][0] * c0 + p0 * s0; x[0][1] = x[0][1] * c1 + p1 * s1; } }
                bf16_t* dst = isq ? Qn + (size_t)row * 1024 + ((u.pn - 2) * 4 + wc) * 64 + 8 * fq
                                  : (u.pn == 7 ? Kslc : Kwin) + ((size_t)((row >> 13) * 2 + wc) * 8192 + t) * 64 + 8 * fq;
#pragma unroll
                for (int bj = 0; bj < 2; ++bj) { u32x4 w; w.x = cvt_pk_bf16(x[bj][0][0], x[bj][0][1]); w.y = cvt_pk_bf16(x[bj][0][2], x[bj][0][3]); w.z = cvt_pk_bf16(x[bj][1][0], x[bj][1][1]); w.w = cvt_pk_bf16(x[bj][1][2], x[bj][1][3]);
                    *(u32x4*)(dst + 32 * bj) = w; } }
    }
};
template <bool ADD> struct EpiGate {
    static constexpr bool PERM = true, AFTER_DRAIN = false;
    bf16_t* O; int ldc; const bf16_t* G; int ldg;
    __device__ __forceinline__ void operator()(const f32x4 (&acc)[2][2][4][2], const Unit& u, int wr, int wc, int fr, int fq) const {
        const int row0 = u.pm * BM + wr * 64 + fr, col0 = u.pn * BM + wc * 32 + 8 * fq;
#pragma unroll
        for (int ai = 0; ai < 2; ++ai)
#pragma unroll
            for (int m = 0; m < 4; ++m) { const size_t row = (size_t)(row0 + ai * HALF + m * 16); bf16_t* rowp = O + row * ldc + col0; const bf16_t* gp = G + row * ldg + col0;
#pragma unroll
                for (int bj = 0; bj < 2; ++bj) { const u32x4 gw = *(const u32x4*)(gp + bj * HALF);
                    f32x4 v0 = acc[ai][bj][m][0], v1 = acc[ai][bj][m][1];
                    v0[0] *= sigmoidf_(bflo(gw.x)); v0[1] *= sigmoidf_(bfhi(gw.x)); v0[2] *= sigmoidf_(bflo(gw.y)); v0[3] *= sigmoidf_(bfhi(gw.y));
                    v1[0] *= sigmoidf_(bflo(gw.z)); v1[1] *= sigmoidf_(bfhi(gw.z)); v1[2] *= sigmoidf_(bflo(gw.w)); v1[3] *= sigmoidf_(bfhi(gw.w));
                    if (ADD) { const u32x4 ow = *(const u32x4*)(rowp + bj * HALF);
                        v0[0] += bflo(ow.x); v0[1] += bfhi(ow.x); v0[2] += bflo(ow.y); v0[3] += bfhi(ow.y);
                        v1[0] += bflo(ow.z); v1[1] += bfhi(ow.z); v1[2] += bflo(ow.w); v1[3] += bfhi(ow.w); }
                    u32x4 w; w.x = cvt_pk_bf16(v0[0], v0[1]); w.y = cvt_pk_bf16(v0[2], v0[3]); w.z = cvt_pk_bf16(v1[0], v1[1]); w.w = cvt_pk_bf16(v1[2], v1[3]);
                    *(u32x4*)(rowp + bj * HALF) = w; } }
    }
};
struct EpiResid {
    static constexpr bool PERM = false, AFTER_DRAIN = false;
    const float* Xin; float* Xout; const float* modp; int mod_bstride; float* ssq;
    __device__ __forceinline__ void operator()(const f32x4 (&acc)[2][2][4][2], const Unit& u, int wr, int wc, int fr, int fq) const {
        const int row0 = u.pm * BM + wr * 64 + fr, col0 = u.pn * BM + wc * 32 + 4 * fq;
        const float* gp = modp + (size_t)((u.pm * BM) >> 13) * mod_bstride;
        f32x4 gv[2][2];
#pragma unroll
        for (int bj = 0; bj < 2; ++bj)
#pragma unroll
            for (int n = 0; n < 2; ++n) gv[bj][n] = *(const f32x4*)(gp + col0 + bj * HALF + n * 16);
#pragma unroll
        for (int ai = 0; ai < 2; ++ai)
#pragma unroll
            for (int m = 0; m < 4; ++m) { const int row = row0 + ai * HALF + m * 16; const size_t off = (size_t)row * 1024 + col0; float q = 0.f;
#pragma unroll
                for (int bj = 0; bj < 2; ++bj)
#pragma unroll
                    for (int n = 0; n < 2; ++n) { const f32x4 xo = *(const f32x4*)(Xin + off + bj * HALF + n * 16); const f32x4 xn = xo + gv[bj][n] * acc[ai][bj][m][n];
                        *(f32x4*)(Xout + off + bj * HALF + n * 16) = xn; q += (xn[0] * xn[0] + xn[1] * xn[1]) + (xn[2] * xn[2] + xn[3] * xn[3]); }
                const int lane = fq * 16 + fr;
                q += __int_as_float(__builtin_amdgcn_ds_bpermute((lane ^ 16) << 2, __float_as_int(q))); q += __int_as_float(__builtin_amdgcn_ds_bpermute((lane ^ 32) << 2, __float_as_int(q)));
                if (fq == 0) ssq[(size_t)row * 16 + u.pn * 4 + wc] = q; }
    }
};
template <bool IN32> struct EpiResidB {
    static constexpr bool PERM = true, AFTER_DRAIN = false;
    const float* Xin32; bf16_t* XB; const float* modp; int mod_bstride; float* ssq;
    __device__ __forceinline__ void operator()(const f32x4 (&acc)[2][2][4][2], const Unit& u, int wr, int wc, int fr, int fq) const {
        const int row0 = u.pm * BM + wr * 64 + fr, col0 = u.pn * BM + wc * 32 + 8 * fq;
        const float* gp = modp + (size_t)((u.pm * BM) >> 13) * mod_bstride;
        f32x4 gv[2][2];
#pragma unroll
        for (int bj = 0; bj < 2; ++bj)
#pragma unroll
            for (int n = 0; n < 2; ++n) gv[bj][n] = *(const f32x4*)(gp + col0 + bj * HALF + 4 * n);
#pragma unroll
        for (int ai = 0; ai < 2; ++ai)
#pragma unroll
            for (int mp = 0; mp < 2; ++mp) {
                f32x4 xo[2][2][2];
#pragma unroll
                for (int mi = 0; mi < 2; ++mi) { const size_t off = (size_t)(row0 + ai * HALF + (2 * mp + mi) * 16) * 1024 + col0;
#pragma unroll
                    for (int bj = 0; bj < 2; ++bj) {
                        if constexpr (IN32) { xo[mi][bj][0] = *(const f32x4*)(Xin32 + off + bj * HALF); xo[mi][bj][1] = *(const f32x4*)(Xin32 + off + bj * HALF + 4); }
                        else { const u32x4 w = *(const u32x4*)(XB + off + bj * HALF); xo[mi][bj][0] = (f32x4){bflo(w.x), bfhi(w.x), bflo(w.y), bfhi(w.y)}; xo[mi][bj][1] = (f32x4){bflo(w.z), bfhi(w.z), bflo(w.w), bfhi(w.w)}; } } }
#pragma unroll
                for (int mi = 0; mi < 2; ++mi) { const int m = 2 * mp + mi; const int row = row0 + ai * HALF + m * 16; const size_t off = (size_t)row * 1024 + col0; float q = 0.f;
#pragma unroll
                    for (int bj = 0; bj < 2; ++bj) { const f32x4 x0 = xo[mi][bj][0] + gv[bj][0] * acc[ai][bj][m][0], x1 = xo[mi][bj][1] + gv[bj][1] * acc[ai][bj][m][1];
                        u32x4 w; w.x = cvt_pk_bf16(x0[0], x0[1]); w.y = cvt_pk_bf16(x0[2], x0[3]); w.z = cvt_pk_bf16(x1[0], x1[1]); w.w = cvt_pk_bf16(x1[2], x1[3]);
                        *(u32x4*)(XB + off + bj * HALF) = w;
                        q += ((x0[0] * x0[0] + x0[1] * x0[1]) + (x0[2] * x0[2] + x0[3] * x0[3])) + ((x1[0] * x1[0] + x1[1] * x1[1]) + (x1[2] * x1[2] + x1[3] * x1[3])); }
                    const int lane = fq * 16 + fr;
                    q += __int_as_float(__builtin_amdgcn_ds_bpermute((lane ^ 16) << 2, __float_as_int(q))); q += __int_as_float(__builtin_amdgcn_ds_bpermute((lane ^ 32) << 2, __float_as_int(q)));
                    if (fq == 0) ssq[(size_t)row * 16 + u.pn * 4 + wc] = q; } }
    }
};
__device__ __forceinline__ float swiglu_(float g, float u) { g = fminf(g, 7.0f); u = fminf(fmaxf(u, -7.0f), 7.0f); return (u + 1.0f) * g * sigmoidf_(g * 1.702f); }
__device__ __forceinline__ f32x2 swiglu2_(const f32x4 v) {
    f32x2 g = {fminf(v[0], 7.0f), fminf(v[2], 7.0f)}, u = {fminf(fmaxf(v[1], -7.0f), 7.0f), fminf(fmaxf(v[3], -7.0f), 7.0f)};
    const f32x2 t = g * (1.702f * -1.4426950408889634f); f32x2 e; e.x = __builtin_amdgcn_exp2f(t.x); e.y = __builtin_amdgcn_exp2f(t.y);
    const f32x2 d = e + 1.0f; f32x2 r; r.x = __builtin_amdgcn_rcpf(d.x); r.y = __builtin_amdgcn_rcpf(d.y);
    return ((u + 1.0f) * g) * r;
}
struct EpiSwiglu {
    static constexpr bool PERM = true, AFTER_DRAIN = false;
    bf16_t* ACT; const float* bias; const int* tile_e;
    __device__ __forceinline__ void operator()(const f32x4 (&acc)[2][2][4][2], const Unit& u, int wr, int wc, int fr, int fq) const {
        const int row0 = u.pm * BM + wr * 64 + fr, col0 = u.pn * BM + wc * 32 + 8 * fq;
        const float* bp = bias + (size_t)tile_e[u.pm] * 2048;
        f32x4 bv[2][2];
#pragma unroll
        for (int bj = 0; bj < 2; ++bj)
#pragma unroll
            for (int n = 0; n < 2; ++n) bv[bj][n] = *(const f32x4*)(bp + col0 + bj * HALF + 4 * n);
#pragma unroll
        for (int ai = 0; ai < 2; ++ai)
#pragma unroll
            for (int m = 0; m < 4; ++m) { bf16_t* rowp = ACT + (size_t)(row0 + ai * HALF + m * 16) * 1024 + (col0 >> 1);
#pragma unroll
                for (int bj = 0; bj < 2; ++bj) { const f32x4 v0 = acc[ai][bj][m][0] + bv[bj][0], v1 = acc[ai][bj][m][1] + bv[bj][1];
                    typedef unsigned u32x2v __attribute__((ext_vector_type(2)));
                    const f32x2 a0 = swiglu2_(v0), a1 = swiglu2_(v1); u32x2v w; w.x = cvt_pk_bf16(a0.x, a0.y); w.y = cvt_pk_bf16(a1.x, a1.y);
                    *(u32x2v*)(rowp + bj * (HALF / 2)) = w; } }
    }
};
struct EpiBiasE {
    static constexpr bool PERM = true, AFTER_DRAIN = false;
    bf16_t* O; const float* bias; const int* tile_e;
    __device__ __forceinline__ void operator()(const f32x4 (&acc)[2][2][4][2], const Unit& u, int wr, int wc, int fr, int fq) const {
        const int row0 = u.pm * BM + wr * 64 + fr, col0 = u.pn * BM + wc * 32 + 8 * fq;
        const float* bp = bias + (size_t)tile_e[u.pm] * 1024;
        f32x4 bv[2][2];
#pragma unroll
        for (int bj = 0; bj < 2; ++bj)
#pragma unroll
            for (int n = 0; n < 2; ++n) bv[bj][n] = *(const f32x4*)(bp + col0 + bj * HALF + 4 * n);
#pragma unroll
        for (int ai = 0; ai < 2; ++ai)
#pragma unroll
            for (int m = 0; m < 4; ++m) { bf16_t* rowp = O + (size_t)(row0 + ai * HALF + m * 16) * 1024 + col0;
#pragma unroll
                for (int bj = 0; bj < 2; ++bj) { const f32x4 v0 = acc[ai][bj][m][0] + bv[bj][0], v1 = acc[ai][bj][m][1] + bv[bj][1];
                    u32x4 w; w.x = cvt_pk_bf16(v0[0], v0[1]); w.y = cvt_pk_bf16(v0[2], v0[3]); w.z = cvt_pk_bf16(v1[0], v1[1]); w.w = cvt_pk_bf16(v1[2], v1[3]);
                    *(u32x4*)(rowp + bj * HALF) = w; } }
    }
};
}


constexpr int NL = 4, NB = 4, SEQ = 8192, DM = 1024, NTOK = NB * SEQ;
constexpr int ZW = 4608;
constexpr int ZC_U = 0, ZC_Q = 512, ZC_KCM = 1536, ZC_VCM = 1664, ZC_KSL = 1792, ZC_VSL = 1920, ZC_KWN = 2048, ZC_VWN = 2176, ZC_MG = 2304, ZC_NG = 4352;
constexpr int IN_W = 4400;
constexpr int NEXP = 32, MOE_ROWS_MAX = (NTOK * 4 / 256 + NEXP) * 256;
constexpr int NPH_LAYER = 13, NPHASES = 2 + NL * NPH_LAYER;
enum { PH_NORM1 = 0, PH_GEMM_IN, PH_POST, PH_ATTN, PH_POOLG, PH_PROJA, PH_PROJB, PH_OUTG, PH_NORM2R, PH_SCATTER, PH_GATEUP, PH_DOWN, PH_COMBINE };

constexpr size_t alignup(size_t x) { return (x + 255) & ~(size_t)255; }
constexpr size_t WS_CTL = 0, CTL_ZERO_BYTES = 1u << 20;
constexpr size_t WS_MOD = WS_CTL + CTL_ZERO_BYTES;
constexpr size_t WS_MODP = WS_MOD + alignup((size_t)NL * NB * 6144 * 4);
constexpr size_t WS_ROPE = WS_MODP + alignup((size_t)16 * NL * NB * 6144 * 4);
constexpr size_t WS_WIN = WS_ROPE + alignup((size_t)SEQ * 16 * 4);
constexpr size_t WS_WPOOL = WS_WIN + alignup((size_t)NL * ZW * DM * 2);
constexpr size_t WS_WA = WS_WPOOL + alignup((size_t)NL * 512 * 512 * 2);
constexpr size_t WS_WB = WS_WA + alignup((size_t)NL * 1024 * 512 * 2);
constexpr size_t WS_WOUT = WS_WB + alignup((size_t)NL * 1024 * 1024 * 2);
constexpr size_t WS_W1 = WS_WOUT + alignup((size_t)NL * 1024 * 1024 * 2);
constexpr size_t WS_W2 = WS_W1 + alignup((size_t)NL * 2 * 256 * 2048 * 2);
constexpr size_t WS_WGU = WS_W2 + alignup((size_t)NL * 2 * 64 * 256 * 2);
constexpr size_t WS_WD = WS_WGU + alignup((size_t)NL * NEXP * 2048 * 1024 * 2);
constexpr size_t WS_H = WS_WD + alignup((size_t)NL * NEXP * 1024 * 1024 * 2);
constexpr size_t WS_Z = WS_H + alignup((size_t)NTOK * DM * 2);
constexpr size_t WS_QN = WS_Z + alignup((size_t)NTOK * ZW * 2);
constexpr size_t WS_KSLC = WS_QN + alignup((size_t)NTOK * DM * 2);
constexpr size_t WS_KWIN = WS_KSLC + alignup((size_t)NB * 2 * SEQ * 64 * 2);
constexpr size_t WS_VSLCT = WS_KWIN + alignup((size_t)NB * 2 * SEQ * 64 * 2);
constexpr size_t WS_VWINT = WS_VSLCT + alignup((size_t)NB * 2 * SEQ * 64 * 2);
constexpr size_t WS_KC = WS_VWINT + alignup((size_t)NB * 2 * SEQ * 64 * 2);
constexpr size_t WS_VCT = WS_KC + alignup((size_t)NB * 2 * 512 * 64 * 2);
constexpr size_t WS_PM = WS_VCT + alignup((size_t)NB * 2 * 512 * 64 * 2);
constexpr size_t WS_PP = WS_PM + alignup((size_t)NTOK * 512 * 2);
constexpr size_t WS_O = WS_PP + alignup((size_t)NTOK * 512 * 2);
constexpr size_t WS_MG = WS_O + alignup((size_t)NTOK * DM * 2);
constexpr size_t WS_TOPE = WS_MG + alignup((size_t)NTOK * DM * 2);
constexpr size_t WS_TOPW = WS_TOPE + alignup((size_t)NTOK * 4 * 4);
constexpr size_t WS_DEST = WS_TOPW + alignup((size_t)NTOK * 4 * 4);
constexpr size_t WS_CNT = WS_DEST + alignup((size_t)NTOK * 4 * 4);
constexpr size_t WS_TILEE = WS_CNT + alignup((size_t)1024 * 32 * 4);
constexpr size_t WS_ROWTOK = WS_TILEE + alignup((size_t)1024 * 4);
constexpr size_t WS_ACT = WS_ROWTOK + alignup((size_t)MOE_ROWS_MAX * 4);
constexpr size_t WS_Y = WS_ACT + alignup((size_t)MOE_ROWS_MAX * 1024 * 2);
constexpr size_t WS_RWT = WS_Y + alignup((size_t)MOE_ROWS_MAX * 1024 * 2);
constexpr size_t WS_MODA = WS_RWT + alignup((size_t)NL * 2 * 32 * 1024 * 2);
constexpr size_t WS_SSQ = WS_MODA + alignup((size_t)NL * NB * 2 * DM * 4);
constexpr size_t WS_SCR = WS_SSQ + alignup((size_t)NTOK * 16 * 4);
constexpr size_t WS_XB = WS_SCR + alignup((size_t)1024 * 8 * 4096 * 4);
constexpr size_t WS_END = WS_XB + alignup((size_t)NTOK * DM * 2);
constexpr int CW_QUEUE = 65536;
constexpr int CW_BAR = 4096;

constexpr int RING_BYTES = 131584;
constexpr int MISC_OFF = 135168;
constexpr int SM_OFF = 136192;
constexpr int LDS_BYTES = 147456;
constexpr int NWAVES = 8;

#define GAS __attribute__((address_space(1)))
#define LAS __attribute__((address_space(3)))
typedef unsigned short bf16;
typedef unsigned v4u __attribute__((ext_vector_type(4)));
typedef unsigned v2u __attribute__((ext_vector_type(2)));
typedef float f32x4 __attribute__((ext_vector_type(4)));
typedef short bf16x8 __attribute__((ext_vector_type(8)));
typedef GAS unsigned gu32;
#define RLX_AGENT __ATOMIC_RELAXED, __HIP_MEMORY_SCOPE_AGENT
#define LDS_WAIT() asm volatile("s_waitcnt lgkmcnt(0)" ::: "memory")
#define VM_WAIT() asm volatile("s_waitcnt vmcnt(0)" ::: "memory")
using pg8::cvt_pk_bf16; using pg8::bflo; using pg8::bfhi; using pg8::sigmoidf_;
__device__ __forceinline__ float bf2f(bf16 h) { return __uint_as_float((unsigned)h << 16); }
__device__ __forceinline__ bf16 f2bf(float f) { return (bf16)(cvt_pk_bf16(f, 0.f) & 0xffffu); }
__device__ __forceinline__ float shx(float v, int mask, int lane) { return __int_as_float(__builtin_amdgcn_ds_bpermute((lane ^ mask) << 2, __float_as_int(v))); }
__device__ __forceinline__ int shxi(int v, int mask, int lane) { return __builtin_amdgcn_ds_bpermute((lane ^ mask) << 2, v); }
__device__ __forceinline__ float shf(float v, int src) { return __int_as_float(__builtin_amdgcn_ds_bpermute(src << 2, __float_as_int(v))); }
__device__ __forceinline__ int shfi(int v, int src) { return __builtin_amdgcn_ds_bpermute(src << 2, v); }
__device__ __forceinline__ float wave_sum(float v, int lane) {
#pragma unroll
    for (int o = 1; o < 64; o <<= 1) v += shx(v, o, lane);
    return v;
}
__device__ __forceinline__ int vt_pos(int n) { return (n & ~31) | (((n >> 2) & 3) << 3) | (((n >> 4) & 1) << 2) | (n & 3); }


#define XB_TMO      128
#define XB_XCNT(j)  (256  + 64 * (j))
#define XB_XSUB(j)  (1280 + 64 * (j))
#define XB_XGEN(j)  (2304 + 64 * (j))
#define XB_TOP      3328
#define XB_TOPGEN   3392
#define XCD_BAR_WORDS 3456
#define XB_SPIN_CAP (1u << 18)

__device__ __forceinline__ unsigned xb_ld(unsigned* p)              { return __hip_atomic_load(p, __ATOMIC_RELAXED, __HIP_MEMORY_SCOPE_AGENT); }
__device__ __forceinline__ unsigned xb_add(unsigned* p, unsigned v) { return __hip_atomic_fetch_add(p, v, __ATOMIC_RELAXED, __HIP_MEMORY_SCOPE_AGENT); }
__device__ __forceinline__ unsigned xb_xcc_id() { return (unsigned)__builtin_amdgcn_s_getreg((3 << 11) | 20) & 0xFu; }
#define XB_SPIN(cond, bar) do { unsigned _sp = 0; while (cond) { __builtin_amdgcn_s_sleep(1); \
    if ((++_sp & 255u) == 0u) { if (xb_ld(&(bar)[XB_TMO])) break; if (_sp > XB_SPIN_CAP) { atomicAdd(&(bar)[XB_TMO], 1u); break; } } } } while (0)

struct XcdBarrier {
    unsigned* bar; unsigned x;
    volatile LAS unsigned* st;
};

__device__ __forceinline__ XcdBarrier xcd_barrier_post(unsigned* bar, volatile LAS unsigned* st, const int tid_x  ) {
    XcdBarrier b; b.bar = bar; b.x = xb_xcc_id(); b.st = st;
    if (tid_x == 0) (void)xb_add(&bar[XB_XCNT(b.x)], 1u);
    return b;
}
__device__ __forceinline__ void xcd_barrier_complete(unsigned* bar, unsigned x, unsigned& nloc, unsigned& nx) {
    const unsigned G = gridDim.x * gridDim.y * gridDim.z;
    unsigned sum, cnt, mine, sp = 0u;
    for (;;) {
        sum = 0u; cnt = 0u; mine = 0u;
#pragma unroll
        for (unsigned j = 0; j < 16; ++j) { const unsigned c = xb_ld(&bar[XB_XCNT(j)]); sum += c; cnt += (c > 0u) ? 1u : 0u; mine = (j == x) ? c : mine; }
        if (sum == G) break;
        __builtin_amdgcn_s_sleep(1);
        if ((++sp & 255u) == 0u) { if (xb_ld(&bar[XB_TMO])) break; if (sp > XB_SPIN_CAP) { atomicAdd(&bar[XB_TMO], 1u); break; } }
    }
    nloc = mine > 0u ? mine : 1u; nx = cnt > 0u ? cnt : 1u;
}

__device__ __forceinline__ void xcd_barrier(const XcdBarrier& b, const int tid_x) {
    asm volatile("s_waitcnt vmcnt(0)" ::: "memory");
    __syncthreads();
    if (tid_x == 0) {
        unsigned* bar = b.bar;
        __builtin_amdgcn_s_waitcnt(0);
        unsigned nloc = b.st[0], nx = b.st[1];
        if (nloc == 0u) { xcd_barrier_complete(bar, b.x, nloc, nx); b.st[0] = nloc; b.st[1] = nx; }
        const unsigned old = xb_add(&bar[XB_XSUB(b.x)], 1u);
        const unsigned gen = old / nloc;
        if (old + 1u == (gen + 1u) * nloc) {
            __builtin_amdgcn_fence(__ATOMIC_RELEASE, "agent");
            asm volatile("s_waitcnt vmcnt(0)" ::: "memory");
            const unsigned og = xb_add(&bar[XB_TOP], 1u);
            const unsigned tg = og / nx;
            if (og + 1u == (tg + 1u) * nx) xb_add(&bar[XB_TOPGEN], 1u);
            else XB_SPIN(xb_ld(&bar[XB_TOPGEN]) == tg, bar);
            __builtin_amdgcn_fence(__ATOMIC_ACQUIRE, "agent");
            xb_add(&bar[XB_XGEN(b.x)], 1u);
            asm volatile("s_waitcnt vmcnt(0)" ::: "memory");
        } else {
            XB_SPIN(xb_ld(&bar[XB_XGEN(b.x)]) == gen, bar);
            __builtin_amdgcn_fence(__ATOMIC_ACQUIRE, "agent");
            asm volatile("s_waitcnt vmcnt(0)" ::: "memory");
        }
    }
    __syncthreads();
}


enum { I_X = 0, I_C, I_NORM1, I_NORM2, I_ADAW, I_ADAB, I_WIN, I_WPOOL, I_PSCALE, I_QNORM, I_KNORM, I_CMPPOS, I_CMPW1, I_CMPB1, I_CMPW2, I_WPA, I_WPB, I_WOUT,
       I_RW, I_RB, I_WGU, I_BGU, I_WD, I_BD, N_IN };
struct Args { const float* in[N_IN]; float* out; unsigned char* ws; int ph_lo, ph_hi, li, pad; };

struct Ctx {
    LAS unsigned char* lds;
    int tid, lane, wave, bx, G;
    unsigned char* ws;
};
__device__ __forceinline__ void fresh(Ctx& C) { unsigned z = 0u; asm volatile("" : "+s"(z));   int t = C.wave * 64 + (int)__builtin_amdgcn_mbcnt_hi(~0u, __builtin_amdgcn_mbcnt_lo(~0u, z)); asm volatile("" : "+v"(t)); C.tid = t; C.lane = t & 63; int bx = blockIdx.x, G = gridDim.x; asm volatile("" : "+s"(bx), "+s"(G)); C.bx = bx; C.G = G; }

__device__ __forceinline__ int inmap(int np) { return np < 2304 ? np : (np < 4352 ? np + 48 : (np < 4400 ? np - 2048 : -1)); }
struct P0Item { const float* W; bf16* WT; int K, N, NP, item; bool mapin; };
__device__ __forceinline__ void p0_load(const P0Item& I, int lane, f32x4 (&v)[8]) {
    const int nblk = I.NP / 32, kb = I.item / nblk, nb = I.item % nblk, k0 = 64 * kb, n0 = 32 * nb;
    const int c4 = 4 * (lane & 7); int sc = n0 + c4; if (I.mapin) { const int x = sc; sc = inmap((x & ~255) | (((x >> 5) & 3) << 6) | (((x >> 7) & 1) << 5) | (x & 31)); }
#pragma unroll
    for (int i = 0; i < 8; ++i) { const int kk = 8 * i + (lane >> 3); v[i] = (sc >= 0) ? *(const f32x4*)(I.W + (size_t)(k0 + kk) * I.N + sc) : (f32x4){0.f, 0.f, 0.f, 0.f}; }
}
__device__ __forceinline__ void p0_store(const P0Item& I, int lane, LAS float* scr, const f32x4 (&v)[8]) {
    const int nblk = I.NP / 32, kb = I.item / nblk, nb = I.item % nblk, k0 = 64 * kb, n0 = 32 * nb; const int c4 = 4 * (lane & 7);
#pragma unroll
    for (int i = 0; i < 8; ++i) { const int kk = 8 * i + (lane >> 3); LAS float* d = scr + kk * 33 + c4; d[0] = v[i].x; d[1] = v[i].y; d[2] = v[i].z; d[3] = v[i].w; }
    LDS_WAIT(); asm volatile("" ::: "memory");
    const int c = lane & 7;
#pragma unroll
    for (int j = 0; j < 4; ++j) { const int n = (lane >> 3) + 8 * j; const LAS float* sp = scr + (8 * c) * 33 + n;
        v4u o; o.x = cvt_pk_bf16(sp[0 * 33], sp[1 * 33]); o.y = cvt_pk_bf16(sp[2 * 33], sp[3 * 33]); o.z = cvt_pk_bf16(sp[4 * 33], sp[5 * 33]); o.w = cvt_pk_bf16(sp[6 * 33], sp[7 * 33]);
        *(v4u*)(I.WT + (size_t)(n0 + n) * I.K + k0 + 8 * c) = o; }
    LDS_WAIT(); asm volatile("" ::: "memory");
}
constexpr int P0_IT_IN = 16 * (ZW / 32), P0_IT_A = 8 * 32, P0_IT_B = 16 * 32, P0_IT_O = 16 * 32, P0_IT_W1 = 32 * 8, P0_IT_W2 = 4 * 2, P0_IT_GU = 16 * 64, P0_IT_D = 16 * 32;
constexpr int P0_IT_LAYER = P0_IT_IN + P0_IT_A + P0_IT_B + P0_IT_O + 2 * P0_IT_W1 + 2 * P0_IT_W2 + NEXP * P0_IT_GU + NEXP * P0_IT_D;
__device__ __forceinline__ P0Item p0_item(const Ctx& C, const Args& a, int it) {
    P0Item I; I.mapin = false; const int l = it / P0_IT_LAYER; int r = it % P0_IT_LAYER;
    if (r < P0_IT_IN) { I.W = a.in[I_WIN] + (size_t)l * DM * IN_W; I.K = DM; I.N = IN_W; I.NP = ZW; I.WT = (bf16*)(C.ws + WS_WIN) + (size_t)l * ZW * DM; I.item = r; I.mapin = true; return I; } r -= P0_IT_IN;
    if (r < P0_IT_A) { I.W = a.in[I_WPA] + (size_t)l * 512 * 1024; I.K = 512; I.N = 1024; I.NP = 1024; I.WT = (bf16*)(C.ws + WS_WA) + (size_t)l * 1024 * 512; I.item = r; return I; } r -= P0_IT_A;
    if (r < P0_IT_B) { I.W = a.in[I_WPB] + (size_t)l * 1024 * 1024; I.K = 1024; I.N = 1024; I.NP = 1024; I.WT = (bf16*)(C.ws + WS_WB) + (size_t)l * 1024 * 1024; I.item = r; return I; } r -= P0_IT_B;
    if (r < P0_IT_O) { I.W = a.in[I_WOUT] + (size_t)l * 1024 * 1024; I.K = 1024; I.N = 1024; I.NP = 1024; I.WT = (bf16*)(C.ws + WS_WOUT) + (size_t)l * 1024 * 1024; I.item = r; return I; } r -= P0_IT_O;
    if (r < 2 * P0_IT_W1) { const int kv = r / P0_IT_W1; I.W = a.in[I_CMPW1] + (size_t)(l * 2 + kv) * 2048 * 256; I.K = 2048; I.N = 256; I.NP = 256; I.WT = (bf16*)(C.ws + WS_W1) + (size_t)(l * 2 + kv) * 256 * 2048; I.item = r % P0_IT_W1; return I; } r -= 2 * P0_IT_W1;
    if (r < 2 * P0_IT_W2) { const int kv = r / P0_IT_W2; I.W = a.in[I_CMPW2] + (size_t)(l * 2 + kv) * 256 * 64; I.K = 256; I.N = 64; I.NP = 64; I.WT = (bf16*)(C.ws + WS_W2) + (size_t)(l * 2 + kv) * 64 * 256; I.item = r % P0_IT_W2; return I; } r -= 2 * P0_IT_W2;
    if (r < NEXP * P0_IT_GU) { const int e = r / P0_IT_GU; I.W = a.in[I_WGU] + (size_t)(l * NEXP + e) * 1024 * 2048; I.K = 1024; I.N = 2048; I.NP = 2048; I.WT = (bf16*)(C.ws + WS_WGU) + (size_t)(l * NEXP + e) * 2048 * 1024; I.item = r % P0_IT_GU; return I; } r -= NEXP * P0_IT_GU;
    { const int e = r / P0_IT_D; I.W = a.in[I_WD] + (size_t)(l * NEXP + e) * 1024 * 1024; I.K = 1024; I.N = 1024; I.NP = 1024; I.WT = (bf16*)(C.ws + WS_WD) + (size_t)(l * NEXP + e) * 1024 * 1024; I.item = r % P0_IT_D; return I; }
}
__device__ __forceinline__ void p0_convert(const Ctx& C, const Args& a) {
    LAS float* scr = (LAS float*)(C.lds + C.wave * 16384);
    const int gw = C.bx * NWAVES + C.wave, NGW = C.G * NWAVES;
    { constexpr int NIT = NL * P0_IT_LAYER; int it = gw;
      if (it < NIT) { f32x4 va[8], vb[8]; P0Item Ia = p0_item(C, a, it), Ib = Ia; p0_load(Ia, C.lane, va);
          for (;;) {
              const int it2 = it + NGW; const bool h2 = it2 < NIT; if (h2) { Ib = p0_item(C, a, it2); p0_load(Ib, C.lane, vb); }
              p0_store(Ia, C.lane, scr, va); if (!h2) break;
              const int it3 = it2 + NGW; const bool h3 = it3 < NIT; if (h3) { Ia = p0_item(C, a, it3); p0_load(Ia, C.lane, va); }
              p0_store(Ib, C.lane, scr, vb); if (!h3) break;
              it = it3; } } }
    const int gt = C.bx * (NWAVES * 64) + C.tid, NGT = C.G * NWAVES * 64;
    { bf16* wp = (bf16*)(C.ws + WS_WPOOL);
      for (int i = gt; i < NL * 512 * 512; i += NGT) { const int l = i >> 18, ep = (i >> 9) & 511, cp = i & 511; float v = 0.f;
          if ((ep >> 7) == (cp >> 7)) v = a.in[I_WPOOL][(((size_t)l * 4 + (ep >> 7)) * 128 + (cp & 127)) * 128 + (ep & 127)];
          wp[i] = f2bf(v); } }
    { bf16* rwt = (bf16*)(C.ws + WS_RWT);
      for (int i = gt; i < NL * 32 * 1024; i += NGT) { const int l = i >> 15, e = (i >> 10) & 31, k = i & 1023; const float w = a.in[I_RW][((size_t)l * DM + k) * NEXP + e];
          const bf16 hi = f2bf(w); rwt[(size_t)(l * 2) * 32768 + e * 1024 + k] = hi; rwt[(size_t)(l * 2 + 1) * 32768 + e * 1024 + k] = f2bf(w - bf2f(hi)); } }
    { float* rp = (float*)(C.ws + WS_ROPE);
      for (int i = gt; i < SEQ * 8; i += NGT) { const int pos = i >> 3, fi = i & 7;
          const float invf[8] = {1.0f, 0.1939227432012558f, 0.03760603070259094f, 0.007292664609849453f, 0.0014142135623842478f, 0.00027424818836152554f, 5.318296098266728e-05f, 1.0313386155758053e-05f};
          float f = invf[0];
#pragma unroll
          for (int q = 1; q < 8; ++q) f = (fi == q) ? invf[q] : f;
          const float ang = (float)pos * f; const double rev = (double)ang * 0.15915494309189535; const float fr = (float)(rev - __builtin_rint(rev));
          rp[pos * 16 + fi] = __builtin_amdgcn_cosf(fr); rp[pos * 16 + 8 + fi] = __builtin_amdgcn_sinf(fr); } }
    __syncthreads();
    { LAS float* sc = (LAS float*)C.lds;
      for (int i = C.tid; i < NB * DM; i += NWAVES * 64) { const float cv = a.in[I_C][i]; sc[i] = cv * sigmoidf_(cv); }
      __syncthreads();
      float* mp = (float*)(C.ws + WS_MODP);
      for (int i = gt; i < 16 * NL * 6144; i += NGT) { const int j = i % 6144, l = (i / 6144) % NL, ks = i / (6144 * NL);
          const float* w = a.in[I_ADAW] + ((size_t)l * DM + ks * 64) * 6144 + j; float a0 = 0.f, a1 = 0.f, a2 = 0.f, a3 = 0.f;
#pragma unroll 16
          for (int k = 0; k < 64; ++k) { const float wv = w[(size_t)k * 6144]; const int kk = ks * 64 + k;
              a0 += sc[kk] * wv; a1 += sc[DM + kk] * wv; a2 += sc[2 * DM + kk] * wv; a3 += sc[3 * DM + kk] * wv; }
          float* o = mp + ((size_t)(ks * NL + l) * NB) * 6144 + j; o[0] = a0; o[6144] = a1; o[2 * 6144] = a2; o[3 * 6144] = a3; }
      __syncthreads(); }
}
__device__ __forceinline__ void p1_mod(const Ctx& C, const Args& a) {
    const int gt = C.bx * (NWAVES * 64) + C.tid, NGT = C.G * NWAVES * 64;
    const float* mp = (const float*)(C.ws + WS_MODP); float* mo = (float*)(C.ws + WS_MOD);
    for (int i = gt; i < NL * NB * 6144; i += NGT) { const int j = i % 6144, l = i / (NB * 6144);
        float s = a.in[I_ADAB][l * 6144 + j];
#pragma unroll
        for (int ks = 0; ks < 16; ++ks) s += mp[(size_t)ks * NL * NB * 6144 + i];
        mo[i] = s; }
    float* ma = (float*)(C.ws + WS_MODA);
    for (int i = gt; i < NL * NB * DM; i += NGT) { const int k = i % DM, lb = i / DM, l = lb / NB;
        float sc = a.in[I_ADAB][l * 6144 + 4 * DM + k], sh = a.in[I_ADAB][l * 6144 + 3 * DM + k];
#pragma unroll
        for (int ks = 0; ks < 16; ++ks) { const float* q = mp + (size_t)ks * NL * NB * 6144 + (size_t)lb * 6144; sc += q[4 * DM + k]; sh += q[3 * DM + k]; }
        ma[(size_t)lb * 2 * DM + k] = a.in[I_NORM2][l * DM + k] * (1.0f + sc); ma[(size_t)lb * 2 * DM + DM + k] = sh; }
}


__device__ __forceinline__ void norm_rows(const Ctx& C, const float* X, const float* gain, const float* mod_l  , int shift_i, int scale_i, bf16* H) {
    const int gw = C.bx * NWAVES + C.wave, NGW = C.G * NWAVES;
    for (int m = gw; m < NTOK; m += NGW) {
        const int b = m >> 13; const f32x4* xr = (const f32x4*)(X + (size_t)m * DM) + C.lane;
        f32x4 v[4]; float s = 0.f;
#pragma unroll
        for (int j = 0; j < 4; ++j) { v[j] = xr[64 * j]; s += (v[j].x * v[j].x + v[j].y * v[j].y) + (v[j].z * v[j].z + v[j].w * v[j].w); }
        const float rstd = 1.0f / sqrtf(wave_sum(s, C.lane) * (1.0f / DM) + 1e-6f);
        const float* mb = mod_l + (size_t)b * 6144; v2u* o8 = (v2u*)(H + (size_t)m * DM) + C.lane;
#pragma unroll
        for (int j = 0; j < 4; ++j) { const int col = 4 * C.lane + 256 * j;
            const f32x4 g = *(const f32x4*)(gain + col), sc = *(const f32x4*)(mb + scale_i * DM + col), sh = *(const f32x4*)(mb + shift_i * DM + col);
            const f32x4 h = v[j] * rstd * g * (sc + 1.0f) + sh;
            v2u w; w.x = cvt_pk_bf16(h.x, h.y); w.y = cvt_pk_bf16(h.z, h.w); o8[64 * j] = w; }
    }
}

#ifndef PROBE_PP
#define PROBE_PP 0
#endif
#define PP_T0(id) unsigned long long pt0_##id = 0ull; if (PROBE_PP == id) pt0_##id = __builtin_amdgcn_s_memrealtime()
#define PP_T1(id) do { if (PROBE_PP == id) { const unsigned long long t1_ = __builtin_amdgcn_s_memrealtime(); while (__builtin_amdgcn_s_memrealtime() - t1_ < t1_ - pt0_##id) __builtin_amdgcn_s_sleep(4); } } while (0)
__device__ __forceinline__ void post_tokens(const Ctx& C, const Args& a, int l) {
    const int gw = C.bx * NWAVES + C.wave, NGW = C.G * NWAVES, lane = C.lane;
    const bf16* Z = (const bf16*)(C.ws + WS_Z); bf16* Pm = (bf16*)(C.ws + WS_PM); (void)a; (void)l;
    PP_T0(1);
    for (int ch = gw; ch < NTOK / 16; ch += NGW) {
      const int pch = lane * 8, pw = 2 << (lane >> 4), t0 = (ch * 16) & (SEQ - 1); float psum[8] = {0.f, 0.f, 0.f, 0.f, 0.f, 0.f, 0.f, 0.f};
      { const bf16* zp = Z + (size_t)(ch * 16) * ZW + ZC_U + pch;
#pragma unroll
        for (int k = 1; k < 16; ++k) { if (k < pw && k <= t0) { const v4u u = *(const v4u*)(zp - (size_t)k * ZW);
              psum[0] += bflo(u.x); psum[1] += bfhi(u.x); psum[2] += bflo(u.y); psum[3] += bfhi(u.y); psum[4] += bflo(u.z); psum[5] += bfhi(u.z); psum[6] += bflo(u.w); psum[7] += bfhi(u.w); } } }
      for (int bt = 0; bt < 2; ++bt) {
        v4u UU[8], VV[8];
        {
#pragma unroll
          for (int i = 0; i < 8; ++i) { const int m = ch * 16 + bt * 8 + i, t = m & (SEQ - 1); const bf16* zr = Z + (size_t)m * ZW;
              UU[i] = *(const v4u*)(zr + ZC_U + pch); const int back = (t + 1 >= pw) ? (pw - 1) : 0; VV[i] = *(const v4u*)(zr - (size_t)back * ZW + ZC_U + pch); } }
#pragma unroll
      for (int i8 = 0; i8 < 8; ++i8) { const int m = ch * 16 + bt * 8 + i8;
        const int t = m & (SEQ - 1);
        { const v4u u = UU[i8]; const float f[8] = {bflo(u.x), bfhi(u.x), bflo(u.y), bfhi(u.y), bflo(u.z), bfhi(u.z), bflo(u.w), bfhi(u.w)};
          const int cnt = (t + 1 < pw) ? (t + 1) : pw; const float inv = 1.0f / (float)cnt; float d[8];
#pragma unroll
          for (int i = 0; i < 8; ++i) { psum[i] += f[i]; d[i] = psum[i] * inv - f[i]; }
          v4u o; o.x = cvt_pk_bf16(d[0], d[1]); o.y = cvt_pk_bf16(d[2], d[3]); o.z = cvt_pk_bf16(d[4], d[5]); o.w = cvt_pk_bf16(d[6], d[7]);
          *(v4u*)(Pm + (size_t)m * 512 + pch) = o;
          if (t + 1 >= pw) { const v4u v = VV[i8];
              psum[0] -= bflo(v.x); psum[1] -= bfhi(v.x); psum[2] -= bflo(v.y); psum[3] -= bfhi(v.y); psum[4] -= bflo(v.z); psum[5] -= bfhi(v.z); psum[6] -= bflo(v.w); psum[7] -= bfhi(v.w); } }
      }
      }
    }
    PP_T1(1);
    PP_T0(2);
    { bf16* VsT = (bf16*)(C.ws + WS_VSLCT); bf16* VwT = (bf16*)(C.ws + WS_VWINT);
      for (int it = gw; it < 2 * NB * 2 * (SEQ / 64); it += NGW) { const int tt = it & 127, g = (it >> 7) & 1, b = (it >> 8) & 3, which = it >> 10;
          const bf16* src = Z + ((size_t)(b * SEQ + tt * 64 + lane)) * ZW + (which ? ZC_VWN : ZC_VSL) + g * 64;
          bf16* dst = (which ? VwT : VsT) + ((size_t)(b * 2 + g) * 64) * SEQ + tt * 64 + vt_pos(lane);
#pragma unroll
          for (int c = 0; c < 8; ++c) { const v4u u = *(const v4u*)(src + 8 * c); bf16* d = dst + (size_t)(8 * c) * SEQ;
              d[0] = (bf16)(u.x & 0xffff); d[SEQ] = (bf16)(u.x >> 16); d[2 * SEQ] = (bf16)(u.y & 0xffff); d[3 * SEQ] = (bf16)(u.y >> 16);
              d[4 * SEQ] = (bf16)(u.z & 0xffff); d[5 * SEQ] = (bf16)(u.z >> 16); d[6 * SEQ] = (bf16)(u.w & 0xffff); d[7 * SEQ] = (bf16)(u.w >> 16); } } }
    PP_T1(2);
}

__device__ __forceinline__ void compress_unit(const Ctx& C, const Args& a, int l, int u) {
    const int kv = u & 1, nt = (u >> 1) & 15, bg = u >> 5, b = bg >> 1, g = bg & 1, n0 = nt * 32;
    const int lane = C.lane, r16 = lane & 15, quad = lane >> 4, w = C.wave;
    const bf16* Z = (const bf16*)(C.ws + WS_Z);
    const bf16* W1t = (const bf16*)(C.ws + WS_W1) + (size_t)(l * 2 + kv) * 256 * 2048;
    const bf16* W2t = (const bf16*)(C.ws + WS_W2) + (size_t)(l * 2 + kv) * 64 * 256;
    const float* pos = a.in[I_CMPPOS] + (size_t)(l * 2 + kv) * 32 * 64;
    const float* b1 = a.in[I_CMPB1] + (size_t)(l * 2 + kv) * 256;
    LAS float* part = (LAS float*)C.lds;
    LAS bf16* hidL = (LAS bf16*)C.lds;
    LAS float* outL = (LAS float*)(C.lds + 32 * 264 * 2);
    const bf16* arow[2];
#pragma unroll
    for (int rt = 0; rt < 2; ++rt) { const int n = n0 + 16 * rt + r16; const int nl = (n > 510) ? 510 : n; arow[rt] = Z + ((size_t)(b * SEQ + 16 * nl)) * ZW + (kv ? ZC_VCM : ZC_KCM) + g * 64; }
    f32x4 acc[2][16];
#pragma unroll
    for (int rt = 0; rt < 2; ++rt)
#pragma unroll
        for (int ct = 0; ct < 16; ++ct) acc[rt][ct] = (f32x4){0.f, 0.f, 0.f, 0.f};
    { const bf16* wb = W1t + (size_t)r16 * 2048 + 256 * w + quad * 8;
      for (int ks = 0; ks < 8; ++ks) { const int lrow = 4 * w + (ks >> 1), d = (ks & 1) * 32 + quad * 8;
          const f32x4 p0 = *(const f32x4*)(pos + lrow * 64 + d), p1 = *(const f32x4*)(pos + lrow * 64 + d + 4); bf16x8 af[2];
#pragma unroll
          for (int rt = 0; rt < 2; ++rt) { const v4u zv = *(const v4u*)(arow[rt] + (size_t)lrow * ZW + d);
              v4u av; av.x = cvt_pk_bf16(bflo(zv.x) + p0.x, bfhi(zv.x) + p0.y); av.y = cvt_pk_bf16(bflo(zv.y) + p0.z, bfhi(zv.y) + p0.w);
              av.z = cvt_pk_bf16(bflo(zv.z) + p1.x, bfhi(zv.z) + p1.y); av.w = cvt_pk_bf16(bflo(zv.w) + p1.z, bfhi(zv.w) + p1.w); af[rt] = __builtin_bit_cast(bf16x8, av); }
#pragma unroll
          for (int ct = 0; ct < 16; ++ct) { const bf16x8 bfr = *(const bf16x8*)(wb + (size_t)(16 * ct) * 2048 + ks * 32);
              acc[0][ct] = __builtin_amdgcn_mfma_f32_16x16x32_bf16(af[0], bfr, acc[0][ct], 0, 0, 0); acc[1][ct] = __builtin_amdgcn_mfma_f32_16x16x32_bf16(af[1], bfr, acc[1][ct], 0, 0, 0); } } }
    v4u hv[2];
    const int row = C.tid >> 5, c0 = (C.tid & 31) * 8;
#pragma unroll
    for (int rt = 0; rt < 2; ++rt) {
#pragma unroll
        for (int ct = 0; ct < 16; ++ct)
#pragma unroll
            for (int r = 0; r < 4; ++r) part[(w * 16 + 4 * quad + r) * 256 + 16 * ct + r16] = acc[rt][ct][r];
        __syncthreads();
        f32x4 s0 = *(const f32x4*)(b1 + c0), s1 = *(const f32x4*)(b1 + c0 + 4);
#pragma unroll
        for (int ww = 0; ww < 8; ++ww) { s0 = s0 + *(const LAS f32x4*)(part + (ww * 16 + row) * 256 + c0); s1 = s1 + *(const LAS f32x4*)(part + (ww * 16 + row) * 256 + c0 + 4); }
        hv[rt].x = cvt_pk_bf16(s0.x * sigmoidf_(s0.x), s0.y * sigmoidf_(s0.y)); hv[rt].y = cvt_pk_bf16(s0.z * sigmoidf_(s0.z), s0.w * sigmoidf_(s0.w));
        hv[rt].z = cvt_pk_bf16(s1.x * sigmoidf_(s1.x), s1.y * sigmoidf_(s1.y)); hv[rt].w = cvt_pk_bf16(s1.z * sigmoidf_(s1.z), s1.w * sigmoidf_(s1.w));
        __syncthreads();
    }
    *(LAS v4u*)(hidL + row * 264 + c0) = hv[0]; *(LAS v4u*)(hidL + (16 + row) * 264 + c0) = hv[1];
    __syncthreads();
    { const int rt = w >> 2, ct = w & 3; f32x4 o = {0.f, 0.f, 0.f, 0.f}; const bf16* w2 = W2t + (size_t)(16 * ct + r16) * 256 + quad * 8;
#pragma unroll
      for (int ks = 0; ks < 8; ++ks) { const bf16x8 af = *(const LAS bf16x8*)(hidL + (16 * rt + r16) * 264 + ks * 32 + quad * 8); const bf16x8 bfr = *(const bf16x8*)(w2 + ks * 32);
          o = __builtin_amdgcn_mfma_f32_16x16x32_bf16(af, bfr, o, 0, 0, 0); }
#pragma unroll
      for (int r = 0; r < 4; ++r) outL[(16 * rt + 4 * quad + r) * 68 + 16 * ct + r16] = o[r]; }
    __syncthreads();
    if (w < 2) { const int i = 16 * w + (lane >> 2), c0e = (lane & 3) * 16, n = n0 + i; float y[16];
#pragma unroll
        for (int j = 0; j < 16; ++j) y[j] = outL[i * 68 + c0e + j];
        if (kv == 0) { float s = 0.f;
#pragma unroll
            for (int j = 0; j < 16; ++j) s += y[j] * y[j];
            s += shx(s, 1, lane); s += shx(s, 2, lane);
            const float rstd = 1.0f / sqrtf(s * (1.0f / 64.0f) + 1e-6f); const float* gk = a.in[I_KNORM] + l * 192 + c0e;
#pragma unroll
            for (int j = 0; j < 16; ++j) y[j] = y[j] * rstd * gk[j];
            if ((lane & 3) == 0 && n <= 510) { const float* rp = (const float*)(C.ws + WS_ROPE) + (16 * n + 31) * 16;
#pragma unroll
                for (int j = 0; j < 8; ++j) { const float c = rp[j], sn = rp[8 + j], x1 = y[j], x2 = y[8 + j]; y[j] = x1 * c - x2 * sn; y[8 + j] = x2 * c + x1 * sn; } }
            if (n > 510) {
#pragma unroll
                for (int j = 0; j < 16; ++j) y[j] = 0.f; }
            v4u o0, o1; o0.x = cvt_pk_bf16(y[0], y[1]); o0.y = cvt_pk_bf16(y[2], y[3]); o0.z = cvt_pk_bf16(y[4], y[5]); o0.w = cvt_pk_bf16(y[6], y[7]);
            o1.x = cvt_pk_bf16(y[8], y[9]); o1.y = cvt_pk_bf16(y[10], y[11]); o1.z = cvt_pk_bf16(y[12], y[13]); o1.w = cvt_pk_bf16(y[14], y[15]);
            bf16* ko = (bf16*)(C.ws + WS_KC) + ((size_t)bg * 512 + n) * 64 + c0e; *(v4u*)ko = o0; *(v4u*)(ko + 8) = o1;
        } else { bf16* vo = (bf16*)(C.ws + WS_VCT) + ((size_t)bg * 64 + c0e) * 512 + vt_pos(n);
#pragma unroll
            for (int j = 0; j < 16; ++j) vo[(size_t)j * 512] = (n > 510) ? (bf16)0 : f2bf(y[j]); } }
    __syncthreads();
}


#ifndef PROBE_AT
#define PROBE_AT 0
#endif
#define AT_T0(id) do { if (PROBE_AT == id) t0_##id = __builtin_amdgcn_s_memrealtime(); } while (0)
#define AT_T1(id) do { if (PROBE_AT == id) { const unsigned long long t1_ = __builtin_amdgcn_s_memrealtime(); while (__builtin_amdgcn_s_memrealtime() - t1_ < t1_ - t0_##id) __builtin_amdgcn_s_sleep(4); } } while (0)
#define MFMA16(a, b, c) __builtin_amdgcn_mfma_f32_16x16x32_bf16(a, b, c, 0, 0, 0)
constexpr float SM_SCALE = 0.125f * 1.4426950408889634f;
constexpr int AT_SLOT = 16384, AT_NSLOT = 6, AT_G = 3;
constexpr int AT_IMP_OFF = AT_SLOT * AT_NSLOT;
constexpr int AT_MASK_OFF = AT_IMP_OFF + 8 * 8 * 128 * 4;
constexpr int AT_NSLOT_S = 8;
constexpr int AT_FLAG_OFF = AT_MASK_OFF + 1024;
__device__ __forceinline__ bf16x8 pack_p(const f32x4& p0, const f32x4& p1) {
    v4u w; w.x = cvt_pk_bf16(p0[0], p0[1]); w.y = cvt_pk_bf16(p0[2], p0[3]); w.z = cvt_pk_bf16(p1[0], p1[1]); w.w = cvt_pk_bf16(p1[2], p1[3]); return __builtin_bit_cast(bf16x8, w);
}
__device__ __forceinline__ int tile_off(int row, int chunk) { return row * 128 + ((chunk ^ ((row >> 1) & 7)) << 4); }
struct AtJob { const bf16* k; const bf16* v; int vpitch; };
struct AtUnit { int b, g, c, bg, nct, njobs, wlo, nssc, nsss, nssw; };
__device__ __forceinline__ AtJob at_job(const Ctx& C, const AtUnit& U, int k) {
    AtJob J; const int k2 = k - 2 * U.nct;
    if (k2 < 0) { const int j = (k < U.nct) ? k : k - U.nct; J.k = (const bf16*)(C.ws + WS_KC) + ((size_t)U.bg * 512 + 64 * j) * 64; J.v = (const bf16*)(C.ws + WS_VCT) + (size_t)U.bg * 64 * 512 + 64 * j; J.vpitch = 512; }
    else if (k2 <= U.c) { J.k = (const bf16*)(C.ws + WS_KSLC) + ((size_t)U.bg * SEQ + 64 * k2) * 64; J.v = (const bf16*)(C.ws + WS_VSLCT) + (size_t)U.bg * 64 * SEQ + 64 * k2; J.vpitch = SEQ; }
    else { const int w = U.wlo + (k2 - U.c - 1); J.k = (const bf16*)(C.ws + WS_KWIN) + ((size_t)U.bg * SEQ + 64 * w) * 64; J.v = (const bf16*)(C.ws + WS_VWINT) + (size_t)U.bg * 64 * SEQ + 64 * w; J.vpitch = SEQ; }
    return J;
}
__device__ __forceinline__ void at_stage(const Ctx& C, const AtJob& J, int slot) {
    int ln = C.lane; asm volatile("" : "+v"(ln));
    const int row = 8 * C.wave + (ln >> 3), chunk = (ln & 7) ^ ((row >> 1) & 7);
    __builtin_amdgcn_global_load_lds((const unsigned*)(J.k + (size_t)row * 64 + chunk * 8), (LAS unsigned*)(C.lds + slot * AT_SLOT + C.wave * 1024), 16, 0, 0);
    __builtin_amdgcn_global_load_lds((const unsigned*)(J.v + (size_t)row * J.vpitch + chunk * 8), (LAS unsigned*)(C.lds + slot * AT_SLOT + 8192 + C.wave * 1024), 16, 0, 0);
}
__device__ __forceinline__ void at_stage_tile(const Ctx& C, const AtJob& J, int slot) {
    int ln = C.lane; asm volatile("" : "+v"(ln));
    const int rr = ln >> 3, ce = (ln & 7) ^ (rr >> 1);
    const unsigned ke = (unsigned)(rr * 128 + ce * 16), ko = (unsigned)(rr * 128 + (ce ^ 4) * 16);
    const unsigned ve = (unsigned)(rr * J.vpitch * 2 + ce * 16), vo = (unsigned)(rr * J.vpitch * 2 + (ce ^ 4) * 16);
#pragma unroll
    for (int seg = 0; seg < 8; ++seg) { const char* kb = (const char*)J.k + seg * 1024; const char* vb = (const char*)J.v + (size_t)seg * 16 * J.vpitch;
        __builtin_amdgcn_global_load_lds((const unsigned*)(kb + ((seg & 1) ? ko : ke)), (LAS unsigned*)(C.lds + slot * AT_SLOT + seg * 1024), 16, 0, 0);
        __builtin_amdgcn_global_load_lds((const unsigned*)(vb + ((seg & 1) ? vo : ve)), (LAS unsigned*)(C.lds + slot * AT_SLOT + 8192 + seg * 1024), 16, 0, 0); }
}
__device__ __forceinline__ void at_stage_ss(const Ctx& C, const AtUnit& U, int sg) {
    int lss = sg, jbase = 0, nj = U.nct;
    if (lss >= U.nssc) { lss -= U.nssc; jbase = U.nct; }
    if (jbase == U.nct && lss >= U.nssc) { lss -= U.nssc; jbase = 2 * U.nct; nj = U.c + 1;
        if (lss >= U.nsss) { lss -= U.nsss; jbase = 2 * U.nct + U.c + 1; nj = U.c - U.wlo + 1; } }
#pragma unroll
    for (int i3 = 0; i3 < AT_G; ++i3) { const int jl = AT_G * lss + i3; if (jl < nj) at_stage(C, at_job(C, U, jbase + jl), AT_G * (sg & 1) + i3); }
}
__device__ __forceinline__ void at_load_k(LAS unsigned char* sl, int jp, int r16, int quad, bf16x8 (&kf)[2][2]) {
#pragma unroll
    for (int h = 0; h < 2; ++h)
#pragma unroll
        for (int kh = 0; kh < 2; ++kh) kf[h][kh] = *(const LAS bf16x8*)(sl + tile_off(32 * jp + 16 * h + r16, kh * 4 + quad));
}
__device__ __forceinline__ void at_load_v(LAS unsigned char* sl, int jp, int r16, int quad, bf16x8 (&vf)[4]) {
#pragma unroll
    for (int db = 0; db < 4; ++db) vf[db] = *(const LAS bf16x8*)(sl + 8192 + tile_off(16 * db + r16, 4 * jp + quad));
}
constexpr float AT_DEFER = 8.0f;
__device__ __forceinline__ bf16x8 at_ones() { const v4u w = {0x3F803F80u, 0x3F803F80u, 0x3F803F80u, 0x3F803F80u}; return __builtin_bit_cast(bf16x8, w); }
template <int CTRL> __device__ __forceinline__ float dppf(float v) { return __int_as_float(__builtin_amdgcn_update_dpp(0, __float_as_int(v), CTRL, 0xF, 0xF, true)); }
template <int CTRL> __device__ __forceinline__ unsigned dppu(unsigned v) { return (unsigned)__builtin_amdgcn_update_dpp(0, (int)v, CTRL, 0xF, 0xF, true); }
__device__ __forceinline__ float sum8(float v) { v += dppf<0xB1>(v); v += dppf<0x4E>(v); v += dppf<0x141>(v); return v; }
__device__ __forceinline__ unsigned max8u(unsigned v) { unsigned o = dppu<0xB1>(v); v = o > v ? o : v; o = dppu<0x4E>(v); v = o > v ? o : v; o = dppu<0x141>(v); return o > v ? o : v; }
__device__ __forceinline__ float vmax3(float a, float b, float c) { return fmaxf(fmaxf(a, b), c); }
__device__ __forceinline__ int imax3(int a, int b, int c) { const int t = a > b ? a : b; return t > c ? t : c; }
__device__ __forceinline__ float vmax8(const f32x4& s0, const f32x4& s1) { const int t1 = imax3(__float_as_int(s0[0]), __float_as_int(s0[1]), __float_as_int(s0[2])), t2 = imax3(__float_as_int(s0[3]), __float_as_int(s1[0]), __float_as_int(s1[1])), t3 = imax3(__float_as_int(s1[2]), __float_as_int(s1[3]), t1); return __int_as_float(t2 > t3 ? t2 : t3); }
__device__ __forceinline__ void at_qk(const bf16x8 (&kf)[2][2], const bf16x8 (&qf)[2], const f32x4& c0, const f32x4& c1, f32x4& s0, f32x4& s1) {
    s0 = MFMA16(kf[0][0], qf[0], c0); s1 = MFMA16(kf[1][0], qf[0], c1); s0 = MFMA16(kf[0][1], qf[1], s0); s1 = MFMA16(kf[1][1], qf[1], s1);
}
__device__ __forceinline__ void at_qk2(const bf16x8 (&kf)[2][2], const bf16x8 (&qa)[2], const bf16x8 (&qb)[2], const f32x4& ca0, const f32x4& ca1, const f32x4& cb0, const f32x4& cb1, f32x4& a0, f32x4& a1, f32x4& b0, f32x4& b1) {
    a0 = MFMA16(kf[0][0], qa[0], ca0); a1 = MFMA16(kf[1][0], qa[0], ca1); b0 = MFMA16(kf[0][0], qb[0], cb0); b1 = MFMA16(kf[1][0], qb[0], cb1);
    a0 = MFMA16(kf[0][1], qa[1], a0); a1 = MFMA16(kf[1][1], qa[1], a1); b0 = MFMA16(kf[0][1], qb[1], b0); b1 = MFMA16(kf[1][1], qb[1], b1);
}
__device__ __forceinline__ void at_online(f32x4& s0, f32x4& s1, float& mrun, f32x4& lacc, f32x4 (&o)[4], const bf16x8 (&vf)[4], int lane, const bf16x8& ones) {
    float bm = vmax8(s0, s1);
    if (__builtin_amdgcn_ballot_w64(bm > AT_DEFER) != 0ull) {
        bm = vmax3(bm, shx(bm, 16, lane), 0.f); bm = vmax3(bm, shx(bm, 32, lane), 0.f);
        const float alpha = __builtin_amdgcn_exp2f(-bm);
        lacc = lacc * alpha; mrun += bm;
#pragma unroll
        for (int db = 0; db < 4; ++db) o[db] = o[db] * alpha;
        s0 = s0 - bm; s1 = s1 - bm;
    }
#pragma unroll
    for (int r = 0; r < 4; ++r) { s0[r] = __builtin_amdgcn_exp2f(s0[r]); s1[r] = __builtin_amdgcn_exp2f(s1[r]); }
    const bf16x8 pb = pack_p(s0, s1);
    lacc = MFMA16(ones, pb, lacc);
#pragma unroll
    for (int db = 0; db < 4; ++db) o[db] = MFMA16(vf[db], pb, o[db]);
}

__device__ __forceinline__ void at_online2(f32x4& a0, f32x4& a1, f32x4& b0, f32x4& b1, float& mA, f32x4& lA, f32x4 (&oA)[4], float& mB, f32x4& lB, f32x4 (&oB)[4], const bf16x8 (&vf)[4], int lane, const bf16x8& ones) {
    float bmA = vmax8(a0, a1);
    float bmB = vmax8(b0, b1);
    if (__builtin_amdgcn_ballot_w64(fmaxf(bmA, bmB) > AT_DEFER) != 0ull) {
        bmA = vmax3(bmA, shx(bmA, 16, lane), 0.f); bmB = vmax3(bmB, shx(bmB, 16, lane), 0.f); bmA = vmax3(bmA, shx(bmA, 32, lane), 0.f); bmB = vmax3(bmB, shx(bmB, 32, lane), 0.f);
        const float alA = __builtin_amdgcn_exp2f(-bmA), alB = __builtin_amdgcn_exp2f(-bmB);
        lA = lA * alA; mA += bmA; lB = lB * alB; mB += bmB;
#pragma unroll
        for (int db = 0; db < 4; ++db) { oA[db] = oA[db] * alA; oB[db] = oB[db] * alB; }
        a0 = a0 - bmA; a1 = a1 - bmA; b0 = b0 - bmB; b1 = b1 - bmB;
    }
#pragma unroll
    for (int r = 0; r < 4; ++r) { a0[r] = __builtin_amdgcn_exp2f(a0[r]); a1[r] = __builtin_amdgcn_exp2f(a1[r]); b0[r] = __builtin_amdgcn_exp2f(b0[r]); b1[r] = __builtin_amdgcn_exp2f(b1[r]); }
    const bf16x8 pA = pack_p(a0, a1), pB = pack_p(b0, b1);
    lA = MFMA16(ones, pA, lA); lB = MFMA16(ones, pB, lB);
#pragma unroll
    for (int db = 0; db < 4; ++db) { oA[db] = MFMA16(vf[db], pA, oA[db]); oB[db] = MFMA16(vf[db], pB, oB[db]); }
}

#define AT_TRY_STAGE() do { if (pend < 0 && mynext < njt && mynext < jl + AT_NSLOT_S) { const int slot_ = mynext % AT_NSLOT_S; \
    if (mynext < AT_NSLOT_S || (unsigned)__builtin_amdgcn_readfirstlane((int)fl[16 + slot_]) >= 8u * (unsigned)(mynext / AT_NSLOT_S)) { \
        at_stage_tile(C, at_job(C, U, j_sl + mynext), slot_); pend = mynext; mynext += NWAVES; __builtin_amdgcn_s_setprio(2); } } } while (0)
__device__ __forceinline__ void attn_unit(const Ctx& C, const AtUnit& U, const int abl  , float* scr  ) {
    const int lane0 = C.lane, wv = C.wave;
    v4u ones_w = {0x3F803F80u, 0x3F803F80u, 0x3F803F80u, 0x3F803F80u}; asm volatile("" : "+v"(ones_w)); const bf16x8 ones = __builtin_bit_cast(bf16x8, ones_w);
    unsigned long long t0_1 = 0ull, t0_2 = 0ull, t0_3 = 0ull, t0_4 = 0ull; (void)t0_1; (void)t0_2; (void)t0_3; (void)t0_4;
    const int ta = 64 * U.c + 8 * wv;
    const bf16* Qn = (const bf16*)(C.ws + WS_QN); const bf16* Z = (const bf16*)(C.ws + WS_Z);
    bf16x8 q[4][2]; f32x4 O[4][4]; float mrun[4], lrun[4], pup[4]; f32x4 Lacc[4]; bf16 gz[3][4];
    { const int lane = lane0, r16 = lane & 15, quad = lane >> 4, tokc = r16 >> 3, head = r16 & 7; LAS float* impL = (LAS float*)(C.lds + AT_IMP_OFF + wv * 4096);
#pragma unroll
    for (int cb = 0; cb < 4; ++cb) { const bf16* qrow = Qn + ((size_t)(U.b * SEQ + ta + 2 * cb + tokc)) * DM + (U.g * 8 + head) * 64;
        q[cb][0] = *(const bf16x8*)(qrow + quad * 8); q[cb][1] = *(const bf16x8*)(qrow + 32 + quad * 8);
        { const bf16* zg = Z + ((size_t)(U.b * SEQ + ta + 2 * cb + tokc)) * ZW + ZC_NG + U.g * 8 + head; gz[0][cb] = zg[0]; gz[1][cb] = zg[16]; gz[2][cb] = zg[32]; }
        mrun[cb] = 0.f; lrun[cb] = 0.f; pup[cb] = 0.f;
#pragma unroll
        for (int db = 0; db < 4; ++db) O[cb][db] = (f32x4){0.f, 0.f, 0.f, 0.f}; }
#pragma unroll
    for (int i = 0; i < 4; ++i) *(LAS f32x4*)(impL + 4 * lane + 256 * i) = (f32x4){0.f, 0.f, 0.f, 0.f};
    }
    const int nvw = ((ta + 7 - 31) >= 0) ? (((ta + 7 - 31) >> 4) + 1) : 0;
    const int nvmin = (ta >= 31) ? (((ta - 31) >> 4) + 1) : 0;
    const int nsp = (nvw + 31) >> 5;
    const int j_c2 = U.nct, j_sl = 2 * U.nct, j_wn = 2 * U.nct + U.c + 1;
    at_stage_ss(C, U, 0);
    int sg = 0; const int nss_total = 2 * U.nssc + U.nsss + U.nssw;
    AT_T0(1);
    for (int lss = 0; lss < U.nssc; ++lss, ++sg) {
        asm volatile("s_waitcnt vmcnt(0)" ::: "memory");
        __builtin_amdgcn_s_barrier(); asm volatile("" ::: "memory");
        if (sg + 1 < nss_total && sg + 1 != 2 * U.nssc) at_stage_ss(C, U, sg + 1);
        for (int i3 = 0; i3 < AT_G; ++i3) { const int jl = AT_G * lss + i3; if (jl >= U.nct) break; const int k = 0 + jl;
        LAS unsigned char* sl = C.lds + (AT_G * (sg & 1) + i3) * AT_SLOT;
        int lane_ = lane0; asm volatile("" : "+v"(lane_));
        const int lane = lane_, r16 = lane & 15, quad = lane >> 4, tokc = r16 >> 3, head = r16 & 7;
        f32x4* scr4 = (f32x4*)(scr + lane * 64);
        LAS float* impL = (LAS float*)(C.lds + AT_IMP_OFF + wv * 4096); LAS unsigned* maskL = (LAS unsigned*)(C.lds + AT_MASK_OFF + wv * 128);
        {
            const int j = k; if (abl & 1) continue;
#pragma unroll
            for (int jp = 0; jp < 2; ++jp) { if (2 * j + jp >= nsp) break;
                bf16x8 kf[2][2]; at_load_k(sl, jp, r16, quad, kf);
                const bool full = (64 * j + 32 * jp + 31) < nvmin;
#pragma unroll
                for (int cb = 0; cb < 4; ++cb) { const int tl = ta + 2 * cb + tokc; const int nvl = (tl >= 31) ? (((tl - 31) >> 4) + 1) : 0;
                    const float nm = -mrun[cb]; f32x4 s0, s1;
                    if (!full) {
                        int n0 = 64 * j + 32 * jp + 4 * quad; asm volatile("" : "+v"(n0)); f32x4 m0, m1;
#pragma unroll
                        for (int r = 0; r < 4; ++r) { m0[r] = (n0 + r < nvl) ? nm : -1e30f; m1[r] = (n0 + 16 + r < nvl) ? nm : -1e30f; }
                        at_qk(kf, q[cb], m0, m1, s0, s1); asm volatile("; cmp1 masked");
                    } else { const f32x4 sd = {nm, nm, nm, nm}; at_qk(kf, q[cb], sd, sd, s0, s1); asm volatile("; cmp1 full"); }
                    const float bm = vmax8(s0, s1);
                    if (__builtin_amdgcn_ballot_w64(bm > AT_DEFER) != 0ull) { const float d = (bm > AT_DEFER) ? bm : 0.f; lrun[cb] *= __builtin_amdgcn_exp2f(-d); mrun[cb] += d; s0 = s0 - d; s1 = s1 - d; }
                    float ps = 0.f;
#pragma unroll
                    for (int r = 0; r < 4; ++r) ps += __builtin_amdgcn_exp2f(s0[r]) + __builtin_amdgcn_exp2f(s1[r]);
                    lrun[cb] += ps; } }
        }
        }
        asm volatile("s_waitcnt lgkmcnt(0)" ::: "memory");
    }
    {
    int lane_ = lane0; asm volatile("" : "+v"(lane_));
    const int lane = lane_, r16 = lane & 15, quad = lane >> 4, tokc = r16 >> 3, head = r16 & 7; f32x4* scr4 = (f32x4*)(scr + lane * 64);
    LAS float* impL = (LAS float*)(C.lds + AT_IMP_OFF + wv * 4096); LAS unsigned* maskL = (LAS unsigned*)(C.lds + AT_MASK_OFF + wv * 128); (void)scr4; (void)impL; (void)maskL; (void)head; (void)tokc; (void)quad;
    {
#pragma unroll
            for (int cb = 0; cb < 4; ++cb) { float mall = fmaxf(mrun[cb], shx(mrun[cb], 16, lane)); mall = fmaxf(mall, shx(mall, 32, lane));
                float ls = lrun[cb] * __builtin_amdgcn_exp2f(mrun[cb] - mall); ls += shx(ls, 16, lane); ls += shx(ls, 32, lane);
                mrun[cb] = mall; lrun[cb] = (ls > 0.f) ? 1.0f / ls : 0.f; }
        }
    }
    for (int lss = 0; lss < U.nssc; ++lss, ++sg) {
        asm volatile("s_waitcnt vmcnt(0)" ::: "memory");
        __builtin_amdgcn_s_barrier(); asm volatile("" ::: "memory");
        if (sg + 1 < nss_total && sg + 1 != 2 * U.nssc) at_stage_ss(C, U, sg + 1);
        for (int i3 = 0; i3 < AT_G; ++i3) { const int jl = AT_G * lss + i3; if (jl >= U.nct) break; const int k = j_c2 + jl;
        LAS unsigned char* sl = C.lds + (AT_G * (sg & 1) + i3) * AT_SLOT;
        int lane_ = lane0; asm volatile("" : "+v"(lane_));
        const int lane = lane_, r16 = lane & 15, quad = lane >> 4, tokc = r16 >> 3, head = r16 & 7;
        f32x4* scr4 = (f32x4*)(scr + lane * 64);
        LAS float* impL = (LAS float*)(C.lds + AT_IMP_OFF + wv * 4096); LAS unsigned* maskL = (LAS unsigned*)(C.lds + AT_MASK_OFF + wv * 128);
        {
            const int j = k - j_c2; if (abl & 1) continue;
#pragma unroll
            for (int jp = 0; jp < 2; ++jp) { if (2 * j + jp >= nsp) break;
                bf16x8 kf[2][2]; at_load_k(sl, jp, r16, quad, kf); bf16x8 vf[4]; at_load_v(sl, jp, r16, quad, vf);
                const bool full = (64 * j + 32 * jp + 31) < nvmin;
#pragma unroll
                for (int cb = 0; cb < 4; ++cb) { const int tok8 = 2 * cb + tokc, tl = ta + tok8; const int nvl = (tl >= 31) ? (((tl - 31) >> 4) + 1) : 0;
                    const float nm = -mrun[cb], inv = lrun[cb]; f32x4 s0, s1;
                    if (!full) {
                        int n0 = 64 * j + 32 * jp + 4 * quad; asm volatile("" : "+v"(n0)); f32x4 m0, m1;
#pragma unroll
                        for (int r = 0; r < 4; ++r) { m0[r] = (n0 + r < nvl) ? nm : -1e30f; m1[r] = (n0 + 16 + r < nvl) ? nm : -1e30f; }
                        at_qk(kf, q[cb], m0, m1, s0, s1); asm volatile("; cmp2 masked");
                    } else { const f32x4 sd = {nm, nm, nm, nm}; at_qk(kf, q[cb], sd, sd, s0, s1); asm volatile("; cmp2 full"); }
#pragma unroll
                    for (int r = 0; r < 4; ++r) { s0[r] = __builtin_amdgcn_exp2f(s0[r]) * inv; s1[r] = __builtin_amdgcn_exp2f(s1[r]) * inv; }
                    const bf16x8 pb = pack_p(s0, s1);
#pragma unroll
                    for (int db = 0; db < 4; ++db) O[cb][db] = MFMA16(vf[db], pb, O[cb][db]);
#pragma unroll
                    for (int h = 0; h < 2; ++h) { const f32x4& st = h ? s1 : s0; const float h3 = sum8(st[3]), hs = sum8((st[0] + st[1]) + (st[2] + st[3]));
                        const float up = shf(h3, (lane + 48) & 63);
                        const float val = hs + ((quad == 0) ? pup[cb] : up); pup[cb] = up;
                        if (head == 0) impL[tok8 * 128 + 4 * (4 * j + 2 * jp + h) + quad] = val; } } }
        }
        }
        asm volatile("s_waitcnt lgkmcnt(0)" ::: "memory");
    }
    AT_T1(1);
    AT_T0(2);
    {
    int lane_ = lane0; asm volatile("" : "+v"(lane_));
    const int lane = lane_, r16 = lane & 15, quad = lane >> 4, tokc = r16 >> 3, head = r16 & 7; f32x4* scr4 = (f32x4*)(scr + lane * 64);
    LAS float* impL = (LAS float*)(C.lds + AT_IMP_OFF + wv * 4096); LAS unsigned* maskL = (LAS unsigned*)(C.lds + AT_MASK_OFF + wv * 128); (void)scr4; (void)impL; (void)maskL; (void)head; (void)tokc; (void)quad;
    {
            asm volatile("s_waitcnt lgkmcnt(0)" ::: "memory");
#pragma unroll
            for (int cb = 0; cb < 4; ++cb) { const int tok8 = 2 * cb + tokc, tl = ta + tok8;
                if (2 * nsp < 32 && head == 0 && quad == 0) impL[tok8 * 128 + 8 * nsp] = pup[cb];
                const float g0 = sigmoidf_(bf2f(gz[0][cb])); (void)tl;
#pragma unroll
                for (int db = 0; db < 4; ++db) { scr4[cb * 4 + db] = O[cb][db] * g0; O[cb][db] = (f32x4){0.f, 0.f, 0.f, 0.f}; }
                mrun[cb] = 0.f; lrun[cb] = 0.f; Lacc[cb] = (f32x4){0.f, 0.f, 0.f, 0.f}; }
            asm volatile("s_waitcnt lgkmcnt(0)" ::: "memory");
            { const int cur = U.c, lam = head * 4 + quad;
              if (cur <= 15 || (abl & 8)) {
                  if (head == 0 && quad == 0) {
#pragma unroll
                      for (int cb = 0; cb < 4; ++cb) { const int tok8 = 2 * cb + tokc; maskL[0 * 8 + tok8] = (2u << cur) - 1u; maskL[1 * 8 + tok8] = 0u; maskL[2 * 8 + tok8] = 0u; maskL[3 * 8 + tok8] = 0u; } }
              } else {
                  if (lane < 32) maskL[lane] = 0u;
                  unsigned key[4][4];
#pragma unroll
                  for (int cb = 0; cb < 4; ++cb) { const f32x4 v = *(const LAS f32x4*)(impL + (2 * cb + tokc) * 128 + 4 * lam);
#pragma unroll
                      for (int jx = 0; jx < 4; ++jx) { const int sb = 4 * lam + jx; unsigned kk = ((__float_as_uint(v[jx]) & 0xFFFFFF80u) + 0x80u) | (unsigned)(127 - sb);
                          kk = (sb > cur) ? 0u : kk; kk = (sb == 0 || sb == cur) ? 1u : kk; key[cb][jx] = kk; } }
                  for (int round = 0; round < 14; ++round) {
                      unsigned bk[4];
#pragma unroll
                      for (int cb = 0; cb < 4; ++cb) { const unsigned a = key[cb][0] > key[cb][1] ? key[cb][0] : key[cb][1], b2 = key[cb][2] > key[cb][3] ? key[cb][2] : key[cb][3]; bk[cb] = a > b2 ? a : b2; }
#pragma unroll
                      for (int cb = 0; cb < 4; ++cb) bk[cb] = max8u(bk[cb]);
#pragma unroll
                      for (int off = 16; off <= 32; off <<= 1) {
#pragma unroll
                          for (int cb = 0; cb < 4; ++cb) { const unsigned o = (unsigned)shxi((int)bk[cb], off, lane); bk[cb] = o > bk[cb] ? o : bk[cb]; } }
#pragma unroll
                      for (int cb = 0; cb < 4; ++cb)
#pragma unroll
                          for (int jx = 0; jx < 4; ++jx) key[cb][jx] = (key[cb][jx] == bk[cb] && bk[cb] > 1u) ? 1u : key[cb][jx];
                  }
                  asm volatile("s_waitcnt lgkmcnt(0)" ::: "memory");
#pragma unroll
                  for (int cb = 0; cb < 4; ++cb) { const unsigned nib = (key[cb][0] == 1u ? 1u : 0u) | (key[cb][1] == 1u ? 2u : 0u) | (key[cb][2] == 1u ? 4u : 0u) | (key[cb][3] == 1u ? 8u : 0u);
                      if (nib) { const unsigned ma = (unsigned)(size_t)(maskL + (lam >> 3) * 8 + 2 * cb + tokc); asm volatile("ds_or_b32 %0, %1" :: "v"(ma), "v"(nib << ((lam & 7) * 4)) : "memory"); } }
              }
            }
            asm volatile("s_waitcnt lgkmcnt(0)" ::: "memory");
        }
    }
    AT_T1(2);
    AT_T0(3);
    { volatile LAS unsigned* fl = (volatile LAS unsigned*)(C.lds + AT_FLAG_OFF);
      asm volatile("s_waitcnt vmcnt(0) lgkmcnt(0)" ::: "memory");
      if (C.tid < 32) fl[C.tid] = 0u;
      asm volatile("s_waitcnt lgkmcnt(0)" ::: "memory");
      __builtin_amdgcn_s_barrier(); asm volatile("" ::: "memory");
      const int nj = U.c + 1, njt = nj + (U.c - U.wlo + 1); unsigned spins = 0u;
      int mynext = wv, pend = -1;
      for (int jl = 0; jl < nj; ++jl) { const int k = j_sl + jl;
        int lane_ = lane0; asm volatile("" : "+v"(lane_));
        const int lane = lane_, r16 = lane & 15, quad = lane >> 4, tokc = r16 >> 3, head = r16 & 7;
        LAS unsigned* maskL = (LAS unsigned*)(C.lds + AT_MASK_OFF + wv * 128);
        const int s = k - j_sl; unsigned selw[4]; bool need[4], both[4]; bool any = false;
#pragma unroll
        for (int cb = 0; cb < 4; ++cb) { selw[cb] = (maskL[(s >> 5) * 8 + 2 * cb + tokc] >> (s & 31)) & 1u; const unsigned long long bl = __builtin_amdgcn_ballot_w64(selw[cb] != 0u); need[cb] = bl != 0ull; both[cb] = bl == ~0ull; any = any || need[cb]; }
        for (;;) {
            if (pend >= 0) { asm volatile("s_waitcnt vmcnt(0)" ::: "memory"); if (C.lane == 0) fl[pend % AT_NSLOT_S] = (unsigned)(pend + 1); pend = -1; __builtin_amdgcn_s_setprio(0); }
            if (mynext < njt && mynext < jl + AT_NSLOT_S) { const int slot = mynext % AT_NSLOT_S;
                if (mynext < AT_NSLOT_S || (unsigned)__builtin_amdgcn_readfirstlane((int)fl[16 + slot]) >= 8u * (unsigned)(mynext / AT_NSLOT_S)) {
                    at_stage_tile(C, at_job(C, U, j_sl + mynext), slot); pend = mynext; mynext += NWAVES; __builtin_amdgcn_s_setprio(2); } }
            if ((unsigned)__builtin_amdgcn_readfirstlane((int)fl[jl % AT_NSLOT_S]) == (unsigned)(jl + 1)) break;
            __builtin_amdgcn_s_sleep(1); if (++spins > (1u << 24)) break;
        }
        asm volatile("" ::: "memory");
        LAS unsigned char* sl = C.lds + (jl % AT_NSLOT_S) * AT_SLOT; (void)head; (void)both;
        {
            if (any && !(abl & 2)) {
#pragma unroll
                for (int jp = 0; jp < 2; ++jp) { if (jp == 1) AT_TRY_STAGE();
                    bf16x8 kf[2][2]; at_load_k(sl, jp, r16, quad, kf); bf16x8 vf[4]; at_load_v(sl, jp, r16, quad, vf);
#pragma unroll
                    for (int cb = 0; cb < 4; ++cb) if (need[cb]) { const bool sel = selw[cb] != 0u;
                        const float nm = sel ? -mrun[cb] : -1e30f; f32x4 s0, s1;
                        if (s == U.c) {
                            int key0 = 64 * s + 32 * jp + 4 * quad; asm volatile("" : "+v"(key0)); const int tl = ta + 2 * cb + tokc; f32x4 m0, m1;
#pragma unroll
                            for (int r = 0; r < 4; ++r) { m0[r] = (key0 + r <= tl) ? nm : -1e30f; m1[r] = (key0 + 16 + r <= tl) ? nm : -1e30f; }
                            at_qk(kf, q[cb], m0, m1, s0, s1); asm volatile("; slc diagonal");
                        } else { const f32x4 sd = {nm, nm, nm, nm}; at_qk(kf, q[cb], sd, sd, s0, s1); asm volatile("; slc full"); }
                        at_online(s0, s1, mrun[cb], Lacc[cb], O[cb], vf, lane, ones); } }
            }
        }
        asm volatile("s_waitcnt lgkmcnt(0)" ::: "memory");
        if (C.lane == 0) { const unsigned ra = (unsigned)(size_t)(C.lds + AT_FLAG_OFF + 4 * (16 + (jl % AT_NSLOT_S))); asm volatile("ds_add_u32 %0, %1" :: "v"(ra), "v"(1u) : "memory"); }
      }
    AT_T1(3);
    AT_T0(4);
    {
    int lane_ = lane0; asm volatile("" : "+v"(lane_));
    const int lane = lane_, r16 = lane & 15, quad = lane >> 4, tokc = r16 >> 3, head = r16 & 7; f32x4* scr4 = (f32x4*)(scr + lane * 64);
    LAS float* impL = (LAS float*)(C.lds + AT_IMP_OFF + wv * 4096); LAS unsigned* maskL = (LAS unsigned*)(C.lds + AT_MASK_OFF + wv * 128); (void)scr4; (void)impL; (void)maskL; (void)head; (void)tokc; (void)quad;
    {
            f32x4 sv[16];
#pragma unroll
            for (int i = 0; i < 16; ++i) sv[i] = scr4[i];
            asm volatile("" ::: "memory");
#pragma unroll
            for (int cb = 0; cb < 4; ++cb) { const int tl = ta + 2 * cb + tokc;
                const float ls = Lacc[cb][0];
                const float g1 = sigmoidf_(bf2f(gz[1][cb])) / ls; (void)tl;
#pragma unroll
                for (int db = 0; db < 4; ++db) { scr4[cb * 4 + db] = sv[cb * 4 + db] + O[cb][db] * g1; O[cb][db] = (f32x4){0.f, 0.f, 0.f, 0.f}; }
                mrun[cb] = 0.f; lrun[cb] = 0.f; Lacc[cb] = (f32x4){0.f, 0.f, 0.f, 0.f}; }
        }
    }
      for (int jl = nj; jl < njt; ++jl) { const int k = j_sl + jl;
        for (;;) {
            if (pend >= 0) { asm volatile("s_waitcnt vmcnt(0)" ::: "memory"); if (C.lane == 0) fl[pend % AT_NSLOT_S] = (unsigned)(pend + 1); pend = -1; __builtin_amdgcn_s_setprio(0); }
            if (mynext < njt && mynext < jl + AT_NSLOT_S) { const int slot = mynext % AT_NSLOT_S;
                if (mynext < AT_NSLOT_S || (unsigned)__builtin_amdgcn_readfirstlane((int)fl[16 + slot]) >= 8u * (unsigned)(mynext / AT_NSLOT_S)) {
                    at_stage_tile(C, at_job(C, U, j_sl + mynext), slot); pend = mynext; mynext += NWAVES; __builtin_amdgcn_s_setprio(2); } }
            if ((unsigned)__builtin_amdgcn_readfirstlane((int)fl[jl % AT_NSLOT_S]) == (unsigned)(jl + 1)) break;
            __builtin_amdgcn_s_sleep(1); if (++spins > (1u << 24)) break;
        }
        asm volatile("" ::: "memory");
        LAS unsigned char* sl = C.lds + (jl % AT_NSLOT_S) * AT_SLOT;
        int lane_ = lane0; asm volatile("" : "+v"(lane_));
        const int lane = lane_, r16 = lane & 15, quad = lane >> 4, tokc = r16 >> 3, head = r16 & 7;
        f32x4* scr4 = (f32x4*)(scr + lane * 64);
        LAS float* impL = (LAS float*)(C.lds + AT_IMP_OFF + wv * 4096); LAS unsigned* maskL = (LAS unsigned*)(C.lds + AT_MASK_OFF + wv * 128);
        {
            const int w = U.wlo + (k - j_wn);
#pragma unroll
            for (int jp = 0; jp < 2; ++jp) { if (abl & 4) break; if (jp == 1) AT_TRY_STAGE(); const int kb = 64 * w + 32 * jp; if (kb > ta + 7 || kb + 31 + 511 < ta) continue;
                bf16x8 kf[2][2]; at_load_k(sl, jp, r16, quad, kf); bf16x8 vf[4]; at_load_v(sl, jp, r16, quad, vf);
                const bool edge = !(kb + 31 <= ta && kb + 511 >= ta + 7);
#pragma unroll
                for (int cp = 0; cp < 2; ++cp) { const int cA = 2 * cp, cB = 2 * cp + 1;
                    const float nA = -mrun[cA], nB = -mrun[cB]; f32x4 a0, a1, b0, b1;
                    if (edge) { int key0 = kb + 4 * quad; asm volatile("" : "+v"(key0)); const int tlA = ta + 2 * cA + tokc, tlB = ta + 2 * cB + tokc; f32x4 ma0, ma1, mb0, mb1;
#pragma unroll
                        for (int r = 0; r < 4; ++r) { const int ka = key0 + r, kc = key0 + 16 + r;
                            ma0[r] = (ka <= tlA && ka + 511 >= tlA) ? nA : -1e30f; ma1[r] = (kc <= tlA && kc + 511 >= tlA) ? nA : -1e30f;
                            mb0[r] = (ka <= tlB && ka + 511 >= tlB) ? nB : -1e30f; mb1[r] = (kc <= tlB && kc + 511 >= tlB) ? nB : -1e30f; }
                        at_qk2(kf, q[cA], q[cB], ma0, ma1, mb0, mb1, a0, a1, b0, b1); asm volatile("; win edge");
                    } else { const f32x4 sA = {nA, nA, nA, nA}, sB = {nB, nB, nB, nB}; at_qk2(kf, q[cA], q[cB], sA, sA, sB, sB, a0, a1, b0, b1); asm volatile("; win full"); }
                    at_online2(a0, a1, b0, b1, mrun[cA], Lacc[cA], O[cA], mrun[cB], Lacc[cB], O[cB], vf, lane, ones); } }
        }
        asm volatile("s_waitcnt lgkmcnt(0)" ::: "memory");
        if (C.lane == 0) { const unsigned ra = (unsigned)(size_t)(C.lds + AT_FLAG_OFF + 4 * (16 + (jl % AT_NSLOT_S))); asm volatile("ds_add_u32 %0, %1" :: "v"(ra), "v"(1u) : "memory"); }
      }
      asm volatile("s_waitcnt vmcnt(0) lgkmcnt(0)" ::: "memory");
      __builtin_amdgcn_s_barrier(); asm volatile("" ::: "memory");
    }
    int lane_ = lane0; asm volatile("" : "+v"(lane_));
    const int lane = lane_, r16 = lane & 15, quad = lane >> 4, tokc = r16 >> 3, head = r16 & 7; f32x4* scr4 = (f32x4*)(scr + lane * 64);
    f32x4 sv[16];
#pragma unroll
    for (int i = 0; i < 16; ++i) sv[i] = scr4[i];
    asm volatile("" ::: "memory");
#pragma unroll
    for (int cb = 0; cb < 4; ++cb) { const int tl = ta + 2 * cb + tokc;
        const float ls = Lacc[cb][0];
        const float g2 = sigmoidf_(bf2f(gz[2][cb])) / ls;
        bf16* orow = (bf16*)(C.ws + WS_O) + ((size_t)(U.b * SEQ + tl)) * DM + (U.g * 8 + head) * 64 + 4 * quad;
#pragma unroll
        for (int db = 0; db < 4; ++db) { const f32x4 v = sv[cb * 4 + db] + O[cb][db] * g2;
            v2u wv2; wv2.x = cvt_pk_bf16(v[0], v[1]); wv2.y = cvt_pk_bf16(v[2], v[3]); *(v2u*)(orow + 16 * db) = wv2; } }
    AT_T1(4);
    asm volatile("s_waitcnt vmcnt(0)" ::: "memory");
    __builtin_amdgcn_s_barrier(); asm volatile("" ::: "memory");
}
__device__ __forceinline__ void attn_phase(const Ctx& C, const int abl, unsigned* queues  ) {
    float* scr = (float*)(C.ws + WS_SCR) + ((size_t)C.bx * NWAVES + C.wave) * 4096;
    LAS int* slot = (LAS int*)(C.lds + SM_OFF + 1024);
    for (int qi = 0; qi < 8; ++qi) { const int x = (C.bx + qi) & 7;
        for (;;) {
            if (C.tid == 0) *slot = (int)__hip_atomic_fetch_add(queues + 64 * x, 1u, __ATOMIC_RELAXED, __HIP_MEMORY_SCOPE_AGENT);
            __syncthreads();
            const int idx = *slot;
            __syncthreads();
            if (idx >= 128) break;
            AtUnit U; U.b = x >> 1; U.g = x & 1; U.bg = x; U.c = 127 - idx;
            U.nct = (4 * U.c + 3 + 63) >> 6; U.wlo = (U.c >= 8) ? U.c - 8 : 0; U.njobs = 2 * U.nct + (U.c + 1) + (U.c - U.wlo + 1); U.nssc = (U.nct + AT_G - 1) / AT_G; U.nsss = (U.c + AT_G) / AT_G; U.nssw = (U.c - U.wlo + AT_G) / AT_G;
            attn_unit(C, U, abl, scr); } }
}


__device__ __forceinline__ unsigned f2key(float f) { const unsigned b = __float_as_uint(f); return (b & 0x80000000u) ? ~b : (b | 0x80000000u); }
__device__ __forceinline__ float key2f(unsigned k) { const unsigned b = (k & 0x80000000u) ? (k & 0x7fffffffu) : ~k; return __uint_as_float(b); }
__device__ __forceinline__ void norm2_router(const Ctx& C, const Args& a, int l) {
    LAS int* hist = (LAS int*)(C.lds + SM_OFF);
    if (C.tid < 32) hist[C.tid] = 0;
    __syncthreads();
    const int lane = C.lane, r16 = lane & 15, quad = lane >> 4;
    const int m = C.bx * 128 + C.wave * 16 + r16, b = m >> 13;
    const bf16* xrow = (const bf16*)(C.ws + WS_XB) + (size_t)m * DM + 8 * quad; const float* ma = (const float*)(C.ws + WS_MODA) + ((size_t)l * NB + b) * 2 * DM + 8 * quad;
    const bf16* wh = (const bf16*)(C.ws + WS_RWT) + (size_t)l * 2 * 32 * 1024 + (size_t)r16 * 1024 + 8 * quad; const bf16* wl = wh + 32 * 1024;
    bf16* hrow = (bf16*)(C.ws + WS_H) + (size_t)m * DM + 8 * quad;
    float ss; { const f32x4 pq = *(const f32x4*)((const float*)(C.ws + WS_SSQ) + (size_t)m * 16 + 4 * quad); ss = (pq.x + pq.y) + (pq.z + pq.w); }
    ss += shx(ss, 16, lane); ss += shx(ss, 32, lane);
    const float rstd = 1.0f / sqrtf(ss * (1.0f / DM) + 1e-6f);
    f32x4 d0 = {0.f, 0.f, 0.f, 0.f}, d1 = {0.f, 0.f, 0.f, 0.f};
#pragma unroll 4
    for (int ks = 0; ks < 32; ++ks) { const int o = 32 * ks;
        const v4u xw = *(const v4u*)(xrow + o); const f32x4 x0 = {bflo(xw.x), bfhi(xw.x), bflo(xw.y), bfhi(xw.y)}, x1 = {bflo(xw.z), bfhi(xw.z), bflo(xw.w), bfhi(xw.w)}, g0 = *(const f32x4*)(ma + o), g1 = *(const f32x4*)(ma + o + 4), s0 = *(const f32x4*)(ma + DM + o), s1 = *(const f32x4*)(ma + DM + o + 4);
        const f32x4 h0 = x0 * rstd * g0 + s0, h1 = x1 * rstd * g1 + s1;
        v4u hi; hi.x = cvt_pk_bf16(h0.x, h0.y); hi.y = cvt_pk_bf16(h0.z, h0.w); hi.z = cvt_pk_bf16(h1.x, h1.y); hi.w = cvt_pk_bf16(h1.z, h1.w);
        *(v4u*)(hrow + o) = hi;
        v4u lo; lo.x = cvt_pk_bf16(h0.x - bflo(hi.x), h0.y - bfhi(hi.x)); lo.y = cvt_pk_bf16(h0.z - bflo(hi.y), h0.w - bfhi(hi.y));
        lo.z = cvt_pk_bf16(h1.x - bflo(hi.z), h1.y - bfhi(hi.z)); lo.w = cvt_pk_bf16(h1.z - bflo(hi.w), h1.w - bfhi(hi.w));
        const bf16x8 bh = __builtin_bit_cast(bf16x8, hi), bl = __builtin_bit_cast(bf16x8, lo);
        const bf16x8 ah0 = *(const bf16x8*)(wh + o), ah1 = *(const bf16x8*)(wh + 16 * 1024 + o), al0 = *(const bf16x8*)(wl + o), al1 = *(const bf16x8*)(wl + 16 * 1024 + o);
        d0 = __builtin_amdgcn_mfma_f32_16x16x32_bf16(ah0, bh, d0, 0, 0, 0); d0 = __builtin_amdgcn_mfma_f32_16x16x32_bf16(ah0, bl, d0, 0, 0, 0); d0 = __builtin_amdgcn_mfma_f32_16x16x32_bf16(al0, bh, d0, 0, 0, 0);
        d1 = __builtin_amdgcn_mfma_f32_16x16x32_bf16(ah1, bh, d1, 0, 0, 0); d1 = __builtin_amdgcn_mfma_f32_16x16x32_bf16(ah1, bl, d1, 0, 0, 0); d1 = __builtin_amdgcn_mfma_f32_16x16x32_bf16(al1, bh, d1, 0, 0, 0); }
    const float* rb = a.in[I_RB] + l * NEXP; unsigned key[8];
#pragma unroll
    for (int r = 0; r < 4; ++r) { const int e0 = 4 * quad + r, e1 = 16 + 4 * quad + r;
        key[r] = (f2key(d0[r] + rb[e0]) & ~31u) | (unsigned)(31 - e0); key[4 + r] = (f2key(d1[r] + rb[e1]) & ~31u) | (unsigned)(31 - e1); }
    unsigned top[4];
#pragma unroll
    for (int k = 0; k < 4; ++k) { unsigned bk = key[0];
#pragma unroll
        for (int i = 1; i < 8; ++i) bk = key[i] > bk ? key[i] : bk;
        { const unsigned o = (unsigned)shxi((int)bk, 16, lane); bk = o > bk ? o : bk; } { const unsigned o = (unsigned)shxi((int)bk, 32, lane); bk = o > bk ? o : bk; }
        top[k] = bk;
#pragma unroll
        for (int i = 0; i < 8; ++i) key[i] = (key[i] == bk) ? 0u : key[i]; }
    if (quad == 0) { const float v0 = key2f(top[0] & ~31u), e1 = __expf(key2f(top[1] & ~31u) - v0), e2 = __expf(key2f(top[2] & ~31u) - v0), e3 = __expf(key2f(top[3] & ~31u) - v0);
        const float inv = 1.0f / (1.0f + e1 + e2 + e3);
        int* tope = (int*)(C.ws + WS_TOPE) + m * 4; float* topw = (float*)(C.ws + WS_TOPW) + m * 4;
        const int x0 = 31 - (int)(top[0] & 31u), x1 = 31 - (int)(top[1] & 31u), x2 = 31 - (int)(top[2] & 31u), x3 = 31 - (int)(top[3] & 31u);
        *(int4*)tope = make_int4(x0, x1, x2, x3); *(float4*)topw = make_float4(inv, e1 * inv, e2 * inv, e3 * inv);
        __hip_atomic_fetch_add(hist + x0, 1, __ATOMIC_RELAXED, __HIP_MEMORY_SCOPE_WORKGROUP); __hip_atomic_fetch_add(hist + x1, 1, __ATOMIC_RELAXED, __HIP_MEMORY_SCOPE_WORKGROUP);
        __hip_atomic_fetch_add(hist + x2, 1, __ATOMIC_RELAXED, __HIP_MEMORY_SCOPE_WORKGROUP); __hip_atomic_fetch_add(hist + x3, 1, __ATOMIC_RELAXED, __HIP_MEMORY_SCOPE_WORKGROUP); }
    __syncthreads();
    if (C.tid < 32) ((int*)(C.ws + WS_CNT))[C.bx * 32 + C.tid] = hist[C.tid];
    __syncthreads();
}
__device__ __forceinline__ void moe_scatter(const Ctx& C) {
    LAS int* sm = (LAS int*)(C.lds + SM_OFF); LAS int* tot = sm + 32; LAS int* base = sm + 64; LAS int* pstart = sm + 96  ; LAS int* lcnt = sm + 160; LAS int* pt = sm + 256; LAS int* pbs = sm + 256 + 512;
    const int* cnt = (const int*)(C.ws + WS_CNT); int* tile_e = (int*)(C.ws + WS_TILEE); int* rowtok = (int*)(C.ws + WS_ROWTOK);
    { const int e = C.tid & 31, part = C.tid >> 5; int t = 0, bs = 0;
#pragma unroll
      for (int i = 0; i < 16; ++i) { const int bb = part * 16 + i; if (bb < C.G) { const int c = cnt[bb * 32 + e]; t += c; bs += (bb < C.bx) ? c : 0; } }
      pt[part * 32 + e] = t; pbs[part * 32 + e] = bs; }
    __syncthreads();
    if (C.tid < 32) { int t = 0, bs = 0;
#pragma unroll
        for (int part = 0; part < 16; ++part) { t += pt[part * 32 + C.tid]; bs += pbs[part * 32 + C.tid]; }
        tot[C.tid] = t; base[C.tid] = bs; lcnt[C.tid] = 0; }
    __syncthreads();
    if (C.tid == 0) { int ps = 0; for (int e = 0; e < 32; ++e) { pstart[e] = ps; ps += ((tot[e] + 255) >> 8) << 8; } pstart[32] = ps; if (C.bx == 0) tile_e[1023] = ps >> 8; }
    __syncthreads();
    if (C.bx == 0) {
        for (int r = C.tid; r < (pstart[32] >> 8); r += NWAVES * 64) { int e = 0;
#pragma unroll
            for (int k = 1; k < 32; ++k) e += (pstart[k] <= r * 256) ? 1 : 0;
            tile_e[r] = e; }
        { const int e = C.tid >> 4; const int end = pstart[e + 1]; for (int r = pstart[e] + tot[e] + (C.tid & 15); r < end; r += 16) rowtok[r] = 0; } }
    const int* tope = (const int*)(C.ws + WS_TOPE); int* dest = (int*)(C.ws + WS_DEST);
    const int t = C.tid;
    { const int m = C.bx * 128 + (t >> 2); const int e = tope[m * 4 + (t & 3)]; const int rank = __hip_atomic_fetch_add(lcnt + e, 1, __ATOMIC_RELAXED, __HIP_MEMORY_SCOPE_WORKGROUP);
      const int row = pstart[e] + base[e] + rank; dest[m * 4 + (t & 3)] = row; rowtok[row] = m; }
    __syncthreads();
}
__device__ __forceinline__ void moe_combine(const Ctx& C, const Args& a, int l, float* Xout32  , bf16* Xout16  , const bool next_norm) {
    const int gw = C.bx * NWAVES + C.wave, NGW = C.G * NWAVES, lane = C.lane;
    const int* dest = (const int*)(C.ws + WS_DEST); const float* topw = (const float*)(C.ws + WS_TOPW); const bf16* Y = (const bf16*)(C.ws + WS_Y);
    const float* mod_l = (const float*)(C.ws + WS_MOD) + (size_t)l * NB * 6144; const bf16* X = (const bf16*)(C.ws + WS_XB);
    const float* gain_n = a.in[I_NORM1] + (l + 1) * DM; bf16* H = (bf16*)(C.ws + WS_H);
    int rn[4]; float wn[4];
    if (gw < NTOK) {
#pragma unroll
        for (int k = 0; k < 4; ++k) { rn[k] = dest[gw * 4 + k]; wn[k] = topw[gw * 4 + k]; } }
    for (int m = gw; m < NTOK; m += NGW) { const int b = m >> 13; const float* g2 = mod_l + (size_t)b * 6144 + 5 * DM;
        int r[4]; float w[4];
#pragma unroll
        for (int k = 0; k < 4; ++k) { r[k] = rn[k]; w[k] = wn[k]; }
        { const int mn = (m + NGW < NTOK) ? m + NGW : m;
#pragma unroll
          for (int k = 0; k < 4; ++k) { rn[k] = dest[mn * 4 + k]; wn[k] = topw[mn * 4 + k]; } }
        const v2u* xr = (const v2u*)(X + (size_t)m * DM) + lane;
        f32x4 xn[4]; float ss = 0.f;
#pragma unroll
        for (int j = 0; j < 4; ++j) { const int col = 4 * lane + 256 * j; f32x4 y = {0.f, 0.f, 0.f, 0.f};
#pragma unroll
            for (int k = 0; k < 4; ++k) { const v2u u = *(const v2u*)(Y + (size_t)r[k] * DM + col); y.x += w[k] * bflo(u.x); y.y += w[k] * bfhi(u.x); y.z += w[k] * bflo(u.y); y.w += w[k] * bfhi(u.y); }
            const f32x4 gv = *(const f32x4*)(g2 + col); const v2u xw = xr[64 * j]; const f32x4 xold = {bflo(xw.x), bfhi(xw.x), bflo(xw.y), bfhi(xw.y)}; xn[j] = xold + gv * y;
            if (Xout32) ((f32x4*)(Xout32 + (size_t)m * DM) + lane)[64 * j] = xn[j]; else { v2u wv; wv.x = cvt_pk_bf16(xn[j].x, xn[j].y); wv.y = cvt_pk_bf16(xn[j].z, xn[j].w); ((v2u*)(Xout16 + (size_t)m * DM) + lane)[64 * j] = wv; }
            ss += (xn[j].x * xn[j].x + xn[j].y * xn[j].y) + (xn[j].z * xn[j].z + xn[j].w * xn[j].w); }
        if (next_norm) {
            const float rstd = 1.0f / sqrtf(wave_sum(ss, lane) * (1.0f / DM) + 1e-6f); const float* mb = mod_l + (size_t)(NB + b) * 6144; v2u* o8 = (v2u*)(H + (size_t)m * DM) + lane;
#pragma unroll
            for (int j = 0; j < 4; ++j) { const int col = 4 * lane + 256 * j;
                const f32x4 g = *(const f32x4*)(gain_n + col), sc = *(const f32x4*)(mb + 1 * DM + col), sh = *(const f32x4*)(mb + col);
                const f32x4 h = xn[j] * rstd * g * (sc + 1.0f) + sh;
                v2u wv; wv.x = cvt_pk_bf16(h.x, h.y); wv.y = cvt_pk_bf16(h.z, h.w); o8[64 * j] = wv; } }
    }
}


#ifndef MK_ONE_LAUNCH
#define MK_ONE_LAUNCH 1
#endif
#ifndef REP_NORM1
#define REP_NORM1 1
#endif
#ifndef REP_PROJ
#define REP_PROJ 1
#endif
#ifndef REP_OUTG
#define REP_OUTG 1
#endif
#ifndef REP_COMB
#define REP_COMB 1
#endif
#ifndef ABL_ATTN
#define ABL_ATTN 0
#endif
#ifndef REP_BAR
#define REP_BAR 1
#endif
#ifndef PROBE_PH
#define PROBE_PH (-1)
#endif
#ifndef REP_P0
#define REP_P0 1
#endif
#ifndef REP_ATTN
#define REP_ATTN 1
#endif
#ifndef REP_POST
#define REP_POST 1
#endif
#ifndef REP_N2R
#define REP_N2R 1
#endif
#ifndef REP_GEMMIN
#define REP_GEMMIN 1
#endif
#ifndef REP_MOE
#define REP_MOE 1
#endif
#ifndef REP_SCAT
#define REP_SCAT 1
#endif
template <int l>
__device__ __forceinline__ void layer_body(Ctx& C, const Args& args, const XcdBarrier& bar, const int lo, const int hi, unsigned long long& tprev) {
    bf16* const H = (bf16*)(C.ws + WS_H); bf16* const Z = (bf16*)(C.ws + WS_Z);
    const float* const MOD = (const float*)(C.ws + WS_MOD);
    const int* const tile_e = (const int*)(C.ws + WS_TILEE);
#define IN(k) (fresh(C), lo <= (k) && (k) < hi)
#define SEAM(k) do { if (IN(k) && IN((k) + 1)) { for (int rb_ = 0; rb_ < REP_BAR; ++rb_) xcd_barrier(bar, C.tid); } \
    if (PROBE_PH >= 0) { const unsigned long long now_ = __builtin_amdgcn_s_memrealtime(); if (((k) >= 2 && ((k) - 2) % NPH_LAYER == PROBE_PH) || ((k) < 2 && (k) + 100 == PROBE_PH)) { while (__builtin_amdgcn_s_memrealtime() - now_ < now_ - tprev) __builtin_amdgcn_s_sleep(8); } tprev = __builtin_amdgcn_s_memrealtime(); } } while (0)

        const int pb = 2 + l * NPH_LAYER;
        const float* mod_l = MOD + (size_t)l * NB * 6144;
        if constexpr (l == 0) {
            if (IN(pb + PH_NORM1)) for (int rep = 0; rep < REP_NORM1; ++rep) norm_rows(C, args.in[I_X], args.in[I_NORM1], mod_l, 0, 1, H);
            SEAM(pb + PH_NORM1); }
        if (IN(pb + PH_GEMM_IN)) for (int rep = 0; rep < REP_GEMMIN; ++rep) {
            pg8::Gemm g{H, (const bf16*)(C.ws + WS_WIN) + (size_t)l * ZW * DM, NTOK, ZW, DM, nullptr, 0, nullptr}; pg8::StaticOrder S; S.init(NTOK, ZW, C.G, C.bx);
            pg8::EpiIn E{Z, (bf16*)(C.ws + WS_QN), (bf16*)(C.ws + WS_KSLC), (bf16*)(C.ws + WS_KWIN), args.in[I_QNORM] + l * 64, args.in[I_KNORM] + l * 192, (const float*)(C.ws + WS_ROPE)};
            pg8::gemm_phase<pg8::EpiIn, pg8::StaticOrder, true, true>(C.lds, g, S, E, C.tid); }
        SEAM(pb + PH_GEMM_IN);
        if (IN(pb + PH_POST)) for (int rep = 0; rep < REP_POST; ++rep) { post_tokens(C, args, l); __syncthreads(); PP_T0(3); for (int u = C.bx; u < 256; u += C.G) compress_unit(C, args, l, u); PP_T1(3); }
        SEAM(pb + PH_POST);
        if (IN(pb + PH_ATTN)) for (int rep = 0; rep < REP_ATTN; ++rep) attn_phase(C, (rep + 1 < REP_ATTN) ? ABL_ATTN : 0, (unsigned*)(C.ws + WS_CTL) + CW_QUEUE + (size_t)((rep * NL + l) * 8) * 64);
        if (IN(pb + PH_ATTN)) for (int rep = 0; rep < REP_PROJ; ++rep) {
            pg8::Gemm g{(const bf16*)(C.ws + WS_PM), (const bf16*)(C.ws + WS_WPOOL) + (size_t)l * 512 * 512, NTOK, 512, 512, nullptr, 0, nullptr}; pg8::StaticOrder S; S.init(NTOK, 512, C.G, C.bx);
            pg8::EpiStore E{(bf16*)(C.ws + WS_PP), 512, args.in[I_PSCALE] + l * 512};
            pg8::gemm_phase<pg8::EpiStore, pg8::StaticOrder, true, true>(C.lds, g, S, E, C.tid); }
        SEAM(pb + PH_POOLG);
        if (IN(pb + PH_PROJA)) {
            pg8::Gemm g{(const bf16*)(C.ws + WS_PP), (const bf16*)(C.ws + WS_WA) + (size_t)l * 1024 * 512, NTOK, 1024, 512, nullptr, 0, nullptr}; pg8::StaticOrder S; S.init(NTOK, 1024, C.G, C.bx);
            pg8::EpiGate<false> E{(bf16*)(C.ws + WS_MG), 1024, Z + ZC_MG, ZW};
            pg8::gemm_phase<pg8::EpiGate<false>, pg8::StaticOrder, true, true>(C.lds, g, S, E, C.tid); }
        if (IN(pb + PH_PROJA)) { for (int rep = 1; rep < REP_PROJ; ++rep) { {
            pg8::Gemm g{(const bf16*)(C.ws + WS_O), (const bf16*)(C.ws + WS_WB) + (size_t)l * 1024 * 1024, NTOK, 1024, 1024, nullptr, 0, nullptr}; pg8::StaticOrder S; S.init(NTOK, 1024, C.G, C.bx);
            pg8::EpiGate<true> E{(bf16*)(C.ws + WS_MG), 1024, Z + ZC_MG + 1024, ZW};
            pg8::gemm_phase<pg8::EpiGate<true>, pg8::StaticOrder, true, true>(C.lds, g, S, E, C.tid); } {
            pg8::Gemm g{(const bf16*)(C.ws + WS_PP), (const bf16*)(C.ws + WS_WA) + (size_t)l * 1024 * 512, NTOK, 1024, 512, nullptr, 0, nullptr}; pg8::StaticOrder S; S.init(NTOK, 1024, C.G, C.bx);
            pg8::EpiGate<false> E{(bf16*)(C.ws + WS_MG), 1024, Z + ZC_MG, ZW};
            pg8::gemm_phase<pg8::EpiGate<false>, pg8::StaticOrder, true, true>(C.lds, g, S, E, C.tid); } }
            {
            pg8::Gemm g{(const bf16*)(C.ws + WS_O), (const bf16*)(C.ws + WS_WB) + (size_t)l * 1024 * 1024, NTOK, 1024, 1024, nullptr, 0, nullptr}; pg8::StaticOrder S; S.init(NTOK, 1024, C.G, C.bx);
            pg8::EpiGate<true> E{(bf16*)(C.ws + WS_MG), 1024, Z + ZC_MG + 1024, ZW};
            pg8::gemm_phase<pg8::EpiGate<true>, pg8::StaticOrder, true, true>(C.lds, g, S, E, C.tid); } }
        SEAM(pb + PH_PROJB);
        if (IN(pb + PH_OUTG)) { for (int rep = 1; rep < REP_OUTG; ++rep) {
            pg8::Gemm g{(const bf16*)(C.ws + WS_MG), (const bf16*)(C.ws + WS_WOUT) + (size_t)l * 1024 * 1024, NTOK, 1024, 1024, nullptr, 0, nullptr}; pg8::StaticOrder S; S.init(NTOK, 1024, C.G, C.bx);
            pg8::EpiResidB<l == 0> E{args.in[I_X], (bf16*)(C.ws + WS_SCR), mod_l + 2 * DM, 6144, (float*)(C.ws + WS_SSQ)};
            pg8::gemm_phase<pg8::EpiResidB<l == 0>, pg8::StaticOrder, true, true>(C.lds, g, S, E, C.tid); }
            {
            pg8::Gemm g{(const bf16*)(C.ws + WS_MG), (const bf16*)(C.ws + WS_WOUT) + (size_t)l * 1024 * 1024, NTOK, 1024, 1024, nullptr, 0, nullptr}; pg8::StaticOrder S; S.init(NTOK, 1024, C.G, C.bx);
            pg8::EpiResidB<l == 0> E{args.in[I_X], (bf16*)(C.ws + WS_XB), mod_l + 2 * DM, 6144, (float*)(C.ws + WS_SSQ)};
            pg8::gemm_phase<pg8::EpiResidB<l == 0>, pg8::StaticOrder, true, true>(C.lds, g, S, E, C.tid); } }
        SEAM(pb + PH_OUTG);
        if (IN(pb + PH_NORM2R)) for (int rep = 0; rep < REP_N2R; ++rep) norm2_router(C, args, l);
        SEAM(pb + PH_NORM2R);
        if (IN(pb + PH_SCATTER)) for (int rep = 0; rep < REP_SCAT; ++rep) moe_scatter(C);
        SEAM(pb + PH_SCATTER);
        if (IN(pb + PH_GATEUP)) for (int rep = 0; rep < REP_MOE; ++rep) { const int R = tile_e[1023];
            pg8::Gemm g{H, (const bf16*)(C.ws + WS_WGU) + (size_t)l * NEXP * 2048 * 1024, R * 256, 2048, 1024, tile_e, (size_t)2048 * 1024 * 2, (const int*)(C.ws + WS_ROWTOK)}; pg8::StaticOrder S; S.init(R * 256, 2048, C.G, C.bx);
            pg8::EpiSwiglu E{(bf16*)(C.ws + WS_ACT), args.in[I_BGU] + (size_t)l * NEXP * 2048, tile_e};
            pg8::gemm_phase<pg8::EpiSwiglu, pg8::StaticOrder, true, true, true>(C.lds, g, S, E, C.tid); }
        SEAM(pb + PH_GATEUP);
        if (IN(pb + PH_DOWN)) for (int rep = 0; rep < REP_MOE; ++rep) { const int R = tile_e[1023];
            pg8::Gemm g{(const bf16*)(C.ws + WS_ACT), (const bf16*)(C.ws + WS_WD) + (size_t)l * NEXP * 1024 * 1024, R * 256, 1024, 1024, tile_e, (size_t)1024 * 1024 * 2, nullptr}; pg8::StaticOrder S; S.init(R * 256, 1024, C.G, C.bx);
            pg8::EpiBiasE E{(bf16*)(C.ws + WS_Y), args.in[I_BD] + (size_t)l * NEXP * 1024, tile_e};
            pg8::gemm_phase<pg8::EpiBiasE, pg8::StaticOrder, true, true>(C.lds, g, S, E, C.tid); }
        SEAM(pb + PH_DOWN);
        if (IN(pb + PH_COMBINE)) { for (int rep = 1; rep < REP_COMB; ++rep) moe_combine(C, args, l, (float*)(C.ws + WS_SCR), nullptr, false); moe_combine(C, args, l, (l + 1 < NL) ? nullptr : args.out, (bf16*)(C.ws + WS_XB), l + 1 < NL); }
        SEAM(pb + PH_COMBINE);

#undef IN
#undef SEAM
}
__global__ void __launch_bounds__(NWAVES * 64, 2) fwd(Args args) {
    extern __shared__ __attribute__((aligned(16))) unsigned char lds_raw[];
    Ctx C; C.lds = (LAS unsigned char*)lds_raw; C.tid = threadIdx.x; C.lane = C.tid & 63; C.wave = __builtin_amdgcn_readfirstlane(C.tid >> 6); C.bx = blockIdx.x; C.G = gridDim.x; C.ws = args.ws;
    for (int u = C.tid; u < (LDS_BYTES - MISC_OFF) / 4; u += NWAVES * 64) ((LAS unsigned*)(C.lds + MISC_OFF))[u] = 0u;
    __syncthreads();
    const int lo = args.ph_lo, hi = args.ph_hi;
    unsigned* barw = (unsigned*)(C.ws + WS_CTL) + CW_BAR + (size_t)args.li * XCD_BAR_WORDS;
    XcdBarrier bar; bar.bar = barw; bar.x = 0; bar.st = nullptr;
    if (hi - lo > 1) bar = xcd_barrier_post(barw, (volatile LAS unsigned*)(C.lds + MISC_OFF) + 8, C.tid);
#define IN(k) (fresh(C), lo <= (k) && (k) < hi)
#define SEAM(k) do { if (IN(k) && IN((k) + 1)) { for (int rb_ = 0; rb_ < REP_BAR; ++rb_) xcd_barrier(bar, C.tid); } \
    if (PROBE_PH >= 0) { const unsigned long long now_ = __builtin_amdgcn_s_memrealtime(); if (((k) >= 2 && ((k) - 2) % NPH_LAYER == PROBE_PH) || ((k) < 2 && (k) + 100 == PROBE_PH)) { while (__builtin_amdgcn_s_memrealtime() - now_ < now_ - tprev) __builtin_amdgcn_s_sleep(8); } tprev = __builtin_amdgcn_s_memrealtime(); } } while (0)
    bf16* const H = (bf16*)(C.ws + WS_H); bf16* const Z = (bf16*)(C.ws + WS_Z);
    const float* const MOD = (const float*)(C.ws + WS_MOD);
    const int* const tile_e = (const int*)(C.ws + WS_TILEE);

    unsigned long long tprev = (PROBE_PH >= 0) ? __builtin_amdgcn_s_memrealtime() : 0ull;
    if (IN(0)) for (int rep = 0; rep < REP_P0; ++rep) p0_convert(C, args);
    SEAM(0);
    if (IN(1)) p1_mod(C, args);
    SEAM(1);
    layer_body<0>(C, args, bar, lo, hi, tprev); layer_body<1>(C, args, bar, lo, hi, tprev); layer_body<2>(C, args, bar, lo, hi, tprev); layer_body<3>(C, args, bar, lo, hi, tprev);
#undef IN
#undef SEAM
}

extern "C" void kernel_launch(void* const* d_in, const int* in_sizes, int n_in, void* d_out, int out_size, void* d_ws, size_t ws_size, hipStream_t stream) {
    static int grid = 0;
    if (grid == 0) {
        if (n_in != N_IN || out_size != NTOK * DM || ws_size < WS_END) { fprintf(stderr, "kernel_launch: unexpected shapes (n_in %d, out %d, ws %zu < %zu)\n", n_in, out_size, ws_size, (size_t)WS_END); grid = -1; return; }
        int dev = 0, cus = 0;
        if (hipGetDevice(&dev) != hipSuccess || hipDeviceGetAttribute(&cus, hipDeviceAttributeMultiprocessorCount, dev) != hipSuccess) { grid = -1; return; }
        if (hipFuncSetAttribute((const void*)fwd, hipFuncAttributeMaxDynamicSharedMemorySize, LDS_BYTES) != hipSuccess) { fprintf(stderr, "kernel_launch: hipFuncSetAttribute failed\n"); grid = -1; return; }
        int per_cu = 0; (void)hipOccupancyMaxActiveBlocksPerMultiprocessor(&per_cu, (const void*)fwd, NWAVES * 64, LDS_BYTES); (void)hipGetLastError();
        if (cus != 256 || per_cu < 1) fprintf(stderr, "kernel_launch: note: %d CUs, occupancy query %d; this kernel is built for one 512-thread workgroup on each of 256 CUs\n", cus, per_cu);
        grid = 256;
    }
    if (grid < 0) return;
    if (hipMemsetAsync((char*)d_ws + WS_CTL, 0, CTL_ZERO_BYTES, stream) != hipSuccess) return;
    Args a{};
    for (int i = 0; i < N_IN; ++i) a.in[i] = (const float*)d_in[i];
    a.out = (float*)d_out; a.ws = (unsigned char*)d_ws;
#if MK_ONE_LAUNCH
    a.ph_lo = 0; a.ph_hi = NPHASES; a.li = 0; a.pad = 0;
    hipLaunchKernelGGL(fwd, dim3(grid), dim3(NWAVES * 64), LDS_BYTES, stream, a);
#else
    for (int ph = 0; ph < NPHASES; ++ph) { a.ph_lo = ph; a.ph_hi = ph + 1; a.li = 0; a.pad = 0;
        hipLaunchKernelGGL(fwd, dim3(grid), dim3(NWAVES * 64), LDS_BYTES, stream, a); }
#endif
}
```

```cpp
#include <hip/hip_runtime.h>
#include <cstdio>
#include <cstdint>

namespace pg8 {
#define PG8_LAS __attribute__((address_space(3)))
typedef unsigned short bf16_t;
typedef short bf16x8 __attribute__((ext_vector_type(8)));
typedef float f32x4 __attribute__((ext_vector_type(4)));
typedef unsigned u32x4 __attribute__((ext_vector_type(4)));
typedef float f32x2 __attribute__((ext_vector_type(2)));
constexpr int BM = 256, BK = 64, HALF = 128, HTB = HALF * BK * 2  , STAGE_BYTES = 8 * HTB, NXCD = 8, WGM = 4;

__host__ __device__ __forceinline__ int lds_byte(int r, int c) { const int st = (r >> 4) * 2 + (c >> 5), rr = r & 15, cc = c & 31, ob = rr * 64 + cc * 2; return st * 1024 + (ob ^ (((ob >> 9) & 1) << 5)); }
__host__ __device__ __forceinline__ void stage_rc(int b, int& R, int& C) { const int st = b / 1024, sb = b % 1024, swz = sb ^ (((sb >> 9) & 1) << 5); R = (st >> 1) * 16 + swz / 64; C = (st & 1) * 32 + (swz % 64) / 2; }
__host__ __device__ __forceinline__ int perm32(int rho) { const int n = rho >> 4, i = rho & 15; return 8 * (i >> 2) + 4 * n + (i & 3); }

struct Unit { int pm, pn; };
struct Gemm { const bf16_t* A; const bf16_t* Bt; int M, N, K; const int* tile_e; size_t be_stride; const int* row_tok; };

struct StaticOrder {
    int nM, nN, nwg, G, c, wgm;
    __host__ __device__ void init(int M, int N, int G_, int c_) { nM = M / BM; nN = N / BM; nwg = nM * nN; G = G_; c = c_; wgm = (nN == 4) ? 8 : (nN == 2) ? 16 : WGM; }
    __host__ __device__ bool next(int i, Unit& u) const {
        const long L = (long)i * G + c; if (L >= nwg) return false;
        int wgid = (int)L; { const int q = nwg / NXCD, r = nwg % NXCD, xcd = wgid % NXCD, off = wgid / NXCD; wgid = (xcd < r ? xcd * (q + 1) : r * (q + 1) + (xcd - r) * q) + off; }
        const int nig = wgm * nN, gid = wgid / nig, fm = gid * wgm, gsz = (nM - fm) < wgm ? (nM - fm) : wgm;
        u.pm = fm + ((wgid % nig) % gsz); u.pn = (wgid % nig) / gsz; return true;
    }
    __device__ __forceinline__ void a_ready(const Unit&) const {}
    __device__ __forceinline__ void done(const Unit&) const {}
};

typedef __bf16 bf16x2_t __attribute__((ext_vector_type(2)));
__device__ __forceinline__ unsigned cvt_pk_bf16(float lo, float hi) { const f32x2 v = {lo, hi}; return __builtin_bit_cast(unsigned, __builtin_convertvector(v, bf16x2_t)); }


template <class Epi, class Sched, bool ALIGN_EPI = false, bool SP2 = false, bool GATHER = false  >
__device__ __forceinline__ void gemm_phase(PG8_LAS unsigned char* lds, const Gemm g, const Sched& S, const Epi& E, const int tid_in  ) {
    int tid_ = tid_in; asm volatile("" : "+v"(tid_));
    float zz = 0.f; asm volatile("" : "+v"(zz));
    const int tid = tid_, wid = __builtin_amdgcn_readfirstlane(tid >> 6), lane = tid & 63, wr = wid >> 2, wc = wid & 3, fr = lane & 15, fq = lane >> 4;
    const int K = g.K, nt = K / BK;
    unsigned voffA[2], voffB[2];
    unsigned vgC[2][2], vgN[2][2], vgS[2][2];
#pragma unroll
    for (int i = 0; i < 2; ++i) { int R, C; stage_rc(tid * 16 + i * 8192, R, C); const int Rb = Epi::PERM ? ((R & ~31) + perm32(R & 31)) : R;
        voffA[i] = (unsigned)(R * K + C) * 2u; voffB[i] = (unsigned)(Rb * K + C) * 2u; }
    const size_t kstep = (size_t)(BK * 2);
    const size_t hstep = (size_t)HALF * K * 2;
    const size_t tstep = 2 * hstep;
    const unsigned ldsw = (unsigned)wid * 1024u;
    const int aoff = lds_byte(wr * 64 + fr, fq * 8), boff = lds_byte(wc * 32 + fr, fq * 8);
#define PG8_SA(b, h) (((b) * 2 + (h)) * HTB)
#define PG8_SB(b, h) ((4 + (b) * 2 + (h)) * HTB)
#define PG8_STAGE(bufoff, gbase, voff) do { _Pragma("unroll") for (int _i = 0; _i < 2; ++_i) \
        __builtin_amdgcn_global_load_lds((const unsigned*)((const char*)(gbase) + (voff)[_i]), (PG8_LAS unsigned*)(lds + (bufoff) + ldsw + _i * 8192), 16, 0, 0); } while (0)
#define PG8_STAGE_A(bufoff, ptr, h, VG) do { if constexpr (GATHER) { PG8_STAGE(bufoff, ptr, VG[h]); } else { PG8_STAGE(bufoff, (ptr) + (h) * hstep, voffA); } } while (0)
#define PG8_ROWS(u, VG) do { _Pragma("unroll") for (int _h = 0; _h < 2; ++_h) _Pragma("unroll") for (int _i = 0; _i < 2; ++_i) { int _R, _C; stage_rc(tid * 16 + _i * 8192, _R, _C); \
        VG[_h][_i] = ((unsigned)g.row_tok[(u).pm * BM + _h * HALF + _R] * (unsigned)K + (unsigned)_C) * 2u; } } while (0)
#define PG8_LDA(dst, b, h) do { _Pragma("unroll") for (int m = 0; m < 4; ++m) _Pragma("unroll") for (int k = 0; k < 2; ++k) dst[m][k] = *(const PG8_LAS bf16x8*)(lds + PG8_SA(b, h) + aoff + m * 2048 + k * 1024); } while (0)
#define PG8_LDB(dst, b, h) do { _Pragma("unroll") for (int n = 0; n < 2; ++n) _Pragma("unroll") for (int k = 0; k < 2; ++k) dst[n][k] = *(const PG8_LAS bf16x8*)(lds + PG8_SB(b, h) + boff + n * 2048 + k * 1024); } while (0)
#define PG8_MMA(ai, bj, At, Bt) do { __builtin_amdgcn_s_setprio(1); _Pragma("unroll") for (int m = 0; m < 4; ++m) _Pragma("unroll") for (int n = 0; n < 2; ++n) _Pragma("unroll") for (int k = 0; k < 2; ++k) \
        acc[ai][bj][m][n] = __builtin_amdgcn_mfma_f32_16x16x32_bf16(Bt[n][k], At[m][k], acc[ai][bj][m][n], 0, 0, 0); __builtin_amdgcn_s_setprio(0); } while (0)
#define PG8_WAIT_V(n) asm volatile("s_waitcnt vmcnt(" #n ")" ::: "memory")
#define PG8_WAIT_L(n) asm volatile("s_waitcnt lgkmcnt(" #n ")" ::: "memory")
#define PG8_BAR __builtin_amdgcn_s_barrier()
#define PG8_SCHED __builtin_amdgcn_sched_barrier(0)
    Unit cur, nxt; int ui = 0;
    if (!S.next(0, cur)) return;
    f32x4 acc[2][2][4][2];
#pragma unroll
    for (int a = 0; a < 2; ++a)
#pragma unroll
        for (int b = 0; b < 2; ++b)
#pragma unroll
            for (int m = 0; m < 4; ++m)
#pragma unroll
                for (int n = 0; n < 2; ++n) acc[a][b][m][n] = (f32x4){zz, zz, zz, zz};
    bf16x8 At[4][2], B0[2][2], B1[2][2];
    const char* cA = (const char*)g.A + (GATHER ? (size_t)0 : (size_t)cur.pm * tstep); const char* cB = (const char*)g.Bt + (g.tile_e ? (size_t)g.tile_e[cur.pm] * g.be_stride : (size_t)0) + (size_t)cur.pn * tstep;
    if constexpr (GATHER) { PG8_ROWS(cur, vgC); }
    S.a_ready(cur);
    if constexpr (SP2) {
        PG8_STAGE(PG8_SB(0, 0), cB, voffB); PG8_STAGE(PG8_SB(0, 1), cB + hstep, voffB); PG8_STAGE_A(PG8_SA(0, 0), cA, 0, vgC); PG8_STAGE_A(PG8_SA(0, 1), cA, 1, vgC);
        if (wr == 1) PG8_BAR;
        PG8_WAIT_V(2); PG8_BAR;
        PG8_STAGE(PG8_SB(1, 0), cB + kstep, voffB); PG8_STAGE_A(PG8_SA(1, 0), cA + kstep, 0, vgC); PG8_STAGE(PG8_SB(1, 1), cB + hstep + kstep, voffB);
        PG8_WAIT_V(6); PG8_BAR;
    } else {
        PG8_STAGE(PG8_SB(0, 0), cB, voffB); PG8_STAGE_A(PG8_SA(0, 0), cA, 0, vgC); PG8_STAGE(PG8_SB(0, 1), cB + hstep, voffB); PG8_STAGE_A(PG8_SA(0, 1), cA, 1, vgC);
        if (wr == 1) PG8_BAR;
        PG8_WAIT_V(4); PG8_BAR;
        PG8_STAGE(PG8_SB(1, 0), cB + kstep, voffB); PG8_STAGE_A(PG8_SA(1, 0), cA + kstep, 0, vgC); PG8_STAGE(PG8_SB(1, 1), cB + hstep + kstep, voffB);
        PG8_WAIT_V(6); PG8_BAR;
    }
    for (;;) {
        const bool has_next = S.next(ui + 1, nxt);
        if constexpr (GATHER) { if (has_next) { PG8_ROWS(nxt, vgN); } else { _Pragma("unroll") for (int _h = 0; _h < 2; ++_h) _Pragma("unroll") for (int _i = 0; _i < 2; ++_i) vgN[_h][_i] = vgC[_h][_i]; } }
        const char* nA = (has_next && !GATHER) ? (const char*)g.A + (size_t)nxt.pm * tstep : cA; const char* nB = has_next ? (const char*)g.Bt + (g.tile_e ? (size_t)g.tile_e[nxt.pm] * g.be_stride : (size_t)0) + (size_t)nxt.pn * tstep : cB;
        for (int t = 0; t < nt; t += 2) {
            const bool last = (t == nt - 2);
            if constexpr (GATHER) { _Pragma("unroll") for (int _h = 0; _h < 2; ++_h) _Pragma("unroll") for (int _i = 0; _i < 2; ++_i) vgS[_h][_i] = last ? vgN[_h][_i] : vgC[_h][_i]; }
            const char* a1 = cA + (size_t)(t + 1) * kstep;
            const char* a2 = last ? nA : cA + (size_t)(t + 2) * kstep; const char* b2 = last ? nB : cB + (size_t)(t + 2) * kstep;
            const char* a3 = a2 + kstep; const char* b3 = b2 + kstep;
            if (last && has_next) S.a_ready(nxt);
            if constexpr (SP2) {
            PG8_LDB(B0, 0, 0); PG8_LDB(B1, 0, 1); PG8_SCHED; PG8_LDA(At, 0, 0); PG8_STAGE_A(PG8_SA(1, 1), a1, 1, vgC);
            PG8_WAIT_V(8); PG8_WAIT_L(0); PG8_BAR; PG8_MMA(0, 0, At, B0); PG8_MMA(0, 1, At, B1); PG8_BAR; PG8_SCHED;
            PG8_LDA(At, 0, 1); PG8_STAGE(PG8_SB(0, 0), b2, voffB); PG8_STAGE(PG8_SB(0, 1), b2 + hstep, voffB); PG8_STAGE_A(PG8_SA(0, 0), a2, 0, vgS);
            PG8_WAIT_V(8); PG8_WAIT_L(0); PG8_BAR; PG8_MMA(1, 0, At, B0); PG8_MMA(1, 1, At, B1); PG8_BAR; PG8_SCHED;
            PG8_LDB(B0, 1, 0); PG8_LDB(B1, 1, 1); PG8_SCHED; PG8_LDA(At, 1, 0); PG8_STAGE_A(PG8_SA(0, 1), a2, 1, vgS);
            PG8_WAIT_V(8); PG8_WAIT_L(0); PG8_BAR; PG8_MMA(0, 0, At, B0); PG8_MMA(0, 1, At, B1); PG8_BAR; PG8_SCHED;
            PG8_LDA(At, 1, 1); PG8_STAGE(PG8_SB(1, 0), b3, voffB); PG8_STAGE(PG8_SB(1, 1), b3 + hstep, voffB); PG8_STAGE_A(PG8_SA(1, 0), a3, 0, vgS);
            PG8_WAIT_V(8); PG8_WAIT_L(0); PG8_BAR; PG8_MMA(1, 0, At, B0); PG8_MMA(1, 1, At, B1); PG8_BAR; PG8_SCHED;
            } else {
            PG8_LDB(B0, 0, 0); PG8_SCHED; PG8_LDA(At, 0, 0); PG8_STAGE_A(PG8_SA(1, 1), a1, 1, vgC);
            PG8_WAIT_L(8); PG8_BAR; PG8_WAIT_L(0); PG8_MMA(0, 0, At, B0); PG8_BAR; PG8_SCHED;
            PG8_LDB(B1, 0, 1); PG8_STAGE(PG8_SB(0, 0), b2, voffB);
            PG8_BAR; PG8_WAIT_L(0); PG8_MMA(0, 1, At, B1); PG8_BAR;
            PG8_LDA(At, 0, 1); PG8_STAGE_A(PG8_SA(0, 0), a2, 0, vgS);
            PG8_BAR; PG8_WAIT_L(0); PG8_MMA(1, 0, At, B0); PG8_BAR; PG8_SCHED;
            PG8_STAGE(PG8_SB(0, 1), b2 + hstep, voffB);
            PG8_WAIT_V(6); PG8_BAR; PG8_MMA(1, 1, At, B1); PG8_BAR;
            PG8_LDB(B0, 1, 0); PG8_SCHED; PG8_LDA(At, 1, 0); PG8_STAGE_A(PG8_SA(0, 1), a2, 1, vgS);
            PG8_WAIT_L(8); PG8_BAR; PG8_WAIT_L(0); PG8_MMA(0, 0, At, B0); PG8_BAR; PG8_SCHED;
            PG8_LDB(B1, 1, 1); PG8_STAGE(PG8_SB(1, 0), b3, voffB);
            PG8_BAR; PG8_WAIT_L(0); PG8_MMA(0, 1, At, B1); PG8_BAR;
            PG8_LDA(At, 1, 1); PG8_STAGE_A(PG8_SA(1, 0), a3, 0, vgS);
            PG8_BAR; PG8_WAIT_L(0); PG8_MMA(1, 0, At, B0); PG8_BAR; PG8_SCHED;
            PG8_STAGE(PG8_SB(1, 1), b3 + hstep, voffB);
            PG8_WAIT_V(6); PG8_BAR; PG8_MMA(1, 1, At, B1); PG8_BAR;
            }
        }
        if constexpr (ALIGN_EPI) { if (wr == 0) PG8_BAR; }
        if constexpr (!Epi::AFTER_DRAIN) { E(acc, cur, wr, wc, fr, fq); S.done(cur); }
        if (!has_next) break;
#pragma unroll
        for (int a = 0; a < 2; ++a)
#pragma unroll
            for (int b = 0; b < 2; ++b)
#pragma unroll
                for (int m = 0; m < 4; ++m)
#pragma unroll
                    for (int n = 0; n < 2; ++n) acc[a][b][m][n] = (f32x4){zz, zz, zz, zz};
        cur = nxt; cA = nA; cB = nB; ++ui; if constexpr (GATHER) { _Pragma("unroll") for (int _h = 0; _h < 2; ++_h) _Pragma("unroll") for (int _i = 0; _i < 2; ++_i) vgC[_h][_i] = vgN[_h][_i]; }
        if constexpr (ALIGN_EPI) { if (wr == 1) PG8_BAR; }
    }
    PG8_WAIT_V(0);
    if constexpr (!ALIGN_EPI) { if (wr == 0) PG8_BAR; }
    PG8_BAR;
    if constexpr (Epi::AFTER_DRAIN) { E.fused(acc, cur, wr, wc, fr, fq, lds, wid, lane); S.done(cur); }
#undef PG8_SA
#undef PG8_SB
#undef PG8_STAGE
#undef PG8_STAGE_A
#undef PG8_ROWS
#undef PG8_LDA
#undef PG8_LDB
#undef PG8_MMA
#undef PG8_WAIT_V
#undef PG8_WAIT_L
#undef PG8_BAR
#undef PG8_SCHED
}

__device__ __forceinline__ float sigmoidf_(float x) { return __builtin_amdgcn_rcpf(1.0f + __builtin_amdgcn_exp2f(x * -1.4426950408889634f)); }
__device__ __forceinline__ float bflo(unsigned w) { return __uint_as_float(w << 16); }
__device__ __forceinline__ float bfhi(unsigned w) { return __uint_as_float(w & 0xffff0000u); }

struct EpiStore {
    static constexpr bool PERM = true, AFTER_DRAIN = false;
    bf16_t* O; int ldc; const float* cs;
    __device__ __forceinline__ void operator()(const f32x4 (&acc)[2][2][4][2], const Unit& u, int wr, int wc, int fr, int fq) const {
        const int row0 = u.pm * BM + wr * 64 + fr, col0 = u.pn * BM + wc * 32 + 8 * fq;
        f32x4 sv[2][2];
#pragma unroll
        for (int bj = 0; bj < 2; ++bj)
#pragma unroll
            for (int n = 0; n < 2; ++n) sv[bj][n] = cs ? *(const f32x4*)(cs + col0 + bj * HALF + 4 * n) : (f32x4){1.f, 1.f, 1.f, 1.f};
#pragma unroll
        for (int ai = 0; ai < 2; ++ai)
#pragma unroll
            for (int m = 0; m < 4; ++m) { bf16_t* rowp = O + (size_t)(row0 + ai * HALF + m * 16) * ldc + col0;
#pragma unroll
                for (int bj = 0; bj < 2; ++bj) { const f32x4 v0 = acc[ai][bj][m][0] * sv[bj][0], v1 = acc[ai][bj][m][1] * sv[bj][1];
                    u32x4 w; w.x = cvt_pk_bf16(v0[0], v0[1]); w.y = cvt_pk_bf16(v0[2], v0[3]); w.z = cvt_pk_bf16(v1[0], v1[1]); w.w = cvt_pk_bf16(v1[2], v1[3]);
                    *(u32x4*)(rowp + bj * HALF) = w; } }
    }
};
struct EpiIn {
    static constexpr bool PERM = true, AFTER_DRAIN = false;
    bf16_t* Z; bf16_t* Qn; bf16_t* Kslc; bf16_t* Kwin; const float* qn; const float* kn  ; const float* rope  ;
    __device__ __forceinline__ void operator()(const f32x4 (&acc)[2][2][4][2], const Unit& u, int wr, int wc, int fr, int fq) const {
        const int row0 = u.pm * BM + wr * 64 + fr, lane = fq * 16 + fr;
        const bool isq = (u.pn >= 2 && u.pn < 6), isk = ((u.pn == 7 || u.pn == 8) && wc < 2);
        if (!isq && !isk) {
            const int col0 = u.pn * BM + wc * 64 + 8 * fq;
#pragma unroll
            for (int ai = 0; ai < 2; ++ai)
#pragma unroll
                for (int m = 0; m < 4; ++m) { bf16_t* rowp = Z + (size_t)(row0 + ai * HALF + m * 16) * 4608 + col0;
#pragma unroll
                    for (int bj = 0; bj < 2; ++bj) { const f32x4 v0 = acc[ai][bj][m][0], v1 = acc[ai][bj][m][1];
                        u32x4 w; w.x = cvt_pk_bf16(v0[0], v0[1]); w.y = cvt_pk_bf16(v0[2], v0[3]); w.z = cvt_pk_bf16(v1[0], v1[1]); w.w = cvt_pk_bf16(v1[2], v1[3]);
                        *(u32x4*)(rowp + bj * 32) = w; } }
            return; }
        const float* gp = isq ? qn : kn + (u.pn == 7 ? 64 : 128); const float gsc = isq ? 0.18033688011112042f : 1.0f;
        f32x4 g[2][2];
#pragma unroll
        for (int bj = 0; bj < 2; ++bj) { g[bj][0] = *(const f32x4*)(gp + 32 * bj + 8 * fq) * gsc; g[bj][1] = *(const f32x4*)(gp + 32 * bj + 8 * fq + 4) * gsc; }
#pragma unroll
        for (int ai = 0; ai < 2; ++ai)
#pragma unroll
            for (int m = 0; m < 4; ++m) { const int row = row0 + ai * HALF + m * 16, t = row & 8191;
                f32x4 x[2][2]; float ss = 0.f;
#pragma unroll
                for (int bj = 0; bj < 2; ++bj)
#pragma unroll
                    for (int n = 0; n < 2; ++n) { x[bj][n] = acc[ai][bj][m][n]; ss += (x[bj][n][0] * x[bj][n][0] + x[bj][n][1] * x[bj][n][1]) + (x[bj][n][2] * x[bj][n][2] + x[bj][n][3] * x[bj][n][3]); }
                ss += __int_as_float(__builtin_amdgcn_ds_bpermute((lane ^ 16) << 2, __float_as_int(ss))); ss += __int_as_float(__builtin_amdgcn_ds_bpermute((lane ^ 32) << 2, __float_as_int(ss)));
                const float rstd = 1.0f / sqrtf(ss * (1.0f / 64.0f) + 1e-6f);
#pragma unroll
                for (int bj = 0; bj < 2; ++bj)
#pragma unroll
                    for (int n = 0; n < 2; ++n) x[bj][n] = x[bj][n] * rstd * g[bj][n];
                f32x4 p0, p1;
#pragma unroll
                for (int i = 0; i < 4; ++i) { p0[i] = __int_as_float(__builtin_amdgcn_ds_bpermute((lane ^ 16) << 2, __float_as_int(x[0][0][i]))); p1[i] = __int_as_float(__builtin_amdgcn_ds_bpermute((lane ^ 16) << 2, __float_as_int(x[0][1][i]))); }
                if (fq < 2) { const float* rp = rope + t * 16; const f32x4 c0 = *(const f32x4*)rp, c1 = *(const f32x4*)(rp + 4), s0 = *(const f32x4*)(rp + 8), s1 = *(const f32x4*)(rp + 12);
                    if (fq == 0) { x[0][0] = x[0][0] * c0 - p0 * s0; x[0][1] = x[0][1] * c1 - p1 * s1; } else { x[0][0] = x[0][0] * c0 + p0 * s0; x[0][1] = x[0][1] * c1 + p1 * s1; } }
                bf16_t* dst = isq ? Qn + (size_t)row * 1024 + ((u.pn - 2) * 4 + wc) * 64 + 8 * fq
                                  : (u.pn == 7 ? Kslc : Kwin) + ((size_t)((row >> 13) * 2 + wc) * 8192 + t) * 64 + 8 * fq;
#pragma unroll
                for (int bj = 0; bj < 2; ++bj) { u32x4 w; w.x = cvt_pk_bf16(x[bj][0][0], x[bj][0][1]); w.y = cvt_pk_bf16(x[bj][0][2], x[bj][0][3]); w.z = cvt_pk_bf16(x[bj][1][0], x[bj][1][1]); w.w = cvt_pk_bf16(x[bj][1][2], x[bj][1][3]);
                    *(u32x4*)(dst + 32 * bj) = w; } }
    }
};
template <bool ADD> struct EpiGate {
    static constexpr bool PERM = true, AFTER_DRAIN = false;
    bf16_t* O; int ldc; const bf16_t* G; int ldg;
    __device__ __forceinline__ void operator()(const f32x4 (&acc)[2][2][4][2], const Unit& u, int wr, int wc, int fr, int fq) const {
        const int row0 = u.pm * BM + wr * 64 + fr, col0 = u.pn * BM + wc * 32 + 8 * fq;
#pragma unroll
        for (int ai = 0; ai < 2; ++ai)
#pragma unroll
            for (int m = 0; m < 4; ++m) { const size_t row = (size_t)(row0 + ai * HALF + m * 16); bf16_t* rowp = O + row * ldc + col0; const bf16_t* gp = G + row * ldg + col0;
#pragma unroll
                for (int bj = 0; bj < 2; ++bj) { const u32x4 gw = *(const u32x4*)(gp + bj * HALF);
                    f32x4 v0 = acc[ai][bj][m][0], v1 = acc[ai][bj][m][1];
                    v0[0] *= sigmoidf_(bflo(gw.x)); v0[1] *= sigmoidf_(bfhi(gw.x)); v0[2] *= sigmoidf_(bflo(gw.y)); v0[3] *= sigmoidf_(bfhi(gw.y));
                    v1[0] *= sigmoidf_(bflo(gw.z)); v1[1] *= sigmoidf_(bfhi(gw.z)); v1[2] *= sigmoidf_(bflo(gw.w)); v1[3] *= sigmoidf_(bfhi(gw.w));
                    if (ADD) { const u32x4 ow = *(const u32x4*)(rowp + bj * HALF);
                        v0[0] += bflo(ow.x); v0[1] += bfhi(ow.x); v0[2] += bflo(ow.y); v0[3] += bfhi(ow.y);
                        v1[0] += bflo(ow.z); v1[1] += bfhi(ow.z); v1[2] += bflo(ow.w); v1[3] += bfhi(ow.w); }
                    u32x4 w; w.x = cvt_pk_bf16(v0[0], v0[1]); w.y = cvt_pk_bf16(v0[2], v0[3]); w.z = cvt_pk_bf16(v1[0], v1[1]); w.w = cvt_pk_bf16(v1[2], v1[3]);
                    *(u32x4*)(rowp + bj * HALF) = w; } }
    }
};
struct EpiResid {
    static constexpr bool PERM = false, AFTER_DRAIN = false;
    const float* Xin; float* Xout; const float* modp; int mod_bstride; float* ssq;
    __device__ __forceinline__ void operator()(const f32x4 (&acc)[2][2][4][2], const Unit& u, int wr, int wc, int fr, int fq) const {
        const int row0 = u.pm * BM + wr * 64 + fr, col0 = u.pn * BM + wc * 32 + 4 * fq;
        const float* gp = modp + (size_t)((u.pm * BM) >> 13) * mod_bstride;
        f32x4 gv[2][2];
#pragma unroll
        for (int bj = 0; bj < 2; ++bj)
#pragma unroll
            for (int n = 0; n < 2; ++n) gv[bj][n] = *(const f32x4*)(gp + col0 + bj * HALF + n * 16);
#pragma unroll
        for (int ai = 0; ai < 2; ++ai)
#pragma unroll
            for (int m = 0; m < 4; ++m) { const int row = row0 + ai * HALF + m * 16; const size_t off = (size_t)row * 1024 + col0; float q = 0.f;
#pragma unroll
                for (int bj = 0; bj < 2; ++bj)
#pragma unroll
                    for (int n = 0; n < 2; ++n) { const f32x4 xo = *(const f32x4*)(Xin + off + bj * HALF + n * 16); const f32x4 xn = xo + gv[bj][n] * acc[ai][bj][m][n];
                        *(f32x4*)(Xout + off + bj * HALF + n * 16) = xn; q += (xn[0] * xn[0] + xn[1] * xn[1]) + (xn[2] * xn[2] + xn[3] * xn[3]); }
                const int lane = fq * 16 + fr;
                q += __int_as_float(__builtin_amdgcn_ds_bpermute((lane ^ 16) << 2, __float_as_int(q))); q += __int_as_float(__builtin_amdgcn_ds_bpermute((lane ^ 32) << 2, __float_as_int(q)));
                if (fq == 0) ssq[(size_t)row * 16 + u.pn * 4 + wc] = q; }
    }
};
template <bool IN32> struct EpiResidB {
    static constexpr bool PERM = true, AFTER_DRAIN = false;
    const float* Xin32; bf16_t* XB; const float* modp; int mod_bstride; float* ssq;
    __device__ __forceinline__ void operator()(const f32x4 (&acc)[2][2][4][2], const Unit& u, int wr, int wc, int fr, int fq) const {
        const int row0 = u.pm * BM + wr * 64 + fr, col0 = u.pn * BM + wc * 32 + 8 * fq;
        const float* gp = modp + (size_t)((u.pm * BM) >> 13) * mod_bstride;
        f32x4 gv[2][2];
#pragma unroll
        for (int bj = 0; bj < 2; ++bj)
#pragma unroll
            for (int n = 0; n < 2; ++n) gv[bj][n] = *(const f32x4*)(gp + col0 + bj * HALF + 4 * n);
#pragma unroll
        for (int ai = 0; ai < 2; ++ai)
#pragma unroll
            for (int mp = 0; mp < 2; ++mp) {
                f32x4 xo[2][2][2];
#pragma unroll
                for (int mi = 0; mi < 2; ++mi) { const size_t off = (size_t)(row0 + ai * HALF + (2 * mp + mi) * 16) * 1024 + col0;
#pragma unroll
                    for (int bj = 0; bj < 2; ++bj) {
                        if constexpr (IN32) { xo[mi][bj][0] = *(const f32x4*)(Xin32 + off + bj * HALF); xo[mi][bj][1] = *(const f32x4*)(Xin32 + off + bj * HALF + 4); }
                        else { const u32x4 w = *(const u32x4*)(XB + off + bj * HALF); xo[mi][bj][0] = (f32x4){bflo(w.x), bfhi(w.x), bflo(w.y), bfhi(w.y)}; xo[mi][bj][1] = (f32x4){bflo(w.z), bfhi(w.z), bflo(w.w), bfhi(w.w)}; } } }
#pragma unroll
                for (int mi = 0; mi < 2; ++mi) { const int m = 2 * mp + mi; const int row = row0 + ai * HALF + m * 16; const size_t off = (size_t)row * 1024 + col0; float q = 0.f;
#pragma unroll
                    for (int bj = 0; bj < 2; ++bj) { const f32x4 x0 = xo[mi][bj][0] + gv[bj][0] * acc[ai][bj][m][0], x1 = xo[mi][bj][1] + gv[bj][1] * acc[ai][bj][m][1];
                        u32x4 w; w.x = cvt_pk_bf16(x0[0], x0[1]); w.y = cvt_pk_bf16(x0[2], x0[3]); w.z = cvt_pk_bf16(x1[0], x1[1]); w.w = cvt_pk_bf16(x1[2], x1[3]);
                        *(u32x4*)(XB + off + bj * HALF) = w;
                        q += ((x0[0] * x0[0] + x0[1] * x0[1]) + (x0[2] * x0[2] + x0[3] * x0[3])) + ((x1[0] * x1[0] + x1[1] * x1[1]) + (x1[2] * x1[2] + x1[3] * x1[3])); }
                    const int lane = fq * 16 + fr;
                    q += __int_as_float(__builtin_amdgcn_ds_bpermute((lane ^ 16) << 2, __float_as_int(q))); q += __int_as_float(__builtin_amdgcn_ds_bpermute((lane ^ 32) << 2, __float_as_int(q)));
                    if (fq == 0) ssq[(size_t)row * 16 + u.pn * 4 + wc] = q; } }
    }
};
__device__ __forceinline__ float swiglu_(float g, float u) { g = fminf(g, 7.0f); u = fminf(fmaxf(u, -7.0f), 7.0f); return (u + 1.0f) * g * sigmoidf_(g * 1.702f); }
__device__ __forceinline__ f32x2 swiglu2_(const f32x4 v) {
    f32x2 g = {fminf(v[0], 7.0f), fminf(v[2], 7.0f)}, u = {fminf(fmaxf(v[1], -7.0f), 7.0f), fminf(fmaxf(v[3], -7.0f), 7.0f)};
    const f32x2 t = g * (1.702f * -1.4426950408889634f); f32x2 e; e.x = __builtin_amdgcn_exp2f(t.x); e.y = __builtin_amdgcn_exp2f(t.y);
    const f32x2 d = e + 1.0f; f32x2 r; r.x = __builtin_amdgcn_rcpf(d.x); r.y = __builtin_amdgcn_rcpf(d.y);
    return ((u + 1.0f) * g) * r;
}
struct EpiSwiglu {
    static constexpr bool PERM = true, AFTER_DRAIN = false;
    bf16_t* ACT; const float* bias; const int* tile_e;
    __device__ __forceinline__ void operator()(const f32x4 (&acc)[2][2][4][2], const Unit& u, int wr, int wc, int fr, int fq) const {
        const int row0 = u.pm * BM + wr * 64 + fr, col0 = u.pn * BM + wc * 32 + 8 * fq;
        const float* bp = bias + (size_t)tile_e[u.pm] * 2048;
        f32x4 bv[2][2];
#pragma unroll
        for (int bj = 0; bj < 2; ++bj)
#pragma unroll
            for (int n = 0; n < 2; ++n) bv[bj][n] = *(const f32x4*)(bp + col0 + bj * HALF + 4 * n);
#pragma unroll
        for (int ai = 0; ai < 2; ++ai)
#pragma unroll
            for (int m = 0; m < 4; ++m) { bf16_t* rowp = ACT + (size_t)(row0 + ai * HALF + m * 16) * 1024 + (col0 >> 1);
#pragma unroll
                for (int bj = 0; bj < 2; ++bj) { const f32x4 v0 = acc[ai][bj][m][0] + bv[bj][0], v1 = acc[ai][bj][m][1] + bv[bj][1];
                    typedef unsigned u32x2v __attribute__((ext_vector_type(2)));
                    const f32x2 a0 = swiglu2_(v0), a1 = swiglu2_(v1); u32x2v w; w.x = cvt_pk_bf16(a0.x, a0.y); w.y = cvt_pk_bf16(a1.x, a1.y);
                    *(u32x2v*)(rowp + bj * (HALF / 2)) = w; } }
    }
};
struct EpiBiasE {
    static constexpr bool PERM = true, AFTER_DRAIN = false;
    bf16_t* O; const float* bias; const int* tile_e;
    __device__ __forceinline__ void operator()(const f32x4 (&acc)[2][2][4][2], const Unit& u, int wr, int wc, int fr, int fq) const {
        const int row0 = u.pm * BM + wr * 64 + fr, col0 = u.pn * BM + wc * 32 + 8 * fq;
        const float* bp = bias + (size_t)tile_e[u.pm] * 1024;
        f32x4 bv[2][2];
#pragma unroll
        for (int bj = 0; bj < 2; ++bj)
#pragma unroll
            for (int n = 0; n < 2; ++n) bv[bj][n] = *(const f32x4*)(bp + col0 + bj * HALF + 4 * n);
#pragma unroll
        for (int ai = 0; ai < 2; ++ai)
#pragma unroll
            for (int m = 0; m < 4; ++m) { bf16_t* rowp = O + (size_t)(row0 + ai * HALF + m * 16) * 1024 + col0;
#pragma unroll
                for (int bj = 0; bj < 2; ++bj) { const f32x4 v0 = acc[ai][bj][m][0] + bv[bj][0], v1 = acc[ai][bj][m][1] + bv[bj][1];
                    u32x4 w; w.x = cvt_pk_bf16(v0[0], v0[1]); w.y = cvt_pk_bf16(v0[2], v0[3]); w.z = cvt_pk_bf16(v1[0], v1[1]); w.w = cvt_pk_bf16(v1[2], v1[3]);
                    *(u32x4*)(rowp + bj * HALF) = w; } }
    }
};
}


constexpr int NL = 4, NB = 4, SEQ = 8192, DM = 1024, NTOK = NB * SEQ;
constexpr int ZW = 4608;
constexpr int ZC_U = 0, ZC_Q = 512, ZC_KCM = 1536, ZC_VCM = 1664, ZC_KSL = 1792, ZC_VSL = 1920, ZC_KWN = 2048, ZC_VWN = 2176, ZC_MG = 2304, ZC_NG = 4352;
constexpr int IN_W = 4400;
constexpr int NEXP = 32, MOE_ROWS_MAX = (NTOK * 4 / 256 + NEXP) * 256;
constexpr int NPH_LAYER = 13, NPHASES = 2 + NL * NPH_LAYER;
enum { PH_NORM1 = 0, PH_GEMM_IN, PH_POST, PH_ATTN, PH_POOLG, PH_PROJA, PH_PROJB, PH_OUTG, PH_NORM2R, PH_SCATTER, PH_GATEUP, PH_DOWN, PH_COMBINE };

constexpr size_t alignup(size_t x) { return (x + 255) & ~(size_t)255; }
constexpr size_t WS_CTL = 0, CTL_ZERO_BYTES = 1u << 20;
constexpr size_t WS_MOD = WS_CTL + CTL_ZERO_BYTES;
constexpr size_t WS_MODP = WS_MOD + alignup((size_t)NL * NB * 6144 * 4);
constexpr size_t WS_ROPE = WS_MODP + alignup((size_t)16 * NL * NB * 6144 * 4);
constexpr size_t WS_WIN = WS_ROPE + alignup((size_t)SEQ * 16 * 4);
constexpr size_t WS_WPOOL = WS_WIN + alignup((size_t)NL * ZW * DM * 2);
constexpr size_t WS_WA = WS_WPOOL + alignup((size_t)NL * 512 * 512 * 2);
constexpr size_t WS_WB = WS_WA + alignup((size_t)NL * 1024 * 512 * 2);
constexpr size_t WS_WOUT = WS_WB + alignup((size_t)NL * 1024 * 1024 * 2);
constexpr size_t WS_W1 = WS_WOUT + alignup((size_t)NL * 1024 * 1024 * 2);
constexpr size_t WS_W2 = WS_W1 + alignup((size_t)NL * 2 * 256 * 2048 * 2);
constexpr size_t WS_WGU = WS_W2 + alignup((size_t)NL * 2 * 64 * 256 * 2);
constexpr size_t WS_WD = WS_WGU + alignup((size_t)NL * NEXP * 2048 * 1024 * 2);
constexpr size_t WS_H = WS_WD + alignup((size_t)NL * NEXP * 1024 * 1024 * 2);
constexpr size_t WS_Z = WS_H + alignup((size_t)NTOK * DM * 2);
constexpr size_t WS_QN = WS_Z + alignup((size_t)NTOK * ZW * 2);
constexpr size_t WS_KSLC = WS_QN + alignup((size_t)NTOK * DM * 2);
constexpr size_t WS_KWIN = WS_KSLC + alignup((size_t)NB * 2 * SEQ * 64 * 2);
constexpr size_t WS_VSLCT = WS_KWIN + alignup((size_t)NB * 2 * SEQ * 64 * 2);
constexpr size_t WS_VWINT = WS_VSLCT + alignup((size_t)NB * 2 * SEQ * 64 * 2);
constexpr size_t WS_KC = WS_VWINT + alignup((size_t)NB * 2 * SEQ * 64 * 2);
constexpr size_t WS_VCT = WS_KC + alignup((size_t)NB * 2 * 512 * 64 * 2);
constexpr size_t WS_PM = WS_VCT + alignup((size_t)NB * 2 * 512 * 64 * 2);
constexpr size_t WS_PP = WS_PM + alignup((size_t)NTOK * 512 * 2);
constexpr size_t WS_O = WS_PP + alignup((size_t)NTOK * 512 * 2);
constexpr size_t WS_MG = WS_O + alignup((size_t)NTOK * DM * 2);
constexpr size_t WS_TOPE = WS_MG + alignup((size_t)NTOK * DM * 2);
constexpr size_t WS_TOPW = WS_TOPE + alignup((size_t)NTOK * 4 * 4);
constexpr size_t WS_DEST = WS_TOPW + alignup((size_t)NTOK * 4 * 4);
constexpr size_t WS_CNT = WS_DEST + alignup((size_t)NTOK * 4 * 4);
constexpr size_t WS_TILEE = WS_CNT + alignup((size_t)1024 * 32 * 4);
constexpr size_t WS_ROWTOK = WS_TILEE + alignup((size_t)1024 * 4);
constexpr size_t WS_ACT = WS_ROWTOK + alignup((size_t)MOE_ROWS_MAX * 4);
constexpr size_t WS_Y = WS_ACT + alignup((size_t)MOE_ROWS_MAX * 1024 * 2);
constexpr size_t WS_RWT = WS_Y + alignup((size_t)MOE_ROWS_MAX * 1024 * 2);
constexpr size_t WS_MODA = WS_RWT + alignup((size_t)NL * 2 * 32 * 1024 * 2);
constexpr size_t WS_SSQ = WS_MODA + alignup((size_t)NL * NB * 2 * DM * 4);
constexpr size_t WS_SCR = WS_SSQ + alignup((size_t)NTOK * 16 * 4);
constexpr size_t WS_XB = WS_SCR + alignup((size_t)1024 * 8 * 4096 * 4);
constexpr size_t WS_END = WS_XB + alignup((size_t)NTOK * DM * 2);
constexpr int CW_QUEUE = 65536;
constexpr int CW_BAR = 4096;

constexpr int RING_BYTES = 131584;
constexpr int MISC_OFF = 135168;
constexpr int SM_OFF = 136192;
constexpr int LDS_BYTES = 147456;
constexpr int NWAVES = 8;

#define GAS __attribute__((address_space(1)))
#define LAS __attribute__((address_space(3)))
typedef unsigned short bf16;
typedef unsigned v4u __attribute__((ext_vector_type(4)));
typedef unsigned v2u __attribute__((ext_vector_type(2)));
typedef float f32x4 __attribute__((ext_vector_type(4)));
typedef short bf16x8 __attribute__((ext_vector_type(8)));
typedef GAS unsigned gu32;
#define RLX_AGENT __ATOMIC_RELAXED, __HIP_MEMORY_SCOPE_AGENT
#define LDS_WAIT() asm volatile("s_waitcnt lgkmcnt(0)" ::: "memory")
#define VM_WAIT() asm volatile("s_waitcnt vmcnt(0)" ::: "memory")
using pg8::cvt_pk_bf16; using pg8::bflo; using pg8::bfhi; using pg8::sigmoidf_;
__device__ __forceinline__ float bf2f(bf16 h) { return __uint_as_float((unsigned)h << 16); }
__device__ __forceinline__ bf16 f2bf(float f) { return (bf16)(cvt_pk_bf16(f, 0.f) & 0xffffu); }
__device__ __forceinline__ float shx(float v, int mask, int lane) { return __int_as_float(__builtin_amdgcn_ds_bpermute((lane ^ mask) << 2, __float_as_int(v))); }
__device__ __forceinline__ int shxi(int v, int mask, int lane) { return __builtin_amdgcn_ds_bpermute((lane ^ mask) << 2, v); }
__device__ __forceinline__ float shf(float v, int src) { return __int_as_float(__builtin_amdgcn_ds_bpermute(src << 2, __float_as_int(v))); }
__device__ __forceinline__ int shfi(int v, int src) { return __builtin_amdgcn_ds_bpermute(src << 2, v); }
__device__ __forceinline__ float wave_sum(float v, int lane) {
#pragma unroll
    for (int o = 1; o < 64; o <<= 1) v += shx(v, o, lane);
    return v;
}
__device__ __forceinline__ int vt_pos(int n) { return (n & ~31) | (((n >> 2) & 3) << 3) | (((n >> 4) & 1) << 2) | (n & 3); }


#define XB_TMO      128
#define XB_XCNT(j)  (256  + 64 * (j))
#define XB_XSUB(j)  (1280 + 64 * (j))
#define XB_XGEN(j)  (2304 + 64 * (j))
#define XB_TOP      3328
#define XB_TOPGEN   3392
#define XCD_BAR_WORDS 3456
#define XB_SPIN_CAP (1u << 18)

__device__ __forceinline__ unsigned xb_ld(unsigned* p)              { return __hip_atomic_load(p, __ATOMIC_RELAXED, __HIP_MEMORY_SCOPE_AGENT); }
__device__ __forceinline__ unsigned xb_add(unsigned* p, unsigned v) { return __hip_atomic_fetch_add(p, v, __ATOMIC_RELAXED, __HIP_MEMORY_SCOPE_AGENT); }
__device__ __forceinline__ unsigned xb_xcc_id() { return (unsigned)__builtin_amdgcn_s_getreg((3 << 11) | 20) & 0xFu; }
#define XB_SPIN(cond, bar) do { unsigned _sp = 0; while (cond) { __builtin_amdgcn_s_sleep(1); \
    if ((++_sp & 255u) == 0u) { if (xb_ld(&(bar)[XB_TMO])) break; if (_sp > XB_SPIN_CAP) { atomicAdd(&(bar)[XB_TMO], 1u); break; } } } } while (0)

struct XcdBarrier {
    unsigned* bar; unsigned x;
    volatile LAS unsigned* st;
};

__device__ __forceinline__ XcdBarrier xcd_barrier_post(unsigned* bar, volatile LAS unsigned* st, const int tid_x  ) {
    XcdBarrier b; b.bar = bar; b.x = xb_xcc_id(); b.st = st;
    if (tid_x == 0) (void)xb_add(&bar[XB_XCNT(b.x)], 1u);
    return b;
}
__device__ __forceinline__ void xcd_barrier_complete(unsigned* bar, unsigned x, unsigned& nloc, unsigned& nx) {
    const unsigned G = gridDim.x * gridDim.y * gridDim.z;
    unsigned sum, cnt, mine, sp = 0u;
    for (;;) {
        sum = 0u; cnt = 0u; mine = 0u;
#pragma unroll
        for (unsigned j = 0; j < 16; ++j) { const unsigned c = xb_ld(&bar[XB_XCNT(j)]); sum += c; cnt += (c > 0u) ? 1u : 0u; mine = (j == x) ? c : mine; }
        if (sum == G) break;
        __builtin_amdgcn_s_sleep(1);
        if ((++sp & 255u) == 0u) { if (xb_ld(&bar[XB_TMO])) break; if (sp > XB_SPIN_CAP) { atomicAdd(&bar[XB_TMO], 1u); break; } }
    }
    nloc = mine > 0u ? mine : 1u; nx = cnt > 0u ? cnt : 1u;
}

__device__ __forceinline__ void xcd_barrier(const XcdBarrier& b, const int tid_x) {
    asm volatile("s_waitcnt vmcnt(0)" ::: "memory");
    __syncthreads();
    if (tid_x == 0) {
        unsigned* bar = b.bar;
        __builtin_amdgcn_s_waitcnt(0);
        unsigned nloc = b.st[0], nx = b.st[1];
        if (nloc == 0u) { xcd_barrier_complete(bar, b.x, nloc, nx); b.st[0] = nloc; b.st[1] = nx; }
        const unsigned old = xb_add(&bar[XB_XSUB(b.x)], 1u);
        const unsigned gen = old / nloc;
        if (old + 1u == (gen + 1u) * nloc) {
            __builtin_amdgcn_fence(__ATOMIC_RELEASE, "agent");
            asm volatile("s_waitcnt vmcnt(0)" ::: "memory");
            const unsigned og = xb_add(&bar[XB_TOP], 1u);
            const unsigned tg = og / nx;
            if (og + 1u == (tg + 1u) * nx) xb_add(&bar[XB_TOPGEN], 1u);
            else XB_SPIN(xb_ld(&bar[XB_TOPGEN]) == tg, bar);
            __builtin_amdgcn_fence(__ATOMIC_ACQUIRE, "agent");
            xb_add(&bar[XB_XGEN(b.x)], 1u);
            asm volatile("s_waitcnt vmcnt(0)" ::: "memory");
        } else {
            XB_SPIN(xb_ld(&bar[XB_XGEN(b.x)]) == gen, bar);
            __builtin_amdgcn_fence(__ATOMIC_ACQUIRE, "agent");
            asm volatile("s_waitcnt vmcnt(0)" ::: "memory");
        }
    }
    __syncthreads();
}


enum { I_X = 0, I_C, I_NORM1, I_NORM2, I_ADAW, I_ADAB, I_WIN, I_WPOOL, I_PSCALE, I_QNORM, I_KNORM, I_CMPPOS, I_CMPW1, I_CMPB1, I_CMPW2, I_WPA, I_WPB, I_WOUT,
       I_RW, I_RB, I_WGU, I_BGU, I_WD, I_BD, N_IN };
struct Args { const float* in[N_IN]; float* out; unsigned char* ws; int ph_lo, ph_hi, li, pad; };

struct Ctx {
    LAS unsigned char* lds;
    int tid, lane, wave, bx, G;
    unsigned char* ws;
};
__device__ __forceinline__ void fresh(Ctx& C) { unsigned z = 0u; asm volatile("" : "+s"(z));   int t = C.wave * 64 + (int)__builtin_amdgcn_mbcnt_hi(~0u, __builtin_amdgcn_mbcnt_lo(~0u, z)); asm volatile("" : "+v"(t)); C.tid = t; C.lane = t & 63; int bx = blockIdx.x, G = gridDim.x; asm volatile("" : "+s"(bx), "+s"(G)); C.bx = bx; C.G = G; }

__device__ __forceinline__ int inmap(int np) { return np < 2304 ? np : (np < 4352 ? np + 48 : (np < 4400 ? np - 2048 : -1)); }
struct P0Item { const float* W; bf16* WT; int K, N, NP, item; bool mapin; };
__device__ __forceinline__ void p0_load(const P0Item& I, int lane, f32x4 (&v)[8]) {
    const int nblk = I.NP / 32, kb = I.item / nblk, nb = I.item % nblk, k0 = 64 * kb, n0 = 32 * nb;
    const int c4 = 4 * (lane & 7); int sc = n0 + c4; if (I.mapin) { const int x = sc; sc = inmap((x & ~255) | (((x >> 5) & 3) << 6) | (((x >> 7) & 1) << 5) | (x & 31)); }
#pragma unroll
    for (int i = 0; i < 8; ++i) { const int kk = 8 * i + (lane >> 3); v[i] = (sc >= 0) ? *(const f32x4*)(I.W + (size_t)(k0 + kk) * I.N + sc) : (f32x4){0.f, 0.f, 0.f, 0.f}; }
}
__device__ __forceinline__ void p0_store(const P0Item& I, int lane, LAS float* scr, const f32x4 (&v)[8]) {
    const int nblk = I.NP / 32, kb = I.item / nblk, nb = I.item % nblk, k0 = 64 * kb, n0 = 32 * nb; const int c4 = 4 * (lane & 7);
#pragma unroll
    for (int i = 0; i < 8; ++i) { const int kk = 8 * i + (lane >> 3); LAS float* d = scr + kk * 33 + c4; d[0] = v[i].x; d[1] = v[i].y; d[2] = v[i].z; d[3] = v[i].w; }
    LDS_WAIT(); asm volatile("" ::: "memory");
    const int c = lane & 7;
#pragma unroll
    for (int j = 0; j < 4; ++j) { const int n = (lane >> 3) + 8 * j; const LAS float* sp = scr + (8 * c) * 33 + n;
        v4u o; o.x = cvt_pk_bf16(sp[0 * 33], sp[1 * 33]); o.y = cvt_pk_bf16(sp[2 * 33], sp[3 * 33]); o.z = cvt_pk_bf16(sp[4 * 33], sp[5 * 33]); o.w = cvt_pk_bf16(sp[6 * 33], sp[7 * 33]);
        *(v4u*)(I.WT + (size_t)(n0 + n) * I.K + k0 + 8 * c) = o; }
    LDS_WAIT(); asm volatile("" ::: "memory");
}
constexpr int P0_IT_IN = 16 * (ZW / 32), P0_IT_A = 8 * 32, P0_IT_B = 16 * 32, P0_IT_O = 16 * 32, P0_IT_W1 = 32 * 8, P0_IT_W2 = 4 * 2, P0_IT_GU = 16 * 64, P0_IT_D = 16 * 32;
constexpr int P0_IT_LAYER = P0_IT_IN + P0_IT_A + P0_IT_B + P0_IT_O + 2 * P0_IT_W1 + 2 * P0_IT_W2 + NEXP * P0_IT_GU + NEXP * P0_IT_D;
__device__ __forceinline__ P0Item p0_item(const Ctx& C, const Args& a, int it) {
    P0Item I; I.mapin = false; const int l = it / P0_IT_LAYER; int r = it % P0_IT_LAYER;
    if (r < P0_IT_IN) { I.W = a.in[I_WIN] + (size_t)l * DM * IN_W; I.K = DM; I.N = IN_W; I.NP = ZW; I.WT = (bf16*)(C.ws + WS_WIN) + (size_t)l * ZW * DM; I.item = r; I.mapin = true; return I; } r -= P0_IT_IN;
    if (r < P0_IT_A) { I.W = a.in[I_WPA] + (size_t)l * 512 * 1024; I.K = 512; I.N = 1024; I.NP = 1024; I.WT = (bf16*)(C.ws + WS_WA) + (size_t)l * 1024 * 512; I.item = r; return I; } r -= P0_IT_A;
    if (r < P0_IT_B) { I.W = a.in[I_WPB] + (size_t)l * 1024 * 1024; I.K = 1024; I.N = 1024; I.NP = 1024; I.WT = (bf16*)(C.ws + WS_WB) + (size_t)l * 1024 * 1024; I.item = r; return I; } r -= P0_IT_B;
    if (r < P0_IT_O) { I.W = a.in[I_WOUT] + (size_t)l * 1024 * 1024; I.K = 1024; I.N = 1024; I.NP = 1024; I.WT = (bf16*)(C.ws + WS_WOUT) + (size_t)l * 1024 * 1024; I.item = r; return I; } r -= P0_IT_O;
    if (r < 2 * P0_IT_W1) { const int kv = r / P0_IT_W1; I.W = a.in[I_CMPW1] + (size_t)(l * 2 + kv) * 2048 * 256; I.K = 2048; I.N = 256; I.NP = 256; I.WT = (bf16*)(C.ws + WS_W1) + (size_t)(l * 2 + kv) * 256 * 2048; I.item = r % P0_IT_W1; return I; } r -= 2 * P0_IT_W1;
    if (r < 2 * P0_IT_W2) { const int kv = r / P0_IT_W2; I.W = a.in[I_CMPW2] + (size_t)(l * 2 + kv) * 256 * 64; I.K = 256; I.N = 64; I.NP = 64; I.WT = (bf16*)(C.ws + WS_W2) + (size_t)(l * 2 + kv) * 64 * 256; I.item = r % P0_IT_W2; return I; } r -= 2 * P0_IT_W2;
    if (r < NEXP * P0_IT_GU) { const int e = r / P0_IT_GU; I.W = a.in[I_WGU] + (size_t)(l * NEXP + e) * 1024 * 2048; I.K = 1024; I.N = 2048; I.NP = 2048; I.WT = (bf16*)(C.ws + WS_WGU) + (size_t)(l * NEXP + e) * 2048 * 1024; I.item = r % P0_IT_GU; return I; } r -= NEXP * P0_IT_GU;
    { const int e = r / P0_IT_D; I.W = a.in[I_WD] + (size_t)(l * NEXP + e) * 1024 * 1024; I.K = 1024; I.N = 1024; I.NP = 1024; I.WT = (bf16*)(C.ws + WS_WD) + (size_t)(l * NEXP + e) * 1024 * 1024; I.item = r % P0_IT_D; return I; }
}
__device__ __forceinline__ void p0_convert(const Ctx& C, const Args& a) {
    LAS float* scr = (LAS float*)(C.lds + C.wave * 16384);
    const int gw = C.bx * NWAVES + C.wave, NGW = C.G * NWAVES;
    { constexpr int NIT = NL * P0_IT_LAYER; int it = gw;
      if (it < NIT) { f32x4 va[8], vb[8]; P0Item Ia = p0_item(C, a, it), Ib = Ia; p0_load(Ia, C.lane, va);
          for (;;) {
              const int it2 = it + NGW; const bool h2 = it2 < NIT; if (h2) { Ib = p0_item(C, a, it2); p0_load(Ib, C.lane, vb); }
              p0_store(Ia, C.lane, scr, va); if (!h2) break;
              const int it3 = it2 + NGW; const bool h3 = it3 < NIT; if (h3) { Ia = p0_item(C, a, it3); p0_load(Ia, C.lane, va); }
              p0_store(Ib, C.lane, scr, vb); if (!h3) break;
              it = it3; } } }
    const int gt = C.bx * (NWAVES * 64) + C.tid, NGT = C.G * NWAVES * 64;
    { bf16* wp = (bf16*)(C.ws + WS_WPOOL);
      for (int i = gt; i < NL * 512 * 512; i += NGT) { const int l = i >> 18, ep = (i >> 9) & 511, cp = i & 511; float v = 0.f;
          if ((ep >> 7) == (cp >> 7)) v = a.in[I_WPOOL][(((size_t)l * 4 + (ep >> 7)) * 128 + (cp & 127)) * 128 + (ep & 127)];
          wp[i] = f2bf(v); } }
    { bf16* rwt = (bf16*)(C.ws + WS_RWT);
      for (int i = gt; i < NL * 32 * 1024; i += NGT) { const int l = i >> 15, e = (i >> 10) & 31, k = i & 1023; const float w = a.in[I_RW][((size_t)l * DM + k) * NEXP + e];
          const bf16 hi = f2bf(w); rwt[(size_t)(l * 2) * 32768 + e * 1024 + k] = hi; rwt[(size_t)(l * 2 + 1) * 32768 + e * 1024 + k] = f2bf(w - bf2f(hi)); } }
    { float* rp = (float*)(C.ws + WS_ROPE);
      for (int i = gt; i < SEQ * 8; i += NGT) { const int pos = i >> 3, fi = i & 7;
          const float invf[8] = {1.0f, 0.1939227432012558f, 0.03760603070259094f, 0.007292664609849453f, 0.0014142135623842478f, 0.00027424818836152554f, 5.318296098266728e-05f, 1.0313386155758053e-05f};
          float f = invf[0];
#pragma unroll
          for (int q = 1; q < 8; ++q) f = (fi == q) ? invf[q] : f;
          const float ang = (float)pos * f; const double rev = (double)ang * 0.15915494309189535; const float fr = (float)(rev - __builtin_rint(rev));
          rp[pos * 16 + fi] = __builtin_amdgcn_cosf(fr); rp[pos * 16 + 8 + fi] = __builtin_amdgcn_sinf(fr); } }
    __syncthreads();
    { LAS float* sc = (LAS float*)C.lds;
      for (int i = C.tid; i < NB * DM; i += NWAVES * 64) { const float cv = a.in[I_C][i]; sc[i] = cv * sigmoidf_(cv); }
      __syncthreads();
      float* mp = (float*)(C.ws + WS_MODP);
      for (int i = gt; i < 16 * NL * 6144; i += NGT) { const int j = i % 6144, l = (i / 6144) % NL, ks = i / (6144 * NL);
          const float* w = a.in[I_ADAW] + ((size_t)l * DM + ks * 64) * 6144 + j; float a0 = 0.f, a1 = 0.f, a2 = 0.f, a3 = 0.f;
#pragma unroll 16
          for (int k = 0; k < 64; ++k) { const float wv = w[(size_t)k * 6144]; const int kk = ks * 64 + k;
              a0 += sc[kk] * wv; a1 += sc[DM + kk] * wv; a2 += sc[2 * DM + kk] * wv; a3 += sc[3 * DM + kk] * wv; }
          float* o = mp + ((size_t)(ks * NL + l) * NB) * 6144 + j; o[0] = a0; o[6144] = a1; o[2 * 6144] = a2; o[3 * 6144] = a3; }
      __syncthreads(); }
}
__device__ __forceinline__ void p1_mod(const Ctx& C, const Args& a) {
    const int gt = C.bx * (NWAVES * 64) + C.tid, NGT = C.G * NWAVES * 64;
    const float* mp = (const float*)(C.ws + WS_MODP); float* mo = (float*)(C.ws + WS_MOD);
    for (int i = gt; i < NL * NB * 6144; i += NGT) { const int j = i % 6144, l = i / (NB * 6144);
        float s = a.in[I_ADAB][l * 6144 + j];
#pragma unroll
        for (int ks = 0; ks < 16; ++ks) s += mp[(size_t)ks * NL * NB * 6144 + i];
        mo[i] = s; }
    float* ma = (float*)(C.ws + WS_MODA);
    for (int i = gt; i < NL * NB * DM; i += NGT) { const int k = i % DM, lb = i / DM, l = lb / NB;
        float sc = a.in[I_ADAB][l * 6144 + 4 * DM + k], sh = a.in[I_ADAB][l * 6144 + 3 * DM + k];
#pragma unroll
        for (int ks = 0; ks < 16; ++ks) { const float* q = mp + (size_t)ks * NL * NB * 6144 + (size_t)lb * 6144; sc += q[4 * DM + k]; sh += q[3 * DM + k]; }
        ma[(size_t)lb * 2 * DM + k] = a.in[I_NORM2][l * DM + k] * (1.0f + sc); ma[(size_t)lb * 2 * DM + DM + k] = sh; }
}


__device__ __forceinline__ void norm_rows(const Ctx& C, const float* X, const float* gain, const float* mod_l  , int shift_i, int scale_i, bf16* H) {
    const int gw = C.bx * NWAVES + C.wave, NGW = C.G * NWAVES;
    for (int m = gw; m < NTOK; m += NGW) {
        const int b = m >> 13; const f32x4* xr = (const f32x4*)(X + (size_t)m * DM) + C.lane;
        f32x4 v[4]; float s = 0.f;
#pragma unroll
        for (int j = 0; j < 4; ++j) { v[j] = xr[64 * j]; s += (v[j].x * v[j].x + v[j].y * v[j].y) + (v[j].z * v[j].z + v[j].w * v[j].w); }
        const float rstd = 1.0f / sqrtf(wave_sum(s, C.lane) * (1.0f / DM) + 1e-6f);
        const float* mb = mod_l + (size_t)b * 6144; v2u* o8 = (v2u*)(H + (size_t)m * DM) + C.lane;
#pragma unroll
        for (int j = 0; j < 4; ++j) { const int col = 4 * C.lane + 256 * j;
            const f32x4 g = *(const f32x4*)(gain + col), sc = *(const f32x4*)(mb + scale_i * DM + col), sh = *(const f32x4*)(mb + shift_i * DM + col);
            const f32x4 h = v[j] * rstd * g * (sc + 1.0f) + sh;
            v2u w; w.x = cvt_pk_bf16(h.x, h.y); w.y = cvt_pk_bf16(h.z, h.w); o8[64 * j] = w; }
    }
}

#ifndef PROBE_PP
#define PROBE_PP 0
#endif
#define PP_T0(id) unsigned long long pt0_##id = 0ull; if (PROBE_PP == id) pt0_##id = __builtin_amdgcn_s_memrealtime()
#define PP_T1(id) do { if (PROBE_PP == id) { const unsigned long long t1_ = __builtin_amdgcn_s_memrealtime(); while (__builtin_amdgcn_s_memrealtime() - t1_ < t1_ - pt0_##id) __builtin_amdgcn_s_sleep(4); } } while (0)
__device__ __forceinline__ void post_tokens(const Ctx& C, const Args& a, int l) {
    const int gw = C.bx * NWAVES + C.wave, NGW = C.G * NWAVES, lane = C.lane;
    const bf16* Z = (const bf16*)(C.ws + WS_Z); bf16* Pm = (bf16*)(C.ws + WS_PM); (void)a; (void)l;
    PP_T0(1);
    for (int ch = gw; ch < NTOK / 16; ch += NGW) {
      const int pch = lane * 8, pw = 2 << (lane >> 4), t0 = (ch * 16) & (SEQ - 1); float psum[8] = {0.f, 0.f, 0.f, 0.f, 0.f, 0.f, 0.f, 0.f};
      { const bf16* zp = Z + (size_t)(ch * 16) * ZW + ZC_U + pch;
#pragma unroll
        for (int k = 1; k < 16; ++k) { if (k < pw && k <= t0) { const v4u u = *(const v4u*)(zp - (size_t)k * ZW);
              psum[0] += bflo(u.x); psum[1] += bfhi(u.x); psum[2] += bflo(u.y); psum[3] += bfhi(u.y); psum[4] += bflo(u.z); psum[5] += bfhi(u.z); psum[6] += bflo(u.w); psum[7] += bfhi(u.w); } } }
      for (int bt = 0; bt < 2; ++bt) {
        v4u UU[8], VV[8];
        {
#pragma unroll
          for (int i = 0; i < 8; ++i) { const int m = ch * 16 + bt * 8 + i, t = m & (SEQ - 1); const bf16* zr = Z + (size_t)m * ZW;
              UU[i] = *(const v4u*)(zr + ZC_U + pch); const int back = (t + 1 >= pw) ? (pw - 1) : 0; VV[i] = *(const v4u*)(zr - (size_t)back * ZW + ZC_U + pch); } }
#pragma unroll
      for (int i8 = 0; i8 < 8; ++i8) { const int m = ch * 16 + bt * 8 + i8;
        const int t = m & (SEQ - 1);
        { const v4u u = UU[i8]; const float f[8] = {bflo(u.x), bfhi(u.x), bflo(u.y), bfhi(u.y), bflo(u.z), bfhi(u.z), bflo(u.w), bfhi(u.w)};
          const int cnt = (t + 1 < pw) ? (t + 1) : pw; const float inv = 1.0f / (float)cnt; float d[8];
#pragma unroll
          for (int i = 0; i < 8; ++i) { psum[i] += f[i]; d[i] = psum[i] * inv - f[i]; }
          v4u o; o.x = cvt_pk_bf16(d[0], d[1]); o.y = cvt_pk_bf16(d[2], d[3]); o.z = cvt_pk_bf16(d[4], d[5]); o.w = cvt_pk_bf16(d[6], d[7]);
          *(v4u*)(Pm + (size_t)m * 512 + pch) = o;
          if (t + 1 >= pw) { const v4u v = VV[i8];
              psum[0] -= bflo(v.x); psum[1] -= bfhi(v.x); psum[2] -= bflo(v.y); psum[3] -= bfhi(v.y); psum[4] -= bflo(v.z); psum[5] -= bfhi(v.z); psum[6] -= bflo(v.w); psum[7] -= bfhi(v.w); } }
      }
      }
    }
    PP_T1(1);
    PP_T0(2);
    { bf16* VsT = (bf16*)(C.ws + WS_VSLCT); bf16* VwT = (bf16*)(C.ws + WS_VWINT);
      for (int it = gw; it < 2 * NB * 2 * (SEQ / 64); it += NGW) { const int tt = it & 127, g = (it >> 7) & 1, b = (it >> 8) & 3, which = it >> 10;
          const bf16* src = Z + ((size_t)(b * SEQ + tt * 64 + lane)) * ZW + (which ? ZC_VWN : ZC_VSL) + g * 64;
          bf16* dst = (which ? VwT : VsT) + ((size_t)(b * 2 + g) * 64) * SEQ + tt * 64 + vt_pos(lane);
#pragma unroll
          for (int c = 0; c < 8; ++c) { const v4u u = *(const v4u*)(src + 8 * c); bf16* d = dst + (size_t)(8 * c) * SEQ;
              d[0] = (bf16)(u.x & 0xffff); d[SEQ] = (bf16)(u.x >> 16); d[2 * SEQ] = (bf16)(u.y & 0xffff); d[3 * SEQ] = (bf16)(u.y >> 16);
              d[4 * SEQ] = (bf16)(u.z & 0xffff); d[5 * SEQ] = (bf16)(u.z >> 16); d[6 * SEQ] = (bf16)(u.w & 0xffff); d[7 * SEQ] = (bf16)(u.w >> 16); } } }
    PP_T1(2);
}

__device__ __forceinline__ void compress_unit(const Ctx& C, const Args& a, int l, int u) {
    const int kv = u & 1, nt = (u >> 1) & 15, bg = u >> 5, b = bg >> 1, g = bg & 1, n0 = nt * 32;
    const int lane = C.lane, r16 = lane & 15, quad = lane >> 4, w = C.wave;
    const bf16* Z = (const bf16*)(C.ws + WS_Z);
    const bf16* W1t = (const bf16*)(C.ws + WS_W1) + (size_t)(l * 2 + kv) * 256 * 2048;
    const bf16* W2t = (const bf16*)(C.ws + WS_W2) + (size_t)(l * 2 + kv) * 64 * 256;
    const float* pos = a.in[I_CMPPOS] + (size_t)(l * 2 + kv) * 32 * 64;
    const float* b1 = a.in[I_CMPB1] + (size_t)(l * 2 + kv) * 256;
    LAS float* part = (LAS float*)C.lds;
    LAS bf16* hidL = (LAS bf16*)C.lds;
    LAS float* outL = (LAS float*)(C.lds + 32 * 264 * 2);
    const bf16* arow[2];
#pragma unroll
    for (int rt = 0; rt < 2; ++rt) { const int n = n0 + 16 * rt + r16; const int nl = (n > 510) ? 510 : n; arow[rt] = Z + ((size_t)(b * SEQ + 16 * nl)) * ZW + (kv ? ZC_VCM : ZC_KCM) + g * 64; }
    f32x4 acc[2][16];
#pragma unroll
    for (int rt = 0; rt < 2; ++rt)
#pragma unroll
        for (int ct = 0; ct < 16; ++ct) acc[rt][ct] = (f32x4){0.f, 0.f, 0.f, 0.f};
    { const bf16* wb = W1t + (size_t)r16 * 2048 + 256 * w + quad * 8;
      for (int ks = 0; ks < 8; ++ks) { const int lrow = 4 * w + (ks >> 1), d = (ks & 1) * 32 + quad * 8;
          const f32x4 p0 = *(const f32x4*)(pos + lrow * 64 + d), p1 = *(const f32x4*)(pos + lrow * 64 + d + 4); bf16x8 af[2];
#pragma unroll
          for (int rt = 0; rt < 2; ++rt) { const v4u zv = *(const v4u*)(arow[rt] + (size_t)lrow * ZW + d);
              v4u av; av.x = cvt_pk_bf16(bflo(zv.x) + p0.x, bfhi(zv.x) + p0.y); av.y = cvt_pk_bf16(bflo(zv.y) + p0.z, bfhi(zv.y) + p0.w);
              av.z = cvt_pk_bf16(bflo(zv.z) + p1.x, bfhi(zv.z) + p1.y); av.w = cvt_pk_bf16(bflo(zv.w) + p1.z, bfhi(zv.w) + p1.w); af[rt] = __builtin_bit_cast(bf16x8, av); }
#pragma unroll
          for (int ct = 0; ct < 16; ++ct) { const bf16x8 bfr = *(const bf16x8*)(wb + (size_t)(16 * ct) * 2048 + ks * 32);
              acc[0][ct] = __builtin_amdgcn_mfma_f32_16x16x32_bf16(af[0], bfr, acc[0][ct], 0, 0, 0); acc[1][ct] = __builtin_amdgcn_mfma_f32_16x16x32_bf16(af[1], bfr, acc[1][ct], 0, 0, 0); } } }
    v4u hv[2];
    const int row = C.tid >> 5, c0 = (C.tid & 31) * 8;
#pragma unroll
    for (int rt = 0; rt < 2; ++rt) {
#pragma unroll
        for (int ct = 0; ct < 16; ++ct)
#pragma unroll
            for (int r = 0; r < 4; ++r) part[(w * 16 + 4 * quad + r) * 256 + 16 * ct + r16] = acc[rt][ct][r];
        __syncthreads();
        f32x4 s0 = *(const f32x4*)(b1 + c0), s1 = *(const f32x4*)(b1 + c0 + 4);
#pragma unroll
        for (int ww = 0; ww < 8; ++ww) { s0 = s0 + *(const LAS f32x4*)(part + (ww * 16 + row) * 256 + c0); s1 = s1 + *(const LAS f32x4*)(part + (ww * 16 + row) * 256 + c0 + 4); }
        hv[rt].x = cvt_pk_bf16(s0.x * sigmoidf_(s0.x), s0.y * sigmoidf_(s0.y)); hv[rt].y = cvt_pk_bf16(s0.z * sigmoidf_(s0.z), s0.w * sigmoidf_(s0.w));
        hv[rt].z = cvt_pk_bf16(s1.x * sigmoidf_(s1.x), s1.y * sigmoidf_(s1.y)); hv[rt].w = cvt_pk_bf16(s1.z * sigmoidf_(s1.z), s1.w * sigmoidf_(s1.w));
        __syncthreads();
    }
    *(LAS v4u*)(hidL + row * 264 + c0) = hv[0]; *(LAS v4u*)(hidL + (16 + row) * 264 + c0) = hv[1];
    __syncthreads();
    { const int rt = w >> 2, ct = w & 3; f32x4 o = {0.f, 0.f, 0.f, 0.f}; const bf16* w2 = W2t + (size_t)(16 * ct + r16) * 256 + quad * 8;
#pragma unroll
      for (int ks = 0; ks < 8; ++ks) { const bf16x8 af = *(const LAS bf16x8*)(hidL + (16 * rt + r16) * 264 + ks * 32 + quad * 8); const bf16x8 bfr = *(const bf16x8*)(w2 + ks * 32);
          o = __builtin_amdgcn_mfma_f32_16x16x32_bf16(af, bfr, o, 0, 0, 0); }
#pragma unroll
      for (int r = 0; r < 4; ++r) outL[(16 * rt + 4 * quad + r) * 68 + 16 * ct + r16] = o[r]; }
    __syncthreads();
    if (w < 2) { const int i = 16 * w + (lane >> 2), c0e = (lane & 3) * 16, n = n0 + i; float y[16];
#pragma unroll
        for (int j = 0; j < 16; ++j) y[j] = outL[i * 68 + c0e + j];
        if (kv == 0) { float s = 0.f;
#pragma unroll
            for (int j = 0; j < 16; ++j) s += y[j] * y[j];
            s += shx(s, 1, lane); s += shx(s, 2, lane);
            const float rstd = 1.0f / sqrtf(s * (1.0f / 64.0f) + 1e-6f); const float* gk = a.in[I_KNORM] + l * 192 + c0e;
#pragma unroll
            for (int j = 0; j < 16; ++j) y[j] = y[j] * rstd * gk[j];
            if ((lane & 3) == 0 && n <= 510) { const float* rp = (const float*)(C.ws + WS_ROPE) + (16 * n + 31) * 16;
#pragma unroll
                for (int j = 0; j < 8; ++j) { const float c = rp[j], sn = rp[8 + j], x1 = y[j], x2 = y[8 + j]; y[j] = x1 * c - x2 * sn; y[8 + j] = x2 * c + x1 * sn; } }
            if (n > 510) {
#pragma unroll
                for (int j = 0; j < 16; ++j) y[j] = 0.f; }
            v4u o0, o1; o0.x = cvt_pk_bf16(y[0], y[1]); o0.y = cvt_pk_bf16(y[2], y[3]); o0.z = cvt_pk_bf16(y[4], y[5]); o0.w = cvt_pk_bf16(y[6], y[7]);
            o1.x = cvt_pk_bf16(y[8], y[9]); o1.y = cvt_pk_bf16(y[10], y[11]); o1.z = cvt_pk_bf16(y[12], y[13]); o1.w = cvt_pk_bf16(y[14], y[15]);
            bf16* ko = (bf16*)(C.ws + WS_KC) + ((size_t)bg * 512 + n) * 64 + c0e; *(v4u*)ko = o0; *(v4u*)(ko + 8) = o1;
        } else { bf16* vo = (bf16*)(C.ws + WS_VCT) + ((size_t)bg * 64 + c0e) * 512 + vt_pos(n);
#pragma unroll
            for (int j = 0; j < 16; ++j) vo[(size_t)j * 512] = (n > 510) ? (bf16)0 : f2bf(y[j]); } }
    __syncthreads();
}


#ifndef PROBE_AT
#define PROBE_AT 0
#endif
#define AT_T0(id) do { if (PROBE_AT == id) t0_##id = __builtin_amdgcn_s_memrealtime(); } while (0)
#define AT_T1(id) do { if (PROBE_AT == id) { const unsigned long long t1_ = __builtin_amdgcn_s_memrealtime(); while (__builtin_amdgcn_s_memrealtime() - t1_ < t1_ - t0_##id) __builtin_amdgcn_s_sleep(4); } } while (0)
#define MFMA16(a, b, c) __builtin_amdgcn_mfma_f32_16x16x32_bf16(a, b, c, 0, 0, 0)
constexpr float SM_SCALE = 0.125f * 1.4426950408889634f;
constexpr int AT_SLOT = 16384, AT_NSLOT = 6, AT_G = 3;
constexpr int AT_IMP_OFF = AT_SLOT * AT_NSLOT;
constexpr int AT_MASK_OFF = AT_IMP_OFF + 8 * 8 * 128 * 4;
constexpr int AT_NSLOT_S = 8;
constexpr int AT_FLAG_OFF = AT_MASK_OFF + 1024;
__device__ __forceinline__ bf16x8 pack_p(const f32x4& p0, const f32x4& p1) {
    v4u w; w.x = cvt_pk_bf16(p0[0], p0[1]); w.y = cvt_pk_bf16(p0[2], p0[3]); w.z = cvt_pk_bf16(p1[0], p1[1]); w.w = cvt_pk_bf16(p1[2], p1[3]); return __builtin_bit_cast(bf16x8, w);
}
__device__ __forceinline__ int tile_off(int row, int chunk) { return row * 128 + ((chunk ^ ((row >> 1) & 7)) << 4); }
struct AtJob { const bf16* k; const bf16* v; int vpitch; };
struct AtUnit { int b, g, c, bg, nct, njobs, wlo, nssc, nsss, nssw; };
__device__ __forceinline__ AtJob at_job(const Ctx& C, const AtUnit& U, int k) {
    AtJob J; const int k2 = k - 2 * U.nct;
    if (k2 < 0) { const int j = (k < U.nct) ? k : k - U.nct; J.k = (const bf16*)(C.ws + WS_KC) + ((size_t)U.bg * 512 + 64 * j) * 64; J.v = (const bf16*)(C.ws + WS_VCT) + (size_t)U.bg * 64 * 512 + 64 * j; J.vpitch = 512; }
    else if (k2 <= U.c) { J.k = (const bf16*)(C.ws + WS_KSLC) + ((size_t)U.bg * SEQ + 64 * k2) * 64; J.v = (const bf16*)(C.ws + WS_VSLCT) + (size_t)U.bg * 64 * SEQ + 64 * k2; J.vpitch = SEQ; }
    else { const int w = U.wlo + (k2 - U.c - 1); J.k = (const bf16*)(C.ws + WS_KWIN) + ((size_t)U.bg * SEQ + 64 * w) * 64; J.v = (const bf16*)(C.ws + WS_VWINT) + (size_t)U.bg * 64 * SEQ + 64 * w; J.vpitch = SEQ; }
    return J;
}
__device__ __forceinline__ void at_stage(const Ctx& C, const AtJob& J, int slot) {
    int ln = C.lane; asm volatile("" : "+v"(ln));
    const int row = 8 * C.wave + (ln >> 3), chunk = (ln & 7) ^ ((row >> 1) & 7);
    __builtin_amdgcn_global_load_lds((const unsigned*)(J.k + (size_t)row * 64 + chunk * 8), (LAS unsigned*)(C.lds + slot * AT_SLOT + C.wave * 1024), 16, 0, 0);
    __builtin_amdgcn_global_load_lds((const unsigned*)(J.v + (size_t)row * J.vpitch + chunk * 8), (LAS unsigned*)(C.lds + slot * AT_SLOT + 8192 + C.wave * 1024), 16, 0, 0);
}
__device__ __forceinline__ void at_stage_tile(const Ctx& C, const AtJob& J, int slot) {
    int ln = C.lane; asm volatile("" : "+v"(ln));
    const int rr = ln >> 3, ce = (ln & 7) ^ (rr >> 1);
    const unsigned ke = (unsigned)(rr * 128 + ce * 16), ko = (unsigned)(rr * 128 + (ce ^ 4) * 16);
    const unsigned ve = (unsigned)(rr * J.vpitch * 2 + ce * 16), vo = (unsigned)(rr * J.vpitch * 2 + (ce ^ 4) * 16);
#pragma unroll
    for (int seg = 0; seg < 8; ++seg) { const char* kb = (const char*)J.k + seg * 1024; const char* vb = (const char*)J.v + (size_t)seg * 16 * J.vpitch;
        __builtin_amdgcn_global_load_lds((const unsigned*)(kb + ((seg & 1) ? ko : ke)), (LAS unsigned*)(C.lds + slot * AT_SLOT + seg * 1024), 16, 0, 0);
        __builtin_amdgcn_global_load_lds((const unsigned*)(vb + ((seg & 1) ? vo : ve)), (LAS unsigned*)(C.lds + slot * AT_SLOT + 8192 + seg * 1024), 16, 0, 0); }
}
__device__ __forceinline__ void at_stage_ss(const Ctx& C, const AtUnit& U, int sg) {
    int lss = sg, jbase = 0, nj = U.nct;
    if (lss >= U.nssc) { lss -= U.nssc; jbase = U.nct; }
    if (jbase == U.nct && lss >= U.nssc) { lss -= U.nssc; jbase = 2 * U.nct; nj = U.c + 1;
        if (lss >= U.nsss) { lss -= U.nsss; jbase = 2 * U.nct + U.c + 1; nj = U.c - U.wlo + 1; } }
#pragma unroll
    for (int i3 = 0; i3 < AT_G; ++i3) { const int jl = AT_G * lss + i3; if (jl < nj) at_stage(C, at_job(C, U, jbase + jl), AT_G * (sg & 1) + i3); }
}
__device__ __forceinline__ void at_load_k(LAS unsigned char* sl, int jp, int r16, int quad, bf16x8 (&kf)[2][2]) {
#pragma unroll
    for (int h = 0; h < 2; ++h)
#pragma unroll
        for (int kh = 0; kh < 2; ++kh) kf[h][kh] = *(const LAS bf16x8*)(sl + tile_off(32 * jp + 16 * h + r16, kh * 4 + quad));
}
__device__ __forceinline__ void at_load_v(LAS unsigned char* sl, int jp, int r16, int quad, bf16x8 (&vf)[4]) {
#pragma unroll
    for (int db = 0; db < 4; ++db) vf[db] = *(const LAS bf16x8*)(sl + 8192 + tile_off(16 * db + r16, 4 * jp + quad));
}
constexpr float AT_DEFER = 8.0f;
__device__ __forceinline__ bf16x8 at_ones() { const v4u w = {0x3F803F80u, 0x3F803F80u, 0x3F803F80u, 0x3F803F80u}; return __builtin_bit_cast(bf16x8, w); }
template <int CTRL> __device__ __forceinline__ float dppf(float v) { return __int_as_float(__builtin_amdgcn_update_dpp(0, __float_as_int(v), CTRL, 0xF, 0xF, true)); }
template <int CTRL> __device__ __forceinline__ unsigned dppu(unsigned v) { return (unsigned)__builtin_amdgcn_update_dpp(0, (int)v, CTRL, 0xF, 0xF, true); }
__device__ __forceinline__ float sum8(float v) { v += dppf<0xB1>(v); v += dppf<0x4E>(v); v += dppf<0x141>(v); return v; }
__device__ __forceinline__ unsigned max8u(unsigned v) { unsigned o = dppu<0xB1>(v); v = o > v ? o : v; o = dppu<0x4E>(v); v = o > v ? o : v; o = dppu<0x141>(v); return o > v ? o : v; }
__device__ __forceinline__ float vmax3(float a, float b, float c) { return fmaxf(fmaxf(a, b), c); }
__device__ __forceinline__ int imax3(int a, int b, int c) { const int t = a > b ? a : b; return t > c ? t : c; }
__device__ __forceinline__ float vmax8(const f32x4& s0, const f32x4& s1) { const int t1 = imax3(__float_as_int(s0[0]), __float_as_int(s0[1]), __float_as_int(s0[2])), t2 = imax3(__float_as_int(s0[3]), __float_as_int(s1[0]), __float_as_int(s1[1])), t3 = imax3(__float_as_int(s1[2]), __float_as_int(s1[3]), t1); return __int_as_float(t2 > t3 ? t2 : t3); }
__device__ __forceinline__ void at_qk(const bf16x8 (&kf)[2][2], const bf16x8 (&qf)[2], const f32x4& c0, const f32x4& c1, f32x4& s0, f32x4& s1) {
    s0 = MFMA16(kf[0][0], qf[0], c0); s1 = MFMA16(kf[1][0], qf[0], c1); s0 = MFMA16(kf[0][1], qf[1], s0); s1 = MFMA16(kf[1][1], qf[1], s1);
}
__device__ __forceinline__ void at_qk2(const bf16x8 (&kf)[2][2], const bf16x8 (&qa)[2], const bf16x8 (&qb)[2], const f32x4& ca0, const f32x4& ca1, const f32x4& cb0, const f32x4& cb1, f32x4& a0, f32x4& a1, f32x4& b0, f32x4& b1) {
    a0 = MFMA16(kf[0][0], qa[0], ca0); a1 = MFMA16(kf[1][0], qa[0], ca1); b0 = MFMA16(kf[0][0], qb[0], cb0); b1 = MFMA16(kf[1][0], qb[0], cb1);
    a0 = MFMA16(kf[0][1], qa[1], a0); a1 = MFMA16(kf[1][1], qa[1], a1); b0 = MFMA16(kf[0][1], qb[1], b0); b1 = MFMA16(kf[1][1], qb[1], b1);
}
__device__ __forceinline__ void at_online(f32x4& s0, f32x4& s1, float& mrun, f32x4& lacc, f32x4 (&o)[4], const bf16x8 (&vf)[4], int lane, const bf16x8& ones) {
    float bm = vmax8(s0, s1);
    if (__builtin_amdgcn_ballot_w64(bm > AT_DEFER) != 0ull) {
        bm = vmax3(bm, shx(bm, 16, lane), 0.f); bm = vmax3(bm, shx(bm, 32, lane), 0.f);
        const float alpha = __builtin_amdgcn_exp2f(-bm);
        lacc = lacc * alpha; mrun += bm;
#pragma unroll
        for (int db = 0; db < 4; ++db) o[db] = o[db] * alpha;
        s0 = s0 - bm; s1 = s1 - bm;
    }
#pragma unroll
    for (int r = 0; r < 4; ++r) { s0[r] = __builtin_amdgcn_exp2f(s0[r]); s1[r] = __builtin_amdgcn_exp2f(s1[r]); }
    const bf16x8 pb = pack_p(s0, s1);
    lacc = MFMA16(ones, pb, lacc);
#pragma unroll
    for (int db = 0; db < 4; ++db) o[db] = MFMA16(vf[db], pb, o[db]);
}

__device__ __forceinline__ void at_online2(f32x4& a0, f32x4& a1, f32x4& b0, f32x4& b1, float& mA, f32x4& lA, f32x4 (&oA)[4], float& mB, f32x4& lB, f32x4 (&oB)[4], const bf16x8 (&vf)[4], int lane, const bf16x8& ones) {
    float bmA = vmax8(a0, a1);
    float bmB = vmax8(b0, b1);
    if (__builtin_amdgcn_ballot_w64(fmaxf(bmA, bmB) > AT_DEFER) != 0ull) {
        bmA = vmax3(bmA, shx(bmA, 16, lane), 0.f); bmB = vmax3(bmB, shx(bmB, 16, lane), 0.f); bmA = vmax3(bmA, shx(bmA, 32, lane), 0.f); bmB = vmax3(bmB, shx(bmB, 32, lane), 0.f);
        const float alA = __builtin_amdgcn_exp2f(-bmA), alB = __builtin_amdgcn_exp2f(-bmB);
        lA = lA * alA; mA += bmA; lB = lB * alB; mB += bmB;
#pragma unroll
        for (int db = 0; db < 4; ++db) { oA[db] = oA[db] * alA; oB[db] = oB[db] * alB; }
        a0 = a0 - bmA; a1 = a1 - bmA; b0 = b0 - bmB; b1 = b1 - bmB;
    }
#pragma unroll
    for (int r = 0; r < 4; ++r) { a0[r] = __builtin_amdgcn_exp2f(a0[r]); a1[r] = __builtin_amdgcn_exp2f(a1[r]); b0[r] = __builtin_amdgcn_exp2f(b0[r]); b1[r] = __builtin_amdgcn_exp2f(b1[r]); }
    const bf16x8 pA = pack_p(a0, a1), pB = pack_p(b0, b1);
    lA = MFMA16(ones, pA, lA); lB = MFMA16(ones, pB, lB);
#pragma unroll
    for (int db = 0; db < 4; ++db) { oA[db] = MFMA16(vf[db], pA, oA[db]); oB[db] = MFMA16(vf[db], pB, oB[db]); }
}

__device__ __forceinline__ void attn_unit(const Ctx& C, const AtUnit& U, const int abl  , float* scr  ) {
    const int lane0 = C.lane, wv = C.wave;
    v4u ones_w = {0x3F803F80u, 0x3F803F80u, 0x3F803F80u, 0x3F803F80u}; asm volatile("" : "+v"(ones_w)); const bf16x8 ones = __builtin_bit_cast(bf16x8, ones_w);
    unsigned long long t0_1 = 0ull, t0_2 = 0ull, t0_3 = 0ull, t0_4 = 0ull; (void)t0_1; (void)t0_2; (void)t0_3; (void)t0_4;
    const int ta = 64 * U.c + 8 * wv;
    const bf16* Qn = (const bf16*)(C.ws + WS_QN); const bf16* Z = (const bf16*)(C.ws + WS_Z);
    bf16x8 q[4][2]; f32x4 O[4][4]; float mrun[4], lrun[4], pup[4]; f32x4 Lacc[4]; bf16 gz[3][4];
    { const int lane = lane0, r16 = lane & 15, quad = lane >> 4, tokc = r16 >> 3, head = r16 & 7; LAS float* impL = (LAS float*)(C.lds + AT_IMP_OFF + wv * 4096);
#pragma unroll
    for (int cb = 0; cb < 4; ++cb) { const bf16* qrow = Qn + ((size_t)(U.b * SEQ + ta + 2 * cb + tokc)) * DM + (U.g * 8 + head) * 64;
        q[cb][0] = *(const bf16x8*)(qrow + quad * 8); q[cb][1] = *(const bf16x8*)(qrow + 32 + quad * 8);
        { const bf16* zg = Z + ((size_t)(U.b * SEQ + ta + 2 * cb + tokc)) * ZW + ZC_NG + U.g * 8 + head; gz[0][cb] = zg[0]; gz[1][cb] = zg[16]; gz[2][cb] = zg[32]; }
        mrun[cb] = 0.f; lrun[cb] = 0.f; pup[cb] = 0.f;
#pragma unroll
        for (int db = 0; db < 4; ++db) O[cb][db] = (f32x4){0.f, 0.f, 0.f, 0.f}; }
#pragma unroll
    for (int i = 0; i < 4; ++i) *(LAS f32x4*)(impL + 4 * lane + 256 * i) = (f32x4){0.f, 0.f, 0.f, 0.f};
    }
    const int nvw = ((ta + 7 - 31) >= 0) ? (((ta + 7 - 31) >> 4) + 1) : 0;
    const int nvmin = (ta >= 31) ? (((ta - 31) >> 4) + 1) : 0;
    const int nsp = (nvw + 31) >> 5;
    const int j_c2 = U.nct, j_sl = 2 * U.nct, j_wn = 2 * U.nct + U.c + 1;
    at_stage_ss(C, U, 0);
    int sg = 0; const int nss_total = 2 * U.nssc + U.nsss + U.nssw;
    AT_T0(1);
    for (int lss = 0; lss < U.nssc; ++lss, ++sg) {
        asm volatile("s_waitcnt vmcnt(0)" ::: "memory");
        __builtin_amdgcn_s_barrier(); asm volatile("" ::: "memory");
        if (sg + 1 < nss_total && sg + 1 != 2 * U.nssc) at_stage_ss(C, U, sg + 1);
        for (int i3 = 0; i3 < AT_G; ++i3) { const int jl = AT_G * lss + i3; if (jl >= U.nct) break; const int k = 0 + jl;
        LAS unsigned char* sl = C.lds + (AT_G * (sg & 1) + i3) * AT_SLOT;
        int lane_ = lane0; asm volatile("" : "+v"(lane_));
        const int lane = lane_, r16 = lane & 15, quad = lane >> 4, tokc = r16 >> 3, head = r16 & 7;
        f32x4* scr4 = (f32x4*)(scr + lane * 64);
        LAS float* impL = (LAS float*)(C.lds + AT_IMP_OFF + wv * 4096); LAS unsigned* maskL = (LAS unsigned*)(C.lds + AT_MASK_OFF + wv * 128);
        {
            const int j = k; if (abl & 1) continue;
#pragma unroll
            for (int jp = 0; jp < 2; ++jp) { if (2 * j + jp >= nsp) break;
                bf16x8 kf[2][2]; at_load_k(sl, jp, r16, quad, kf);
                const bool full = (64 * j + 32 * jp + 31) < nvmin;
#pragma unroll
                for (int cb = 0; cb < 4; ++cb) { const int tl = ta + 2 * cb + tokc; const int nvl = (tl >= 31) ? (((tl - 31) >> 4) + 1) : 0;
                    const float nm = -mrun[cb]; f32x4 s0, s1;
                    if (!full) {
                        int n0 = 64 * j + 32 * jp + 4 * quad; asm volatile("" : "+v"(n0)); f32x4 m0, m1;
#pragma unroll
                        for (int r = 0; r < 4; ++r) { m0[r] = (n0 + r < nvl) ? nm : -1e30f; m1[r] = (n0 + 16 + r < nvl) ? nm : -1e30f; }
                        at_qk(kf, q[cb], m0, m1, s0, s1); asm volatile("; cmp1 masked");
                    } else { const f32x4 sd = {nm, nm, nm, nm}; at_qk(kf, q[cb], sd, sd, s0, s1); asm volatile("; cmp1 full"); }
                    const float bm = vmax8(s0, s1);
                    if (__builtin_amdgcn_ballot_w64(bm > AT_DEFER) != 0ull) { const float d = (bm > AT_DEFER) ? bm : 0.f; lrun[cb] *= __builtin_amdgcn_exp2f(-d); mrun[cb] += d; s0 = s0 - d; s1 = s1 - d; }
                    float ps = 0.f;
#pragma unroll
                    for (int r = 0; r < 4; ++r) ps += __builtin_amdgcn_exp2f(s0[r]) + __builtin_amdgcn_exp2f(s1[r]);
                    lrun[cb] += ps; } }
        }
        }
        asm volatile("s_waitcnt lgkmcnt(0)" ::: "memory");
    }
    {
    int lane_ = lane0; asm volatile("" : "+v"(lane_));
    const int lane = lane_, r16 = lane & 15, quad = lane >> 4, tokc = r16 >> 3, head = r16 & 7; f32x4* scr4 = (f32x4*)(scr + lane * 64);
    LAS float* impL = (LAS float*)(C.lds + AT_IMP_OFF + wv * 4096); LAS unsigned* maskL = (LAS unsigned*)(C.lds + AT_MASK_OFF + wv * 128); (void)scr4; (void)impL; (void)maskL; (void)head; (void)tokc; (void)quad;
    {
#pragma unroll
            for (int cb = 0; cb < 4; ++cb) { float mall = fmaxf(mrun[cb], shx(mrun[cb], 16, lane)); mall = fmaxf(mall, shx(mall, 32, lane));
                float ls = lrun[cb] * __builtin_amdgcn_exp2f(mrun[cb] - mall); ls += shx(ls, 16, lane); ls += shx(ls, 32, lane);
                mrun[cb] = mall; lrun[cb] = (ls > 0.f) ? 1.0f / ls : 0.f; }
        }
    }
    for (int lss = 0; lss < U.nssc; ++lss, ++sg) {
        asm volatile("s_waitcnt vmcnt(0)" ::: "memory");
        __builtin_amdgcn_s_barrier(); asm volatile("" ::: "memory");
        if (sg + 1 < nss_total && sg + 1 != 2 * U.nssc) at_stage_ss(C, U, sg + 1);
        for (int i3 = 0; i3 < AT_G; ++i3) { const int jl = AT_G * lss + i3; if (jl >= U.nct) break; const int k = j_c2 + jl;
        LAS unsigned char* sl = C.lds + (AT_G * (sg & 1) + i3) * AT_SLOT;
        int lane_ = lane0; asm volatile("" : "+v"(lane_));
        const int lane = lane_, r16 = lane & 15, quad = lane >> 4, tokc = r16 >> 3, head = r16 & 7;
        f32x4* scr4 = (f32x4*)(scr + lane * 64);
        LAS float* impL = (LAS float*)(C.lds + AT_IMP_OFF + wv * 4096); LAS unsigned* maskL = (LAS unsigned*)(C.lds + AT_MASK_OFF + wv * 128);
        {
            const int j = k - j_c2; if (abl & 1) continue;
#pragma unroll
            for (int jp = 0; jp < 2; ++jp) { if (2 * j + jp >= nsp) break;
                bf16x8 kf[2][2]; at_load_k(sl, jp, r16, quad, kf); bf16x8 vf[4]; at_load_v(sl, jp, r16, quad, vf);
                const bool full = (64 * j + 32 * jp + 31) < nvmin;
#pragma unroll
                for (int cb = 0; cb < 4; ++cb) { const int tok8 = 2 * cb + tokc, tl = ta + tok8; const int nvl = (tl >= 31) ? (((tl - 31) >> 4) + 1) : 0;
                    const float nm = -mrun[cb], inv = lrun[cb]; f32x4 s0, s1;
                    if (!full) {
                        int n0 = 64 * j + 32 * jp + 4 * quad; asm volatile("" : "+v"(n0)); f32x4 m0, m1;
#pragma unroll
                        for (int r = 0; r < 4; ++r) { m0[r] = (n0 + r < nvl) ? nm : -1e30f; m1[r] = (n0 + 16 + r < nvl) ? nm : -1e30f; }
                        at_qk(kf, q[cb], m0, m1, s0, s1); asm volatile("; cmp2 masked");
                    } else { const f32x4 sd = {nm, nm, nm, nm}; at_qk(kf, q[cb], sd, sd, s0, s1); asm volatile("; cmp2 full"); }
#pragma unroll
                    for (int r = 0; r < 4; ++r) { s0[r] = __builtin_amdgcn_exp2f(s0[r]) * inv; s1[r] = __builtin_amdgcn_exp2f(s1[r]) * inv; }
                    const bf16x8 pb = pack_p(s0, s1);
#pragma unroll
                    for (int db = 0; db < 4; ++db) O[cb][db] = MFMA16(vf[db], pb, O[cb][db]);
#pragma unroll
                    for (int h = 0; h < 2; ++h) { const f32x4& st = h ? s1 : s0; const float h3 = sum8(st[3]), hs = sum8((st[0] + st[1]) + (st[2] + st[3]));
                        const float up = shf(h3, (lane + 48) & 63);
                        const float val = hs + ((quad == 0) ? pup[cb] : up); pup[cb] = up;
                        if (head == 0) impL[tok8 * 128 + 4 * (4 * j + 2 * jp + h) + quad] = val; } } }
        }
        }
        asm volatile("s_waitcnt lgkmcnt(0)" ::: "memory");
    }
    AT_T1(1);
    AT_T0(2);
    {
    int lane_ = lane0; asm volatile("" : "+v"(lane_));
    const int lane = lane_, r16 = lane & 15, quad = lane >> 4, tokc = r16 >> 3, head = r16 & 7; f32x4* scr4 = (f32x4*)(scr + lane * 64);
    LAS float* impL = (LAS float*)(C.lds + AT_IMP_OFF + wv * 4096); LAS unsigned* maskL = (LAS unsigned*)(C.lds + AT_MASK_OFF + wv * 128); (void)scr4; (void)impL; (void)maskL; (void)head; (void)tokc; (void)quad;
    {
            asm volatile("s_waitcnt lgkmcnt(0)" ::: "memory");
#pragma unroll
            for (int cb = 0; cb < 4; ++cb) { const int tok8 = 2 * cb + tokc, tl = ta + tok8;
                if (2 * nsp < 32 && head == 0 && quad == 0) impL[tok8 * 128 + 8 * nsp] = pup[cb];
                const float g0 = sigmoidf_(bf2f(gz[0][cb])); (void)tl;
#pragma unroll
                for (int db = 0; db < 4; ++db) { scr4[cb * 4 + db] = O[cb][db] * g0; O[cb][db] = (f32x4){0.f, 0.f, 0.f, 0.f}; }
                mrun[cb] = 0.f; lrun[cb] = 0.f; Lacc[cb] = (f32x4){0.f, 0.f, 0.f, 0.f}; }
            asm volatile("s_waitcnt lgkmcnt(0)" ::: "memory");
            { const int cur = U.c, lam = head * 4 + quad;
              if (cur <= 15 || (abl & 8)) {
                  if (head == 0 && quad == 0) {
#pragma unroll
                      for (int cb = 0; cb < 4; ++cb) { const int tok8 = 2 * cb + tokc; maskL[0 * 8 + tok8] = (2u << cur) - 1u; maskL[1 * 8 + tok8] = 0u; maskL[2 * 8 + tok8] = 0u; maskL[3 * 8 + tok8] = 0u; } }
              } else {
                  if (lane < 32) maskL[lane] = 0u;
                  unsigned key[4][4];
#pragma unroll
                  for (int cb = 0; cb < 4; ++cb) { const f32x4 v = *(const LAS f32x4*)(impL + (2 * cb + tokc) * 128 + 4 * lam);
#pragma unroll
                      for (int jx = 0; jx < 4; ++jx) { const int sb = 4 * lam + jx; unsigned kk = ((__float_as_uint(v[jx]) & 0xFFFFFF80u) + 0x80u) | (unsigned)(127 - sb);
                          kk = (sb > cur) ? 0u : kk; kk = (sb == 0 || sb == cur) ? 1u : kk; key[cb][jx] = kk; } }
                  for (int round = 0; round < 14; ++round) {
                      unsigned bk[4];
#pragma unroll
                      for (int cb = 0; cb < 4; ++cb) { const unsigned a = key[cb][0] > key[cb][1] ? key[cb][0] : key[cb][1], b2 = key[cb][2] > key[cb][3] ? key[cb][2] : key[cb][3]; bk[cb] = a > b2 ? a : b2; }
#pragma unroll
                      for (int cb = 0; cb < 4; ++cb) bk[cb] = max8u(bk[cb]);
#pragma unroll
                      for (int off = 16; off <= 32; off <<= 1) {
#pragma unroll
                          for (int cb = 0; cb < 4; ++cb) { const unsigned o = (unsigned)shxi((int)bk[cb], off, lane); bk[cb] = o > bk[cb] ? o : bk[cb]; } }
#pragma unroll
                      for (int cb = 0; cb < 4; ++cb)
#pragma unroll
                          for (int jx = 0; jx < 4; ++jx) key[cb][jx] = (key[cb][jx] == bk[cb] && bk[cb] > 1u) ? 1u : key[cb][jx];
                  }
                  asm volatile("s_waitcnt lgkmcnt(0)" ::: "memory");
#pragma unroll
                  for (int cb = 0; cb < 4; ++cb) { const unsigned nib = (key[cb][0] == 1u ? 1u : 0u) | (key[cb][1] == 1u ? 2u : 0u) | (key[cb][2] == 1u ? 4u : 0u) | (key[cb][3] == 1u ? 8u : 0u);
                      if (nib) { const unsigned ma = (unsigned)(size_t)(maskL + (lam >> 3) * 8 + 2 * cb + tokc); asm volatile("ds_or_b32 %0, %1" :: "v"(ma), "v"(nib << ((lam & 7) * 4)) : "memory"); } }
              }
            }
            asm volatile("s_waitcnt lgkmcnt(0)" ::: "memory");
        }
    }
    AT_T1(2);
    AT_T0(3);
    { volatile LAS unsigned* fl = (volatile LAS unsigned*)(C.lds + AT_FLAG_OFF);
      asm volatile("s_waitcnt vmcnt(0) lgkmcnt(0)" ::: "memory");
      if (C.tid < 32) fl[C.tid] = 0u;
      asm volatile("s_waitcnt lgkmcnt(0)" ::: "memory");
      __builtin_amdgcn_s_barrier(); asm volatile("" ::: "memory");
      const int nj = U.c + 1, njt = nj + (U.c - U.wlo + 1); unsigned spins = 0u;
      int mynext = wv, pend = -1;
      for (int jl = 0; jl < nj; ++jl) { const int k = j_sl + jl;
        int lane_ = lane0; asm volatile("" : "+v"(lane_));
        const int lane = lane_, r16 = lane & 15, quad = lane >> 4, tokc = r16 >> 3, head = r16 & 7;
        LAS unsigned* maskL = (LAS unsigned*)(C.lds + AT_MASK_OFF + wv * 128);
        const int s = k - j_sl; unsigned selw[4]; bool need[4], both[4]; bool any = false;
#pragma unroll
        for (int cb = 0; cb < 4; ++cb) { selw[cb] = (maskL[(s >> 5) * 8 + 2 * cb + tokc] >> (s & 31)) & 1u; const unsigned long long bl = __builtin_amdgcn_ballot_w64(selw[cb] != 0u); need[cb] = bl != 0ull; both[cb] = bl == ~0ull; any = any || need[cb]; }
        for (;;) {
            if (pend >= 0) { asm volatile("s_waitcnt vmcnt(0)" ::: "memory"); if (C.lane == 0) fl[pend % AT_NSLOT_S] = (unsigned)(pend + 1); pend = -1; __builtin_amdgcn_s_setprio(0); }
            if (mynext < njt && mynext < jl + AT_NSLOT_S) { const int slot = mynext % AT_NSLOT_S;
                if (mynext < AT_NSLOT_S || (unsigned)__builtin_amdgcn_readfirstlane((int)fl[16 + slot]) >= 8u * (unsigned)(mynext / AT_NSLOT_S)) {
                    at_stage_tile(C, at_job(C, U, j_sl + mynext), slot); pend = mynext; mynext += NWAVES; __builtin_amdgcn_s_setprio(3); } }
            if ((unsigned)__builtin_amdgcn_readfirstlane((int)fl[jl % AT_NSLOT_S]) == (unsigned)(jl + 1)) break;
            __builtin_amdgcn_s_sleep(1); if (++spins > (1u << 24)) break;
        }
        asm volatile("" ::: "memory");
        LAS unsigned char* sl = C.lds + (jl % AT_NSLOT_S) * AT_SLOT; (void)head; (void)both;
        {
            if (any && !(abl & 2)) {
#pragma unroll
                for (int jp = 0; jp < 2; ++jp) { bf16x8 kf[2][2]; at_load_k(sl, jp, r16, quad, kf); bf16x8 vf[4]; at_load_v(sl, jp, r16, quad, vf);
#pragma unroll
                    for (int cb = 0; cb < 4; ++cb) if (need[cb]) { const bool sel = selw[cb] != 0u;
                        const float nm = sel ? -mrun[cb] : -1e30f; f32x4 s0, s1;
                        if (s == U.c) {
                            int key0 = 64 * s + 32 * jp + 4 * quad; asm volatile("" : "+v"(key0)); const int tl = ta + 2 * cb + tokc; f32x4 m0, m1;
#pragma unroll
                            for (int r = 0; r < 4; ++r) { m0[r] = (key0 + r <= tl) ? nm : -1e30f; m1[r] = (key0 + 16 + r <= tl) ? nm : -1e30f; }
                            at_qk(kf, q[cb], m0, m1, s0, s1); asm volatile("; slc diagonal");
                        } else { const f32x4 sd = {nm, nm, nm, nm}; at_qk(kf, q[cb], sd, sd, s0, s1); asm volatile("; slc full"); }
                        at_online(s0, s1, mrun[cb], Lacc[cb], O[cb], vf, lane, ones); } }
            }
        }
        asm volatile("s_waitcnt lgkmcnt(0)" ::: "memory");
        if (C.lane == 0) { const unsigned ra = (unsigned)(size_t)(C.lds + AT_FLAG_OFF + 4 * (16 + (jl % AT_NSLOT_S))); asm volatile("ds_add_u32 %0, %1" :: "v"(ra), "v"(1u) : "memory"); }
      }
    AT_T1(3);
    AT_T0(4);
    {
    int lane_ = lane0; asm volatile("" : "+v"(lane_));
    const int lane = lane_, r16 = lane & 15, quad = lane >> 4, tokc = r16 >> 3, head = r16 & 7; f32x4* scr4 = (f32x4*)(scr + lane * 64);
    LAS float* impL = (LAS float*)(C.lds + AT_IMP_OFF + wv * 4096); LAS unsigned* maskL = (LAS unsigned*)(C.lds + AT_MASK_OFF + wv * 128); (void)scr4; (void)impL; (void)maskL; (void)head; (void)tokc; (void)quad;
    {
            f32x4 sv[16];
#pragma unroll
            for (int i = 0; i < 16; ++i) sv[i] = scr4[i];
            asm volatile("" ::: "memory");
#pragma unroll
            for (int cb = 0; cb < 4; ++cb) { const int tl = ta + 2 * cb + tokc;
                const float ls = Lacc[cb][0];
                const float g1 = sigmoidf_(bf2f(gz[1][cb])) / ls; (void)tl;
#pragma unroll
                for (int db = 0; db < 4; ++db) { scr4[cb * 4 + db] = sv[cb * 4 + db] + O[cb][db] * g1; O[cb][db] = (f32x4){0.f, 0.f, 0.f, 0.f}; }
                mrun[cb] = 0.f; lrun[cb] = 0.f; Lacc[cb] = (f32x4){0.f, 0.f, 0.f, 0.f}; }
        }
    }
      for (int jl = nj; jl < njt; ++jl) { const int k = j_sl + jl;
        for (;;) {
            if (pend >= 0) { asm volatile("s_waitcnt vmcnt(0)" ::: "memory"); if (C.lane == 0) fl[pend % AT_NSLOT_S] = (unsigned)(pend + 1); pend = -1; __builtin_amdgcn_s_setprio(0); }
            if (mynext < njt && mynext < jl + AT_NSLOT_S) { const int slot = mynext % AT_NSLOT_S;
                if (mynext < AT_NSLOT_S || (unsigned)__builtin_amdgcn_readfirstlane((int)fl[16 + slot]) >= 8u * (unsigned)(mynext / AT_NSLOT_S)) {
                    at_stage_tile(C, at_job(C, U, j_sl + mynext), slot); pend = mynext; mynext += NWAVES; __builtin_amdgcn_s_setprio(3); } }
            if ((unsigned)__builtin_amdgcn_readfirstlane((int)fl[jl % AT_NSLOT_S]) == (unsigned)(jl + 1)) break;
            __builtin_amdgcn_s_sleep(1); if (++spins > (1u << 24)) break;
        }
        asm volatile("" ::: "memory");
        LAS unsigned char* sl = C.lds + (jl % AT_NSLOT_S) * AT_SLOT;
        int lane_ = lane0; asm volatile("" : "+v"(lane_));
        const int lane = lane_, r16 = lane & 15, quad = lane >> 4, tokc = r16 >> 3, head = r16 & 7;
        f32x4* scr4 = (f32x4*)(scr + lane * 64);
        LAS float* impL = (LAS float*)(C.lds + AT_IMP_OFF + wv * 4096); LAS unsigned* maskL = (LAS unsigned*)(C.lds + AT_MASK_OFF + wv * 128);
        {
            const int w = U.wlo + (k - j_wn);
#pragma unroll
            for (int jp = 0; jp < 2; ++jp) { if (abl & 4) break; const int kb = 64 * w + 32 * jp; if (kb > ta + 7 || kb + 31 + 511 < ta) continue;
                bf16x8 kf[2][2]; at_load_k(sl, jp, r16, quad, kf); bf16x8 vf[4]; at_load_v(sl, jp, r16, quad, vf);
                const bool edge = !(kb + 31 <= ta && kb + 511 >= ta + 7);
#pragma unroll
                for (int cp = 0; cp < 2; ++cp) { const int cA = 2 * cp, cB = 2 * cp + 1;
                    const float nA = -mrun[cA], nB = -mrun[cB]; f32x4 a0, a1, b0, b1;
                    if (edge) { int key0 = kb + 4 * quad; asm volatile("" : "+v"(key0)); const int tlA = ta + 2 * cA + tokc, tlB = ta + 2 * cB + tokc; f32x4 ma0, ma1, mb0, mb1;
#pragma unroll
                        for (int r = 0; r < 4; ++r) { const int ka = key0 + r, kc = key0 + 16 + r;
                            ma0[r] = (ka <= tlA && ka + 511 >= tlA) ? nA : -1e30f; ma1[r] = (kc <= tlA && kc + 511 >= tlA) ? nA : -1e30f;
                            mb0[r] = (ka <= tlB && ka + 511 >= tlB) ? nB : -1e30f; mb1[r] = (kc <= tlB && kc + 511 >= tlB) ? nB : -1e30f; }
                        at_qk2(kf, q[cA], q[cB], ma0, ma1, mb0, mb1, a0, a1, b0, b1); asm volatile("; win edge");
                    } else { const f32x4 sA = {nA, nA, nA, nA}, sB = {nB, nB, nB, nB}; at_qk2(kf, q[cA], q[cB], sA, sA, sB, sB, a0, a1, b0, b1); asm volatile("; win full"); }
                    at_online2(a0, a1, b0, b1, mrun[cA], Lacc[cA], O[cA], mrun[cB], Lacc[cB], O[cB], vf, lane, ones); } }
        }
        asm volatile("s_waitcnt lgkmcnt(0)" ::: "memory");
        if (C.lane == 0) { const unsigned ra = (unsigned)(size_t)(C.lds + AT_FLAG_OFF + 4 * (16 + (jl % AT_NSLOT_S))); asm volatile("ds_add_u32 %0, %1" :: "v"(ra), "v"(1u) : "memory"); }
      }
      asm volatile("s_waitcnt vmcnt(0) lgkmcnt(0)" ::: "memory");
      __builtin_amdgcn_s_barrier(); asm volatile("" ::: "memory");
    }
    int lane_ = lane0; asm volatile("" : "+v"(lane_));
    const int lane = lane_, r16 = lane & 15, quad = lane >> 4, tokc = r16 >> 3, head = r16 & 7; f32x4* scr4 = (f32x4*)(scr + lane * 64);
    f32x4 sv[16];
#pragma unroll
    for (int i = 0; i < 16; ++i) sv[i] = scr4[i];
    asm volatile("" ::: "memory");
#pragma unroll
    for (int cb = 0; cb < 4; ++cb) { const int tl = ta + 2 * cb + tokc;
        const float ls = Lacc[cb][0];
        const float g2 = sigmoidf_(bf2f(gz[2][cb])) / ls;
        bf16* orow = (bf16*)(C.ws + WS_O) + ((size_t)(U.b * SEQ + tl)) * DM + (U.g * 8 + head) * 64 + 4 * quad;
#pragma unroll
        for (int db = 0; db < 4; ++db) { const f32x4 v = sv[cb * 4 + db] + O[cb][db] * g2;
            v2u wv2; wv2.x = cvt_pk_bf16(v[0], v[1]); wv2.y = cvt_pk_bf16(v[2], v[3]); *(v2u*)(orow + 16 * db) = wv2; } }
    AT_T1(4);
    asm volatile("s_waitcnt vmcnt(0)" ::: "memory");
    __builtin_amdgcn_s_barrier(); asm volatile("" ::: "memory");
}
__device__ __forceinline__ void attn_phase(const Ctx& C, const int abl, unsigned* queues  ) {
    float* scr = (float*)(C.ws + WS_SCR) + ((size_t)C.bx * NWAVES + C.wave) * 4096;
    LAS int* slot = (LAS int*)(C.lds + SM_OFF + 1024);
    for (int qi = 0; qi < 8; ++qi) { const int x = (C.bx + qi) & 7;
        for (;;) {
            if (C.tid == 0) *slot = (int)__hip_atomic_fetch_add(queues + 64 * x, 1u, __ATOMIC_RELAXED, __HIP_MEMORY_SCOPE_AGENT);
            __syncthreads();
            const int idx = *slot;
            __syncthreads();
            if (idx >= 128) break;
            AtUnit U; U.b = x >> 1; U.g = x & 1; U.bg = x; U.c = 127 - idx;
            U.nct = (4 * U.c + 3 + 63) >> 6; U.wlo = (U.c >= 8) ? U.c - 8 : 0; U.njobs = 2 * U.nct + (U.c + 1) + (U.c - U.wlo + 1); U.nssc = (U.nct + AT_G - 1) / AT_G; U.nsss = (U.c + AT_G) / AT_G; U.nssw = (U.c - U.wlo + AT_G) / AT_G;
            attn_unit(C, U, abl, scr); } }
}


__device__ __forceinline__ unsigned f2key(float f) { const unsigned b = __float_as_uint(f); return (b & 0x80000000u) ? ~b : (b | 0x80000000u); }
__device__ __forceinline__ float key2f(unsigned k) { const unsigned b = (k & 0x80000000u) ? (k & 0x7fffffffu) : ~k; return __uint_as_float(b); }
__device__ __forceinline__ void norm2_router(const Ctx& C, const Args& a, int l) {
    LAS int* hist = (LAS int*)(C.lds + SM_OFF);
    if (C.tid < 32) hist[C.tid] = 0;
    __syncthreads();
    const int lane = C.lane, r16 = lane & 15, quad = lane >> 4;
    const int m = C.bx * 128 + C.wave * 16 + r16, b = m >> 13;
    const bf16* xrow = (const bf16*)(C.ws + WS_XB) + (size_t)m * DM + 8 * quad; const float* ma = (const float*)(C.ws + WS_MODA) + ((size_t)l * NB + b) * 2 * DM + 8 * quad;
    const bf16* wh = (const bf16*)(C.ws + WS_RWT) + (size_t)l * 2 * 32 * 1024 + (size_t)r16 * 1024 + 8 * quad; const bf16* wl = wh + 32 * 1024;
    bf16* hrow = (bf16*)(C.ws + WS_H) + (size_t)m * DM + 8 * quad;
    float ss; { const f32x4 pq = *(const f32x4*)((const float*)(C.ws + WS_SSQ) + (size_t)m * 16 + 4 * quad); ss = (pq.x + pq.y) + (pq.z + pq.w); }
    ss += shx(ss, 16, lane); ss += shx(ss, 32, lane);
    const float rstd = 1.0f / sqrtf(ss * (1.0f / DM) + 1e-6f);
    f32x4 d0 = {0.f, 0.f, 0.f, 0.f}, d1 = {0.f, 0.f, 0.f, 0.f};
#pragma unroll 4
    for (int ks = 0; ks < 32; ++ks) { const int o = 32 * ks;
        const v4u xw = *(const v4u*)(xrow + o); const f32x4 x0 = {bflo(xw.x), bfhi(xw.x), bflo(xw.y), bfhi(xw.y)}, x1 = {bflo(xw.z), bfhi(xw.z), bflo(xw.w), bfhi(xw.w)}, g0 = *(const f32x4*)(ma + o), g1 = *(const f32x4*)(ma + o + 4), s0 = *(const f32x4*)(ma + DM + o), s1 = *(const f32x4*)(ma + DM + o + 4);
        const f32x4 h0 = x0 * rstd * g0 + s0, h1 = x1 * rstd * g1 + s1;
        v4u hi; hi.x = cvt_pk_bf16(h0.x, h0.y); hi.y = cvt_pk_bf16(h0.z, h0.w); hi.z = cvt_pk_bf16(h1.x, h1.y); hi.w = cvt_pk_bf16(h1.z, h1.w);
        *(v4u*)(hrow + o) = hi;
        v4u lo; lo.x = cvt_pk_bf16(h0.x - bflo(hi.x), h0.y - bfhi(hi.x)); lo.y = cvt_pk_bf16(h0.z - bflo(hi.y), h0.w - bfhi(hi.y));
        lo.z = cvt_pk_bf16(h1.x - bflo(hi.z), h1.y - bfhi(hi.z)); lo.w = cvt_pk_bf16(h1.z - bflo(hi.w), h1.w - bfhi(hi.w));
        const bf16x8 bh = __builtin_bit_cast(bf16x8, hi), bl = __builtin_bit_cast(bf16x8, lo);
        const bf16x8 ah0 = *(const bf16x8*)(wh + o), ah1 = *(const bf16x8*)(wh + 16 * 1024 + o), al0 = *(const bf16x8*)(wl + o), al1 = *(const bf16x8*)(wl + 16 * 1024 + o);
        d0 = __builtin_amdgcn_mfma_f32_16x16x32_bf16(ah0, bh, d0, 0, 0, 0); d0 = __builtin_amdgcn_mfma_f32_16x16x32_bf16(ah0, bl, d0, 0, 0, 0); d0 = __builtin_amdgcn_mfma_f32_16x16x32_bf16(al0, bh, d0, 0, 0, 0);
        d1 = __builtin_amdgcn_mfma_f32_16x16x32_bf16(ah1, bh, d1, 0, 0, 0); d1 = __builtin_amdgcn_mfma_f32_16x16x32_bf16(ah1, bl, d1, 0, 0, 0); d1 = __builtin_amdgcn_mfma_f32_16x16x32_bf16(al1, bh, d1, 0, 0, 0); }
    const float* rb = a.in[I_RB] + l * NEXP; unsigned key[8];
#pragma unroll
    for (int r = 0; r < 4; ++r) { const int e0 = 4 * quad + r, e1 = 16 + 4 * quad + r;
        key[r] = (f2key(d0[r] + rb[e0]) & ~31u) | (unsigned)(31 - e0); key[4 + r] = (f2key(d1[r] + rb[e1]) & ~31u) | (unsigned)(31 - e1); }
    unsigned top[4];
#pragma unroll
    for (int k = 0; k < 4; ++k) { unsigned bk = key[0];
#pragma unroll
        for (int i = 1; i < 8; ++i) bk = key[i] > bk ? key[i] : bk;
        { const unsigned o = (unsigned)shxi((int)bk, 16, lane); bk = o > bk ? o : bk; } { const unsigned o = (unsigned)shxi((int)bk, 32, lane); bk = o > bk ? o : bk; }
        top[k] = bk;
#pragma unroll
        for (int i = 0; i < 8; ++i) key[i] = (key[i] == bk) ? 0u : key[i]; }
    if (quad == 0) { const float v0 = key2f(top[0] & ~31u), e1 = __expf(key2f(top[1] & ~31u) - v0), e2 = __expf(key2f(top[2] & ~31u) - v0), e3 = __expf(key2f(top[3] & ~31u) - v0);
        const float inv = 1.0f / (1.0f + e1 + e2 + e3);
        int* tope = (int*)(C.ws + WS_TOPE) + m * 4; float* topw = (float*)(C.ws + WS_TOPW) + m * 4;
        const int x0 = 31 - (int)(top[0] & 31u), x1 = 31 - (int)(top[1] & 31u), x2 = 31 - (int)(top[2] & 31u), x3 = 31 - (int)(top[3] & 31u);
        *(int4*)tope = make_int4(x0, x1, x2, x3); *(float4*)topw = make_float4(inv, e1 * inv, e2 * inv, e3 * inv);
        __hip_atomic_fetch_add(hist + x0, 1, __ATOMIC_RELAXED, __HIP_MEMORY_SCOPE_WORKGROUP); __hip_atomic_fetch_add(hist + x1, 1, __ATOMIC_RELAXED, __HIP_MEMORY_SCOPE_WORKGROUP);
        __hip_atomic_fetch_add(hist + x2, 1, __ATOMIC_RELAXED, __HIP_MEMORY_SCOPE_WORKGROUP); __hip_atomic_fetch_add(hist + x3, 1, __ATOMIC_RELAXED, __HIP_MEMORY_SCOPE_WORKGROUP); }
    __syncthreads();
    if (C.tid < 32) ((int*)(C.ws + WS_CNT))[C.bx * 32 + C.tid] = hist[C.tid];
    __syncthreads();
}
__device__ __forceinline__ void moe_scatter(const Ctx& C) {
    LAS int* sm = (LAS int*)(C.lds + SM_OFF); LAS int* tot = sm + 32; LAS int* base = sm + 64; LAS int* pstart = sm + 96  ; LAS int* lcnt = sm + 160; LAS int* pt = sm + 256; LAS int* pbs = sm + 256 + 512;
    const int* cnt = (const int*)(C.ws + WS_CNT); int* tile_e = (int*)(C.ws + WS_TILEE); int* rowtok = (int*)(C.ws + WS_ROWTOK);
    { const int e = C.tid & 31, part = C.tid >> 5; int t = 0, bs = 0;
#pragma unroll
      for (int i = 0; i < 16; ++i) { const int bb = part * 16 + i; if (bb < C.G) { const int c = cnt[bb * 32 + e]; t += c; bs += (bb < C.bx) ? c : 0; } }
      pt[part * 32 + e] = t; pbs[part * 32 + e] = bs; }
    __syncthreads();
    if (C.tid < 32) { int t = 0, bs = 0;
#pragma unroll
        for (int part = 0; part < 16; ++part) { t += pt[part * 32 + C.tid]; bs += pbs[part * 32 + C.tid]; }
        tot[C.tid] = t; base[C.tid] = bs; lcnt[C.tid] = 0; }
    __syncthreads();
    if (C.tid == 0) { int ps = 0; for (int e = 0; e < 32; ++e) { pstart[e] = ps; ps += ((tot[e] + 255) >> 8) << 8; } pstart[32] = ps; if (C.bx == 0) tile_e[1023] = ps >> 8; }
    __syncthreads();
    if (C.bx == 0) {
        for (int r = C.tid; r < (pstart[32] >> 8); r += NWAVES * 64) { int e = 0;
#pragma unroll
            for (int k = 1; k < 32; ++k) e += (pstart[k] <= r * 256) ? 1 : 0;
            tile_e[r] = e; }
        { const int e = C.tid >> 4; const int end = pstart[e + 1]; for (int r = pstart[e] + tot[e] + (C.tid & 15); r < end; r += 16) rowtok[r] = 0; } }
    const int* tope = (const int*)(C.ws + WS_TOPE); int* dest = (int*)(C.ws + WS_DEST);
    const int t = C.tid;
    { const int m = C.bx * 128 + (t >> 2); const int e = tope[m * 4 + (t & 3)]; const int rank = __hip_atomic_fetch_add(lcnt + e, 1, __ATOMIC_RELAXED, __HIP_MEMORY_SCOPE_WORKGROUP);
      const int row = pstart[e] + base[e] + rank; dest[m * 4 + (t & 3)] = row; rowtok[row] = m; }
    __syncthreads();
}
__device__ __forceinline__ void moe_combine(const Ctx& C, const Args& a, int l, float* Xout32  , bf16* Xout16  , const bool next_norm) {
    const int gw = C.bx * NWAVES + C.wave, NGW = C.G * NWAVES, lane = C.lane;
    const int* dest = (const int*)(C.ws + WS_DEST); const float* topw = (const float*)(C.ws + WS_TOPW); const bf16* Y = (const bf16*)(C.ws + WS_Y);
    const float* mod_l = (const float*)(C.ws + WS_MOD) + (size_t)l * NB * 6144; const bf16* X = (const bf16*)(C.ws + WS_XB);
    const float* gain_n = a.in[I_NORM1] + (l + 1) * DM; bf16* H = (bf16*)(C.ws + WS_H);
    int rn[4]; float wn[4];
    if (gw < NTOK) {
#pragma unroll
        for (int k = 0; k < 4; ++k) { rn[k] = dest[gw * 4 + k]; wn[k] = topw[gw * 4 + k]; } }
    for (int m = gw; m < NTOK; m += NGW) { const int b = m >> 13; const float* g2 = mod_l + (size_t)b * 6144 + 5 * DM;
        int r[4]; float w[4];
#pragma unroll
        for (int k = 0; k < 4; ++k) { r[k] = rn[k]; w[k] = wn[k]; }
        { const int mn = (m + NGW < NTOK) ? m + NGW : m;
#pragma unroll
          for (int k = 0; k < 4; ++k) { rn[k] = dest[mn * 4 + k]; wn[k] = topw[mn * 4 + k]; } }
        f32x4 xn[2][2]; float ss = 0.f;
#pragma unroll
        for (int j = 0; j < 2; ++j) { const int col = 8 * lane + 512 * j; f32x4 y0 = {0.f, 0.f, 0.f, 0.f}, y1 = {0.f, 0.f, 0.f, 0.f};
#pragma unroll
            for (int k = 0; k < 4; ++k) { const v4u u = *(const v4u*)(Y + (size_t)r[k] * DM + col);
                y0.x += w[k] * bflo(u.x); y0.y += w[k] * bfhi(u.x); y0.z += w[k] * bflo(u.y); y0.w += w[k] * bfhi(u.y); y1.x += w[k] * bflo(u.z); y1.y += w[k] * bfhi(u.z); y1.z += w[k] * bflo(u.w); y1.w += w[k] * bfhi(u.w); }
            const f32x4 gv0 = *(const f32x4*)(g2 + col), gv1 = *(const f32x4*)(g2 + col + 4); const v4u xw = *(const v4u*)(X + (size_t)m * DM + col);
            const f32x4 xo0 = {bflo(xw.x), bfhi(xw.x), bflo(xw.y), bfhi(xw.y)}, xo1 = {bflo(xw.z), bfhi(xw.z), bflo(xw.w), bfhi(xw.w)};
            const f32x4 a0 = xo0 + gv0 * y0, a1 = xo1 + gv1 * y1; xn[j][0] = a0; xn[j][1] = a1;
            if (Xout32) { *(f32x4*)(Xout32 + (size_t)m * DM + col) = a0; *(f32x4*)(Xout32 + (size_t)m * DM + col + 4) = a1; }
            else { v4u wv; wv.x = cvt_pk_bf16(a0.x, a0.y); wv.y = cvt_pk_bf16(a0.z, a0.w); wv.z = cvt_pk_bf16(a1.x, a1.y); wv.w = cvt_pk_bf16(a1.z, a1.w); *(v4u*)(Xout16 + (size_t)m * DM + col) = wv; }
            ss += ((a0.x * a0.x + a0.y * a0.y) + (a0.z * a0.z + a0.w * a0.w)) + ((a1.x * a1.x + a1.y * a1.y) + (a1.z * a1.z + a1.w * a1.w)); }
        if (next_norm) {
            const float rstd = 1.0f / sqrtf(wave_sum(ss, lane) * (1.0f / DM) + 1e-6f); const float* mb = mod_l + (size_t)(NB + b) * 6144;
#pragma unroll
            for (int j = 0; j < 2; ++j) { const int col = 8 * lane + 512 * j; f32x4 h[2];
#pragma unroll
                for (int n = 0; n < 2; ++n) { const f32x4 g = *(const f32x4*)(gain_n + col + 4 * n), sc = *(const f32x4*)(mb + 1 * DM + col + 4 * n), sh = *(const f32x4*)(mb + col + 4 * n);
                    h[n] = xn[j][n] * rstd * g * (sc + 1.0f) + sh; }
                v4u wv; wv.x = cvt_pk_bf16(h[0].x, h[0].y); wv.y = cvt_pk_bf16(h[0].z, h[0].w); wv.z = cvt_pk_bf16(h[1].x, h[1].y); wv.w = cvt_pk_bf16(h[1].z, h[1].w);
                *(v4u*)(H + (size_t)m * DM + col) = wv; } }
    }
}


#ifndef MK_ONE_LAUNCH
#define MK_ONE_LAUNCH 1
#endif
#ifndef REP_NORM1
#define REP_NORM1 1
#endif
#ifndef REP_PROJ
#define REP_PROJ 1
#endif
#ifndef REP_OUTG
#define REP_OUTG 1
#endif
#ifndef REP_COMB
#define REP_COMB 1
#endif
#ifndef ABL_ATTN
#define ABL_ATTN 0
#endif
#ifndef REP_BAR
#define REP_BAR 1
#endif
#ifndef PROBE_PH
#define PROBE_PH (-1)
#endif
#ifndef REP_P0
#define REP_P0 1
#endif
#ifndef REP_ATTN
#define REP_ATTN 1
#endif
#ifndef REP_POST
#define REP_POST 1
#endif
#ifndef REP_N2R
#define REP_N2R 1
#endif
#ifndef REP_GEMMIN
#define REP_GEMMIN 1
#endif
#ifndef REP_MOE
#define REP_MOE 1
#endif
#ifndef REP_SCAT
#define REP_SCAT 1
#endif
template <int l>
__device__ __forceinline__ void layer_body(Ctx& C, const Args& args, const XcdBarrier& bar, const int lo, const int hi, unsigned long long& tprev) {
    bf16* const H = (bf16*)(C.ws + WS_H); bf16* const Z = (bf16*)(C.ws + WS_Z);
    const float* const MOD = (const float*)(C.ws + WS_MOD);
    const int* const tile_e = (const int*)(C.ws + WS_TILEE);
#define IN(k) (fresh(C), lo <= (k) && (k) < hi)
#define SEAM(k) do { if (IN(k) && IN((k) + 1)) { for (int rb_ = 0; rb_ < REP_BAR; ++rb_) xcd_barrier(bar, C.tid); } \
    if (PROBE_PH >= 0) { const unsigned long long now_ = __builtin_amdgcn_s_memrealtime(); if (((k) >= 2 && ((k) - 2) % NPH_LAYER == PROBE_PH) || ((k) < 2 && (k) + 100 == PROBE_PH)) { while (__builtin_amdgcn_s_memrealtime() - now_ < now_ - tprev) __builtin_amdgcn_s_sleep(8); } tprev = __builtin_amdgcn_s_memrealtime(); } } while (0)

        const int pb = 2 + l * NPH_LAYER;
        const float* mod_l = MOD + (size_t)l * NB * 6144;
        if constexpr (l == 0) {
            if (IN(pb + PH_NORM1)) for (int rep = 0; rep < REP_NORM1; ++rep) norm_rows(C, args.in[I_X], args.in[I_NORM1], mod_l, 0, 1, H);
            SEAM(pb + PH_NORM1); }
        if (IN(pb + PH_GEMM_IN)) for (int rep = 0; rep < REP_GEMMIN; ++rep) {
            pg8::Gemm g{H, (const bf16*)(C.ws + WS_WIN) + (size_t)l * ZW * DM, NTOK, ZW, DM, nullptr, 0, nullptr}; pg8::StaticOrder S; S.init(NTOK, ZW, C.G, C.bx);
            pg8::EpiIn E{Z, (bf16*)(C.ws + WS_QN), (bf16*)(C.ws + WS_KSLC), (bf16*)(C.ws + WS_KWIN), args.in[I_QNORM] + l * 64, args.in[I_KNORM] + l * 192, (const float*)(C.ws + WS_ROPE)};
            pg8::gemm_phase<pg8::EpiIn, pg8::StaticOrder, true, true>(C.lds, g, S, E, C.tid); }
        SEAM(pb + PH_GEMM_IN);
        if (IN(pb + PH_POST)) for (int rep = 0; rep < REP_POST; ++rep) { post_tokens(C, args, l); __syncthreads(); PP_T0(3); for (int u = C.bx; u < 256; u += C.G) compress_unit(C, args, l, u); PP_T1(3); }
        SEAM(pb + PH_POST);
        if (IN(pb + PH_ATTN)) for (int rep = 0; rep < REP_ATTN; ++rep) attn_phase(C, (rep + 1 < REP_ATTN) ? ABL_ATTN : 0, (unsigned*)(C.ws + WS_CTL) + CW_QUEUE + (size_t)((rep * NL + l) * 8) * 64);
        if (IN(pb + PH_ATTN)) for (int rep = 0; rep < REP_PROJ; ++rep) {
            pg8::Gemm g{(const bf16*)(C.ws + WS_PM), (const bf16*)(C.ws + WS_WPOOL) + (size_t)l * 512 * 512, NTOK, 512, 512, nullptr, 0, nullptr}; pg8::StaticOrder S; S.init(NTOK, 512, C.G, C.bx);
            pg8::EpiStore E{(bf16*)(C.ws + WS_PP), 512, args.in[I_PSCALE] + l * 512};
            pg8::gemm_phase<pg8::EpiStore, pg8::StaticOrder, true, true>(C.lds, g, S, E, C.tid); }
        SEAM(pb + PH_POOLG);
        if (IN(pb + PH_PROJA)) {
            pg8::Gemm g{(const bf16*)(C.ws + WS_PP), (const bf16*)(C.ws + WS_WA) + (size_t)l * 1024 * 512, NTOK, 1024, 512, nullptr, 0, nullptr}; pg8::StaticOrder S; S.init(NTOK, 1024, C.G, C.bx);
            pg8::EpiGate<false> E{(bf16*)(C.ws + WS_MG), 1024, Z + ZC_MG, ZW};
            pg8::gemm_phase<pg8::EpiGate<false>, pg8::StaticOrder, true, true>(C.lds, g, S, E, C.tid); }
        if (IN(pb + PH_PROJA)) { for (int rep = 1; rep < REP_PROJ; ++rep) { {
            pg8::Gemm g{(const bf16*)(C.ws + WS_O), (const bf16*)(C.ws + WS_WB) + (size_t)l * 1024 * 1024, NTOK, 1024, 1024, nullptr, 0, nullptr}; pg8::StaticOrder S; S.init(NTOK, 1024, C.G, C.bx);
            pg8::EpiGate<true> E{(bf16*)(C.ws + WS_MG), 1024, Z + ZC_MG + 1024, ZW};
            pg8::gemm_phase<pg8::EpiGate<true>, pg8::StaticOrder, true, true>(C.lds, g, S, E, C.tid); } {
            pg8::Gemm g{(const bf16*)(C.ws + WS_PP), (const bf16*)(C.ws + WS_WA) + (size_t)l * 1024 * 512, NTOK, 1024, 512, nullptr, 0, nullptr}; pg8::StaticOrder S; S.init(NTOK, 1024, C.G, C.bx);
            pg8::EpiGate<false> E{(bf16*)(C.ws + WS_MG), 1024, Z + ZC_MG, ZW};
            pg8::gemm_phase<pg8::EpiGate<false>, pg8::StaticOrder, true, true>(C.lds, g, S, E, C.tid); } }
            {
            pg8::Gemm g{(const bf16*)(C.ws + WS_O), (const bf16*)(C.ws + WS_WB) + (size_t)l * 1024 * 1024, NTOK, 1024, 1024, nullptr, 0, nullptr}; pg8::StaticOrder S; S.init(NTOK, 1024, C.G, C.bx);
            pg8::EpiGate<true> E{(bf16*)(C.ws + WS_MG), 1024, Z + ZC_MG + 1024, ZW};
            pg8::gemm_phase<pg8::EpiGate<true>, pg8::StaticOrder, true, true>(C.lds, g, S, E, C.tid); } }
        SEAM(pb + PH_PROJB);
        if (IN(pb + PH_OUTG)) { for (int rep = 1; rep < REP_OUTG; ++rep) {
            pg8::Gemm g{(const bf16*)(C.ws + WS_MG), (const bf16*)(C.ws + WS_WOUT) + (size_t)l * 1024 * 1024, NTOK, 1024, 1024, nullptr, 0, nullptr}; pg8::StaticOrder S; S.init(NTOK, 1024, C.G, C.bx);
            pg8::EpiResidB<l == 0> E{args.in[I_X], (bf16*)(C.ws + WS_SCR), mod_l + 2 * DM, 6144, (float*)(C.ws + WS_SSQ)};
            pg8::gemm_phase<pg8::EpiResidB<l == 0>, pg8::StaticOrder, true, true>(C.lds, g, S, E, C.tid); }
            {
            pg8::Gemm g{(const bf16*)(C.ws + WS_MG), (const bf16*)(C.ws + WS_WOUT) + (size_t)l * 1024 * 1024, NTOK, 1024, 1024, nullptr, 0, nullptr}; pg8::StaticOrder S; S.init(NTOK, 1024, C.G, C.bx);
            pg8::EpiResidB<l == 0> E{args.in[I_X], (bf16*)(C.ws + WS_XB), mod_l + 2 * DM, 6144, (float*)(C.ws + WS_SSQ)};
            pg8::gemm_phase<pg8::EpiResidB<l == 0>, pg8::StaticOrder, true, true>(C.lds, g, S, E, C.tid); } }
        SEAM(pb + PH_OUTG);
        if (IN(pb + PH_NORM2R)) for (int rep = 0; rep < REP_N2R; ++rep) norm2_router(C, args, l);
        SEAM(pb + PH_NORM2R);
        if (IN(pb + PH_SCATTER)) for (int rep = 0; rep < REP_SCAT; ++rep) moe_scatter(C);
        SEAM(pb + PH_SCATTER);
        if (IN(pb + PH_GATEUP)) for (int rep = 0; rep < REP_MOE; ++rep) { const int R = tile_e[1023];
            pg8::Gemm g{H, (const bf16*)(C.ws + WS_WGU) + (size_t)l * NEXP * 2048 * 1024, R * 256, 2048, 1024, tile_e, (size_t)2048 * 1024 * 2, (const int*)(C.ws + WS_ROWTOK)}; pg8::StaticOrder S; S.init(R * 256, 2048, C.G, C.bx);
            pg8::EpiSwiglu E{(bf16*)(C.ws + WS_ACT), args.in[I_BGU] + (size_t)l * NEXP * 2048, tile_e};
            pg8::gemm_phase<pg8::EpiSwiglu, pg8::StaticOrder, true, true, true>(C.lds, g, S, E, C.tid); }
        SEAM(pb + PH_GATEUP);
        if (IN(pb + PH_DOWN)) for (int rep = 0; rep < REP_MOE; ++rep) { const int R = tile_e[1023];
            pg8::Gemm g{(const bf16*)(C.ws + WS_ACT), (const bf16*)(C.ws + WS_WD) + (size_t)l * NEXP * 1024 * 1024, R * 256, 1024, 1024, tile_e, (size_t)1024 * 1024 * 2, nullptr}; pg8::StaticOrder S; S.init(R * 256, 1024, C.G, C.bx);
            pg8::EpiBiasE E{(bf16*)(C.ws + WS_Y), args.in[I_BD] + (size_t)l * NEXP * 1024, tile_e};
            pg8::gemm_phase<pg8::EpiBiasE, pg8::StaticOrder, true, true>(C.lds, g, S, E, C.tid); }
        SEAM(pb + PH_DOWN);
        if (IN(pb + PH_COMBINE)) { for (int rep = 1; rep < REP_COMB; ++rep) moe_combine(C, args, l, (float*)(C.ws + WS_SCR), nullptr, false); moe_combine(C, args, l, (l + 1 < NL) ? nullptr : args.out, (bf16*)(C.ws + WS_XB), l + 1 < NL); }
        SEAM(pb + PH_COMBINE);

#undef IN
#undef SEAM
}
__global__ void __launch_bounds__(NWAVES * 64, 2) fwd(Args args) {
    extern __shared__ __attribute__((aligned(16))) unsigned char lds_raw[];
    Ctx C; C.lds = (LAS unsigned char*)lds_raw; C.tid = threadIdx.x; C.lane = C.tid & 63; C.wave = __builtin_amdgcn_readfirstlane(C.tid >> 6); C.bx = blockIdx.x; C.G = gridDim.x; C.ws = args.ws;
    for (int u = C.tid; u < (LDS_BYTES - MISC_OFF) / 4; u += NWAVES * 64) ((LAS unsigned*)(C.lds + MISC_OFF))[u] = 0u;
    __syncthreads();
    const int lo = args.ph_lo, hi = args.ph_hi;
    unsigned* barw = (unsigned*)(C.ws + WS_CTL) + CW_BAR + (size_t)args.li * XCD_BAR_WORDS;
    XcdBarrier bar; bar.bar = barw; bar.x = 0; bar.st = nullptr;
    if (hi - lo > 1) bar = xcd_barrier_post(barw, (volatile LAS unsigned*)(C.lds + MISC_OFF) + 8, C.tid);
#define IN(k) (fresh(C), lo <= (k) && (k) < hi)
#define SEAM(k) do { if (IN(k) && IN((k) + 1)) { for (int rb_ = 0; rb_ < REP_BAR; ++rb_) xcd_barrier(bar, C.tid); } \
    if (PROBE_PH >= 0) { const unsigned long long now_ = __builtin_amdgcn_s_memrealtime(); if (((k) >= 2 && ((k) - 2) % NPH_LAYER == PROBE_PH) || ((k) < 2 && (k) + 100 == PROBE_PH)) { while (__builtin_amdgcn_s_memrealtime() - now_ < now_ - tprev) __builtin_amdgcn_s_sleep(8); } tprev = __builtin_amdgcn_s_memrealtime(); } } while (0)
    bf16* const H = (bf16*)(C.ws + WS_H); bf16* const Z = (bf16*)(C.ws + WS_Z);
    const float* const MOD = (const float*)(C.ws + WS_MOD);
    const int* const tile_e = (const int*)(C.ws + WS_TILEE);

    unsigned long long tprev = (PROBE_PH >= 0) ? __builtin_amdgcn_s_memrealtime() : 0ull;
    if (IN(0)) for (int rep = 0; rep < REP_P0; ++rep) p0_convert(C, args);
    SEAM(0);
    if (IN(1)) p1_mod(C, args);
    SEAM(1);
    layer_body<0>(C, args, bar, lo, hi, tprev); layer_body<1>(C, args, bar, lo, hi, tprev); layer_body<2>(C, args, bar, lo, hi, tprev); layer_body<3>(C, args, bar, lo, hi, tprev);
#undef IN
#undef SEAM
}

extern "C" void kernel_launch(void* const* d_in, const int* in_sizes, int n_in, void* d_out, int out_size, void* d_ws, size_t ws_size, hipStream_t stream) {
    static int grid = 0;
    if (grid == 0) {
        if (n_in != N_IN || out_size != NTOK * DM || ws_size < WS_END) { fprintf(stderr, "kernel_launch: unexpected shapes (n_in %d, out %d, ws %zu < %zu)\n", n_in, out_size, ws_size, (size_t)WS_END); grid = -1; return; }
        int dev = 0, cus = 0;
        if (hipGetDevice(&dev) != hipSuccess || hipDeviceGetAttribute(&cus, hipDeviceAttributeMultiprocessorCount, dev) != hipSuccess) { grid = -1; return; }
        if (hipFuncSetAttribute((const void*)fwd, hipFuncAttributeMaxDynamicSharedMemorySize, LDS_BYTES) != hipSuccess) { fprintf(stderr, "kernel_launch: hipFuncSetAttribute failed\n"); grid = -1; return; }
        int per_cu = 0; (void)hipOccupancyMaxActiveBlocksPerMultiprocessor(&per_cu, (const void*)fwd, NWAVES * 64, LDS_BYTES); (void)hipGetLastError();
        if (cus != 256 || per_cu < 1) fprintf(stderr, "kernel_launch: note: %d CUs, occupancy query %d; this kernel is built for one 512-thread workgroup on each of 256 CUs\n", cus, per_cu);
        grid = 256;
    }
    if (grid < 0) return;
    if (hipMemsetAsync((char*)d_ws + WS_CTL, 0, CTL_ZERO_BYTES, stream) != hipSuccess) return;
    Args a{};
    for (int i = 0; i < N_IN; ++i) a.in[i] = (const float*)d_in[i];
    a.out = (float*)d_out; a.ws = (unsigned char*)d_ws;
#if MK_ONE_LAUNCH
    a.ph_lo = 0; a.ph_hi = NPHASES; a.li = 0; a.pad = 0;
    hipLaunchKernelGGL(fwd, dim3(grid), dim3(NWAVES * 64), LDS_BYTES, stream, a);
#else
    for (int ph = 0; ph < NPHASES; ++ph) { a.ph_lo = ph; a.ph_hi = ph + 1; a.li = 0; a.pad = 0;
        hipLaunchKernelGGL(fwd, dim3(grid), dim3(NWAVES * 64), LDS_BYTES, stream, a); }
#endif
}
```
